# Optimizing an MI355X kernel written in HIP

```python
import jax, jax.numpy as jnp
from jax import lax
import numpy as np

D_MODEL = 1024
BATCH = 8
SEQ = 4096
DEPTH = 2

N_BRANCH = 4
BRANCH_W = D_MODEL // 4
FOURIER_GROUPS = 4
FOURIER_GW = BRANCH_W // FOURIER_GROUPS
CONV_WIDTH = 31
CONV_PAD = CONV_WIDTH // 2
LN_EPS = 1e-5
HEAD_DIM = 64
HEADS_PER_GROUP = BRANCH_W // HEAD_DIM
DILATED_CFG = ((128, 1), (512, 4), (2048, 16))
N_ATT_GROUPS = len(DILATED_CFG)
ATT_QKV_W = N_ATT_GROUPS * HEADS_PER_GROUP * HEAD_DIM
ROPE_THETA = 10000.0
NEG_BIG = -1e30
POOL_SIZES = (2, 4, 8, 16)
POOL_GROUPS = len(POOL_SIZES)
POOL_GW = BRANCH_W // POOL_GROUPS
NORM_EPS = 1e-6

IN_A = BRANCH_W
IN_B = 2 * BRANCH_W
IN_C = 3 * ATT_QKV_W
IN_D = BRANCH_W
IN_VALUE = IN_A + IN_B + IN_C + IN_D
D_IN = IN_VALUE + N_BRANCH * BRANCH_W
SPLIT_POINTS = (IN_A, IN_A + IN_B, IN_A + IN_B + IN_C, IN_VALUE)

kernel_name = "hybrid_parallel_gated_mixer_encoder"


def rms_norm(x, g):
    xf = x.astype(jnp.float32)
    y = xf * lax.rsqrt(jnp.mean(xf * xf, axis=-1, keepdims=True) + NORM_EPS)
    return (y * g.astype(jnp.float32)).astype(x.dtype)


def layer_norm(x, g, b):
    xf = x.astype(jnp.float32)
    mu = jnp.mean(xf, axis=-1, keepdims=True)
    var = jnp.mean(jnp.square(xf - mu), axis=-1, keepdims=True)
    y = (xf - mu) * lax.rsqrt(var + LN_EPS)
    return (y * g.astype(jnp.float32) + b.astype(jnp.float32)).astype(x.dtype)


def rope_tables(seq):
    inv = 1.0 / (ROPE_THETA ** (jnp.arange(0, HEAD_DIM, 2, dtype=jnp.float32) / HEAD_DIM))
    ang = jnp.arange(seq, dtype=jnp.float32)[:, None] * inv[None, :]
    return jnp.cos(ang), jnp.sin(ang)


def apply_rope(t, cos, sin):
    half = t.shape[-1] // 2
    t1 = t[..., :half].astype(jnp.float32)
    t2 = t[..., half:].astype(jnp.float32)
    c = cos[None, :, None, :]
    s = sin[None, :, None, :]
    return jnp.concatenate([t1 * c - t2 * s, t2 * c + t1 * s], axis=-1).astype(t.dtype)


def fourier_mix(u, w_lin):
    B, S, _ = u.shape
    ug = u.astype(jnp.float32).reshape(B, S, FOURIER_GROUPS, FOURIER_GW)
    f = jnp.fft.fft2(ug, axes=(1, 3), norm="ortho").real
    f = f.astype(u.dtype).reshape(B, S, BRANCH_W)
    return f @ w_lin


def conformer_conv(u2, conv_w, conv_b, ln_g, ln_b, w_pw):
    a, g = jnp.split(u2, 2, axis=-1)
    u = a * jax.nn.sigmoid(g)
    y = lax.conv_general_dilated(
        u, conv_w.astype(u.dtype)[:, None, :], window_strides=(1,),
        padding=[(CONV_PAD, CONV_PAD)], dimension_numbers=("NWC", "WIO", "NWC"),
        feature_group_count=BRANCH_W) + conv_b
    y = jax.nn.silu(layer_norm(y, ln_g, ln_b))
    return y @ w_pw


def band_attention(q, k, v, half):
    N, L, H, dh = q.shape
    blk = half
    nb = -(-L // blk)
    Lp = nb * blk
    pad = Lp - L
    q = jnp.pad(q, ((0, 0), (0, pad), (0, 0), (0, 0)))
    k = jnp.pad(k, ((0, 0), (blk, pad + blk), (0, 0), (0, 0)))
    v = jnp.pad(v, ((0, 0), (blk, pad + blk), (0, 0), (0, 0)))
    qb = q.reshape(N, nb, blk, H, dh)
    kb = k.reshape(N, nb + 2, blk, H, dh)
    vb = v.reshape(N, nb + 2, blk, H, dh)
    kw = jnp.concatenate([kb[:, :-2], kb[:, 1:-1], kb[:, 2:]], axis=2)
    vw = jnp.concatenate([vb[:, :-2], vb[:, 1:-1], vb[:, 2:]], axis=2)
    s = jnp.einsum("nbqhd,nbkhd->nbhqk", qb, kw).astype(jnp.float32) * (HEAD_DIM ** -0.5)
    qi = jnp.arange(nb)[:, None, None] * blk + jnp.arange(blk)[None, :, None]
    kj = (jnp.arange(nb)[:, None, None] - 1) * blk + jnp.arange(3 * blk)[None, None, :]
    valid = (jnp.abs(qi - kj) <= half) & (kj >= 0) & (kj < L)
    s = jnp.where(valid[None, :, None], s, NEG_BIG)
    m = jnp.max(s, axis=-1, keepdims=True)
    p = jnp.exp(s - m)
    den = jnp.sum(p, axis=-1, keepdims=True)
    o = jnp.einsum("nbhqk,nbkhd->nbqhd", (p / den).astype(v.dtype), vw)
    lse = (m + jnp.log(den))[..., 0]
    o = o.reshape(N, Lp, H, dh)[:, :L]
    lse = lse.transpose(0, 1, 3, 2).reshape(N, Lp, H)[:, :L]
    return o, lse


def dilated_window_attention(q, k, v, dil, half):
    B, S, H, dh = q.shape
    L = S // dil

    def to_res(t):
        return t.reshape(B, L, dil, H, dh).transpose(0, 2, 1, 3, 4).reshape(B * dil, L, H, dh)

    o, lse = band_attention(to_res(q), to_res(k), to_res(v), half)
    o = o.reshape(B, dil, L, H, dh).transpose(0, 2, 1, 3, 4).reshape(B, S, H, dh)
    lse = lse.reshape(B, dil, L, H).transpose(0, 2, 1, 3).reshape(B, S, H)
    return o, lse


def dilated_mixture(qkv, cos, sin):
    B, S, _ = qkv.shape
    qkv = qkv.reshape(B, S, 3, N_ATT_GROUPS * HEADS_PER_GROUP, HEAD_DIM)
    q = apply_rope(qkv[:, :, 0], cos, sin).reshape(B, S, N_ATT_GROUPS, HEADS_PER_GROUP, HEAD_DIM)
    k = apply_rope(qkv[:, :, 1], cos, sin).reshape(B, S, N_ATT_GROUPS, HEADS_PER_GROUP, HEAD_DIM)
    v = qkv[:, :, 2].reshape(B, S, N_ATT_GROUPS, HEADS_PER_GROUP, HEAD_DIM)
    outs, lses = [], []
    for g, (window, dil) in enumerate(DILATED_CFG):
        o, l = dilated_window_attention(q[:, :, g], k[:, :, g], v[:, :, g], dil, window // (2 * dil))
        outs.append(o)
        lses.append(l)
    alpha = jax.nn.softmax(jnp.stack(lses, axis=0), axis=0)
    out = outs[0] * alpha[0][..., None].astype(outs[0].dtype)
    for g in range(1, N_ATT_GROUPS):
        out = out + outs[g] * alpha[g][..., None].astype(outs[g].dtype)
    return out.reshape(B, S, BRANCH_W)


def multiscale_pool(u, w_pool, pool_scale):
    B, S, _ = u.shape
    ug = u.astype(jnp.float32).reshape(B, S, POOL_GROUPS, POOL_GW)
    c = lax.cumsum(ug, axis=1)
    c = jnp.pad(c, ((0, 0), (1, 0), (0, 0), (0, 0)))
    pos = jnp.arange(S)
    outs = []
    for gi, size in enumerate(POOL_SIZES):
        lo = jnp.clip(pos - size // 2, 0, S - 1)
        hi = jnp.clip(pos + size - 1 - size // 2, 0, S - 1)
        cg = c[:, :, gi]
        win_sum = cg[:, hi + 1] - cg[:, lo]
        cnt = (hi - lo + 1).astype(jnp.float32)[None, :, None]
        outs.append(win_sum / cnt - ug[:, :, gi])
    pooled = jnp.stack(outs, axis=2).astype(u.dtype)
    y = jnp.einsum("bsgc,gcd->bsgd", pooled, w_pool).reshape(B, S, BRANCH_W)
    return y * pool_scale


def hybrid_layer(x, cos, sin, norm_g, w_in, w_fourier, conv_w, conv_b, conv_ln_g, conv_ln_b,
                 w_pw, w_pool, pool_scale, w_branch, w_gate, b_gate, w_out):
    B, S, _ = x.shape
    h = rms_norm(x, norm_g)
    z = h @ w_in
    u_a, u_b, u_c, u_d, u_gate = jnp.split(z, SPLIT_POINTS, axis=-1)
    gate_paths = jax.nn.silu(u_gate).reshape(B, S, N_BRANCH, BRANCH_W)
    branch_outs = (
        fourier_mix(u_a, w_fourier),
        conformer_conv(u_b, conv_w, conv_b, conv_ln_g, conv_ln_b, w_pw),
        dilated_mixture(u_c, cos, sin),
        multiscale_pool(u_d, w_pool, pool_scale),
    )
    merged = None
    for n, y in enumerate(branch_outs):
        y_n = (y * gate_paths[:, :, n]) @ w_branch[n]
        mg = jax.nn.sigmoid(h @ w_gate[n] + b_gate[n])
        merged = mg * y_n if merged is None else merged + mg * y_n
    return x + merged @ w_out


def setup_inputs(seed: int = 0) -> dict:
    key = jax.random.key(seed)
    ks = jax.random.split(key, 16)
    f32 = jnp.float32

    def nrm(k, shape, fan_in):
        return jax.random.normal(k, shape, f32) * (fan_in ** -0.5)

    return {
        "x": jax.random.normal(ks[0], (BATCH, SEQ, D_MODEL), f32),
        "norm_g": 1.0 + 0.05 * jax.random.normal(ks[1], (DEPTH, D_MODEL), f32),
        "w_in": nrm(ks[2], (DEPTH, D_MODEL, D_IN), D_MODEL),
        "w_fourier": nrm(ks[3], (DEPTH, BRANCH_W, BRANCH_W), BRANCH_W),
        "conv_w": nrm(ks[4], (DEPTH, CONV_WIDTH, BRANCH_W), CONV_WIDTH),
        "conv_b": 0.02 * jax.random.normal(ks[5], (DEPTH, BRANCH_W), f32),
        "conv_ln_g": 1.0 + 0.05 * jax.random.normal(ks[6], (DEPTH, BRANCH_W), f32),
        "conv_ln_b": 0.02 * jax.random.normal(ks[7], (DEPTH, BRANCH_W), f32),
        "w_pw": nrm(ks[8], (DEPTH, BRANCH_W, BRANCH_W), BRANCH_W),
        "w_pool": nrm(ks[9], (DEPTH, POOL_GROUPS, POOL_GW, POOL_GW), POOL_GW),
        "pool_scale": 1.0 + 0.1 * jax.random.normal(ks[10], (DEPTH, BRANCH_W), f32),
        "w_branch": nrm(ks[11], (DEPTH, N_BRANCH, BRANCH_W, D_MODEL), BRANCH_W),
        "w_gate": nrm(ks[12], (DEPTH, N_BRANCH, D_MODEL, D_MODEL), D_MODEL),
        "b_gate": 0.1 * jax.random.normal(ks[13], (DEPTH, N_BRANCH, D_MODEL), f32),
        "w_out": nrm(ks[14], (DEPTH, D_MODEL, D_MODEL), D_MODEL),
        "final_g": 1.0 + 0.05 * jax.random.normal(ks[15], (D_MODEL,), f32),
    }


def reference(x, norm_g, w_in, w_fourier, conv_w, conv_b, conv_ln_g, conv_ln_b, w_pw,
              w_pool, pool_scale, w_branch, w_gate, b_gate, w_out, final_g):
    cos, sin = rope_tables(x.shape[1])
    for l in range(DEPTH):
        x = hybrid_layer(x, cos, sin, norm_g[l], w_in[l], w_fourier[l], conv_w[l], conv_b[l],
                         conv_ln_g[l], conv_ln_b[l], w_pw[l], w_pool[l], pool_scale[l],
                         w_branch[l], w_gate[l], b_gate[l], w_out[l])
    return rms_norm(x, final_g)
```

```cpp
#include <hip/hip_runtime.h>
#include <hip/hip_cooperative_groups.h>
#include <cstdio>
#include <cstdint>
namespace cg = cooperative_groups;

#ifndef ONE_LAUNCH
#define ONE_LAUNCH 1
#endif

typedef unsigned short bf16_t;
typedef short bf16x8 __attribute__((ext_vector_type(8)));
typedef float f32x4 __attribute__((ext_vector_type(4)));
typedef unsigned u32x4 __attribute__((ext_vector_type(4)));

constexpr int NB = 8, SEQ = 4096, DM = 1024, MT = NB * SEQ, DIN = 4352, DEPTH = 2;
constexpr int ZA = 0, ZB = 256, ZQ = 768, ZK = 1536, ZV = 2304, ZD = 3072, ZG = 3328;
constexpr int NTHREADS = 512, NWAVES = 8;
constexpr int LDS_BYTES = 147456;

constexpr size_t WS_CTL = 0;
constexpr size_t WS_WIN = 65536;
constexpr size_t WS_WG = WS_WIN + (size_t)DEPTH * DIN * DM * 2;
constexpr size_t WS_WB = WS_WG + (size_t)DEPTH * 4096 * DM * 2;
constexpr size_t WS_WO = WS_WB + (size_t)DEPTH * 4 * 1024 * 256 * 2;
constexpr size_t WS_TW = WS_WO + (size_t)DEPTH * DM * DM * 2;
constexpr size_t WS_RC = WS_TW + 4096 * 8;
constexpr size_t WS_RS = WS_RC + 4096 * 32 * 4;
constexpr size_t WS_H = WS_RS + 4096 * 32 * 4;
constexpr size_t WS_Z = WS_H + (size_t)MT * DM * 2;
constexpr size_t WS_P = WS_Z + (size_t)MT * DIN * 2;
constexpr size_t WS_FY = WS_P + (size_t)MT * DM * 2;
constexpr size_t WS_LSE = WS_FY + (size_t)NB * 4 * 64 * 64 * 64 * 4;
constexpr size_t WS_END = WS_LSE + (size_t)3 * MT * 4 * 4;

struct Args { const float* in[16]; float* out; unsigned char* ws; int ph_lo, ph_hi; };

__device__ __forceinline__ float bf2f(bf16_t v) { return __uint_as_float((unsigned)v << 16); }
__device__ __forceinline__ float bflo(unsigned w) { return __uint_as_float(w << 16); }
__device__ __forceinline__ float bfhi(unsigned w) { return __uint_as_float(w & 0xffff0000u); }
__device__ __forceinline__ bf16_t f2bf(float f) { unsigned u = __float_as_uint(f); u += 0x7fffu + ((u >> 16) & 1u); return (bf16_t)(u >> 16); }
__device__ __forceinline__ unsigned pk2(float lo, float hi) { return (unsigned)f2bf(lo) | ((unsigned)f2bf(hi) << 16); }
__device__ __forceinline__ float sigmoidf_(float x) { return 1.f / (1.f + __expf(-x)); }
__device__ __forceinline__ float siluf_(float x) { return x / (1.f + __expf(-x)); }
__device__ __forceinline__ int opq(int v) { asm volatile("" : "+v"(v)); return v; }
#define TIDX opq((int)threadIdx.x)
__device__ __forceinline__ float wave_sum(float v) {
#pragma unroll
    for (int o = 1; o < 64; o <<= 1) v += __shfl_xor(v, o);
    return v;
}

struct Ctx {
    const float *x, *norm_g, *w_in, *w_fourier, *conv_w, *conv_b, *conv_ln_g, *conv_ln_b, *w_pw, *w_pool, *pool_scale, *w_branch, *w_gate, *b_gate, *w_out, *final_g;
    float* out;
    bf16_t *WinT, *WgT, *WbT, *WoT, *H, *Z, *P;
    float2* TW; float *RC, *RS, *LSE; unsigned* FY;
};

__device__ __forceinline__ void transpose_mat(const float* W, int K, int N, bf16_t* WT, float* scr) {
    const int t = TIDX, nkb = K / 64, nnb = N / 64;
    for (int item = blockIdx.x; item < nkb * nnb; item += gridDim.x) {
        const int kb = item / nnb, nb = item % nnb;
#pragma unroll
        for (int i = 0; i < 8; ++i) { const int kk = (t >> 6) + 8 * i, nn = t & 63; scr[kk * 65 + nn] = W[(size_t)(kb * 64 + kk) * N + nb * 64 + nn]; }
        __syncthreads();
#pragma unroll
        for (int i = 0; i < 8; ++i) { const int nn = (t >> 6) + 8 * i, kk = t & 63; WT[(size_t)(nb * 64 + nn) * K + kb * 64 + kk] = f2bf(scr[kk * 65 + nn]); }
        __syncthreads();
    }
}
__device__ __forceinline__ void phase_pre(const Ctx& c, float* lds) {
    for (int l = 0; l < DEPTH; ++l) {
        transpose_mat(c.w_in + (size_t)l * DM * DIN, DM, DIN, c.WinT + (size_t)l * DIN * DM, lds);
        for (int n = 0; n < 4; ++n) {
            transpose_mat(c.w_gate + (size_t)(l * 4 + n) * DM * DM, DM, DM, c.WgT + ((size_t)l * 4096 + n * 1024) * DM, lds);
            transpose_mat(c.w_branch + (size_t)(l * 4 + n) * 256 * DM, 256, DM, c.WbT + (size_t)(l * 4 + n) * 1024 * 256, lds);
        }
        transpose_mat(c.w_out + (size_t)l * DM * DM, DM, DM, c.WoT + (size_t)l * DM * DM, lds);
    }
    const int gt = blockIdx.x * NTHREADS + TIDX, NT = gridDim.x * NTHREADS;
    for (int i = gt; i < 4096; i += NT) { float s, co; sincospif((float)i / 2048.f, &s, &co); c.TW[i] = make_float2(co, s); }
    for (int i = gt; i < 4096 * 32; i += NT) {
        const int pos = i >> 5, k = i & 31;
        const double inv = exp2(-(double)k * (13.287712379549449 / 32.0));
        double tq = (double)pos * inv * 0.3183098861837907;
        tq -= 2.0 * rint(tq * 0.5);
        float s, co; sincospif((float)tq, &s, &co);
        c.RC[i] = co; c.RS[i] = s;
    }
}

__device__ __forceinline__ void phase_norm_bf16(const float* xin, const float* g, bf16_t* H) {
    const int tid_ = TIDX; const int lane = tid_ & 63, wave = tid_ >> 6;
    const int gw = blockIdx.x * NWAVES + wave, NGW = gridDim.x * NWAVES;
    f32x4 gv[4];
#pragma unroll
    for (int j = 0; j < 4; ++j) gv[j] = *(const f32x4*)(g + 4 * (lane + 64 * j));
    for (int m = gw; m < MT; m += NGW) {
        const f32x4* xr = (const f32x4*)(xin + (size_t)m * DM);
        f32x4 v[4]; float s = 0.f;
#pragma unroll
        for (int j = 0; j < 4; ++j) { v[j] = xr[lane + 64 * j]; s += v[j].x * v[j].x + v[j].y * v[j].y + v[j].z * v[j].z + v[j].w * v[j].w; }
        const float rstd = 1.0f / sqrtf(wave_sum(s) * (1.f / DM) + 1e-6f);
        uint2* o = (uint2*)(H + (size_t)m * DM);
#pragma unroll
        for (int j = 0; j < 4; ++j) { const f32x4 y = v[j] * rstd * gv[j]; o[lane + 64 * j] = make_uint2(pk2(y.x, y.y), pk2(y.z, y.w)); }
    }
}
__device__ __forceinline__ void phase_norm_final(float* xio, const float* g) {
    const int tid_ = TIDX; const int lane = tid_ & 63, wave = tid_ >> 6;
    const int gw = blockIdx.x * NWAVES + wave, NGW = gridDim.x * NWAVES;
    f32x4 gv[4];
#pragma unroll
    for (int j = 0; j < 4; ++j) gv[j] = *(const f32x4*)(g + 4 * (lane + 64 * j));
    for (int m = gw; m < MT; m += NGW) {
        f32x4* xr = (f32x4*)(xio + (size_t)m * DM);
        f32x4 v[4]; float s = 0.f;
#pragma unroll
        for (int j = 0; j < 4; ++j) { v[j] = xr[lane + 64 * j]; s += v[j].x * v[j].x + v[j].y * v[j].y + v[j].z * v[j].z + v[j].w * v[j].w; }
        const float rstd = 1.0f / sqrtf(wave_sum(s) * (1.f / DM) + 1e-6f);
#pragma unroll
        for (int j = 0; j < 4; ++j) xr[lane + 64 * j] = v[j] * rstd * gv[j];
    }
}

template <class Epi>
__device__ __forceinline__ void gemm_simple(const bf16_t* A, int lda, const bf16_t* Bt, int ldb, int Mr, int N, int K, const Epi& epi) {
    const int tid_ = TIDX; const int wid = tid_ >> 6, lane = tid_ & 63, fr = lane & 15, fq = lane >> 4;
    const int nM = Mr / 128, nN = N / 64;
    for (int u = blockIdx.x; u < nM * nN; u += gridDim.x) {
        const int pm = u / nN, pn = u % nN;
        const bf16_t* ap = A + (size_t)(pm * 128 + wid * 16 + fr) * lda + fq * 8;
        const bf16_t* bp = Bt + (size_t)(pn * 64 + fr) * ldb + fq * 8;
        f32x4 acc[4];
#pragma unroll
        for (int n = 0; n < 4; ++n) acc[n] = (f32x4){0.f, 0.f, 0.f, 0.f};
        for (int k0 = 0; k0 < K; k0 += 32) {
            const bf16x8 a = *(const bf16x8*)(ap + k0);
#pragma unroll
            for (int n = 0; n < 4; ++n) { const bf16x8 b = *(const bf16x8*)(bp + (size_t)n * 16 * ldb + k0); acc[n] = __builtin_amdgcn_mfma_f32_16x16x32_bf16(a, b, acc[n], 0, 0, 0); }
        }
#pragma unroll
        for (int n = 0; n < 4; ++n)
#pragma unroll
            for (int j = 0; j < 4; ++j) epi(pm * 128 + wid * 16 + fq * 4 + j, pn * 64 + n * 16 + fr, acc[n][j]);
    }
}
struct EpiZ { bf16_t* Z; __device__ __forceinline__ void operator()(int r, int c, float v) const { Z[(size_t)r * DIN + c] = f2bf(v); } };
struct EpiGate { bf16_t* MG; const float* bg; __device__ __forceinline__ void operator()(int r, int c, float v) const { MG[(size_t)r * 4096 + c] = f2bf(sigmoidf_(v + bg[c])); } };
struct EpiOut { const float* xin; float* out; __device__ __forceinline__ void operator()(int r, int c, float v) const { const size_t i = (size_t)r * DM + c; out[i] = xin[i] + v; } };

__device__ __forceinline__ void gemm_merge(const bf16_t* P, const bf16_t* WbT, const bf16_t* MG, bf16_t* MERGED) {
    const int tid_ = TIDX; const int wid = tid_ >> 6, lane = tid_ & 63, fr = lane & 15, fq = lane >> 4;
    const int nM = MT / 128, nN = DM / 64;
    for (int u = blockIdx.x; u < nM * nN; u += gridDim.x) {
        const int pm = u / nN, pn = u % nN;
        f32x4 tot[4];
#pragma unroll
        for (int n = 0; n < 4; ++n) tot[n] = (f32x4){0.f, 0.f, 0.f, 0.f};
        for (int n4 = 0; n4 < 4; ++n4) {
            const bf16_t* ap = P + (size_t)(pm * 128 + wid * 16 + fr) * DM + n4 * 256 + fq * 8;
            const bf16_t* bp = WbT + (size_t)n4 * 1024 * 256 + (size_t)(pn * 64 + fr) * 256 + fq * 8;
            f32x4 acc[4];
#pragma unroll
            for (int n = 0; n < 4; ++n) acc[n] = (f32x4){0.f, 0.f, 0.f, 0.f};
            for (int k0 = 0; k0 < 256; k0 += 32) {
                const bf16x8 a = *(const bf16x8*)(ap + k0);
#pragma unroll
                for (int n = 0; n < 4; ++n) { const bf16x8 b = *(const bf16x8*)(bp + (size_t)n * 16 * 256 + k0); acc[n] = __builtin_amdgcn_mfma_f32_16x16x32_bf16(a, b, acc[n], 0, 0, 0); }
            }
#pragma unroll
            for (int n = 0; n < 4; ++n)
#pragma unroll
                for (int j = 0; j < 4; ++j) { const int r = pm * 128 + wid * 16 + fq * 4 + j, cc = pn * 64 + n * 16 + fr; tot[n][j] += bf2f(MG[(size_t)r * 4096 + n4 * 1024 + cc]) * acc[n][j]; }
        }
#pragma unroll
        for (int n = 0; n < 4; ++n)
#pragma unroll
            for (int j = 0; j < 4; ++j) { const int r = pm * 128 + wid * 16 + fq * 4 + j, cc = pn * 64 + n * 16 + fr; MERGED[(size_t)r * DM + cc] = f2bf(tot[n][j]); }
    }
}

__device__ __forceinline__ void fft1_unit(const Ctx& c, int u, float* lds) {
    const int t = TIDX, s2 = u & 63, bg = u >> 6, g = bg & 3, b = bg >> 2;
    float* U = lds; float* Wre = lds + 64 * 65; float* Wim = Wre + 4096; float* cs = Wim + 4096; float* sn = cs + 64;
    if (t < 64) { float s, co; sincospif((float)t / 32.f, &s, &co); cs[t] = co; sn[t] = s; }
#pragma unroll
    for (int i = 0; i < 8; ++i) { const int s1 = (t >> 6) + 8 * i, ci = t & 63; U[s1 * 65 + ci] = bf2f(c.Z[(size_t)(b * SEQ + 64 * s1 + s2) * DIN + ZA + 64 * g + ci]); }
    __syncthreads();
    const int cp = t & 63;
#pragma unroll 1
    for (int i = 0; i < 8; ++i) {
        const int s1 = (t >> 6) + 8 * i; float re = 0.f, im = 0.f;
        for (int ci = 0; ci < 64; ++ci) { const float x = U[s1 * 65 + ci]; const int e = (ci * cp) & 63; re += x * cs[e]; im -= x * sn[e]; }
        Wre[s1 * 64 + cp] = re; Wim[s1 * 64 + cp] = im;
    }
    __syncthreads();
#pragma unroll 1
    for (int i = 0; i < 8; ++i) {
        const int k1 = (t >> 6) + 8 * i; float yr = 0.f, yi = 0.f;
        for (int s1 = 0; s1 < 64; ++s1) { const int e = (k1 * s1) & 63; const float co = cs[e], si = sn[e], wr = Wre[s1 * 64 + cp], wi = Wim[s1 * 64 + cp]; yr += co * wr + si * wi; yi += co * wi - si * wr; }
        const float2 tw = c.TW[(k1 * s2) & 4095];
        const float zr = yr * tw.x + yi * tw.y, zi = yi * tw.x - yr * tw.y;
        c.FY[((size_t)(bg * 64 + k1) * 64 + s2) * 64 + cp] = pk2(zr, zi);
    }
    __syncthreads();
}

__device__ __forceinline__ void tok_unit(const Ctx& c, int l, int u, float* lds) {
    const int t = TIDX, lane = t & 63, wave = t >> 6, ch = t & 255, half = t >> 8;
    const int b = u >> 6, s0 = (u & 63) * 64, tok0 = b * SEQ + s0;
    float* A = lds;
#pragma unroll 1
    for (int i = 0; i < 47; ++i) {
        const int r = half + 2 * i, s = s0 - 15 + r; float val = 0.f;
        if (s >= 0 && s < SEQ) { const bf16_t* zr = c.Z + (size_t)(b * SEQ + s) * DIN + ZB; val = bf2f(zr[ch]) * sigmoidf_(bf2f(zr[256 + ch])); }
        A[r * 256 + ch] = val;
    }
    __syncthreads();
    float y[32];
    {
        float cw[31];
#pragma unroll
        for (int w = 0; w < 31; ++w) cw[w] = c.conv_w[(size_t)l * 31 * 256 + w * 256 + ch];
        const float cb = c.conv_b[l * 256 + ch];
#pragma unroll
        for (int cc = 0; cc < 4; ++cc) {
            float rows[38];
#pragma unroll
            for (int r = 0; r < 38; ++r) rows[r] = A[(half * 32 + cc * 8 + r) * 256 + ch];
#pragma unroll
            for (int i = 0; i < 8; ++i) {
                float acc = cb;
#pragma unroll
                for (int w = 0; w < 31; ++w) acc += rows[i + w] * cw[w];
                y[cc * 8 + i] = acc;
            }
            __builtin_amdgcn_sched_barrier(0);
        }
    }
    __syncthreads();
#pragma unroll
    for (int i = 0; i < 32; ++i) A[(half * 32 + i) * 256 + ch] = y[i];
    __syncthreads();
    {
        float lg[4], lb[4];
#pragma unroll
        for (int q = 0; q < 4; ++q) { lg[q] = c.conv_ln_g[l * 256 + lane + 64 * q]; lb[q] = c.conv_ln_b[l * 256 + lane + 64 * q]; }
        for (int i = 0; i < 8; ++i) {
            const int tk = wave * 8 + i; float xv[4]; float s = 0.f;
#pragma unroll
            for (int q = 0; q < 4; ++q) { xv[q] = A[tk * 256 + lane + 64 * q]; s += xv[q]; }
            const float mean = wave_sum(s) * (1.f / 256.f); float s2 = 0.f;
#pragma unroll
            for (int q = 0; q < 4; ++q) { xv[q] -= mean; s2 += xv[q] * xv[q]; }
            const float rstd = 1.0f / sqrtf(wave_sum(s2) * (1.f / 256.f) + 1e-5f);
#pragma unroll
            for (int q = 0; q < 4; ++q) { const float yv = xv[q] * rstd * lg[q] + lb[q]; A[tk * 256 + lane + 64 * q] = siluf_(yv); }
        }
    }
    __syncthreads();
    {
        float acc[32];
#pragma unroll
        for (int i = 0; i < 32; ++i) acc[i] = 0.f;
        const float* W = c.w_pw + (size_t)l * 65536;
#pragma unroll 2
        for (int k = 0; k < 256; ++k) {
            const float wv = W[k * 256 + ch];
#pragma unroll
            for (int i = 0; i < 32; ++i) acc[i] += A[(half * 32 + i) * 256 + k] * wv;
        }
        __syncthreads();
#pragma unroll
        for (int i = 0; i < 32; ++i) A[(half * 32 + i) * 256 + ch] = acc[i];
        __syncthreads();
#pragma unroll 1
        for (int i = 0; i < 32; ++i) {
            const size_t tok = tok0 + half * 32 + i;
            const float gp = bf2f(c.Z[tok * DIN + ZG + 256 + ch]);
            c.P[tok * DM + 256 + ch] = f2bf(A[(half * 32 + i) * 256 + ch] * siluf_(gp));
        }
    }
    __syncthreads();
#pragma unroll 1
    for (int i = 0; i < 40; ++i) {
        const int r = half + 2 * i;
        if (r < 79) { const int s = s0 - 8 + r; float val = 0.f; if (s >= 0 && s < SEQ) val = bf2f(c.Z[(size_t)(b * SEQ + s) * DIN + ZD + ch]); A[r * 256 + ch] = val; }
    }
    __syncthreads();
    float* PL = lds + 79 * 256;
    {
        const int gi = ch >> 6, sz = 2 << gi;
#pragma unroll 1
        for (int i = 0; i < 32; ++i) {
            const int tk = half * 32 + i, s = s0 + tk;
            int lo = s - sz / 2; if (lo < 0) lo = 0;
            int hi = s + sz - 1 - sz / 2; if (hi > SEQ - 1) hi = SEQ - 1;
            float sum = 0.f;
            for (int p = lo; p <= hi; ++p) sum += A[(p - s0 + 8) * 256 + ch];
            PL[tk * 256 + ch] = sum / (float)(hi - lo + 1) - A[(tk + 8) * 256 + ch];
        }
    }
    __syncthreads();
    {
        const int gi = ch >> 6, dd = ch & 63;
        float acc[32];
#pragma unroll
        for (int i = 0; i < 32; ++i) acc[i] = 0.f;
        const float* W = c.w_pool + (size_t)(l * 4 + gi) * 4096;
#pragma unroll 2
        for (int k = 0; k < 64; ++k) {
            const float wv = W[k * 64 + dd];
#pragma unroll
            for (int i = 0; i < 32; ++i) acc[i] += PL[(half * 32 + i) * 256 + gi * 64 + k] * wv;
        }
        const float ps = c.pool_scale[l * 256 + ch];
        __syncthreads();
#pragma unroll
        for (int i = 0; i < 32; ++i) A[(half * 32 + i) * 256 + ch] = acc[i];
        __syncthreads();
#pragma unroll 1
        for (int i = 0; i < 32; ++i) {
            const size_t tok = tok0 + half * 32 + i;
            const float gp = bf2f(c.Z[tok * DIN + ZG + 768 + ch]);
            c.P[tok * DM + 768 + ch] = f2bf(A[(half * 32 + i) * 256 + ch] * ps * siluf_(gp));
        }
    }
    __syncthreads();
}

__device__ __forceinline__ void attn_unit(const Ctx& c, int u, float* ldsf) {
    unsigned* lds = (unsigned*)ldsf;
    const int t = TIDX;
    const int b = u / 192, rem = u % 192, g = rem >> 6, rem2 = rem & 63, hI = rem2 >> 4, rq = rem2 & 15;
    const int d = 1 << (2 * g), L = SEQ / d, nqb = L / 256, r = rq / nqb, qb = rq % nqb, hh = g * 4 + hI, i0 = qb * 256;
    unsigned* Kt = lds; unsigned* Vt = lds + 384 * 33;
    for (int pass = 0; pass < 2; ++pass) {
        const int jl = pass * 256 + (t >> 1), hf = t & 1, j = i0 - 64 + jl;
        if (jl < 384 && j >= 0 && j < L) {
            const int pos = r + d * j; const size_t tok = (size_t)b * SEQ + pos;
            const u32x4* kr = (const u32x4*)(c.Z + tok * DIN + ZK + hh * 64);
            unsigned kw[32];
#pragma unroll
            for (int q = 0; q < 8; ++q) { const u32x4 v = kr[q]; kw[4 * q] = v.x; kw[4 * q + 1] = v.y; kw[4 * q + 2] = v.z; kw[4 * q + 3] = v.w; }
            const float* rc = c.RC + pos * 32; const float* rs = c.RS + pos * 32;
#pragma unroll
            for (int w = 0; w < 16; ++w) {
                const float lo0 = bflo(kw[w]), lo1 = bfhi(kw[w]), hi0 = bflo(kw[16 + w]), hi1 = bfhi(kw[16 + w]);
                const float c0 = rc[2 * w], c1 = rc[2 * w + 1], s0 = rs[2 * w], s1 = rs[2 * w + 1];
                float o0, o1;
                if (hf == 0) { o0 = lo0 * c0 - hi0 * s0; o1 = lo1 * c1 - hi1 * s1; } else { o0 = hi0 * c0 + lo0 * s0; o1 = hi1 * c1 + lo1 * s1; }
                Kt[jl * 33 + hf * 16 + w] = pk2(o0, o1);
            }
            const u32x4* vr = (const u32x4*)(c.Z + tok * DIN + ZV + hh * 64 + hf * 32);
#pragma unroll
            for (int q = 0; q < 4; ++q) { const u32x4 v = vr[q]; Vt[jl * 33 + hf * 16 + 4 * q] = v.x; Vt[jl * 33 + hf * 16 + 4 * q + 1] = v.y; Vt[jl * 33 + hf * 16 + 4 * q + 2] = v.z; Vt[jl * 33 + hf * 16 + 4 * q + 3] = v.w; }
        }
    }
    const int ql = t >> 1, hf = t & 1, iq = i0 + ql, posq = r + d * iq;
    const size_t tokq = (size_t)b * SEQ + posq;
    bf16_t* qrow = c.Z + tokq * DIN + ZQ + hh * 64;
    float qv[32];
    {
        const u32x4* qr = (const u32x4*)qrow;
        unsigned kw[32];
#pragma unroll
        for (int q = 0; q < 8; ++q) { const u32x4 v = qr[q]; kw[4 * q] = v.x; kw[4 * q + 1] = v.y; kw[4 * q + 2] = v.z; kw[4 * q + 3] = v.w; }
        const float* rc = c.RC + posq * 32; const float* rs = c.RS + posq * 32;
#pragma unroll
        for (int w = 0; w < 16; ++w) {
            const float lo0 = bflo(kw[w]), lo1 = bfhi(kw[w]), hi0 = bflo(kw[16 + w]), hi1 = bfhi(kw[16 + w]);
            const float c0 = rc[2 * w], c1 = rc[2 * w + 1], s0 = rs[2 * w], s1 = rs[2 * w + 1];
            if (hf == 0) { qv[2 * w] = (lo0 * c0 - hi0 * s0) * 0.125f; qv[2 * w + 1] = (lo1 * c1 - hi1 * s1) * 0.125f; }
            else { qv[2 * w] = (hi0 * c0 + lo0 * s0) * 0.125f; qv[2 * w + 1] = (hi1 * c1 + lo1 * s1) * 0.125f; }
        }
    }
    __syncthreads();
    float m = -1e30f, lsum = 0.f, o[32];
#pragma unroll
    for (int w = 0; w < 32; ++w) o[w] = 0.f;
    for (int t2 = 0; t2 <= 128; ++t2) {
        const int j = iq - 64 + t2;
        if (j >= 0 && j < L) {
            const int jl = ql + t2;
            const unsigned* kp = Kt + jl * 33 + hf * 16;
            float sp = 0.f;
#pragma unroll
            for (int w = 0; w < 16; ++w) { const unsigned kwv = kp[w]; sp += qv[2 * w] * bflo(kwv) + qv[2 * w + 1] * bfhi(kwv); }
            const float s = sp + __shfl_xor(sp, 1);
            const float mn = fmaxf(m, s), corr = __expf(m - mn), p = __expf(s - mn);
            lsum = lsum * corr + p; m = mn;
            const unsigned* vp = Vt + jl * 33 + hf * 16;
#pragma unroll
            for (int w = 0; w < 16; ++w) { const unsigned vw = vp[w]; o[2 * w] = o[2 * w] * corr + p * bflo(vw); o[2 * w + 1] = o[2 * w + 1] * corr + p * bfhi(vw); }
        }
    }
    const float inv = 1.f / lsum;
    unsigned* orow = (unsigned*)(qrow + hf * 32);
#pragma unroll
    for (int w = 0; w < 16; ++w) orow[w] = pk2(o[2 * w] * inv, o[2 * w + 1] * inv);
    if (hf == 0) c.LSE[((size_t)g * MT + tokq) * 4 + hI] = m + __logf(lsum);
    __syncthreads();
}

__device__ __forceinline__ void fft2_unit(const Ctx& c, int l, int u, float* lds) {
    const int t = TIDX, b = u >> 6, k1 = u & 63, cp = t & 63;
    float* Ft = lds; float* Yre = lds + 64 * 260; float* Yim = Yre + 4096; float* cs = Yim + 4096; float* sn = cs + 64;
    if (t < 64) { float s, co; sincospif((float)t / 32.f, &s, &co); cs[t] = co; sn[t] = s; }
    for (int g = 0; g < 4; ++g) {
        const unsigned* src = c.FY + (size_t)((b * 4 + g) * 64 + k1) * 4096;
#pragma unroll
        for (int i = 0; i < 8; ++i) { const int idx = t + 512 * i; const unsigned w = src[idx]; Yre[idx] = bflo(w); Yim[idx] = bfhi(w); }
        __syncthreads();
#pragma unroll 1
        for (int i = 0; i < 8; ++i) {
            const int k2 = (t >> 6) + 8 * i; float acc = 0.f;
            for (int s2 = 0; s2 < 64; ++s2) { const int e = (k2 * s2) & 63; acc += cs[e] * Yre[s2 * 64 + cp] + sn[e] * Yim[s2 * 64 + cp]; }
            Ft[k2 * 260 + g * 64 + cp] = acc * (1.f / 512.f);
        }
        __syncthreads();
    }
    const int j = t & 255, half = t >> 8;
    float acc[32];
#pragma unroll
    for (int i = 0; i < 32; ++i) acc[i] = 0.f;
    const float* W = c.w_fourier + (size_t)l * 65536;
#pragma unroll 2
    for (int k = 0; k < 256; ++k) {
        const float wv = W[k * 256 + j];
#pragma unroll
        for (int i = 0; i < 32; ++i) acc[i] += Ft[(half * 32 + i) * 260 + k] * wv;
    }
    __syncthreads();
#pragma unroll
    for (int i = 0; i < 32; ++i) Ft[(half * 32 + i) * 260 + j] = acc[i];
    __syncthreads();
#pragma unroll 1
    for (int i = 0; i < 32; ++i) {
        const size_t tok = (size_t)b * SEQ + k1 + 64 * (half * 32 + i);
        const float gp = bf2f(c.Z[tok * DIN + ZG + j]);
        c.P[tok * DM + j] = f2bf(Ft[(half * 32 + i) * 260 + j] * siluf_(gp));
    }
    __syncthreads();
}

__device__ __forceinline__ void phase_combine(const Ctx& c) {
    const int gt = blockIdx.x * NTHREADS + TIDX, NT = gridDim.x * NTHREADS;
    for (int idx = gt; idx < MT * 32; idx += NT) {
        const size_t m = idx >> 5; const int c8 = (idx & 31) * 8, hI = c8 >> 6;
        const float l0 = c.LSE[((size_t)0 * MT + m) * 4 + hI], l1 = c.LSE[((size_t)1 * MT + m) * 4 + hI], l2 = c.LSE[((size_t)2 * MT + m) * 4 + hI];
        const float mx = fmaxf(l0, fmaxf(l1, l2));
        const float e0 = __expf(l0 - mx), e1 = __expf(l1 - mx), e2 = __expf(l2 - mx), inv = 1.f / (e0 + e1 + e2);
        const float a0 = e0 * inv, a1 = e1 * inv, a2 = e2 * inv;
        const bf16_t* zr = c.Z + m * DIN;
        const u32x4 o0 = *(const u32x4*)(zr + ZQ + (0 * 4 + hI) * 64 + (c8 & 63));
        const u32x4 o1 = *(const u32x4*)(zr + ZQ + (1 * 4 + hI) * 64 + (c8 & 63));
        const u32x4 o2 = *(const u32x4*)(zr + ZQ + (2 * 4 + hI) * 64 + (c8 & 63));
        const u32x4 gp = *(const u32x4*)(zr + ZG + 512 + c8);
        u32x4 res;
#pragma unroll
        for (int q = 0; q < 4; ++q) {
            const float vlo = (a0 * bflo(o0[q]) + a1 * bflo(o1[q]) + a2 * bflo(o2[q])) * siluf_(bflo(gp[q]));
            const float vhi = (a0 * bfhi(o0[q]) + a1 * bfhi(o1[q]) + a2 * bfhi(o2[q])) * siluf_(bfhi(gp[q]));
            res[q] = pk2(vlo, vhi);
        }
        *(u32x4*)(c.P + m * DM + 512 + c8) = res;
    }
}

constexpr int NPHASES = 1 + 7 * DEPTH;
__global__ void __launch_bounds__(NTHREADS) fwd_kernel(Args a) {
    extern __shared__ __attribute__((aligned(16))) unsigned char lds_raw[];
    float* lds = (float*)lds_raw;
    Ctx c;
    c.x = a.in[0]; c.norm_g = a.in[1]; c.w_in = a.in[2]; c.w_fourier = a.in[3]; c.conv_w = a.in[4]; c.conv_b = a.in[5]; c.conv_ln_g = a.in[6]; c.conv_ln_b = a.in[7];
    c.w_pw = a.in[8]; c.w_pool = a.in[9]; c.pool_scale = a.in[10]; c.w_branch = a.in[11]; c.w_gate = a.in[12]; c.b_gate = a.in[13]; c.w_out = a.in[14]; c.final_g = a.in[15];
    c.out = a.out;
    unsigned char* ws = a.ws;
    c.WinT = (bf16_t*)(ws + WS_WIN); c.WgT = (bf16_t*)(ws + WS_WG); c.WbT = (bf16_t*)(ws + WS_WB); c.WoT = (bf16_t*)(ws + WS_WO);
    c.TW = (float2*)(ws + WS_TW); c.RC = (float*)(ws + WS_RC); c.RS = (float*)(ws + WS_RS);
    c.H = (bf16_t*)(ws + WS_H); c.Z = (bf16_t*)(ws + WS_Z); c.P = (bf16_t*)(ws + WS_P); c.FY = (unsigned*)(ws + WS_FY); c.LSE = (float*)(ws + WS_LSE);

    for (int ph = a.ph_lo; ph < a.ph_hi; ++ph) {
        if (ph == 0) {
            phase_pre(c, lds);
            phase_norm_bf16(c.x, c.norm_g, c.H);
        } else {
            const int l = (ph - 1) / 7, q = (ph - 1) % 7;
            const float* xin = (l == 0) ? c.x : c.out;
            if (q == 0) {
                EpiZ e{c.Z};
                gemm_simple(c.H, DM, c.WinT + (size_t)l * DIN * DM, DM, MT, DIN, DM, e);
            } else if (q == 1) {
                constexpr int NF = NB * 4 * 64, NTK = NB * 64, NAT = NB * 192;
                for (int u = blockIdx.x; u < NAT; u += gridDim.x) attn_unit(c, u, lds);
                __builtin_amdgcn_sched_barrier(0);
                for (int u = blockIdx.x; u < NTK; u += gridDim.x) tok_unit(c, l, u, lds);
                __builtin_amdgcn_sched_barrier(0);
                for (int u = blockIdx.x; u < NF; u += gridDim.x) fft1_unit(c, u, lds);
            } else if (q == 2) {
                for (int u = blockIdx.x; u < NB * 64; u += gridDim.x) fft2_unit(c, l, u, lds);
                phase_combine(c);
            } else if (q == 3) {
                EpiGate e{c.Z, c.b_gate + (size_t)l * 4096};
                gemm_simple(c.H, DM, c.WgT + (size_t)l * 4096 * DM, DM, MT, 4096, DM, e);
            } else if (q == 4) {
                gemm_merge(c.P, c.WbT + (size_t)l * 4 * 1024 * 256, c.Z, c.H);
            } else if (q == 5) {
                EpiOut e{xin, c.out};
                gemm_simple(c.H, DM, c.WoT + (size_t)l * DM * DM, DM, MT, DM, DM, e);
            } else {
                if (l + 1 < DEPTH) phase_norm_bf16(c.out, c.norm_g + (size_t)(l + 1) * DM, c.H);
                else phase_norm_final(c.out, c.final_g);
            }
        }
        if (ph + 1 < a.ph_hi) cg::this_grid().sync();
    }
}

extern "C" void kernel_launch(void* const* d_in, const int* in_sizes, int n_in, void* d_out, int out_size, void* d_ws, size_t ws_size, hipStream_t stream) {
    static int grid = 0;
    if (grid == 0) {
        if (n_in != 16 || in_sizes[0] != MT * DM || out_size != MT * DM || ws_size < WS_END) {
            fprintf(stderr, "kernel_launch: unexpected shapes: n_in %d in0 %d out %d ws %zu (need %zu)\n", n_in, n_in > 0 ? in_sizes[0] : -1, out_size, ws_size, (size_t)WS_END);
            grid = -1; return;
        }
        int dev = 0, cus = 0, per_cu = 0;
        hipGetDevice(&dev); hipDeviceGetAttribute(&cus, hipDeviceAttributeMultiprocessorCount, dev);
        if (hipFuncSetAttribute((const void*)fwd_kernel, hipFuncAttributeMaxDynamicSharedMemorySize, LDS_BYTES) != hipSuccess) { fprintf(stderr, "kernel_launch: hipFuncSetAttribute failed\n"); grid = -1; return; }
        hipOccupancyMaxActiveBlocksPerMultiprocessor(&per_cu, (const void*)fwd_kernel, NTHREADS, LDS_BYTES);
        if (per_cu < 1) { fprintf(stderr, "kernel_launch: occupancy query says %d blocks/CU\n", per_cu); per_cu = 1; }
        (void)hipGetLastError();
        grid = cus;
    }
    if (grid < 0) return;
    Args a{};
    for (int i = 0; i < 16; ++i) a.in[i] = (const float*)d_in[i];
    a.out = (float*)d_out; a.ws = (unsigned char*)d_ws;
#if ONE_LAUNCH
    a.ph_lo = 0; a.ph_hi = NPHASES;
    void* args[] = {&a};
    hipError_t e = hipLaunchCooperativeKernel((const void*)fwd_kernel, dim3(grid), dim3(NTHREADS), args, LDS_BYTES, stream);
    if (e != hipSuccess) fprintf(stderr, "kernel_launch: cooperative launch failed: %s (grid %d)\n", hipGetErrorString(e), grid);
#else
    for (int ph = 0; ph < NPHASES; ++ph) {
        a.ph_lo = ph; a.ph_hi = ph + 1;
        hipLaunchKernelGGL(fwd_kernel, dim3(grid), dim3(NTHREADS), LDS_BYTES, stream, a);
    }
#endif
}
```

```cpp
#include <hip/hip_runtime.h>
#include <hip/hip_cooperative_groups.h>
#include <cstdio>
#include <cstdint>
namespace cg = cooperative_groups;

#ifndef ENG_MASK
#define ENG_MASK 15
#endif
#ifndef ONE_LAUNCH
#define ONE_LAUNCH 1
#endif

typedef unsigned short bf16_t;
typedef short bf16x8 __attribute__((ext_vector_type(8)));
typedef float f32x4 __attribute__((ext_vector_type(4)));
typedef unsigned u32x4 __attribute__((ext_vector_type(4)));

constexpr int NB = 8, SEQ = 4096, DM = 1024, MT = NB * SEQ, DIN = 4352, DEPTH = 2;
constexpr int ZA = 0, ZB = 256, ZQ = 768, ZK = 1536, ZV = 2304, ZD = 3072, ZG = 3328;
constexpr int NTHREADS = 512, NWAVES = 8;
constexpr int LDS_BYTES = 147456;

constexpr size_t WS_CTL = 0;
constexpr size_t WS_WIN = 65536;
constexpr size_t WS_WG = WS_WIN + (size_t)DEPTH * DIN * DM * 2;
constexpr size_t WS_WB = WS_WG + (size_t)DEPTH * 4096 * DM * 2;
constexpr size_t WS_WO = WS_WB + (size_t)DEPTH * 4 * 1024 * 256 * 2;
constexpr size_t WS_TW = WS_WO + (size_t)DEPTH * DM * DM * 2;
constexpr size_t WS_RC = WS_TW + 4096 * 8;
constexpr size_t WS_RS = WS_RC + 4096 * 32 * 4;
constexpr size_t WS_H = WS_RS + 4096 * 32 * 4;
constexpr size_t WS_Z = WS_H + (size_t)MT * DM * 2;
constexpr size_t WS_P = WS_Z + (size_t)MT * DIN * 2;
constexpr size_t WS_FY = WS_P + (size_t)MT * DM * 2;
constexpr size_t WS_LSE = WS_FY + (size_t)NB * 4 * 64 * 64 * 64 * 4;
constexpr size_t WS_END = WS_LSE + (size_t)3 * MT * 4 * 4;

struct Args { const float* in[16]; float* out; unsigned char* ws; int ph_lo, ph_hi; };

__device__ __forceinline__ float bf2f(bf16_t v) { return __uint_as_float((unsigned)v << 16); }
__device__ __forceinline__ float bflo(unsigned w) { return __uint_as_float(w << 16); }
__device__ __forceinline__ float bfhi(unsigned w) { return __uint_as_float(w & 0xffff0000u); }
__device__ __forceinline__ bf16_t f2bf(float f) { unsigned u = __float_as_uint(f); u += 0x7fffu + ((u >> 16) & 1u); return (bf16_t)(u >> 16); }
__device__ __forceinline__ unsigned pk2(float lo, float hi) { return (unsigned)f2bf(lo) | ((unsigned)f2bf(hi) << 16); }
__device__ __forceinline__ float sigmoidf_(float x) { return 1.f / (1.f + __expf(-x)); }
__device__ __forceinline__ float siluf_(float x) { return x / (1.f + __expf(-x)); }
__device__ __forceinline__ int opq(int v) { asm volatile("" : "+v"(v)); return v; }
#define TIDX opq((int)threadIdx.x)
__device__ __forceinline__ int opqs(int v) { asm volatile("" : "+s"(v)); return v; }
#define BIDX opqs((int)blockIdx.x)
__device__ __forceinline__ float wave_sum(float v) {
#pragma unroll
    for (int o = 1; o < 64; o <<= 1) v += __shfl_xor(v, o);
    return v;
}

struct Ctx {
    const float *x, *norm_g, *w_in, *w_fourier, *conv_w, *conv_b, *conv_ln_g, *conv_ln_b, *w_pw, *w_pool, *pool_scale, *w_branch, *w_gate, *b_gate, *w_out, *final_g;
    float* out;
    bf16_t *WinT, *WgT, *WbT, *WoT, *H, *Z, *P;
    float2* TW; float *RC, *RS, *LSE; unsigned* FY;
};

__device__ __forceinline__ void transpose_mat(const float* W, int K, int N, bf16_t* WT, float* scr) {
    const int t = TIDX, nkb = K / 64, nnb = N / 64;
    for (int item = BIDX; item < nkb * nnb; item += gridDim.x) {
        const int kb = item / nnb, nb = item % nnb;
#pragma unroll
        for (int i = 0; i < 8; ++i) { const int kk = (t >> 6) + 8 * i, nn = t & 63; scr[kk * 65 + nn] = W[(size_t)(kb * 64 + kk) * N + nb * 64 + nn]; }
        __syncthreads();
#pragma unroll
        for (int i = 0; i < 8; ++i) { const int nn = (t >> 6) + 8 * i, kk = t & 63; WT[(size_t)(nb * 64 + nn) * K + kb * 64 + kk] = f2bf(scr[kk * 65 + nn]); }
        __syncthreads();
    }
}
__device__ __forceinline__ void phase_pre(const Ctx& c, float* lds) {
    for (int l = 0; l < DEPTH; ++l) {
        transpose_mat(c.w_in + (size_t)l * DM * DIN, DM, DIN, c.WinT + (size_t)l * DIN * DM, lds);
        for (int n = 0; n < 4; ++n) {
            transpose_mat(c.w_gate + (size_t)(l * 4 + n) * DM * DM, DM, DM, c.WgT + ((size_t)l * 4096 + n * 1024) * DM, lds);
            transpose_mat(c.w_branch + (size_t)(l * 4 + n) * 256 * DM, 256, DM, c.WbT + (size_t)(l * 4 + n) * 1024 * 256, lds);
        }
        transpose_mat(c.w_out + (size_t)l * DM * DM, DM, DM, c.WoT + (size_t)l * DM * DM, lds);
    }
    const int gt = BIDX * NTHREADS + TIDX, NT = gridDim.x * NTHREADS;
    for (int i = gt; i < 4096; i += NT) { float s, co; sincospif((float)i / 2048.f, &s, &co); c.TW[i] = make_float2(co, s); }
    for (int i = gt; i < 4096 * 32; i += NT) {
        const int pos = i >> 5, k = i & 31;
        const float inv = exp2f(-(float)k * (13.287712379549449f / 32.0f));
        double tq = (double)pos * (double)inv * 0.3183098861837907;
        tq -= 2.0 * rint(tq * 0.5);
        float s, co; sincospif((float)tq, &s, &co);
        c.RC[i] = co; c.RS[i] = s;
    }
}

__device__ __forceinline__ void phase_norm_bf16(const float* xin, const float* g, bf16_t* H) {
    const int tid_ = TIDX; const int lane = tid_ & 63, wave = tid_ >> 6;
    const int gw = BIDX * NWAVES + wave, NGW = gridDim.x * NWAVES;
    f32x4 gv[4];
#pragma unroll
    for (int j = 0; j < 4; ++j) gv[j] = *(const f32x4*)(g + 4 * (lane + 64 * j));
    for (int m = gw; m < MT; m += NGW) {
        const f32x4* xr = (const f32x4*)(xin + (size_t)m * DM);
        f32x4 v[4]; float s = 0.f;
#pragma unroll
        for (int j = 0; j < 4; ++j) { v[j] = xr[lane + 64 * j]; s += v[j].x * v[j].x + v[j].y * v[j].y + v[j].z * v[j].z + v[j].w * v[j].w; }
        const float rstd = 1.0f / sqrtf(wave_sum(s) * (1.f / DM) + 1e-6f);
        uint2* o = (uint2*)(H + (size_t)m * DM);
#pragma unroll
        for (int j = 0; j < 4; ++j) { const f32x4 y = v[j] * rstd * gv[j]; o[lane + 64 * j] = make_uint2(pk2(y.x, y.y), pk2(y.z, y.w)); }
    }
}
__device__ __forceinline__ void phase_norm_final(float* xio, const float* g) {
    const int tid_ = TIDX; const int lane = tid_ & 63, wave = tid_ >> 6;
    const int gw = BIDX * NWAVES + wave, NGW = gridDim.x * NWAVES;
    f32x4 gv[4];
#pragma unroll
    for (int j = 0; j < 4; ++j) gv[j] = *(const f32x4*)(g + 4 * (lane + 64 * j));
    for (int m = gw; m < MT; m += NGW) {
        f32x4* xr = (f32x4*)(xio + (size_t)m * DM);
        f32x4 v[4]; float s = 0.f;
#pragma unroll
        for (int j = 0; j < 4; ++j) { v[j] = xr[lane + 64 * j]; s += v[j].x * v[j].x + v[j].y * v[j].y + v[j].z * v[j].z + v[j].w * v[j].w; }
        const float rstd = 1.0f / sqrtf(wave_sum(s) * (1.f / DM) + 1e-6f);
#pragma unroll
        for (int j = 0; j < 4; ++j) xr[lane + 64 * j] = v[j] * rstd * gv[j];
    }
}

template <class Epi>
__device__ __forceinline__ void gemm_simple(const bf16_t* A, int lda, const bf16_t* Bt, int ldb, int Mr, int N, int K, const Epi& epi) {
    const int tid_ = TIDX; const int wid = tid_ >> 6, lane = tid_ & 63, fr = lane & 15, fq = lane >> 4;
    const int nM = Mr / 128, nN = N / 64;
    for (int u = BIDX; u < nM * nN; u += gridDim.x) {
        const int pm = u / nN, pn = u % nN;
        const bf16_t* ap = A + (size_t)(pm * 128 + wid * 16 + fr) * lda + fq * 8;
        const bf16_t* bp = Bt + (size_t)(pn * 64 + fr) * ldb + fq * 8;
        f32x4 acc[4];
#pragma unroll
        for (int n = 0; n < 4; ++n) acc[n] = (f32x4){0.f, 0.f, 0.f, 0.f};
        for (int k0 = 0; k0 < K; k0 += 32) {
            const bf16x8 a = *(const bf16x8*)(ap + k0);
#pragma unroll
            for (int n = 0; n < 4; ++n) { const bf16x8 b = *(const bf16x8*)(bp + (size_t)n * 16 * ldb + k0); acc[n] = __builtin_amdgcn_mfma_f32_16x16x32_bf16(a, b, acc[n], 0, 0, 0); }
        }
#pragma unroll
        for (int n = 0; n < 4; ++n)
#pragma unroll
            for (int j = 0; j < 4; ++j) epi(pm * 128 + wid * 16 + fq * 4 + j, pn * 64 + n * 16 + fr, acc[n][j]);
    }
}
struct EpiZ { bf16_t* Z; __device__ __forceinline__ void operator()(int r, int c, float v) const { Z[(size_t)r * DIN + c] = f2bf(v); } };
struct EpiGate { bf16_t* MG; const float* bg; __device__ __forceinline__ void operator()(int r, int c, float v) const { MG[(size_t)r * 4096 + c] = f2bf(sigmoidf_(v + bg[c])); } };
struct EpiOut { const float* xin; float* out; __device__ __forceinline__ void operator()(int r, int c, float v) const { const size_t i = (size_t)r * DM + c; out[i] = xin[i] + v; } };

__device__ __forceinline__ void gemm_merge(const bf16_t* P, const bf16_t* WbT, const bf16_t* MG, bf16_t* MERGED) {
    const int tid_ = TIDX; const int wid = tid_ >> 6, lane = tid_ & 63, fr = lane & 15, fq = lane >> 4;
    const int nM = MT / 128, nN = DM / 64;
    for (int u = BIDX; u < nM * nN; u += gridDim.x) {
        const int pm = u / nN, pn = u % nN;
        f32x4 tot[4];
#pragma unroll
        for (int n = 0; n < 4; ++n) tot[n] = (f32x4){0.f, 0.f, 0.f, 0.f};
        for (int n4 = 0; n4 < 4; ++n4) {
            const bf16_t* ap = P + (size_t)(pm * 128 + wid * 16 + fr) * DM + n4 * 256 + fq * 8;
            const bf16_t* bp = WbT + (size_t)n4 * 1024 * 256 + (size_t)(pn * 64 + fr) * 256 + fq * 8;
            f32x4 acc[4];
#pragma unroll
            for (int n = 0; n < 4; ++n) acc[n] = (f32x4){0.f, 0.f, 0.f, 0.f};
            for (int k0 = 0; k0 < 256; k0 += 32) {
                const bf16x8 a = *(const bf16x8*)(ap + k0);
#pragma unroll
                for (int n = 0; n < 4; ++n) { const bf16x8 b = *(const bf16x8*)(bp + (size_t)n * 16 * 256 + k0); acc[n] = __builtin_amdgcn_mfma_f32_16x16x32_bf16(a, b, acc[n], 0, 0, 0); }
            }
#pragma unroll
            for (int n = 0; n < 4; ++n)
#pragma unroll
                for (int j = 0; j < 4; ++j) { const int r = pm * 128 + wid * 16 + fq * 4 + j, cc = pn * 64 + n * 16 + fr; tot[n][j] += bf2f(MG[(size_t)r * 4096 + n4 * 1024 + cc]) * acc[n][j]; }
        }
#pragma unroll
        for (int n = 0; n < 4; ++n)
#pragma unroll
            for (int j = 0; j < 4; ++j) { const int r = pm * 128 + wid * 16 + fq * 4 + j, cc = pn * 64 + n * 16 + fr; MERGED[(size_t)r * DM + cc] = f2bf(tot[n][j]); }
    }
}

__device__ __forceinline__ void fft1_unit(const Ctx& c, int u, float* lds) {
    const int t = TIDX, s2 = u & 63, bg = u >> 6, g = bg & 3, b = bg >> 2;
    float* U = lds; float* Wre = lds + 64 * 65; float* Wim = Wre + 4096; float* cs = Wim + 4096; float* sn = cs + 64;
    if (t < 64) { float s, co; sincospif((float)t / 32.f, &s, &co); cs[t] = co; sn[t] = s; }
#pragma unroll
    for (int i = 0; i < 8; ++i) { const int s1 = (t >> 6) + 8 * i, ci = t & 63; U[s1 * 65 + ci] = bf2f(c.Z[(size_t)(b * SEQ + 64 * s1 + s2) * DIN + ZA + 64 * g + ci]); }
    __syncthreads();
    const int cp = t & 63;
#pragma unroll 1
    for (int i = 0; i < 8; ++i) {
        const int s1 = (t >> 6) + 8 * i; float re = 0.f, im = 0.f;
        for (int ci = 0; ci < 64; ++ci) { const float x = U[s1 * 65 + ci]; const int e = (ci * cp) & 63; re += x * cs[e]; im -= x * sn[e]; }
        Wre[s1 * 64 + cp] = re; Wim[s1 * 64 + cp] = im;
    }
    __syncthreads();
#pragma unroll 1
    for (int i = 0; i < 8; ++i) {
        const int k1 = (t >> 6) + 8 * i; float yr = 0.f, yi = 0.f;
        for (int s1 = 0; s1 < 64; ++s1) { const int e = (k1 * s1) & 63; const float co = cs[e], si = sn[e], wr = Wre[s1 * 64 + cp], wi = Wim[s1 * 64 + cp]; yr += co * wr + si * wi; yi += co * wi - si * wr; }
        const float2 tw = c.TW[(k1 * s2) & 4095];
        const float zr = yr * tw.x + yi * tw.y, zi = yi * tw.x - yr * tw.y;
        c.FY[((size_t)(bg * 64 + k1) * 64 + s2) * 64 + cp] = pk2(zr, zi);
    }
    __syncthreads();
}

__device__ __forceinline__ void tok_unit(const Ctx& c, int l, int u, float* lds) {
    const int t = TIDX, lane = t & 63, wave = t >> 6, ch = t & 255, half = t >> 8;
    const int b = u >> 6, s0 = (u & 63) * 64, tok0 = b * SEQ + s0;
    float* A = lds;
#pragma unroll 1
    for (int i = 0; i < 47; ++i) {
        const int r = half + 2 * i, s = s0 - 15 + r; float val = 0.f;
        if (s >= 0 && s < SEQ) { const bf16_t* zr = c.Z + (size_t)(b * SEQ + s) * DIN + ZB; val = bf2f(zr[ch]) * sigmoidf_(bf2f(zr[256 + ch])); }
        A[r * 256 + ch] = val;
    }
    __syncthreads();
    float y[32];
    {
        float cw[31];
#pragma unroll
        for (int w = 0; w < 31; ++w) cw[w] = c.conv_w[(size_t)l * 31 * 256 + w * 256 + ch];
        const float cb = c.conv_b[l * 256 + ch];
#pragma unroll
        for (int cc = 0; cc < 4; ++cc) {
            float rows[38];
#pragma unroll
            for (int r = 0; r < 38; ++r) rows[r] = A[(half * 32 + cc * 8 + r) * 256 + ch];
#pragma unroll
            for (int i = 0; i < 8; ++i) {
                float acc = cb;
#pragma unroll
                for (int w = 0; w < 31; ++w) acc += rows[i + w] * cw[w];
                y[cc * 8 + i] = acc;
            }
            __builtin_amdgcn_sched_barrier(0);
        }
    }
    __syncthreads();
#pragma unroll
    for (int i = 0; i < 32; ++i) A[(half * 32 + i) * 256 + ch] = y[i];
    __syncthreads();
    {
        float lg[4], lb[4];
#pragma unroll
        for (int q = 0; q < 4; ++q) { lg[q] = c.conv_ln_g[l * 256 + lane + 64 * q]; lb[q] = c.conv_ln_b[l * 256 + lane + 64 * q]; }
        for (int i = 0; i < 8; ++i) {
            const int tk = wave * 8 + i; float xv[4]; float s = 0.f;
#pragma unroll
            for (int q = 0; q < 4; ++q) { xv[q] = A[tk * 256 + lane + 64 * q]; s += xv[q]; }
            const float mean = wave_sum(s) * (1.f / 256.f); float s2 = 0.f;
#pragma unroll
            for (int q = 0; q < 4; ++q) { xv[q] -= mean; s2 += xv[q] * xv[q]; }
            const float rstd = 1.0f / sqrtf(wave_sum(s2) * (1.f / 256.f) + 1e-5f);
#pragma unroll
            for (int q = 0; q < 4; ++q) { const float yv = xv[q] * rstd * lg[q] + lb[q]; A[tk * 256 + lane + 64 * q] = siluf_(yv); }
        }
    }
    __syncthreads();
    {
        float acc[32];
#pragma unroll
        for (int i = 0; i < 32; ++i) acc[i] = 0.f;
        const float* W = c.w_pw + (size_t)l * 65536;
#pragma unroll 2
        for (int k = 0; k < 256; ++k) {
            const float wv = W[k * 256 + ch];
#pragma unroll
            for (int i = 0; i < 32; ++i) acc[i] += A[(half * 32 + i) * 256 + k] * wv;
        }
        __syncthreads();
#pragma unroll
        for (int i = 0; i < 32; ++i) A[(half * 32 + i) * 256 + ch] = acc[i];
        __syncthreads();
#pragma unroll 1
        for (int i = 0; i < 32; ++i) {
            const size_t tok = tok0 + half * 32 + i;
            const float gp = bf2f(c.Z[tok * DIN + ZG + 256 + ch]);
            c.P[tok * DM + 256 + ch] = f2bf(A[(half * 32 + i) * 256 + ch] * siluf_(gp));
        }
    }
    __syncthreads();
#pragma unroll 1
    for (int i = 0; i < 40; ++i) {
        const int r = half + 2 * i;
        if (r < 79) { const int s = s0 - 8 + r; float val = 0.f; if (s >= 0 && s < SEQ) val = bf2f(c.Z[(size_t)(b * SEQ + s) * DIN + ZD + ch]); A[r * 256 + ch] = val; }
    }
    __syncthreads();
    float* PL = lds + 79 * 256;
    {
        const int gi = ch >> 6, sz = 2 << gi;
#pragma unroll 1
        for (int i = 0; i < 32; ++i) {
            const int tk = half * 32 + i, s = s0 + tk;
            int lo = s - sz / 2; if (lo < 0) lo = 0;
            int hi = s + sz - 1 - sz / 2; if (hi > SEQ - 1) hi = SEQ - 1;
            float sum = 0.f;
            for (int p = lo; p <= hi; ++p) sum += A[(p - s0 + 8) * 256 + ch];
            PL[tk * 256 + ch] = sum / (float)(hi - lo + 1) - A[(tk + 8) * 256 + ch];
        }
    }
    __syncthreads();
    {
        const int gi = ch >> 6, dd = ch & 63;
        float acc[32];
#pragma unroll
        for (int i = 0; i < 32; ++i) acc[i] = 0.f;
        const float* W = c.w_pool + (size_t)(l * 4 + gi) * 4096;
#pragma unroll 2
        for (int k = 0; k < 64; ++k) {
            const float wv = W[k * 64 + dd];
#pragma unroll
            for (int i = 0; i < 32; ++i) acc[i] += PL[(half * 32 + i) * 256 + gi * 64 + k] * wv;
        }
        const float ps = c.pool_scale[l * 256 + ch];
        __syncthreads();
#pragma unroll
        for (int i = 0; i < 32; ++i) A[(half * 32 + i) * 256 + ch] = acc[i];
        __syncthreads();
#pragma unroll 1
        for (int i = 0; i < 32; ++i) {
            const size_t tok = tok0 + half * 32 + i;
            const float gp = bf2f(c.Z[tok * DIN + ZG + 768 + ch]);
            c.P[tok * DM + 768 + ch] = f2bf(A[(half * 32 + i) * 256 + ch] * ps * siluf_(gp));
        }
    }
    __syncthreads();
}

__device__ __forceinline__ void attn_unit(const Ctx& c, int u, float* ldsf) {
    unsigned* lds = (unsigned*)ldsf;
    const int t = TIDX;
    const int b = u / 192, rem = u % 192, g = rem >> 6, rem2 = rem & 63, hI = rem2 >> 4, rq = rem2 & 15;
    const int d = 1 << (2 * g), L = SEQ / d, nqb = L / 256, r = rq / nqb, qb = rq % nqb, hh = g * 4 + hI, i0 = qb * 256;
    unsigned* Kt = lds; unsigned* Vt = lds + 384 * 33;
    for (int pass = 0; pass < 2; ++pass) {
        const int jl = pass * 256 + (t >> 1), hf = t & 1, j = i0 - 64 + jl;
        if (jl < 384 && j >= 0 && j < L) {
            const int pos = r + d * j; const size_t tok = (size_t)b * SEQ + pos;
            const u32x4* kr = (const u32x4*)(c.Z + tok * DIN + ZK + hh * 64);
            unsigned kw[32];
#pragma unroll
            for (int q = 0; q < 8; ++q) { const u32x4 v = kr[q]; kw[4 * q] = v.x; kw[4 * q + 1] = v.y; kw[4 * q + 2] = v.z; kw[4 * q + 3] = v.w; }
            const float* rc = c.RC + pos * 32; const float* rs = c.RS + pos * 32;
#pragma unroll
            for (int w = 0; w < 16; ++w) {
                const float lo0 = bflo(kw[w]), lo1 = bfhi(kw[w]), hi0 = bflo(kw[16 + w]), hi1 = bfhi(kw[16 + w]);
                const float c0 = rc[2 * w], c1 = rc[2 * w + 1], s0 = rs[2 * w], s1 = rs[2 * w + 1];
                float o0, o1;
                if (hf == 0) { o0 = lo0 * c0 - hi0 * s0; o1 = lo1 * c1 - hi1 * s1; } else { o0 = hi0 * c0 + lo0 * s0; o1 = hi1 * c1 + lo1 * s1; }
                Kt[jl * 33 + hf * 16 + w] = pk2(o0, o1);
            }
            const u32x4* vr = (const u32x4*)(c.Z + tok * DIN + ZV + hh * 64 + hf * 32);
#pragma unroll
            for (int q = 0; q < 4; ++q) { const u32x4 v = vr[q]; Vt[jl * 33 + hf * 16 + 4 * q] = v.x; Vt[jl * 33 + hf * 16 + 4 * q + 1] = v.y; Vt[jl * 33 + hf * 16 + 4 * q + 2] = v.z; Vt[jl * 33 + hf * 16 + 4 * q + 3] = v.w; }
        }
    }
    const int ql = t >> 1, hf = t & 1, iq = i0 + ql, posq = r + d * iq;
    const size_t tokq = (size_t)b * SEQ + posq;
    bf16_t* qrow = c.Z + tokq * DIN + ZQ + hh * 64;
    float qv[32];
    {
        const u32x4* qr = (const u32x4*)qrow;
        unsigned kw[32];
#pragma unroll
        for (int q = 0; q < 8; ++q) { const u32x4 v = qr[q]; kw[4 * q] = v.x; kw[4 * q + 1] = v.y; kw[4 * q + 2] = v.z; kw[4 * q + 3] = v.w; }
        const float* rc = c.RC + posq * 32; const float* rs = c.RS + posq * 32;
#pragma unroll
        for (int w = 0; w < 16; ++w) {
            const float lo0 = bflo(kw[w]), lo1 = bfhi(kw[w]), hi0 = bflo(kw[16 + w]), hi1 = bfhi(kw[16 + w]);
            const float c0 = rc[2 * w], c1 = rc[2 * w + 1], s0 = rs[2 * w], s1 = rs[2 * w + 1];
            if (hf == 0) { qv[2 * w] = (lo0 * c0 - hi0 * s0) * 0.125f; qv[2 * w + 1] = (lo1 * c1 - hi1 * s1) * 0.125f; }
            else { qv[2 * w] = (hi0 * c0 + lo0 * s0) * 0.125f; qv[2 * w + 1] = (hi1 * c1 + lo1 * s1) * 0.125f; }
        }
    }
    __syncthreads();
    float m = -1e30f, lsum = 0.f, o[32];
#pragma unroll
    for (int w = 0; w < 32; ++w) o[w] = 0.f;
    for (int t2 = 0; t2 <= 128; ++t2) {
        const int j = iq - 64 + t2;
        if (j >= 0 && j < L) {
            const int jl = ql + t2;
            const unsigned* kp = Kt + jl * 33 + hf * 16;
            float sp = 0.f;
#pragma unroll
            for (int w = 0; w < 16; ++w) { const unsigned kwv = kp[w]; sp += qv[2 * w] * bflo(kwv) + qv[2 * w + 1] * bfhi(kwv); }
            const float s = sp + __shfl_xor(sp, 1);
            const float mn = fmaxf(m, s), corr = __expf(m - mn), p = __expf(s - mn);
            lsum = lsum * corr + p; m = mn;
            const unsigned* vp = Vt + jl * 33 + hf * 16;
#pragma unroll
            for (int w = 0; w < 16; ++w) { const unsigned vw = vp[w]; o[2 * w] = o[2 * w] * corr + p * bflo(vw); o[2 * w + 1] = o[2 * w + 1] * corr + p * bfhi(vw); }
        }
    }
    const float inv = 1.f / lsum;
    unsigned* orow = (unsigned*)(qrow + hf * 32);
#pragma unroll
    for (int w = 0; w < 16; ++w) orow[w] = pk2(o[2 * w] * inv, o[2 * w + 1] * inv);
    if (hf == 0) c.LSE[((size_t)g * MT + tokq) * 4 + hI] = m + __logf(lsum);
    __syncthreads();
}

__device__ __forceinline__ void fft2_unit(const Ctx& c, int l, int u, float* lds) {
    const int t = TIDX, b = u >> 6, k1 = u & 63, cp = t & 63;
    float* Ft = lds; float* Yre = lds + 64 * 260; float* Yim = Yre + 4096; float* cs = Yim + 4096; float* sn = cs + 64;
    if (t < 64) { float s, co; sincospif((float)t / 32.f, &s, &co); cs[t] = co; sn[t] = s; }
    for (int g = 0; g < 4; ++g) {
        const unsigned* src = c.FY + (size_t)((b * 4 + g) * 64 + k1) * 4096;
#pragma unroll
        for (int i = 0; i < 8; ++i) { const int idx = t + 512 * i; const unsigned w = src[idx]; Yre[idx] = bflo(w); Yim[idx] = bfhi(w); }
        __syncthreads();
#pragma unroll 1
        for (int i = 0; i < 8; ++i) {
            const int k2 = (t >> 6) + 8 * i; float acc = 0.f;
            for (int s2 = 0; s2 < 64; ++s2) { const int e = (k2 * s2) & 63; acc += cs[e] * Yre[s2 * 64 + cp] + sn[e] * Yim[s2 * 64 + cp]; }
            Ft[k2 * 260 + g * 64 + cp] = acc * (1.f / 512.f);
        }
        __syncthreads();
    }
    const int j = t & 255, half = t >> 8;
    float acc[32];
#pragma unroll
    for (int i = 0; i < 32; ++i) acc[i] = 0.f;
    const float* W = c.w_fourier + (size_t)l * 65536;
#pragma unroll 2
    for (int k = 0; k < 256; ++k) {
        const float wv = W[k * 256 + j];
#pragma unroll
        for (int i = 0; i < 32; ++i) acc[i] += Ft[(half * 32 + i) * 260 + k] * wv;
    }
    __syncthreads();
#pragma unroll
    for (int i = 0; i < 32; ++i) Ft[(half * 32 + i) * 260 + j] = acc[i];
    __syncthreads();
#pragma unroll 1
    for (int i = 0; i < 32; ++i) {
        const size_t tok = (size_t)b * SEQ + k1 + 64 * (half * 32 + i);
        const float gp = bf2f(c.Z[tok * DIN + ZG + j]);
        c.P[tok * DM + j] = f2bf(Ft[(half * 32 + i) * 260 + j] * siluf_(gp));
    }
    __syncthreads();
}

__device__ __forceinline__ void phase_combine(const Ctx& c) {
    const int gt = BIDX * NTHREADS + TIDX, NT = gridDim.x * NTHREADS;
    for (int idx = gt; idx < MT * 32; idx += NT) {
        const size_t m = idx >> 5; const int c8 = (idx & 31) * 8, hI = c8 >> 6;
        const float l0 = c.LSE[((size_t)0 * MT + m) * 4 + hI], l1 = c.LSE[((size_t)1 * MT + m) * 4 + hI], l2 = c.LSE[((size_t)2 * MT + m) * 4 + hI];
        const float mx = fmaxf(l0, fmaxf(l1, l2));
        const float e0 = __expf(l0 - mx), e1 = __expf(l1 - mx), e2 = __expf(l2 - mx), inv = 1.f / (e0 + e1 + e2);
        const float a0 = e0 * inv, a1 = e1 * inv, a2 = e2 * inv;
        const bf16_t* zr = c.Z + m * DIN;
        const u32x4 o0 = *(const u32x4*)(zr + ZQ + (0 * 4 + hI) * 64 + (c8 & 63));
        const u32x4 o1 = *(const u32x4*)(zr + ZQ + (1 * 4 + hI) * 64 + (c8 & 63));
        const u32x4 o2 = *(const u32x4*)(zr + ZQ + (2 * 4 + hI) * 64 + (c8 & 63));
        const u32x4 gp = *(const u32x4*)(zr + ZG + 512 + c8);
        u32x4 res;
#pragma unroll
        for (int q = 0; q < 4; ++q) {
            const float vlo = (a0 * bflo(o0[q]) + a1 * bflo(o1[q]) + a2 * bflo(o2[q])) * siluf_(bflo(gp[q]));
            const float vhi = (a0 * bfhi(o0[q]) + a1 * bfhi(o1[q]) + a2 * bfhi(o2[q])) * siluf_(bfhi(gp[q]));
            res[q] = pk2(vlo, vhi);
        }
        *(u32x4*)(c.P + m * DM + 512 + c8) = res;
    }
}

namespace pg8 {
#define PG8_LAS __attribute__((address_space(3)))
typedef unsigned short bf16_t;
typedef short bf16x8 __attribute__((ext_vector_type(8)));
typedef float f32x4 __attribute__((ext_vector_type(4)));
typedef unsigned u32x4 __attribute__((ext_vector_type(4)));
constexpr int BM = 256, BK = 64, HALF = 128, HTB = HALF * BK * 2  , STAGE_BYTES = 8 * HTB, NXCD = 8, WGM = 8;

__host__ __device__ __forceinline__ int lds_byte(int r, int c) { const int st = (r >> 4) * 2 + (c >> 5), rr = r & 15, cc = c & 31, ob = rr * 64 + cc * 2; return st * 1024 + (ob ^ (((ob >> 9) & 1) << 5)); }
__host__ __device__ __forceinline__ void stage_rc(int b, int& R, int& C) { const int st = b / 1024, sb = b % 1024, swz = sb ^ (((sb >> 9) & 1) << 5); R = (st >> 1) * 16 + swz / 64; C = (st & 1) * 32 + (swz % 64) / 2; }
__host__ __device__ __forceinline__ int perm32(int rho) { const int n = rho >> 4, i = rho & 15; return 8 * (i >> 2) + 4 * n + (i & 3); }

struct Unit { int pm, pn, sub; };
template <int LDA_, int LDB_, int K_, int ASUB_, int BSUB_> struct GemmT { const bf16_t* A; const bf16_t* Bt; static constexpr int lda = LDA_, ldb = LDB_, K = K_; static constexpr size_t a_sub = ASUB_, b_sub = BSUB_; };

struct StaticOrder {
    int nM, nN, nwg, G, c;
    __host__ __device__ void init(int M, int N, int G_, int c_) { nM = M / BM; nN = N / BM; nwg = nM * nN; G = G_; c = c_; }
    __host__ __device__ bool next(int i, Unit& u) const {
        const long L = (long)i * G + c; if (L >= nwg) return false;
        int wgid = (int)L; { const int q = nwg / NXCD, r = nwg % NXCD, xcd = wgid % NXCD, off = wgid / NXCD; wgid = (xcd < r ? xcd * (q + 1) : r * (q + 1) + (xcd - r) * q) + off; }
        const int nig = WGM * nN, gid = wgid / nig, fm = gid * WGM, gsz = (nM - fm) < WGM ? (nM - fm) : WGM;
        u.pm = fm + ((wgid % nig) % gsz); u.pn = (wgid % nig) / gsz; u.sub = 0; return true;
    }
    __device__ __forceinline__ void a_ready(const Unit&) const {}
    __device__ __forceinline__ void done(const Unit&) const {}
};


__device__ __forceinline__ unsigned cvt_pk_bf16(float lo, float hi) { unsigned r; asm volatile("s_nop 0\n\tv_cvt_pk_bf16_f32 %0, %1, %2" : "=v"(r) : "v"(lo), "v"(hi)); return r; }
template <int ACT  > struct EpiBf16 {
    static constexpr bool PERM = true, AFTER_DRAIN = false; static_assert(ACT == 0 || ACT == 2, "EpiBf16: ACT is 0 (none) or 2 (sigmoid)");
    bf16_t* O; int ldc; const float* bias; int split_cols; size_t split_stride; float scale0;
    __device__ __forceinline__ void operator()(const f32x4 (&acc)[2][2][4][2], const Unit& u, int wr, int wc, int fr, int fq) const {
        const int row0 = u.pm * BM + wr * 64 + fr; int colt = u.pn * BM; bf16_t* base = O;
        float sc = 1.f; if (split_cols) { const int t = colt / split_cols; base += (size_t)t * split_stride; colt -= t * split_cols; if (t == 0) sc = scale0; }
        const int col0 = colt + wc * 32 + 8 * fq, bcol0 = u.pn * BM + wc * 32 + 8 * fq;
        f32x4 bv[2][2];
#pragma unroll
        for (int bj = 0; bj < 2; ++bj)
#pragma unroll
            for (int n = 0; n < 2; ++n) bv[bj][n] = bias ? *(const f32x4*)(bias + bcol0 + bj * HALF + 4 * n) : (f32x4){0.f, 0.f, 0.f, 0.f};
#pragma unroll
        for (int ai = 0; ai < 2; ++ai)
#pragma unroll
            for (int m = 0; m < 4; ++m) { bf16_t* rowp = base + (size_t)(row0 + ai * HALF + m * 16) * ldc + col0;
#pragma unroll
                for (int bj = 0; bj < 2; ++bj) { f32x4 v0 = acc[ai][bj][m][0] + bv[bj][0], v1 = acc[ai][bj][m][1] + bv[bj][1];
                    if (ACT == 2) {
#pragma unroll
                        for (int q = 0; q < 4; ++q) { v0[q] = __builtin_amdgcn_rcpf(1.0f + __builtin_amdgcn_exp2f(v0[q] * -1.44269504f)); v1[q] = __builtin_amdgcn_rcpf(1.0f + __builtin_amdgcn_exp2f(v1[q] * -1.44269504f)); } }
                    v0 = v0 * sc; v1 = v1 * sc; u32x4 w; w.x = cvt_pk_bf16(v0[0], v0[1]); w.y = cvt_pk_bf16(v0[2], v0[3]); w.z = cvt_pk_bf16(v1[0], v1[1]); w.w = cvt_pk_bf16(v1[2], v1[3]);
                    *(u32x4*)(rowp + bj * HALF) = w; } }
    }
};

struct EpiMerge {
    static constexpr bool PERM = true, AFTER_DRAIN = false;
    const bf16_t* MG; bf16_t* O;
    __device__ __forceinline__ void operator()(const f32x4 (&acc)[2][2][4][2], const Unit& u, int wr, int wc, int fr, int fq) const {
        const int row0 = u.pm * BM + wr * 64 + fr, col0 = u.pn * BM + wc * 32 + 8 * fq;
#pragma unroll
        for (int ai = 0; ai < 2; ++ai)
#pragma unroll
            for (int m = 0; m < 4; ++m) { const size_t row = (size_t)(row0 + ai * HALF + m * 16);
#pragma unroll
                for (int bj = 0; bj < 2; ++bj) {
                    const u32x4 g = *(const u32x4*)(MG + row * 4096 + u.sub * 1024 + col0 + bj * HALF);
                    bf16_t* op = O + row * 1024 + col0 + bj * HALF;
                    f32x4 v0 = acc[ai][bj][m][0], v1 = acc[ai][bj][m][1];
                    v0[0] *= __uint_as_float(g.x << 16); v0[1] *= __uint_as_float(g.x & 0xffff0000u); v0[2] *= __uint_as_float(g.y << 16); v0[3] *= __uint_as_float(g.y & 0xffff0000u);
                    v1[0] *= __uint_as_float(g.z << 16); v1[1] *= __uint_as_float(g.z & 0xffff0000u); v1[2] *= __uint_as_float(g.w << 16); v1[3] *= __uint_as_float(g.w & 0xffff0000u);
                    if (u.sub != 0) { const u32x4 p = *(const u32x4*)op;
                        v0[0] += __uint_as_float(p.x << 16); v0[1] += __uint_as_float(p.x & 0xffff0000u); v0[2] += __uint_as_float(p.y << 16); v0[3] += __uint_as_float(p.y & 0xffff0000u);
                        v1[0] += __uint_as_float(p.z << 16); v1[1] += __uint_as_float(p.z & 0xffff0000u); v1[2] += __uint_as_float(p.w << 16); v1[3] += __uint_as_float(p.w & 0xffff0000u); }
                    u32x4 w; w.x = cvt_pk_bf16(v0[0], v0[1]); w.y = cvt_pk_bf16(v0[2], v0[3]); w.z = cvt_pk_bf16(v1[0], v1[1]); w.w = cvt_pk_bf16(v1[2], v1[3]);
                    *(u32x4*)op = w; }
                asm volatile("" ::: "memory"); }
    }
};
struct EpiOutF32 {
    static constexpr bool PERM = true, AFTER_DRAIN = false;
    const float* xin; float* out;
    __device__ __forceinline__ void operator()(const f32x4 (&acc)[2][2][4][2], const Unit& u, int wr, int wc, int fr, int fq) const {
        const int row0 = u.pm * BM + wr * 64 + fr, col0 = u.pn * BM + wc * 32 + 8 * fq;
#pragma unroll
        for (int ai = 0; ai < 2; ++ai)
#pragma unroll
            for (int m = 0; m < 4; ++m) { const size_t off = (size_t)(row0 + ai * HALF + m * 16) * 1024 + col0;
#pragma unroll
                for (int bj = 0; bj < 2; ++bj) {
                    const f32x4 x0 = *(const f32x4*)(xin + off + bj * HALF), x1 = *(const f32x4*)(xin + off + bj * HALF + 4);
                    *(f32x4*)(out + off + bj * HALF) = x0 + acc[ai][bj][m][0]; *(f32x4*)(out + off + bj * HALF + 4) = x1 + acc[ai][bj][m][1]; }
                asm volatile("" ::: "memory"); }
    }
};
struct MergeOrder : StaticOrder {
    __device__ bool next(int i, Unit& u) const { const bool ok = StaticOrder::next(i >> 2, u); u.sub = i & 3; return ok; }
};

template <class Epi, class Sched, class Gemm, bool ALIGN_EPI = false, bool SP2 = false>
__device__ __forceinline__ void gemm_phase(PG8_LAS unsigned char* lds, const Gemm g, const Sched& S, const Epi& E) {
    const int tid = TIDX, wid = __builtin_amdgcn_readfirstlane(tid >> 6), lane = tid & 63, wr = wid >> 2, wc = wid & 3, fr = lane & 15, fq = lane >> 4;
    constexpr int K = Gemm::K, nt = K / BK, lda = Gemm::lda, ldb = Gemm::ldb;
    unsigned voffA[2], voffB[2];
#pragma unroll
    for (int i = 0; i < 2; ++i) { int R, C; stage_rc(tid * 16 + i * 8192, R, C); const int Rb = Epi::PERM ? ((R & ~31) + perm32(R & 31)) : R;
        voffA[i] = (unsigned)(R * lda + C) * 2u; voffB[i] = (unsigned)(Rb * ldb + C) * 2u; }
    const size_t kstep = (size_t)(BK * 2);
    const size_t hstepA = (size_t)HALF * lda * 2, hstepB = (size_t)HALF * ldb * 2;
    const size_t tstepA = 2 * hstepA, tstepB = 2 * hstepB;
    const unsigned ldsw = (unsigned)wid * 1024u;
    const int aoff = lds_byte(wr * 64 + fr, fq * 8), boff = lds_byte(wc * 32 + fr, fq * 8);
#define PG8_SA(b, h) (((b) * 2 + (h)) * HTB)
#define PG8_SB(b, h) ((4 + (b) * 2 + (h)) * HTB)
#define PG8_STAGE(bufoff, gbase, voff) do { _Pragma("unroll") for (int _i = 0; _i < 2; ++_i) \
        __builtin_amdgcn_global_load_lds((const unsigned*)((const char*)(gbase) + (voff)[_i]), (PG8_LAS unsigned*)(lds + (bufoff) + ldsw + _i * 8192), 16, 0, 0); } while (0)
#define PG8_LDA(dst, b, h) do { _Pragma("unroll") for (int m = 0; m < 4; ++m) _Pragma("unroll") for (int k = 0; k < 2; ++k) dst[m][k] = *(const PG8_LAS bf16x8*)(lds + PG8_SA(b, h) + aoff + m * 2048 + k * 1024); } while (0)
#define PG8_LDB(dst, b, h) do { _Pragma("unroll") for (int n = 0; n < 2; ++n) _Pragma("unroll") for (int k = 0; k < 2; ++k) dst[n][k] = *(const PG8_LAS bf16x8*)(lds + PG8_SB(b, h) + boff + n * 2048 + k * 1024); } while (0)
#define PG8_MMA(ai, bj, At, Bt) do { __builtin_amdgcn_s_setprio(1); _Pragma("unroll") for (int m = 0; m < 4; ++m) _Pragma("unroll") for (int n = 0; n < 2; ++n) _Pragma("unroll") for (int k = 0; k < 2; ++k) \
        acc[ai][bj][m][n] = __builtin_amdgcn_mfma_f32_16x16x32_bf16(Bt[n][k], At[m][k], acc[ai][bj][m][n], 0, 0, 0); __builtin_amdgcn_s_setprio(0); } while (0)
#define PG8_WAIT_V(n) asm volatile("s_waitcnt vmcnt(" #n ")" ::: "memory")
#define PG8_WAIT_L(n) asm volatile("s_waitcnt lgkmcnt(" #n ")" ::: "memory")
#define PG8_BAR __builtin_amdgcn_s_barrier()
#define PG8_SCHED __builtin_amdgcn_sched_barrier(0)
    Unit cur, nxt; int ui = 0;
    if (!S.next(0, cur)) return;
    f32x4 acc[2][2][4][2];
#pragma unroll
    for (int a = 0; a < 2; ++a)
#pragma unroll
        for (int b = 0; b < 2; ++b)
#pragma unroll
            for (int m = 0; m < 4; ++m)
#pragma unroll
                for (int n = 0; n < 2; ++n) acc[a][b][m][n] = (f32x4){0.f, 0.f, 0.f, 0.f};
    bf16x8 At[4][2], B0[2][2], B1[2][2];
    const char* cA = (const char*)g.A + (size_t)cur.pm * tstepA + (size_t)cur.sub * g.a_sub; const char* cB = (const char*)g.Bt + (size_t)cur.pn * tstepB + (size_t)cur.sub * g.b_sub;
    S.a_ready(cur);
    if constexpr (SP2) {
        PG8_STAGE(PG8_SB(0, 0), cB, voffB); PG8_STAGE(PG8_SB(0, 1), cB + hstepB, voffB); PG8_STAGE(PG8_SA(0, 0), cA, voffA); PG8_STAGE(PG8_SA(0, 1), cA + hstepA, voffA);
        if (wr == 1) PG8_BAR;
        PG8_WAIT_V(2); PG8_BAR;
        PG8_STAGE(PG8_SB(1, 0), cB + kstep, voffB); PG8_STAGE(PG8_SA(1, 0), cA + kstep, voffA); PG8_STAGE(PG8_SB(1, 1), cB + hstepB + kstep, voffB);
        PG8_WAIT_V(6); PG8_BAR;
    } else {
        PG8_STAGE(PG8_SB(0, 0), cB, voffB); PG8_STAGE(PG8_SA(0, 0), cA, voffA); PG8_STAGE(PG8_SB(0, 1), cB + hstepB, voffB); PG8_STAGE(PG8_SA(0, 1), cA + hstepA, voffA);
        if (wr == 1) PG8_BAR;
        PG8_WAIT_V(4); PG8_BAR;
        PG8_STAGE(PG8_SB(1, 0), cB + kstep, voffB); PG8_STAGE(PG8_SA(1, 0), cA + kstep, voffA); PG8_STAGE(PG8_SB(1, 1), cB + hstepB + kstep, voffB);
        PG8_WAIT_V(6); PG8_BAR;
    }
    for (;;) {
        const bool has_next = S.next(ui + 1, nxt);
        const char* nA = has_next ? (const char*)g.A + (size_t)nxt.pm * tstepA + (size_t)nxt.sub * g.a_sub : cA; const char* nB = has_next ? (const char*)g.Bt + (size_t)nxt.pn * tstepB + (size_t)nxt.sub * g.b_sub : cB;
        for (int t = 0; t < nt; t += 2) {
            const bool last = (t == nt - 2);
            const char* a1 = cA + (size_t)(t + 1) * kstep;
            const char* a2 = last ? nA : cA + (size_t)(t + 2) * kstep; const char* b2 = last ? nB : cB + (size_t)(t + 2) * kstep;
            const char* a3 = a2 + kstep; const char* b3 = b2 + kstep;
            if (last && has_next) S.a_ready(nxt);
            if constexpr (SP2) {
            PG8_LDB(B0, 0, 0); PG8_LDB(B1, 0, 1); PG8_SCHED; PG8_LDA(At, 0, 0); PG8_STAGE(PG8_SA(1, 1), a1 + hstepA, voffA);
            PG8_WAIT_V(8); PG8_WAIT_L(0); PG8_BAR; PG8_MMA(0, 0, At, B0); PG8_MMA(0, 1, At, B1); PG8_BAR; PG8_SCHED;
            PG8_LDA(At, 0, 1); PG8_STAGE(PG8_SB(0, 0), b2, voffB); PG8_STAGE(PG8_SB(0, 1), b2 + hstepB, voffB); PG8_STAGE(PG8_SA(0, 0), a2, voffA);
            PG8_WAIT_V(8); PG8_WAIT_L(0); PG8_BAR; PG8_MMA(1, 0, At, B0); PG8_MMA(1, 1, At, B1); PG8_BAR; PG8_SCHED;
            PG8_LDB(B0, 1, 0); PG8_LDB(B1, 1, 1); PG8_SCHED; PG8_LDA(At, 1, 0); PG8_STAGE(PG8_SA(0, 1), a2 + hstepA, voffA);
            PG8_WAIT_V(8); PG8_WAIT_L(0); PG8_BAR; PG8_MMA(0, 0, At, B0); PG8_MMA(0, 1, At, B1); PG8_BAR; PG8_SCHED;
            PG8_LDA(At, 1, 1); PG8_STAGE(PG8_SB(1, 0), b3, voffB); PG8_STAGE(PG8_SB(1, 1), b3 + hstepB, voffB); PG8_STAGE(PG8_SA(1, 0), a3, voffA);
            PG8_WAIT_V(8); PG8_WAIT_L(0); PG8_BAR; PG8_MMA(1, 0, At, B0); PG8_MMA(1, 1, At, B1); PG8_BAR; PG8_SCHED;
            } else {
            PG8_LDB(B0, 0, 0); PG8_SCHED; PG8_LDA(At, 0, 0); PG8_STAGE(PG8_SA(1, 1), a1 + hstepA, voffA);
            PG8_WAIT_L(8); PG8_BAR; PG8_WAIT_L(0); PG8_MMA(0, 0, At, B0); PG8_BAR; PG8_SCHED;
            PG8_LDB(B1, 0, 1); PG8_STAGE(PG8_SB(0, 0), b2, voffB);
            PG8_BAR; PG8_WAIT_L(0); PG8_MMA(0, 1, At, B1); PG8_BAR;
            PG8_LDA(At, 0, 1); PG8_STAGE(PG8_SA(0, 0), a2, voffA);
            PG8_BAR; PG8_WAIT_L(0); PG8_MMA(1, 0, At, B0); PG8_BAR; PG8_SCHED;
            PG8_STAGE(PG8_SB(0, 1), b2 + hstepB, voffB);
            PG8_WAIT_V(6); PG8_BAR; PG8_MMA(1, 1, At, B1); PG8_BAR;
            PG8_LDB(B0, 1, 0); PG8_SCHED; PG8_LDA(At, 1, 0); PG8_STAGE(PG8_SA(0, 1), a2 + hstepA, voffA);
            PG8_WAIT_L(8); PG8_BAR; PG8_WAIT_L(0); PG8_MMA(0, 0, At, B0); PG8_BAR; PG8_SCHED;
            PG8_LDB(B1, 1, 1); PG8_STAGE(PG8_SB(1, 0), b3, voffB);
            PG8_BAR; PG8_WAIT_L(0); PG8_MMA(0, 1, At, B1); PG8_BAR;
            PG8_LDA(At, 1, 1); PG8_STAGE(PG8_SA(1, 0), a3, voffA);
            PG8_BAR; PG8_WAIT_L(0); PG8_MMA(1, 0, At, B0); PG8_BAR; PG8_SCHED;
            PG8_STAGE(PG8_SB(1, 1), b3 + hstepB, voffB);
            PG8_WAIT_V(6); PG8_BAR; PG8_MMA(1, 1, At, B1); PG8_BAR;
            }
        }
        if constexpr (ALIGN_EPI) { if (wr == 0) PG8_BAR; }
        if constexpr (!Epi::AFTER_DRAIN) { E(acc, cur, wr, wc, fr, fq); S.done(cur); }
        if (!has_next) break;
#pragma unroll
        for (int a = 0; a < 2; ++a)
#pragma unroll
            for (int b = 0; b < 2; ++b)
#pragma unroll
                for (int m = 0; m < 4; ++m)
#pragma unroll
                    for (int n = 0; n < 2; ++n) acc[a][b][m][n] = (f32x4){0.f, 0.f, 0.f, 0.f};
        cur = nxt; cA = nA; cB = nB; ++ui;
        if constexpr (ALIGN_EPI) { if (wr == 1) PG8_BAR; }
    }
    PG8_WAIT_V(0);
    if constexpr (!ALIGN_EPI) { if (wr == 0) PG8_BAR; }
    PG8_BAR;
    if constexpr (Epi::AFTER_DRAIN) { E.fused(acc, cur, wr, wc, fr, fq, lds, wid, lane); S.done(cur); }
#undef PG8_SA
#undef PG8_SB
#undef PG8_STAGE
#undef PG8_LDA
#undef PG8_LDB
#undef PG8_MMA
#undef PG8_WAIT_V
#undef PG8_WAIT_L
#undef PG8_BAR
#undef PG8_SCHED
}
}

typedef const __attribute__((address_space(4))) Args* KArgs;
__device__ __forceinline__ void make_ctx(Ctx& c) {
    KArgs ap = (KArgs)__builtin_amdgcn_kernarg_segment_ptr();
    asm volatile("" : "+s"(ap));
    c.x = ap->in[0]; c.norm_g = ap->in[1]; c.w_in = ap->in[2]; c.w_fourier = ap->in[3]; c.conv_w = ap->in[4]; c.conv_b = ap->in[5]; c.conv_ln_g = ap->in[6]; c.conv_ln_b = ap->in[7];
    c.w_pw = ap->in[8]; c.w_pool = ap->in[9]; c.pool_scale = ap->in[10]; c.w_branch = ap->in[11]; c.w_gate = ap->in[12]; c.b_gate = ap->in[13]; c.w_out = ap->in[14]; c.final_g = ap->in[15];
    c.out = ap->out;
    unsigned char* ws = ap->ws;
    c.WinT = (bf16_t*)(ws + WS_WIN); c.WgT = (bf16_t*)(ws + WS_WG); c.WbT = (bf16_t*)(ws + WS_WB); c.WoT = (bf16_t*)(ws + WS_WO);
    c.TW = (float2*)(ws + WS_TW); c.RC = (float*)(ws + WS_RC); c.RS = (float*)(ws + WS_RS);
    c.H = (bf16_t*)(ws + WS_H); c.Z = (bf16_t*)(ws + WS_Z); c.P = (bf16_t*)(ws + WS_P); c.FY = (unsigned*)(ws + WS_FY); c.LSE = (float*)(ws + WS_LSE);
}
constexpr int NPHASES = 1 + 7 * DEPTH;
__global__ void __launch_bounds__(NTHREADS, 2) fwd_kernel(Args a) {
    extern __shared__ __attribute__((aligned(16))) unsigned char lds_raw[];
    float* lds = (float*)lds_raw;
    for (int ph = a.ph_lo; ph < a.ph_hi; ++ph) {
        if (ph == 0) {
            Ctx c; make_ctx(c);
            phase_pre(c, lds);
            phase_norm_bf16(c.x, c.norm_g, c.H);
        } else {
            const int l = (ph - 1) / 7, q = (ph - 1) % 7;
            if (q == 0) {
                Ctx c; make_ctx(c);
                if (ENG_MASK & 1) {
                typedef pg8::GemmT<DM, DM, DM, 0, 0> GT; GT g{c.H, c.WinT + (size_t)l * DIN * DM}; pg8::StaticOrder S; S.init(MT, DIN, (int)gridDim.x, BIDX);
                pg8::EpiBf16<0> E{c.Z, DIN, nullptr, 0, 0, 1.f};
                pg8::gemm_phase<pg8::EpiBf16<0>, pg8::StaticOrder, GT, true, true>((PG8_LAS unsigned char*)lds_raw, g, S, E);
                } else { EpiZ e{c.Z}; gemm_simple(c.H, DM, c.WinT + (size_t)l * DIN * DM, DM, MT, DIN, DM, e); }
            } else if (q == 1) {
                Ctx c; make_ctx(c);
                constexpr int NF = NB * 4 * 64, NTK = NB * 64, NAT = NB * 192;
                for (int u = BIDX; u < NAT; u += gridDim.x) attn_unit(c, u, lds);
                __builtin_amdgcn_sched_barrier(0);
                for (int u = BIDX; u < NTK; u += gridDim.x) tok_unit(c, l, u, lds);
                __builtin_amdgcn_sched_barrier(0);
                for (int u = BIDX; u < NF; u += gridDim.x) fft1_unit(c, u, lds);
            } else if (q == 2) {
                Ctx c; make_ctx(c);
                for (int u = BIDX; u < NB * 64; u += gridDim.x) fft2_unit(c, l, u, lds);
                phase_combine(c);
            } else if (q == 3) {
                Ctx c; make_ctx(c);
                if (ENG_MASK & 2) {
                typedef pg8::GemmT<DM, DM, DM, 0, 0> GT; GT g{c.H, c.WgT + (size_t)l * 4096 * DM}; pg8::StaticOrder S; S.init(MT, 4096, (int)gridDim.x, BIDX);
                pg8::EpiBf16<2> E{c.Z, 4096, c.b_gate + (size_t)l * 4096, 0, 0, 1.f};
                pg8::gemm_phase<pg8::EpiBf16<2>, pg8::StaticOrder, GT, true, true>((PG8_LAS unsigned char*)lds_raw, g, S, E);
                } else { EpiGate e{c.Z, c.b_gate + (size_t)l * 4096}; gemm_simple(c.H, DM, c.WgT + (size_t)l * 4096 * DM, DM, MT, 4096, DM, e); }
            } else if (q == 4) {
                Ctx c; make_ctx(c);
                if (ENG_MASK & 4) {
                typedef pg8::GemmT<DM, 256, 256, 512, 1024 * 256 * 2> GT; GT g{c.P, c.WbT + (size_t)l * 4 * 1024 * 256}; pg8::MergeOrder S; S.init(MT, DM, (int)gridDim.x, BIDX);
                pg8::EpiMerge E{c.Z, c.H};
                pg8::gemm_phase<pg8::EpiMerge, pg8::MergeOrder, GT, true, true>((PG8_LAS unsigned char*)lds_raw, g, S, E);
                } else { gemm_merge(c.P, c.WbT + (size_t)l * 4 * 1024 * 256, c.Z, c.H); }
            } else if (q == 5) {
                Ctx c; make_ctx(c);
                if (ENG_MASK & 8) {
                typedef pg8::GemmT<DM, DM, DM, 0, 0> GT; GT g{c.H, c.WoT + (size_t)l * DM * DM}; pg8::StaticOrder S; S.init(MT, DM, (int)gridDim.x, BIDX);
                pg8::EpiOutF32 E{(l == 0) ? c.x : c.out, c.out};
                pg8::gemm_phase<pg8::EpiOutF32, pg8::StaticOrder, GT, true, true>((PG8_LAS unsigned char*)lds_raw, g, S, E);
                } else { EpiOut e{(l == 0) ? c.x : c.out, c.out}; gemm_simple(c.H, DM, c.WoT + (size_t)l * DM * DM, DM, MT, DM, DM, e); }
            } else {
                Ctx c; make_ctx(c);
                if (l + 1 < DEPTH) phase_norm_bf16(c.out, c.norm_g + (size_t)(l + 1) * DM, c.H);
                else phase_norm_final(c.out, c.final_g);
            }
        }
        if (ph + 1 < a.ph_hi) cg::this_grid().sync();
    }
}

extern "C" void kernel_launch(void* const* d_in, const int* in_sizes, int n_in, void* d_out, int out_size, void* d_ws, size_t ws_size, hipStream_t stream) {
    static int grid = 0;
    if (grid == 0) {
        if (n_in != 16 || in_sizes[0] != MT * DM || out_size != MT * DM || ws_size < WS_END) {
            fprintf(stderr, "kernel_launch: unexpected shapes: n_in %d in0 %d out %d ws %zu (need %zu)\n", n_in, n_in > 0 ? in_sizes[0] : -1, out_size, ws_size, (size_t)WS_END);
            grid = -1; return;
        }
        int dev = 0, cus = 0, per_cu = 0;
        hipGetDevice(&dev); hipDeviceGetAttribute(&cus, hipDeviceAttributeMultiprocessorCount, dev);
        if (hipFuncSetAttribute((const void*)fwd_kernel, hipFuncAttributeMaxDynamicSharedMemorySize, LDS_BYTES) != hipSuccess) { fprintf(stderr, "kernel_launch: hipFuncSetAttribute failed\n"); grid = -1; return; }
        hipOccupancyMaxActiveBlocksPerMultiprocessor(&per_cu, (const void*)fwd_kernel, NTHREADS, LDS_BYTES);
        if (per_cu < 1) { fprintf(stderr, "kernel_launch: occupancy query says %d blocks/CU\n", per_cu); per_cu = 1; }
        (void)hipGetLastError();
        grid = cus;
    }
    if (grid < 0) return;
    Args a{};
    for (int i = 0; i < 16; ++i) a.in[i] = (const float*)d_in[i];
    a.out = (float*)d_out; a.ws = (unsigned char*)d_ws;
#if ONE_LAUNCH
    a.ph_lo = 0; a.ph_hi = NPHASES;
    void* args[] = {&a};
    hipError_t e = hipLaunchCooperativeKernel((const void*)fwd_kernel, dim3(grid), dim3(NTHREADS), args, LDS_BYTES, stream);
    if (e != hipSuccess) fprintf(stderr, "kernel_launch: cooperative launch failed: %s (grid %d)\n", hipGetErrorString(e), grid);
#else
    for (int ph = 0; ph < NPHASES; ++ph) {
        a.ph_lo = ph; a.ph_hi = ph + 1;
        hipLaunchKernelGGL(fwd_kernel, dim3(grid), dim3(NTHREADS), LDS_BYTES, stream, a);
    }
#endif
}
```

```cpp
#include <hip/hip_runtime.h>
#include <hip/hip_cooperative_groups.h>
#include <cstdio>
#include <cstdint>
namespace cg = cooperative_groups;

#ifndef NEW_TOK
#define NEW_TOK 1
#endif
#ifndef NEW_FFT1
#define NEW_FFT1 0
#endif
#ifndef NEW_FFT2
#define NEW_FFT2 1
#endif
#ifndef REPQ
#define REPQ -1
#endif
#ifndef REPSUB
#define REPSUB 4
#endif
#ifndef ENG_MASK
#define ENG_MASK 15
#endif
#ifndef ONE_LAUNCH
#define ONE_LAUNCH 1
#endif

typedef unsigned short bf16_t;
typedef short bf16x8 __attribute__((ext_vector_type(8)));
typedef float f32x4 __attribute__((ext_vector_type(4)));
typedef unsigned u32x4 __attribute__((ext_vector_type(4)));

constexpr int NB = 8, SEQ = 4096, DM = 1024, MT = NB * SEQ, DIN = 4352, DEPTH = 2;
constexpr int ZA = 0, ZB = 256, ZQ = 768, ZK = 1536, ZV = 2304, ZD = 3072, ZG = 3328;
constexpr int NTHREADS = 512, NWAVES = 8;
constexpr int LDS_BYTES = 147456;

constexpr size_t WS_CTL = 0;
constexpr size_t WS_WIN = 65536;
constexpr size_t WS_WG = WS_WIN + (size_t)DEPTH * DIN * DM * 2;
constexpr size_t WS_WB = WS_WG + (size_t)DEPTH * 4096 * DM * 2;
constexpr size_t WS_WO = WS_WB + (size_t)DEPTH * 4 * 1024 * 256 * 2;
constexpr size_t WS_WF = WS_WO + (size_t)DEPTH * DM * DM * 2;
constexpr size_t WS_WPW = WS_WF + (size_t)DEPTH * 65536 * 2;
constexpr size_t WS_WPOOL = WS_WPW + (size_t)DEPTH * 65536 * 2;
constexpr size_t WS_TW = WS_WPOOL + (size_t)DEPTH * 4 * 4096 * 2;
constexpr size_t WS_RC = WS_TW + 4096 * 8;
constexpr size_t WS_RS = WS_RC + 4096 * 32 * 4;
constexpr size_t WS_H = WS_RS + 4096 * 32 * 4;
constexpr size_t WS_Z = WS_H + (size_t)MT * DM * 2;
constexpr size_t WS_P = WS_Z + (size_t)MT * DIN * 2;
constexpr size_t WS_FY = WS_P + (size_t)MT * DM * 2;
constexpr size_t WS_LSE = WS_FY + (size_t)NB * 4 * 64 * 64 * 64 * 4;
constexpr size_t WS_END = WS_LSE + (size_t)3 * MT * 4 * 4;

struct Args { const float* in[16]; float* out; unsigned char* ws; int ph_lo, ph_hi; };

__device__ __forceinline__ float bf2f(bf16_t v) { return __uint_as_float((unsigned)v << 16); }
__device__ __forceinline__ float bflo(unsigned w) { return __uint_as_float(w << 16); }
__device__ __forceinline__ float bfhi(unsigned w) { return __uint_as_float(w & 0xffff0000u); }
__device__ __forceinline__ bf16_t f2bf(float f) { unsigned u = __float_as_uint(f); u += 0x7fffu + ((u >> 16) & 1u); return (bf16_t)(u >> 16); }
typedef float f32x2n __attribute__((ext_vector_type(2)));
typedef __bf16 bf16x2n __attribute__((ext_vector_type(2)));
__device__ __forceinline__ unsigned pk2(float lo, float hi) { const f32x2n v = {lo, hi}; return __builtin_bit_cast(unsigned, __builtin_convertvector(v, bf16x2n)); }
__device__ __forceinline__ float sigmoidf_(float x) { return 1.f / (1.f + __expf(-x)); }
__device__ __forceinline__ float siluf_(float x) { return x / (1.f + __expf(-x)); }
__device__ __forceinline__ int opq(int v) { asm volatile("" : "+v"(v)); return v; }
#define TIDX opq((int)threadIdx.x)
__device__ __forceinline__ int opqs(int v) { asm volatile("" : "+s"(v)); return v; }
#define BIDX opqs((int)blockIdx.x)
__device__ __forceinline__ float wave_sum(float v) {
#pragma unroll
    for (int o = 1; o < 64; o <<= 1) v += __shfl_xor(v, o);
    return v;
}

struct Ctx {
    const float *x, *norm_g, *w_in, *w_fourier, *conv_w, *conv_b, *conv_ln_g, *conv_ln_b, *w_pw, *w_pool, *pool_scale, *w_branch, *w_gate, *b_gate, *w_out, *final_g;
    float* out;
    bf16_t *WinT, *WgT, *WbT, *WoT, *WfT, *WpwT, *WpoolT, *H, *Z, *P;
    float2* TW; float *RC, *RS, *LSE; unsigned* FY;
};

__device__ __forceinline__ void transpose_mat(const float* W, int K, int N, bf16_t* WT, float* scr) {
    const int t = TIDX, nkb = K / 64, nnb = N / 64;
    for (int item = BIDX; item < nkb * nnb; item += gridDim.x) {
        const int kb = item / nnb, nb = item % nnb;
#pragma unroll
        for (int i = 0; i < 8; ++i) { const int kk = (t >> 6) + 8 * i, nn = t & 63; scr[kk * 65 + nn] = W[(size_t)(kb * 64 + kk) * N + nb * 64 + nn]; }
        __syncthreads();
#pragma unroll
        for (int i = 0; i < 8; ++i) { const int nn = (t >> 6) + 8 * i, kk = t & 63; WT[(size_t)(nb * 64 + nn) * K + kb * 64 + kk] = f2bf(scr[kk * 65 + nn]); }
        __syncthreads();
    }
}
__device__ __forceinline__ void phase_pre(const Ctx& c, float* lds) {
    for (int l = 0; l < DEPTH; ++l) {
        transpose_mat(c.w_in + (size_t)l * DM * DIN, DM, DIN, c.WinT + (size_t)l * DIN * DM, lds);
        for (int n = 0; n < 4; ++n) {
            transpose_mat(c.w_gate + (size_t)(l * 4 + n) * DM * DM, DM, DM, c.WgT + ((size_t)l * 4096 + n * 1024) * DM, lds);
            transpose_mat(c.w_branch + (size_t)(l * 4 + n) * 256 * DM, 256, DM, c.WbT + (size_t)(l * 4 + n) * 1024 * 256, lds);
        }
        transpose_mat(c.w_out + (size_t)l * DM * DM, DM, DM, c.WoT + (size_t)l * DM * DM, lds);
        transpose_mat(c.w_fourier + (size_t)l * 65536, 256, 256, c.WfT + (size_t)l * 65536, lds);
        transpose_mat(c.w_pw + (size_t)l * 65536, 256, 256, c.WpwT + (size_t)l * 65536, lds);
        for (int n = 0; n < 4; ++n) transpose_mat(c.w_pool + (size_t)(l * 4 + n) * 4096, 64, 64, c.WpoolT + (size_t)(l * 4 + n) * 4096, lds);
    }
    const int gt = BIDX * NTHREADS + TIDX, NT = gridDim.x * NTHREADS;
    for (int i = gt; i < 4096; i += NT) { float s, co; sincospif((float)i / 2048.f, &s, &co); c.TW[i] = make_float2(co, s); }
    for (int i = gt; i < 4096 * 32; i += NT) {
        const int pos = i >> 5, k = i & 31;
        const float inv = exp2f(-(float)k * (13.287712379549449f / 32.0f));
        double tq = (double)pos * (double)inv * 0.3183098861837907;
        tq -= 2.0 * rint(tq * 0.5);
        float s, co; sincospif((float)tq, &s, &co);
        c.RC[i] = co; c.RS[i] = s;
    }
}

__device__ __forceinline__ void phase_norm_bf16(const float* xin, const float* g, bf16_t* H) {
    const int tid_ = TIDX; const int lane = tid_ & 63, wave = tid_ >> 6;
    const int gw = BIDX * NWAVES + wave, NGW = gridDim.x * NWAVES;
    f32x4 gv[4];
#pragma unroll
    for (int j = 0; j < 4; ++j) gv[j] = *(const f32x4*)(g + 4 * (lane + 64 * j));
    for (int m = gw; m < MT; m += NGW) {
        const f32x4* xr = (const f32x4*)(xin + (size_t)m * DM);
        f32x4 v[4]; float s = 0.f;
#pragma unroll
        for (int j = 0; j < 4; ++j) { v[j] = xr[lane + 64 * j]; s += v[j].x * v[j].x + v[j].y * v[j].y + v[j].z * v[j].z + v[j].w * v[j].w; }
        const float rstd = 1.0f / sqrtf(wave_sum(s) * (1.f / DM) + 1e-6f);
        uint2* o = (uint2*)(H + (size_t)m * DM);
#pragma unroll
        for (int j = 0; j < 4; ++j) { const f32x4 y = v[j] * rstd * gv[j]; o[lane + 64 * j] = make_uint2(pk2(y.x, y.y), pk2(y.z, y.w)); }
    }
}
__device__ __forceinline__ void phase_norm_final(float* xio, const float* g) {
    const int tid_ = TIDX; const int lane = tid_ & 63, wave = tid_ >> 6;
    const int gw = BIDX * NWAVES + wave, NGW = gridDim.x * NWAVES;
    f32x4 gv[4];
#pragma unroll
    for (int j = 0; j < 4; ++j) gv[j] = *(const f32x4*)(g + 4 * (lane + 64 * j));
    for (int m = gw; m < MT; m += NGW) {
        f32x4* xr = (f32x4*)(xio + (size_t)m * DM);
        f32x4 v[4]; float s = 0.f;
#pragma unroll
        for (int j = 0; j < 4; ++j) { v[j] = xr[lane + 64 * j]; s += v[j].x * v[j].x + v[j].y * v[j].y + v[j].z * v[j].z + v[j].w * v[j].w; }
        const float rstd = 1.0f / sqrtf(wave_sum(s) * (1.f / DM) + 1e-6f);
#pragma unroll
        for (int j = 0; j < 4; ++j) xr[lane + 64 * j] = v[j] * rstd * gv[j];
    }
}

template <class Epi>
__device__ __forceinline__ void gemm_simple(const bf16_t* A, int lda, const bf16_t* Bt, int ldb, int Mr, int N, int K, const Epi& epi) {
    const int tid_ = TIDX; const int wid = tid_ >> 6, lane = tid_ & 63, fr = lane & 15, fq = lane >> 4;
    const int nM = Mr / 128, nN = N / 64;
    for (int u = BIDX; u < nM * nN; u += gridDim.x) {
        const int pm = u / nN, pn = u % nN;
        const bf16_t* ap = A + (size_t)(pm * 128 + wid * 16 + fr) * lda + fq * 8;
        const bf16_t* bp = Bt + (size_t)(pn * 64 + fr) * ldb + fq * 8;
        f32x4 acc[4];
#pragma unroll
        for (int n = 0; n < 4; ++n) acc[n] = (f32x4){0.f, 0.f, 0.f, 0.f};
        for (int k0 = 0; k0 < K; k0 += 32) {
            const bf16x8 a = *(const bf16x8*)(ap + k0);
#pragma unroll
            for (int n = 0; n < 4; ++n) { const bf16x8 b = *(const bf16x8*)(bp + (size_t)n * 16 * ldb + k0); acc[n] = __builtin_amdgcn_mfma_f32_16x16x32_bf16(a, b, acc[n], 0, 0, 0); }
        }
#pragma unroll
        for (int n = 0; n < 4; ++n)
#pragma unroll
            for (int j = 0; j < 4; ++j) epi(pm * 128 + wid * 16 + fq * 4 + j, pn * 64 + n * 16 + fr, acc[n][j]);
    }
}
struct EpiZ { bf16_t* Z; __device__ __forceinline__ void operator()(int r, int c, float v) const { Z[(size_t)r * DIN + c] = f2bf(v); } };
struct EpiGate { bf16_t* MG; const float* bg; __device__ __forceinline__ void operator()(int r, int c, float v) const { MG[(size_t)r * 4096 + c] = f2bf(sigmoidf_(v + bg[c])); } };
struct EpiOut { const float* xin; float* out; __device__ __forceinline__ void operator()(int r, int c, float v) const { const size_t i = (size_t)r * DM + c; out[i] = xin[i] + v; } };

__device__ __forceinline__ void gemm_merge(const bf16_t* P, const bf16_t* WbT, const bf16_t* MG, bf16_t* MERGED) {
    const int tid_ = TIDX; const int wid = tid_ >> 6, lane = tid_ & 63, fr = lane & 15, fq = lane >> 4;
    const int nM = MT / 128, nN = DM / 64;
    for (int u = BIDX; u < nM * nN; u += gridDim.x) {
        const int pm = u / nN, pn = u % nN;
        f32x4 tot[4];
#pragma unroll
        for (int n = 0; n < 4; ++n) tot[n] = (f32x4){0.f, 0.f, 0.f, 0.f};
        for (int n4 = 0; n4 < 4; ++n4) {
            const bf16_t* ap = P + (size_t)(pm * 128 + wid * 16 + fr) * DM + n4 * 256 + fq * 8;
            const bf16_t* bp = WbT + (size_t)n4 * 1024 * 256 + (size_t)(pn * 64 + fr) * 256 + fq * 8;
            f32x4 acc[4];
#pragma unroll
            for (int n = 0; n < 4; ++n) acc[n] = (f32x4){0.f, 0.f, 0.f, 0.f};
            for (int k0 = 0; k0 < 256; k0 += 32) {
                const bf16x8 a = *(const bf16x8*)(ap + k0);
#pragma unroll
                for (int n = 0; n < 4; ++n) { const bf16x8 b = *(const bf16x8*)(bp + (size_t)n * 16 * 256 + k0); acc[n] = __builtin_amdgcn_mfma_f32_16x16x32_bf16(a, b, acc[n], 0, 0, 0); }
            }
#pragma unroll
            for (int n = 0; n < 4; ++n)
#pragma unroll
                for (int j = 0; j < 4; ++j) { const int r = pm * 128 + wid * 16 + fq * 4 + j, cc = pn * 64 + n * 16 + fr; tot[n][j] += bf2f(MG[(size_t)r * 4096 + n4 * 1024 + cc]) * acc[n][j]; }
        }
#pragma unroll
        for (int n = 0; n < 4; ++n)
#pragma unroll
            for (int j = 0; j < 4; ++j) { const int r = pm * 128 + wid * 16 + fq * 4 + j, cc = pn * 64 + n * 16 + fr; MERGED[(size_t)r * DM + cc] = f2bf(tot[n][j]); }
    }
}

__device__ __forceinline__ void fft1_unit(const Ctx& c, int u, float* lds) {
    const int t = TIDX, s2 = u & 63, bg = u >> 6, g = bg & 3, b = bg >> 2;
    float* U = lds; float* Wre = lds + 64 * 65; float* Wim = Wre + 4096; float* cs = Wim + 4096; float* sn = cs + 64;
    if (t < 64) { float s, co; sincospif((float)t / 32.f, &s, &co); cs[t] = co; sn[t] = s; }
#pragma unroll
    for (int i = 0; i < 8; ++i) { const int s1 = (t >> 6) + 8 * i, ci = t & 63; U[s1 * 65 + ci] = bf2f(c.Z[(size_t)(b * SEQ + 64 * s1 + s2) * DIN + ZA + 64 * g + ci]); }
    __syncthreads();
    const int cp = t & 63;
#pragma unroll 1
    for (int i = 0; i < 8; ++i) {
        const int s1 = (t >> 6) + 8 * i; float re = 0.f, im = 0.f;
        for (int ci = 0; ci < 64; ++ci) { const float x = U[s1 * 65 + ci]; const int e = (ci * cp) & 63; re += x * cs[e]; im -= x * sn[e]; }
        Wre[s1 * 64 + cp] = re; Wim[s1 * 64 + cp] = im;
    }
    __syncthreads();
#pragma unroll 1
    for (int i = 0; i < 8; ++i) {
        const int k1 = (t >> 6) + 8 * i; float yr = 0.f, yi = 0.f;
        for (int s1 = 0; s1 < 64; ++s1) { const int e = (k1 * s1) & 63; const float co = cs[e], si = sn[e], wr = Wre[s1 * 64 + cp], wi = Wim[s1 * 64 + cp]; yr += co * wr + si * wi; yi += co * wi - si * wr; }
        const float2 tw = c.TW[(k1 * s2) & 4095];
        const float zr = yr * tw.x + yi * tw.y, zi = yi * tw.x - yr * tw.y;
        c.FY[((size_t)(bg * 64 + k1) * 64 + s2) * 64 + cp] = pk2(zr, zi);
    }
    __syncthreads();
}

__device__ __forceinline__ void tok_unit(const Ctx& c, int l, int u, float* lds) {
    const int t = TIDX, lane = t & 63, wave = t >> 6, ch = t & 255, half = t >> 8;
    const int b = u >> 6, s0 = (u & 63) * 64, tok0 = b * SEQ + s0;
    float* A = lds;
#pragma unroll 1
    for (int i = 0; i < 47; ++i) {
        const int r = half + 2 * i, s = s0 - 15 + r; float val = 0.f;
        if (s >= 0 && s < SEQ) { const bf16_t* zr = c.Z + (size_t)(b * SEQ + s) * DIN + ZB; val = bf2f(zr[ch]) * sigmoidf_(bf2f(zr[256 + ch])); }
        A[r * 256 + ch] = val;
    }
    __syncthreads();
    float y[32];
    {
        float cw[31];
#pragma unroll
        for (int w = 0; w < 31; ++w) cw[w] = c.conv_w[(size_t)l * 31 * 256 + w * 256 + ch];
        const float cb = c.conv_b[l * 256 + ch];
#pragma unroll
        for (int cc = 0; cc < 4; ++cc) {
            float rows[38];
#pragma unroll
            for (int r = 0; r < 38; ++r) rows[r] = A[(half * 32 + cc * 8 + r) * 256 + ch];
#pragma unroll
            for (int i = 0; i < 8; ++i) {
                float acc = cb;
#pragma unroll
                for (int w = 0; w < 31; ++w) acc += rows[i + w] * cw[w];
                y[cc * 8 + i] = acc;
            }
            __builtin_amdgcn_sched_barrier(0);
        }
    }
    __syncthreads();
#pragma unroll
    for (int i = 0; i < 32; ++i) A[(half * 32 + i) * 256 + ch] = y[i];
    __syncthreads();
    {
        float lg[4], lb[4];
#pragma unroll
        for (int q = 0; q < 4; ++q) { lg[q] = c.conv_ln_g[l * 256 + lane + 64 * q]; lb[q] = c.conv_ln_b[l * 256 + lane + 64 * q]; }
        for (int i = 0; i < 8; ++i) {
            const int tk = wave * 8 + i; float xv[4]; float s = 0.f;
#pragma unroll
            for (int q = 0; q < 4; ++q) { xv[q] = A[tk * 256 + lane + 64 * q]; s += xv[q]; }
            const float mean = wave_sum(s) * (1.f / 256.f); float s2 = 0.f;
#pragma unroll
            for (int q = 0; q < 4; ++q) { xv[q] -= mean; s2 += xv[q] * xv[q]; }
            const float rstd = 1.0f / sqrtf(wave_sum(s2) * (1.f / 256.f) + 1e-5f);
#pragma unroll
            for (int q = 0; q < 4; ++q) { const float yv = xv[q] * rstd * lg[q] + lb[q]; A[tk * 256 + lane + 64 * q] = siluf_(yv); }
        }
    }
    __syncthreads();
    {
        float acc[32];
#pragma unroll
        for (int i = 0; i < 32; ++i) acc[i] = 0.f;
        const float* W = c.w_pw + (size_t)l * 65536;
#pragma unroll 2
        for (int k = 0; k < 256; ++k) {
            const float wv = W[k * 256 + ch];
#pragma unroll
            for (int i = 0; i < 32; ++i) acc[i] += A[(half * 32 + i) * 256 + k] * wv;
        }
        __syncthreads();
#pragma unroll
        for (int i = 0; i < 32; ++i) A[(half * 32 + i) * 256 + ch] = acc[i];
        __syncthreads();
#pragma unroll 1
        for (int i = 0; i < 32; ++i) {
            const size_t tok = tok0 + half * 32 + i;
            const float gp = bf2f(c.Z[tok * DIN + ZG + 256 + ch]);
            c.P[tok * DM + 256 + ch] = f2bf(A[(half * 32 + i) * 256 + ch] * siluf_(gp));
        }
    }
    __syncthreads();
#pragma unroll 1
    for (int i = 0; i < 40; ++i) {
        const int r = half + 2 * i;
        if (r < 79) { const int s = s0 - 8 + r; float val = 0.f; if (s >= 0 && s < SEQ) val = bf2f(c.Z[(size_t)(b * SEQ + s) * DIN + ZD + ch]); A[r * 256 + ch] = val; }
    }
    __syncthreads();
    float* PL = lds + 79 * 256;
    {
        const int gi = ch >> 6, sz = 2 << gi;
#pragma unroll 1
        for (int i = 0; i < 32; ++i) {
            const int tk = half * 32 + i, s = s0 + tk;
            int lo = s - sz / 2; if (lo < 0) lo = 0;
            int hi = s + sz - 1 - sz / 2; if (hi > SEQ - 1) hi = SEQ - 1;
            float sum = 0.f;
            for (int p = lo; p <= hi; ++p) sum += A[(p - s0 + 8) * 256 + ch];
            PL[tk * 256 + ch] = sum / (float)(hi - lo + 1) - A[(tk + 8) * 256 + ch];
        }
    }
    __syncthreads();
    {
        const int gi = ch >> 6, dd = ch & 63;
        float acc[32];
#pragma unroll
        for (int i = 0; i < 32; ++i) acc[i] = 0.f;
        const float* W = c.w_pool + (size_t)(l * 4 + gi) * 4096;
#pragma unroll 2
        for (int k = 0; k < 64; ++k) {
            const float wv = W[k * 64 + dd];
#pragma unroll
            for (int i = 0; i < 32; ++i) acc[i] += PL[(half * 32 + i) * 256 + gi * 64 + k] * wv;
        }
        const float ps = c.pool_scale[l * 256 + ch];
        __syncthreads();
#pragma unroll
        for (int i = 0; i < 32; ++i) A[(half * 32 + i) * 256 + ch] = acc[i];
        __syncthreads();
#pragma unroll 1
        for (int i = 0; i < 32; ++i) {
            const size_t tok = tok0 + half * 32 + i;
            const float gp = bf2f(c.Z[tok * DIN + ZG + 768 + ch]);
            c.P[tok * DM + 768 + ch] = f2bf(A[(half * 32 + i) * 256 + ch] * ps * siluf_(gp));
        }
    }
    __syncthreads();
}

__device__ __forceinline__ void attn_unit(const Ctx& c, int u, float* ldsf, bool do_store = true) {
    unsigned* lds = (unsigned*)ldsf;
    const int t = TIDX;
    const int b = u / 192, rem = u % 192, g = rem >> 6, rem2 = rem & 63, hI = rem2 >> 4, rq = rem2 & 15;
    const int d = 1 << (2 * g), L = SEQ / d, nqb = L / 256, r = rq / nqb, qb = rq % nqb, hh = g * 4 + hI, i0 = qb * 256;
    unsigned* Kt = lds; unsigned* Vt = lds + 384 * 33;
    for (int pass = 0; pass < 2; ++pass) {
        const int jl = pass * 256 + (t >> 1), hf = t & 1, j = i0 - 64 + jl;
        if (jl < 384 && j >= 0 && j < L) {
            const int pos = r + d * j; const size_t tok = (size_t)b * SEQ + pos;
            const u32x4* kr = (const u32x4*)(c.Z + tok * DIN + ZK + hh * 64);
            unsigned kw[32];
#pragma unroll
            for (int q = 0; q < 8; ++q) { const u32x4 v = kr[q]; kw[4 * q] = v.x; kw[4 * q + 1] = v.y; kw[4 * q + 2] = v.z; kw[4 * q + 3] = v.w; }
            const float* rc = c.RC + pos * 32; const float* rs = c.RS + pos * 32;
#pragma unroll
            for (int w = 0; w < 16; ++w) {
                const float lo0 = bflo(kw[w]), lo1 = bfhi(kw[w]), hi0 = bflo(kw[16 + w]), hi1 = bfhi(kw[16 + w]);
                const float c0 = rc[2 * w], c1 = rc[2 * w + 1], s0 = rs[2 * w], s1 = rs[2 * w + 1];
                float o0, o1;
                if (hf == 0) { o0 = lo0 * c0 - hi0 * s0; o1 = lo1 * c1 - hi1 * s1; } else { o0 = hi0 * c0 + lo0 * s0; o1 = hi1 * c1 + lo1 * s1; }
                Kt[jl * 33 + hf * 16 + w] = pk2(o0, o1);
            }
            const u32x4* vr = (const u32x4*)(c.Z + tok * DIN + ZV + hh * 64 + hf * 32);
#pragma unroll
            for (int q = 0; q < 4; ++q) { const u32x4 v = vr[q]; Vt[jl * 33 + hf * 16 + 4 * q] = v.x; Vt[jl * 33 + hf * 16 + 4 * q + 1] = v.y; Vt[jl * 33 + hf * 16 + 4 * q + 2] = v.z; Vt[jl * 33 + hf * 16 + 4 * q + 3] = v.w; }
        }
    }
    const int ql = t >> 1, hf = t & 1, iq = i0 + ql, posq = r + d * iq;
    const size_t tokq = (size_t)b * SEQ + posq;
    bf16_t* qrow = c.Z + tokq * DIN + ZQ + hh * 64;
    float qv[32];
    {
        const u32x4* qr = (const u32x4*)qrow;
        unsigned kw[32];
#pragma unroll
        for (int q = 0; q < 8; ++q) { const u32x4 v = qr[q]; kw[4 * q] = v.x; kw[4 * q + 1] = v.y; kw[4 * q + 2] = v.z; kw[4 * q + 3] = v.w; }
        const float* rc = c.RC + posq * 32; const float* rs = c.RS + posq * 32;
#pragma unroll
        for (int w = 0; w < 16; ++w) {
            const float lo0 = bflo(kw[w]), lo1 = bfhi(kw[w]), hi0 = bflo(kw[16 + w]), hi1 = bfhi(kw[16 + w]);
            const float c0 = rc[2 * w], c1 = rc[2 * w + 1], s0 = rs[2 * w], s1 = rs[2 * w + 1];
            if (hf == 0) { qv[2 * w] = (lo0 * c0 - hi0 * s0) * 0.125f; qv[2 * w + 1] = (lo1 * c1 - hi1 * s1) * 0.125f; }
            else { qv[2 * w] = (hi0 * c0 + lo0 * s0) * 0.125f; qv[2 * w + 1] = (hi1 * c1 + lo1 * s1) * 0.125f; }
        }
    }
    __syncthreads();
    float m = -1e30f, lsum = 0.f, o[32];
#pragma unroll
    for (int w = 0; w < 32; ++w) o[w] = 0.f;
    for (int t2 = 0; t2 <= 128; ++t2) {
        const int j = iq - 64 + t2;
        if (j >= 0 && j < L) {
            const int jl = ql + t2;
            const unsigned* kp = Kt + jl * 33 + hf * 16;
            float sp = 0.f;
#pragma unroll
            for (int w = 0; w < 16; ++w) { const unsigned kwv = kp[w]; sp += qv[2 * w] * bflo(kwv) + qv[2 * w + 1] * bfhi(kwv); }
            const float s = sp + __shfl_xor(sp, 1);
            const float mn = fmaxf(m, s), corr = __expf(m - mn), p = __expf(s - mn);
            lsum = lsum * corr + p; m = mn;
            const unsigned* vp = Vt + jl * 33 + hf * 16;
#pragma unroll
            for (int w = 0; w < 16; ++w) { const unsigned vw = vp[w]; o[2 * w] = o[2 * w] * corr + p * bflo(vw); o[2 * w + 1] = o[2 * w + 1] * corr + p * bfhi(vw); }
        }
    }
    const float inv = 1.f / lsum;
    unsigned* orow = (unsigned*)(qrow + hf * 32);
    if (do_store) {
#pragma unroll
    for (int w = 0; w < 16; ++w) orow[w] = pk2(o[2 * w] * inv, o[2 * w + 1] * inv);
    if (hf == 0) c.LSE[((size_t)g * MT + tokq) * 4 + hI] = m + __logf(lsum);
    }
    __syncthreads();
}


typedef float f32x16 __attribute__((ext_vector_type(16)));
typedef unsigned u32x2 __attribute__((ext_vector_type(2)));
#define LASP __attribute__((address_space(3)))
__device__ __forceinline__ unsigned cvtpk(float lo, float hi) { return pk2(lo, hi); }
__device__ __forceinline__ void attn_unit_mfma(const Ctx& c, int u, unsigned char* lds_raw, bool do_store = true) {
    LASP unsigned char* Kt = (LASP unsigned char*)lds_raw;
    LASP unsigned* Vt = (LASP unsigned*)(lds_raw + 49152);
    const int t = TIDX, lane = t & 63, wave = __builtin_amdgcn_readfirstlane(t >> 6), rq = lane & 31, h = lane >> 5;
    const int b = u / 192, rem = u % 192, g = rem >> 6, rem2 = rem & 63, hI = rem2 >> 4, rqb = rem2 & 15;
    const int d = 1 << (2 * g), L = SEQ / d, nqb = L / 256, r = rqb / nqb, qb = rqb % nqb, hh = g * 4 + hI, i0 = qb * 256;
#pragma unroll
    for (int i = 0; i < 3; ++i) {
        const int id = t + 512 * i, row = id >> 2, dc = id & 3, j = i0 - 64 + row;
        u32x4 olo = (u32x4){0u, 0u, 0u, 0u}, ohi = olo;
        if (j >= 0 && j < L) {
            const int pos = r + d * j;
            const bf16_t* kr = c.Z + ((size_t)b * SEQ + pos) * DIN + ZK + hh * 64 + 8 * dc;
            const u32x4 a = *(const u32x4*)kr, bq = *(const u32x4*)(kr + 32);
            const f32x4 c0 = *(const f32x4*)(c.RC + pos * 32 + 8 * dc), c1 = *(const f32x4*)(c.RC + pos * 32 + 8 * dc + 4);
            const f32x4 s0 = *(const f32x4*)(c.RS + pos * 32 + 8 * dc), s1 = *(const f32x4*)(c.RS + pos * 32 + 8 * dc + 4);
#pragma unroll
            for (int e = 0; e < 4; ++e) {
                const float l0 = bflo(a[e]), l1 = bfhi(a[e]), h0 = bflo(bq[e]), h1 = bfhi(bq[e]);
                const float cc0 = (e < 2) ? c0[2 * e] : c1[2 * e - 4], cc1 = (e < 2) ? c0[2 * e + 1] : c1[2 * e - 3];
                const float ss0 = (e < 2) ? s0[2 * e] : s1[2 * e - 4], ss1 = (e < 2) ? s0[2 * e + 1] : s1[2 * e - 3];
                olo[e] = pk2(l0 * cc0 - h0 * ss0, l1 * cc1 - h1 * ss1);
                ohi[e] = pk2(h0 * cc0 + l0 * ss0, h1 * cc1 + l1 * ss1);
            }
        }
        *(LASP u32x4*)(Kt + row * 128 + ((dc ^ (row & 7)) << 4)) = olo;
        *(LASP u32x4*)(Kt + row * 128 + (((4 + dc) ^ (row & 7)) << 4)) = ohi;
    }
#pragma unroll
    for (int i = 0; i < 3; ++i) {
        const int id = t + 512 * i, rp = id % 192, dc8 = id / 192, j0 = i0 - 64 + 2 * rp;
        u32x4 v0 = (u32x4){0u, 0u, 0u, 0u}, v1 = v0;
        if (j0 >= 0 && j0 < L) v0 = *(const u32x4*)(c.Z + ((size_t)b * SEQ + r + d * j0) * DIN + ZV + hh * 64 + 8 * dc8);
        if (j0 + 1 >= 0 && j0 + 1 < L) v1 = *(const u32x4*)(c.Z + ((size_t)b * SEQ + r + d * (j0 + 1)) * DIN + ZV + hh * 64 + 8 * dc8);
#pragma unroll
        for (int e = 0; e < 4; ++e) {
            Vt[(8 * dc8 + 2 * e) * 194 + rp] = (v0[e] & 0xffffu) | (v1[e] << 16);
            Vt[(8 * dc8 + 2 * e + 1) * 194 + rp] = (v0[e] >> 16) | (v1[e] & 0xffff0000u);
        }
    }
    const int iq = i0 + 32 * wave + rq, posq = r + d * iq;
    const size_t tokq = (size_t)b * SEQ + posq;
    bf16_t* qrow = c.Z + tokq * DIN + ZQ + hh * 64;
    bf16x8 qf[4];
    {
        const u32x4 q0 = *(const u32x4*)(qrow + 8 * h), q1 = *(const u32x4*)(qrow + 16 + 8 * h), q2 = *(const u32x4*)(qrow + 32 + 8 * h), q3 = *(const u32x4*)(qrow + 48 + 8 * h);
        const float* rc = c.RC + posq * 32 + 8 * h; const float* rs = c.RS + posq * 32 + 8 * h;
        const f32x4 ca0 = *(const f32x4*)rc, ca1 = *(const f32x4*)(rc + 4), cb0 = *(const f32x4*)(rc + 16), cb1 = *(const f32x4*)(rc + 20);
        const f32x4 sa0 = *(const f32x4*)rs, sa1 = *(const f32x4*)(rs + 4), sb0 = *(const f32x4*)(rs + 16), sb1 = *(const f32x4*)(rs + 20);
        const float sc = 0.125f * 1.44269504f;
        u32x4 o0, o1, o2, o3;
#pragma unroll
        for (int e = 0; e < 4; ++e) {
            const float ca_0 = (e < 2) ? ca0[2 * e] : ca1[2 * e - 4], ca_1 = (e < 2) ? ca0[2 * e + 1] : ca1[2 * e - 3];
            const float sa_0 = (e < 2) ? sa0[2 * e] : sa1[2 * e - 4], sa_1 = (e < 2) ? sa0[2 * e + 1] : sa1[2 * e - 3];
            const float cb_0 = (e < 2) ? cb0[2 * e] : cb1[2 * e - 4], cb_1 = (e < 2) ? cb0[2 * e + 1] : cb1[2 * e - 3];
            const float sb_0 = (e < 2) ? sb0[2 * e] : sb1[2 * e - 4], sb_1 = (e < 2) ? sb0[2 * e + 1] : sb1[2 * e - 3];
            const float a0 = bflo(q0[e]), a1 = bfhi(q0[e]), b0 = bflo(q2[e]), b1 = bfhi(q2[e]);
            const float e0 = bflo(q1[e]), e1 = bfhi(q1[e]), f0 = bflo(q3[e]), f1 = bfhi(q3[e]);
            o0[e] = pk2((a0 * ca_0 - b0 * sa_0) * sc, (a1 * ca_1 - b1 * sa_1) * sc);
            o2[e] = pk2((b0 * ca_0 + a0 * sa_0) * sc, (b1 * ca_1 + a1 * sa_1) * sc);
            o1[e] = pk2((e0 * cb_0 - f0 * sb_0) * sc, (e1 * cb_1 - f1 * sb_1) * sc);
            o3[e] = pk2((f0 * cb_0 + e0 * sb_0) * sc, (f1 * cb_1 + e1 * sb_1) * sc);
        }
        qf[0] = __builtin_bit_cast(bf16x8, o0); qf[1] = __builtin_bit_cast(bf16x8, o1); qf[2] = __builtin_bit_cast(bf16x8, o2); qf[3] = __builtin_bit_cast(bf16x8, o3);
    }
    __syncthreads();
    f32x16 sacc[5];
#pragma unroll
    for (int kb = 0; kb < 5; ++kb) {
        f32x16 acc;
#pragma unroll
        for (int e = 0; e < 16; ++e) acc[e] = 0.f;
        const int row = 32 * wave + 32 * kb + rq;
#pragma unroll
        for (int s4 = 0; s4 < 4; ++s4) {
            const bf16x8 kf = *(const LASP bf16x8*)(Kt + row * 128 + (((2 * s4 + h) ^ (row & 7)) << 4));
            acc = __builtin_amdgcn_mfma_f32_32x32x16_bf16(kf, qf[s4], acc, 0, 0, 0);
        }
        sacc[kb] = acc;
    }
    const int jbase = i0 - 64 + 32 * wave;
    float mx = -1e30f;
#pragma unroll
    for (int kb = 0; kb < 5; ++kb)
#pragma unroll
        for (int e = 0; e < 16; ++e) {
            const int row = (e & 3) + 8 * (e >> 2) + 4 * h, rel = 32 * kb + row - rq, j = jbase + 32 * kb + row;
            const bool valid = (rel >= 0) && (rel <= 128) && (j >= 0) && (j < L);
            const float sv = valid ? sacc[kb][e] : -1e30f;
            sacc[kb][e] = sv; mx = fmaxf(mx, sv);
        }
    mx = fmaxf(mx, __shfl_xor(mx, 32));
    float lsum = 0.f;
#pragma unroll
    for (int kb = 0; kb < 5; ++kb)
#pragma unroll
        for (int e = 0; e < 16; ++e) { const float p = __builtin_amdgcn_exp2f(sacc[kb][e] - mx); sacc[kb][e] = p; lsum += p; }
    lsum += __shfl_xor(lsum, 32);
    f32x16 oacc[2];
#pragma unroll
    for (int db = 0; db < 2; ++db)
#pragma unroll
        for (int e = 0; e < 16; ++e) oacc[db][e] = 0.f;
#pragma unroll
    for (int kb = 0; kb < 5; ++kb)
#pragma unroll
        for (int s2 = 0; s2 < 2; ++s2) {
            u32x4 pw;
#pragma unroll
            for (int e = 0; e < 4; ++e) pw[e] = cvtpk(sacc[kb][8 * s2 + 2 * e], sacc[kb][8 * s2 + 2 * e + 1]);
            const bf16x8 pf = __builtin_bit_cast(bf16x8, pw);
            const int kp = (32 * wave + 32 * kb + 16 * s2 + 4 * h) >> 1;
#pragma unroll
            for (int db = 0; db < 2; ++db) {
                const LASP unsigned* vp = Vt + (32 * db + rq) * 194 + kp;
                const u32x2 g0 = *(const LASP u32x2*)vp, g1 = *(const LASP u32x2*)(vp + 4);
                const u32x4 aw = (u32x4){g0.x, g0.y, g1.x, g1.y};
                oacc[db] = __builtin_amdgcn_mfma_f32_32x32x16_bf16(__builtin_bit_cast(bf16x8, aw), pf, oacc[db], 0, 0, 0);
            }
        }
    if (do_store) {
        const float inv = 1.f / lsum;
#pragma unroll
        for (int db = 0; db < 2; ++db)
#pragma unroll
            for (int g4 = 0; g4 < 4; ++g4) {
                const u32x2 w = (u32x2){cvtpk(oacc[db][4 * g4] * inv, oacc[db][4 * g4 + 1] * inv), cvtpk(oacc[db][4 * g4 + 2] * inv, oacc[db][4 * g4 + 3] * inv)};
                *(u32x2*)(qrow + 32 * db + 8 * g4 + 4 * h) = w;
            }
        if (h == 0) c.LSE[((size_t)g * MT + tokq) * 4 + hI] = mx * 0.69314718f + __logf(lsum);
    }
    __syncthreads();
}


__device__ __forceinline__ f32x4 mfma16(bf16x8 a, bf16x8 b, f32x4 c) { return __builtin_amdgcn_mfma_f32_16x16x32_bf16(a, b, c, 0, 0, 0); }
template <int KSTEPS>
__device__ __forceinline__ void gemm64(const LASP unsigned char* Y, int kbyte0, const bf16_t* Bt, int ldb, f32x4 (&acc)[4][2], int fr, int fq) {
#pragma unroll 2
    for (int ks = 0; ks < KSTEPS; ++ks) {
        bf16x8 bfr[2], afr[4];
#pragma unroll
        for (int n = 0; n < 2; ++n) bfr[n] = *(const bf16x8*)(Bt + (size_t)(16 * n + fr) * ldb + ks * 32 + 8 * fq);
#pragma unroll
        for (int m = 0; m < 4; ++m) afr[m] = *(const LASP bf16x8*)(Y + (16 * m + fr) * 528 + kbyte0 + (ks * 32 + 8 * fq) * 2);
#pragma unroll
        for (int m = 0; m < 4; ++m)
#pragma unroll
            for (int n = 0; n < 2; ++n) acc[m][n] = mfma16(bfr[n], afr[m], acc[m][n]);
    }
}
__device__ __forceinline__ bf16x8 pack8(f32x4 lo, f32x4 hi) {
    u32x4 w; w.x = cvtpk(lo[0], lo[1]); w.y = cvtpk(lo[2], lo[3]); w.z = cvtpk(hi[0], hi[1]); w.w = cvtpk(hi[2], hi[3]);
    return __builtin_bit_cast(bf16x8, w);
}
__device__ __forceinline__ bf16x8 dft_frag(int rowidx, int kbase, int fq, bool perm, int which  ) {
    float v[8];
#pragma unroll
    for (int j = 0; j < 8; ++j) {
        const int k = kbase + (perm ? (16 * (j >> 2) + 4 * fq + (j & 3)) : (8 * fq + j));
        float sn, cs; sincospif((float)((rowidx * k) & 63) * (1.f / 32.f), &sn, &cs);
        v[j] = which == 0 ? cs : (which == 1 ? sn : -sn);
    }
    u32x4 w; w.x = pk2(v[0], v[1]); w.y = pk2(v[2], v[3]); w.z = pk2(v[4], v[5]); w.w = pk2(v[6], v[7]);
    return __builtin_bit_cast(bf16x8, w);
}

__device__ __forceinline__ void fft1_phase_mfma(const Ctx& c) {
    const int t = TIDX, lane = t & 63, wave = __builtin_amdgcn_readfirstlane(t >> 6), fr = lane & 15, fq = lane >> 4, n = wave & 3, hsel = wave >> 2;
    bf16x8 cA[2], sA[2], cB[2][2], sB[2][2], nsB[2][2];
#pragma unroll
    for (int ks = 0; ks < 2; ++ks) {
        cA[ks] = dft_frag(16 * n + fr, 32 * ks, fq, false, 0); sA[ks] = dft_frag(16 * n + fr, 32 * ks, fq, false, 1);
#pragma unroll
        for (int mbi = 0; mbi < 2; ++mbi) {
            const int k1r = 16 * (2 * hsel + mbi) + fr;
            cB[mbi][ks] = dft_frag(k1r, 32 * ks, fq, true, 0); sB[mbi][ks] = dft_frag(k1r, 32 * ks, fq, true, 1); nsB[mbi][ks] = dft_frag(k1r, 32 * ks, fq, true, 2);
        }
    }
    for (int u = BIDX; u < NB * 4 * 64; u += gridDim.x) {
        const int s2 = u & 63, bg = u >> 6, g = bg & 3, b = bg >> 2;
        f32x4 wre[4], wim[4];
#pragma unroll
        for (int m = 0; m < 4; ++m) { wre[m] = (f32x4){0.f, 0.f, 0.f, 0.f}; wim[m] = wre[m]; }
#pragma unroll
        for (int m = 0; m < 4; ++m)
#pragma unroll
            for (int ks = 0; ks < 2; ++ks) {
                const bf16x8 a = *(const bf16x8*)(c.Z + (size_t)(b * SEQ + 64 * (16 * m + fr) + s2) * DIN + ZA + 64 * g + 32 * ks + 8 * fq);
                wre[m] = mfma16(a, cA[ks], wre[m]); wim[m] = mfma16(a, sA[ks], wim[m]);
                asm volatile("" :: "v"(a), "v"(wre[m]), "v"(wim[m]));
            }
        asm volatile("s_nop 15\n\ts_nop 15" : "+v"(wre[0]), "+v"(wre[1]), "+v"(wre[2]), "+v"(wre[3]), "+v"(wim[0]), "+v"(wim[1]), "+v"(wim[2]), "+v"(wim[3]));
        bf16x8 bre[2], bim[2];
#pragma unroll
        for (int ks = 0; ks < 2; ++ks) { bre[ks] = pack8(wre[2 * ks], wre[2 * ks + 1]); bim[ks] = pack8(wim[2 * ks], wim[2 * ks + 1]); }
        asm volatile("s_nop 7" : "+v"(bre[0]), "+v"(bre[1]), "+v"(bim[0]), "+v"(bim[1]));
#pragma unroll
        for (int mbi = 0; mbi < 2; ++mbi) {
            f32x4 yre = (f32x4){0.f, 0.f, 0.f, 0.f}, yin = yre;
#pragma unroll
            for (int ks = 0; ks < 2; ++ks) {
                yre = mfma16(cB[mbi][ks], bre[ks], yre); yre = mfma16(nsB[mbi][ks], bim[ks], yre);
                yin = mfma16(cB[mbi][ks], bim[ks], yin); yin = mfma16(sB[mbi][ks], bre[ks], yin);
            }
            asm volatile("s_nop 15\n\ts_nop 15" : "+v"(yre), "+v"(yin));
#pragma unroll
            for (int rg = 0; rg < 4; ++rg) {
                const int k1 = 16 * (2 * hsel + mbi) + 4 * fq + rg;
                const float2 tw = c.TW[(k1 * s2) & 4095];
                const float yr = yre[rg], yi = -yin[rg];
                c.FY[((size_t)(bg * 64 + k1) * 64 + s2) * 64 + 16 * n + fr] = pk2(yr * tw.x + yi * tw.y, yi * tw.x - yr * tw.y);
            }
        }
    }
}

__device__ __forceinline__ void fft2_phase_mfma(const Ctx& c, int l, unsigned char* lds_raw) {
    LASP unsigned char* F = (LASP unsigned char*)lds_raw;
    const int t = TIDX, lane = t & 63, wave = __builtin_amdgcn_readfirstlane(t >> 6), fr = lane & 15, fq = lane >> 4, g = wave >> 1, nh = wave & 1;
    bf16x8 cF[4][2], sF[4][2];
#pragma unroll
    for (int m = 0; m < 4; ++m)
#pragma unroll
        for (int ks = 0; ks < 2; ++ks) { cF[m][ks] = dft_frag(16 * m + fr, 32 * ks, fq, false, 0); sF[m][ks] = dft_frag(16 * m + fr, 32 * ks, fq, false, 1); }
    for (int u = BIDX; u < NB * 64; u += gridDim.x) {
        const int b = u >> 6, k1 = u & 63;
        const unsigned* src = c.FY + (size_t)((b * 4 + g) * 64 + k1) * 4096;
#pragma unroll
        for (int nn = 0; nn < 2; ++nn) {
            const int cp = 16 * (2 * nh + nn) + fr;
            bf16x8 bre[2], bim[2];
#pragma unroll
            for (int ks = 0; ks < 2; ++ks) {
                unsigned w[8];
#pragma unroll
                for (int j = 0; j < 8; ++j) w[j] = src[(32 * ks + 8 * fq + j) * 64 + cp];
                u32x4 re, im;
#pragma unroll
                for (int e = 0; e < 4; ++e) { re[e] = (w[2 * e] & 0xffffu) | (w[2 * e + 1] << 16); im[e] = (w[2 * e] >> 16) | (w[2 * e + 1] & 0xffff0000u); }
                bre[ks] = __builtin_bit_cast(bf16x8, re); bim[ks] = __builtin_bit_cast(bf16x8, im);
            }
#pragma unroll
            for (int m = 0; m < 4; ++m) {
                f32x4 acc = (f32x4){0.f, 0.f, 0.f, 0.f};
#pragma unroll
                for (int ks = 0; ks < 2; ++ks) { acc = mfma16(bre[ks], cF[m][ks], acc); acc = mfma16(bim[ks], sF[m][ks], acc); }
                u32x2 wv; wv.x = cvtpk(acc[0] * (1.f / 512.f), acc[1] * (1.f / 512.f)); wv.y = cvtpk(acc[2] * (1.f / 512.f), acc[3] * (1.f / 512.f));
                *(LASP u32x2*)(F + (16 * m + fr) * 528 + (g * 64 + 16 * (2 * nh + nn) + 4 * fq) * 2) = wv;
            }
        }
        __syncthreads();
        f32x4 acc[4][2];
#pragma unroll
        for (int m = 0; m < 4; ++m)
#pragma unroll
            for (int n = 0; n < 2; ++n) acc[m][n] = (f32x4){0.f, 0.f, 0.f, 0.f};
        gemm64<8>(F, 0, c.WfT + (size_t)l * 65536 + (size_t)(32 * wave) * 256, 256, acc, fr, fq);
#pragma unroll
        for (int m = 0; m < 4; ++m)
#pragma unroll
            for (int n = 0; n < 2; ++n) {
                const size_t tok = (size_t)b * SEQ + k1 + 64 * (16 * m + fr); const int col = 32 * wave + 16 * n + 4 * fq;
                const u32x2 gp = *(const u32x2*)(c.Z + tok * DIN + ZG + col);
                u32x2 o; o.x = cvtpk(acc[m][n][0] * siluf_(bflo(gp.x)), acc[m][n][1] * siluf_(bfhi(gp.x))); o.y = cvtpk(acc[m][n][2] * siluf_(bflo(gp.y)), acc[m][n][3] * siluf_(bfhi(gp.y)));
                *(u32x2*)(c.P + tok * DM + col) = o;
            }
        __syncthreads();
    }
}

__device__ __forceinline__ void tok_unit_mfma(const Ctx& c, int l, int u, unsigned char* lds_raw) {
    LASP float* A = (LASP float*)lds_raw;
    LASP unsigned char* Y = (LASP unsigned char*)(lds_raw + 96256);
    const int t = TIDX, lane = t & 63, wave = __builtin_amdgcn_readfirstlane(t >> 6), ch = t & 255, half = t >> 8, fr = lane & 15, fq = lane >> 4;
    const int b = u >> 6, s0 = (u & 63) * 64, tok0 = b * SEQ + s0;
#pragma unroll 2
    for (int i = 0; i < 6; ++i) {
        const int id = t + 512 * i;
        if (id < 94 * 32) {
            const int row = id >> 5, c8 = (id & 31) * 8, sp = s0 - 15 + row;
            f32x4 v0 = (f32x4){0.f, 0.f, 0.f, 0.f}, v1 = v0;
            if (sp >= 0 && sp < SEQ) {
                const bf16_t* zr = c.Z + (size_t)(b * SEQ + sp) * DIN + ZB + c8;
                const u32x4 a = *(const u32x4*)zr, gg = *(const u32x4*)(zr + 256);
                v0[0] = bflo(a.x) * sigmoidf_(bflo(gg.x)); v0[1] = bfhi(a.x) * sigmoidf_(bfhi(gg.x)); v0[2] = bflo(a.y) * sigmoidf_(bflo(gg.y)); v0[3] = bfhi(a.y) * sigmoidf_(bfhi(gg.y));
                v1[0] = bflo(a.z) * sigmoidf_(bflo(gg.z)); v1[1] = bfhi(a.z) * sigmoidf_(bfhi(gg.z)); v1[2] = bflo(a.w) * sigmoidf_(bflo(gg.w)); v1[3] = bfhi(a.w) * sigmoidf_(bfhi(gg.w));
            }
            *(LASP f32x4*)(A + row * 256 + c8) = v0; *(LASP f32x4*)(A + row * 256 + c8 + 4) = v1;
        }
    }
    __syncthreads();
    float y[32];
    {
        float cw[31];
#pragma unroll
        for (int w = 0; w < 31; ++w) cw[w] = c.conv_w[(size_t)l * 31 * 256 + w * 256 + ch];
        const float cb = c.conv_b[l * 256 + ch];
#pragma unroll
        for (int cc = 0; cc < 4; ++cc) {
            float rows[38];
#pragma unroll
            for (int r = 0; r < 38; ++r) rows[r] = A[(half * 32 + cc * 8 + r) * 256 + ch];
#pragma unroll
            for (int i = 0; i < 8; ++i) {
                float acc = cb;
#pragma unroll
                for (int w = 0; w < 31; ++w) acc += rows[i + w] * cw[w];
                y[cc * 8 + i] = acc;
            }
            __builtin_amdgcn_sched_barrier(0);
        }
    }
    __syncthreads();
#pragma unroll
    for (int i = 0; i < 32; ++i) A[(half * 32 + i) * 256 + ch] = y[i];
    __syncthreads();
    {
        const f32x4 lg = *(const f32x4*)(c.conv_ln_g + l * 256 + 4 * lane), lb = *(const f32x4*)(c.conv_ln_b + l * 256 + 4 * lane);
#pragma unroll 2
        for (int i = 0; i < 8; ++i) {
            const int tk = wave * 8 + i;
            f32x4 xv = *(const LASP f32x4*)(A + tk * 256 + 4 * lane);
            const float mean = wave_sum((xv[0] + xv[1]) + (xv[2] + xv[3])) * (1.f / 256.f);
            xv = xv - mean;
            const float rstd = 1.0f / sqrtf(wave_sum((xv[0] * xv[0] + xv[1] * xv[1]) + (xv[2] * xv[2] + xv[3] * xv[3])) * (1.f / 256.f) + 1e-5f);
            const f32x4 yv = xv * rstd * lg + lb;
            u32x2 o; o.x = cvtpk(siluf_(yv[0]), siluf_(yv[1])); o.y = cvtpk(siluf_(yv[2]), siluf_(yv[3]));
            *(LASP u32x2*)(Y + tk * 528 + 8 * lane) = o;
        }
    }
    __syncthreads();
    {
        f32x4 acc[4][2];
#pragma unroll
        for (int m = 0; m < 4; ++m)
#pragma unroll
            for (int n = 0; n < 2; ++n) acc[m][n] = (f32x4){0.f, 0.f, 0.f, 0.f};
        gemm64<8>(Y, 0, c.WpwT + (size_t)l * 65536 + (size_t)(32 * wave) * 256, 256, acc, fr, fq);
#pragma unroll
        for (int m = 0; m < 4; ++m)
#pragma unroll
            for (int n = 0; n < 2; ++n) {
                const size_t tok = (size_t)tok0 + 16 * m + fr; const int col = 32 * wave + 16 * n + 4 * fq;
                const u32x2 gp = *(const u32x2*)(c.Z + tok * DIN + ZG + 256 + col);
                u32x2 o; o.x = cvtpk(acc[m][n][0] * siluf_(bflo(gp.x)), acc[m][n][1] * siluf_(bfhi(gp.x))); o.y = cvtpk(acc[m][n][2] * siluf_(bflo(gp.y)), acc[m][n][3] * siluf_(bfhi(gp.y)));
                *(u32x2*)(c.P + tok * DM + 256 + col) = o;
            }
    }
    __syncthreads();
#pragma unroll 2
    for (int i = 0; i < 5; ++i) {
        const int id = t + 512 * i;
        if (id < 79 * 32) {
            const int row = id >> 5, c8 = (id & 31) * 8, sp = s0 - 8 + row;
            f32x4 v0 = (f32x4){0.f, 0.f, 0.f, 0.f}, v1 = v0;
            if (sp >= 0 && sp < SEQ) {
                const u32x4 a = *(const u32x4*)(c.Z + (size_t)(b * SEQ + sp) * DIN + ZD + c8);
                v0[0] = bflo(a.x); v0[1] = bfhi(a.x); v0[2] = bflo(a.y); v0[3] = bfhi(a.y); v1[0] = bflo(a.z); v1[1] = bfhi(a.z); v1[2] = bflo(a.w); v1[3] = bfhi(a.w);
            }
            *(LASP f32x4*)(A + row * 256 + c8) = v0; *(LASP f32x4*)(A + row * 256 + c8 + 4) = v1;
        }
    }
    __syncthreads();
    {
        const int gi = ch >> 6, sz = 2 << gi;
#pragma unroll 1
        for (int i = 0; i < 32; ++i) {
            const int tk = half * 32 + i, sp = s0 + tk;
            int lo = sp - sz / 2; if (lo < 0) lo = 0;
            int hi = sp + sz - 1 - sz / 2; if (hi > SEQ - 1) hi = SEQ - 1;
            float sum = 0.f;
            for (int p = lo; p <= hi; ++p) sum += A[(p - s0 + 8) * 256 + ch];
            *(LASP bf16_t*)(Y + tk * 528 + ch * 2) = f2bf(sum / (float)(hi - lo + 1) - A[(tk + 8) * 256 + ch]);
        }
    }
    __syncthreads();
    {
        const int gi = wave >> 1, cb = (wave & 1) * 32;
        f32x4 acc[4][2];
#pragma unroll
        for (int m = 0; m < 4; ++m)
#pragma unroll
            for (int n = 0; n < 2; ++n) acc[m][n] = (f32x4){0.f, 0.f, 0.f, 0.f};
        gemm64<2>(Y, gi * 128, c.WpoolT + (size_t)(l * 4 + gi) * 4096 + (size_t)cb * 64, 64, acc, fr, fq);
#pragma unroll
        for (int m = 0; m < 4; ++m)
#pragma unroll
            for (int n = 0; n < 2; ++n) {
                const size_t tok = (size_t)tok0 + 16 * m + fr; const int col = gi * 64 + cb + 16 * n + 4 * fq;
                const u32x2 gp = *(const u32x2*)(c.Z + tok * DIN + ZG + 768 + col);
                const f32x4 ps = *(const f32x4*)(c.pool_scale + l * 256 + col);
                u32x2 o; o.x = cvtpk(acc[m][n][0] * ps[0] * siluf_(bflo(gp.x)), acc[m][n][1] * ps[1] * siluf_(bfhi(gp.x))); o.y = cvtpk(acc[m][n][2] * ps[2] * siluf_(bflo(gp.y)), acc[m][n][3] * ps[3] * siluf_(bfhi(gp.y)));
                *(u32x2*)(c.P + tok * DM + 768 + col) = o;
            }
    }
    __syncthreads();
}

__device__ __forceinline__ void fft2_unit(const Ctx& c, int l, int u, float* lds) {
    const int t = TIDX, b = u >> 6, k1 = u & 63, cp = t & 63;
    float* Ft = lds; float* Yre = lds + 64 * 260; float* Yim = Yre + 4096; float* cs = Yim + 4096; float* sn = cs + 64;
    if (t < 64) { float s, co; sincospif((float)t / 32.f, &s, &co); cs[t] = co; sn[t] = s; }
    for (int g = 0; g < 4; ++g) {
        const unsigned* src = c.FY + (size_t)((b * 4 + g) * 64 + k1) * 4096;
#pragma unroll
        for (int i = 0; i < 8; ++i) { const int idx = t + 512 * i; const unsigned w = src[idx]; Yre[idx] = bflo(w); Yim[idx] = bfhi(w); }
        __syncthreads();
#pragma unroll 1
        for (int i = 0; i < 8; ++i) {
            const int k2 = (t >> 6) + 8 * i; float acc = 0.f;
            for (int s2 = 0; s2 < 64; ++s2) { const int e = (k2 * s2) & 63; acc += cs[e] * Yre[s2 * 64 + cp] + sn[e] * Yim[s2 * 64 + cp]; }
            Ft[k2 * 260 + g * 64 + cp] = acc * (1.f / 512.f);
        }
        __syncthreads();
    }
    const int j = t & 255, half = t >> 8;
    float acc[32];
#pragma unroll
    for (int i = 0; i < 32; ++i) acc[i] = 0.f;
    const float* W = c.w_fourier + (size_t)l * 65536;
#pragma unroll 2
    for (int k = 0; k < 256; ++k) {
        const float wv = W[k * 256 + j];
#pragma unroll
        for (int i = 0; i < 32; ++i) acc[i] += Ft[(half * 32 + i) * 260 + k] * wv;
    }
    __syncthreads();
#pragma unroll
    for (int i = 0; i < 32; ++i) Ft[(half * 32 + i) * 260 + j] = acc[i];
    __syncthreads();
#pragma unroll 1
    for (int i = 0; i < 32; ++i) {
        const size_t tok = (size_t)b * SEQ + k1 + 64 * (half * 32 + i);
        const float gp = bf2f(c.Z[tok * DIN + ZG + j]);
        c.P[tok * DM + j] = f2bf(Ft[(half * 32 + i) * 260 + j] * siluf_(gp));
    }
    __syncthreads();
}

__device__ __forceinline__ void phase_combine(const Ctx& c) {
    const int gt = BIDX * NTHREADS + TIDX, NT = gridDim.x * NTHREADS;
    for (int idx = gt; idx < MT * 32; idx += NT) {
        const size_t m = idx >> 5; const int c8 = (idx & 31) * 8, hI = c8 >> 6;
        const float l0 = c.LSE[((size_t)0 * MT + m) * 4 + hI], l1 = c.LSE[((size_t)1 * MT + m) * 4 + hI], l2 = c.LSE[((size_t)2 * MT + m) * 4 + hI];
        const float mx = fmaxf(l0, fmaxf(l1, l2));
        const float e0 = __expf(l0 - mx), e1 = __expf(l1 - mx), e2 = __expf(l2 - mx), inv = 1.f / (e0 + e1 + e2);
        const float a0 = e0 * inv, a1 = e1 * inv, a2 = e2 * inv;
        const bf16_t* zr = c.Z + m * DIN;
        const u32x4 o0 = *(const u32x4*)(zr + ZQ + (0 * 4 + hI) * 64 + (c8 & 63));
        const u32x4 o1 = *(const u32x4*)(zr + ZQ + (1 * 4 + hI) * 64 + (c8 & 63));
        const u32x4 o2 = *(const u32x4*)(zr + ZQ + (2 * 4 + hI) * 64 + (c8 & 63));
        const u32x4 gp = *(const u32x4*)(zr + ZG + 512 + c8);
        u32x4 res;
#pragma unroll
        for (int q = 0; q < 4; ++q) {
            const float vlo = (a0 * bflo(o0[q]) + a1 * bflo(o1[q]) + a2 * bflo(o2[q])) * siluf_(bflo(gp[q]));
            const float vhi = (a0 * bfhi(o0[q]) + a1 * bfhi(o1[q]) + a2 * bfhi(o2[q])) * siluf_(bfhi(gp[q]));
            res[q] = pk2(vlo, vhi);
        }
        *(u32x4*)(c.P + m * DM + 512 + c8) = res;
    }
}

namespace pg8 {
#define PG8_LAS __attribute__((address_space(3)))
typedef unsigned short bf16_t;
typedef short bf16x8 __attribute__((ext_vector_type(8)));
typedef float f32x4 __attribute__((ext_vector_type(4)));
typedef unsigned u32x4 __attribute__((ext_vector_type(4)));
constexpr int BM = 256, BK = 64, HALF = 128, HTB = HALF * BK * 2  , STAGE_BYTES = 8 * HTB, NXCD = 8, WGM = 8;

__host__ __device__ __forceinline__ int lds_byte(int r, int c) { const int st = (r >> 4) * 2 + (c >> 5), rr = r & 15, cc = c & 31, ob = rr * 64 + cc * 2; return st * 1024 + (ob ^ (((ob >> 9) & 1) << 5)); }
__host__ __device__ __forceinline__ void stage_rc(int b, int& R, int& C) { const int st = b / 1024, sb = b % 1024, swz = sb ^ (((sb >> 9) & 1) << 5); R = (st >> 1) * 16 + swz / 64; C = (st & 1) * 32 + (swz % 64) / 2; }
__host__ __device__ __forceinline__ int perm32(int rho) { const int n = rho >> 4, i = rho & 15; return 8 * (i >> 2) + 4 * n + (i & 3); }

struct Unit { int pm, pn, sub; };
template <int LDA_, int LDB_, int K_, int ASUB_, int BSUB_> struct GemmT { const bf16_t* A; const bf16_t* Bt; static constexpr int lda = LDA_, ldb = LDB_, K = K_; static constexpr size_t a_sub = ASUB_, b_sub = BSUB_; };

struct StaticOrder {
    int nM, nN, nwg, G, c;
    __host__ __device__ void init(int M, int N, int G_, int c_) { nM = M / BM; nN = N / BM; nwg = nM * nN; G = G_; c = c_; }
    __host__ __device__ bool next(int i, Unit& u) const {
        const long L = (long)i * G + c; if (L >= nwg) return false;
        int wgid = (int)L; { const int q = nwg / NXCD, r = nwg % NXCD, xcd = wgid % NXCD, off = wgid / NXCD; wgid = (xcd < r ? xcd * (q + 1) : r * (q + 1) + (xcd - r) * q) + off; }
        const int nig = WGM * nN, gid = wgid / nig, fm = gid * WGM, gsz = (nM - fm) < WGM ? (nM - fm) : WGM;
        u.pm = fm + ((wgid % nig) % gsz); u.pn = (wgid % nig) / gsz; u.sub = 0; return true;
    }
    __device__ __forceinline__ void a_ready(const Unit&) const {}
    __device__ __forceinline__ void done(const Unit&) const {}
};


__device__ __forceinline__ unsigned cvt_pk_bf16(float lo, float hi) { return ::pk2(lo, hi); }
template <int ACT  > struct EpiBf16 {
    static constexpr bool PERM = true, AFTER_DRAIN = false; static_assert(ACT == 0 || ACT == 2, "EpiBf16: ACT is 0 (none) or 2 (sigmoid)");
    bf16_t* O; int ldc; const float* bias; int split_cols; size_t split_stride; float scale0;
    __device__ __forceinline__ void operator()(const f32x4 (&acc)[2][2][4][2], const Unit& u, int wr, int wc, int fr, int fq) const {
        asm volatile("" : "+v"(fr), "+v"(fq));
        const int row0 = u.pm * BM + wr * 64 + fr; int colt = u.pn * BM; bf16_t* base = O;
        float sc = 1.f; if (split_cols) { const int t = colt / split_cols; base += (size_t)t * split_stride; colt -= t * split_cols; if (t == 0) sc = scale0; }
        const int col0 = colt + wc * 32 + 8 * fq, bcol0 = u.pn * BM + wc * 32 + 8 * fq;
        f32x4 bv[2][2];
#pragma unroll
        for (int bj = 0; bj < 2; ++bj)
#pragma unroll
            for (int n = 0; n < 2; ++n) bv[bj][n] = bias ? *(const f32x4*)(bias + bcol0 + bj * HALF + 4 * n) : (f32x4){0.f, 0.f, 0.f, 0.f};
#pragma unroll
        for (int ai = 0; ai < 2; ++ai)
#pragma unroll
            for (int m = 0; m < 4; ++m) { bf16_t* rowp = base + (size_t)(row0 + ai * HALF + m * 16) * ldc + col0;
#pragma unroll
                for (int bj = 0; bj < 2; ++bj) { f32x4 v0 = acc[ai][bj][m][0] + bv[bj][0], v1 = acc[ai][bj][m][1] + bv[bj][1];
                    if (ACT == 2) {
#pragma unroll
                        for (int q = 0; q < 4; ++q) { v0[q] = __builtin_amdgcn_rcpf(1.0f + __builtin_amdgcn_exp2f(v0[q] * -1.44269504f)); v1[q] = __builtin_amdgcn_rcpf(1.0f + __builtin_amdgcn_exp2f(v1[q] * -1.44269504f)); } }
                    v0 = v0 * sc; v1 = v1 * sc; u32x4 w; w.x = cvt_pk_bf16(v0[0], v0[1]); w.y = cvt_pk_bf16(v0[2], v0[3]); w.z = cvt_pk_bf16(v1[0], v1[1]); w.w = cvt_pk_bf16(v1[2], v1[3]);
                    *(u32x4*)(rowp + bj * HALF) = w; } }
    }
};

struct EpiMerge {
    static constexpr bool PERM = true, AFTER_DRAIN = false;
    const bf16_t* MG; bf16_t* O;
    __device__ __forceinline__ void operator()(const f32x4 (&acc)[2][2][4][2], const Unit& u, int wr, int wc, int fr, int fq) const {
        asm volatile("" : "+v"(fr), "+v"(fq));
        const int row0 = u.pm * BM + wr * 64 + fr, col0 = u.pn * BM + wc * 32 + 8 * fq;
#pragma unroll
        for (int ai = 0; ai < 2; ++ai)
#pragma unroll
            for (int m = 0; m < 4; ++m) { const size_t row = (size_t)(row0 + ai * HALF + m * 16);
#pragma unroll
                for (int bj = 0; bj < 2; ++bj) {
                    const u32x4 g = *(const u32x4*)(MG + row * 4096 + u.sub * 1024 + col0 + bj * HALF);
                    bf16_t* op = O + row * 1024 + col0 + bj * HALF;
                    f32x4 v0 = acc[ai][bj][m][0], v1 = acc[ai][bj][m][1];
                    v0[0] *= __uint_as_float(g.x << 16); v0[1] *= __uint_as_float(g.x & 0xffff0000u); v0[2] *= __uint_as_float(g.y << 16); v0[3] *= __uint_as_float(g.y & 0xffff0000u);
                    v1[0] *= __uint_as_float(g.z << 16); v1[1] *= __uint_as_float(g.z & 0xffff0000u); v1[2] *= __uint_as_float(g.w << 16); v1[3] *= __uint_as_float(g.w & 0xffff0000u);
                    if (u.sub != 0) { const u32x4 p = *(const u32x4*)op;
                        v0[0] += __uint_as_float(p.x << 16); v0[1] += __uint_as_float(p.x & 0xffff0000u); v0[2] += __uint_as_float(p.y << 16); v0[3] += __uint_as_float(p.y & 0xffff0000u);
                        v1[0] += __uint_as_float(p.z << 16); v1[1] += __uint_as_float(p.z & 0xffff0000u); v1[2] += __uint_as_float(p.w << 16); v1[3] += __uint_as_float(p.w & 0xffff0000u); }
                    u32x4 w; w.x = cvt_pk_bf16(v0[0], v0[1]); w.y = cvt_pk_bf16(v0[2], v0[3]); w.z = cvt_pk_bf16(v1[0], v1[1]); w.w = cvt_pk_bf16(v1[2], v1[3]);
                    *(u32x4*)op = w; }
                asm volatile("" ::: "memory"); }
    }
};
struct EpiOutF32 {
    static constexpr bool PERM = true, AFTER_DRAIN = false;
    const float* xin; float* out;
    __device__ __forceinline__ void operator()(const f32x4 (&acc)[2][2][4][2], const Unit& u, int wr, int wc, int fr, int fq) const {
        asm volatile("" : "+v"(fr), "+v"(fq));
        const int row0 = u.pm * BM + wr * 64 + fr, col0 = u.pn * BM + wc * 32 + 8 * fq;
#pragma unroll
        for (int ai = 0; ai < 2; ++ai)
#pragma unroll
            for (int m = 0; m < 4; ++m) { const size_t off = (size_t)(row0 + ai * HALF + m * 16) * 1024 + col0;
#pragma unroll
                for (int bj = 0; bj < 2; ++bj) {
                    const f32x4 x0 = *(const f32x4*)(xin + off + bj * HALF), x1 = *(const f32x4*)(xin + off + bj * HALF + 4);
                    *(f32x4*)(out + off + bj * HALF) = x0 + acc[ai][bj][m][0]; *(f32x4*)(out + off + bj * HALF + 4) = x1 + acc[ai][bj][m][1]; }
                asm volatile("" ::: "memory"); }
    }
};
struct MergeOrder : StaticOrder {
    __device__ bool next(int i, Unit& u) const { const bool ok = StaticOrder::next(i >> 2, u); u.sub = i & 3; return ok; }
};

template <class Epi, class Sched, class Gemm, bool ALIGN_EPI = false, bool SP2 = false>
__device__ __forceinline__ void gemm_phase(PG8_LAS unsigned char* lds, const Gemm g, const Sched& S, const Epi& E) {
    const int tid = TIDX, wid = __builtin_amdgcn_readfirstlane(tid >> 6), lane = tid & 63, wr = wid >> 2, wc = wid & 3, fr = lane & 15, fq = lane >> 4;
    constexpr int K = Gemm::K, nt = K / BK, lda = Gemm::lda, ldb = Gemm::ldb;
    unsigned voffA[2], voffB[2];
#pragma unroll
    for (int i = 0; i < 2; ++i) { int R, C; stage_rc(tid * 16 + i * 8192, R, C); const int Rb = Epi::PERM ? ((R & ~31) + perm32(R & 31)) : R;
        voffA[i] = (unsigned)(R * lda + C) * 2u; voffB[i] = (unsigned)(Rb * ldb + C) * 2u; }
    const size_t kstep = (size_t)(BK * 2);
    const size_t hstepA = (size_t)HALF * lda * 2, hstepB = (size_t)HALF * ldb * 2;
    const size_t tstepA = 2 * hstepA, tstepB = 2 * hstepB;
    const unsigned ldsw = (unsigned)wid * 1024u;
    const int aoff = lds_byte(wr * 64 + fr, fq * 8), boff = lds_byte(wc * 32 + fr, fq * 8);
#define PG8_SA(b, h) (((b) * 2 + (h)) * HTB)
#define PG8_SB(b, h) ((4 + (b) * 2 + (h)) * HTB)
#define PG8_STAGE(bufoff, gbase, voff) do { _Pragma("unroll") for (int _i = 0; _i < 2; ++_i) \
        __builtin_amdgcn_global_load_lds((const unsigned*)((const char*)(gbase) + (voff)[_i]), (PG8_LAS unsigned*)(lds + (bufoff) + ldsw + _i * 8192), 16, 0, 0); } while (0)
#define PG8_LDA(dst, b, h) do { _Pragma("unroll") for (int m = 0; m < 4; ++m) _Pragma("unroll") for (int k = 0; k < 2; ++k) dst[m][k] = *(const PG8_LAS bf16x8*)(lds + PG8_SA(b, h) + aoff + m * 2048 + k * 1024); } while (0)
#define PG8_LDB(dst, b, h) do { _Pragma("unroll") for (int n = 0; n < 2; ++n) _Pragma("unroll") for (int k = 0; k < 2; ++k) dst[n][k] = *(const PG8_LAS bf16x8*)(lds + PG8_SB(b, h) + boff + n * 2048 + k * 1024); } while (0)
#define PG8_MMA(ai, bj, At, Bt) do { __builtin_amdgcn_s_setprio(1); _Pragma("unroll") for (int m = 0; m < 4; ++m) _Pragma("unroll") for (int n = 0; n < 2; ++n) _Pragma("unroll") for (int k = 0; k < 2; ++k) \
        acc[ai][bj][m][n] = __builtin_amdgcn_mfma_f32_16x16x32_bf16(Bt[n][k], At[m][k], acc[ai][bj][m][n], 0, 0, 0); __builtin_amdgcn_s_setprio(0); } while (0)
#define PG8_WAIT_V(n) asm volatile("s_waitcnt vmcnt(" #n ")" ::: "memory")
#define PG8_WAIT_L(n) asm volatile("s_waitcnt lgkmcnt(" #n ")" ::: "memory")
#define PG8_BAR __builtin_amdgcn_s_barrier()
#define PG8_SCHED __builtin_amdgcn_sched_barrier(0)
    Unit cur, nxt; int ui = 0;
    if (!S.next(0, cur)) return;
    f32x4 acc[2][2][4][2];
#pragma unroll
    for (int a = 0; a < 2; ++a)
#pragma unroll
        for (int b = 0; b < 2; ++b)
#pragma unroll
            for (int m = 0; m < 4; ++m)
#pragma unroll
                for (int n = 0; n < 2; ++n) acc[a][b][m][n] = (f32x4){0.f, 0.f, 0.f, 0.f};
    bf16x8 At[4][2], B0[2][2], B1[2][2];
    const char* cA = (const char*)g.A + (size_t)cur.pm * tstepA + (size_t)cur.sub * g.a_sub; const char* cB = (const char*)g.Bt + (size_t)cur.pn * tstepB + (size_t)cur.sub * g.b_sub;
    S.a_ready(cur);
    if constexpr (SP2) {
        PG8_STAGE(PG8_SB(0, 0), cB, voffB); PG8_STAGE(PG8_SB(0, 1), cB + hstepB, voffB); PG8_STAGE(PG8_SA(0, 0), cA, voffA); PG8_STAGE(PG8_SA(0, 1), cA + hstepA, voffA);
        if (wr == 1) PG8_BAR;
        PG8_WAIT_V(2); PG8_BAR;
        PG8_STAGE(PG8_SB(1, 0), cB + kstep, voffB); PG8_STAGE(PG8_SA(1, 0), cA + kstep, voffA); PG8_STAGE(PG8_SB(1, 1), cB + hstepB + kstep, voffB);
        PG8_WAIT_V(6); PG8_BAR;
    } else {
        PG8_STAGE(PG8_SB(0, 0), cB, voffB); PG8_STAGE(PG8_SA(0, 0), cA, voffA); PG8_STAGE(PG8_SB(0, 1), cB + hstepB, voffB); PG8_STAGE(PG8_SA(0, 1), cA + hstepA, voffA);
        if (wr == 1) PG8_BAR;
        PG8_WAIT_V(4); PG8_BAR;
        PG8_STAGE(PG8_SB(1, 0), cB + kstep, voffB); PG8_STAGE(PG8_SA(1, 0), cA + kstep, voffA); PG8_STAGE(PG8_SB(1, 1), cB + hstepB + kstep, voffB);
        PG8_WAIT_V(6); PG8_BAR;
    }
    for (;;) {
        const bool has_next = S.next(ui + 1, nxt);
        const char* nA = has_next ? (const char*)g.A + (size_t)nxt.pm * tstepA + (size_t)nxt.sub * g.a_sub : cA; const char* nB = has_next ? (const char*)g.Bt + (size_t)nxt.pn * tstepB + (size_t)nxt.sub * g.b_sub : cB;
        for (int t = 0; t < nt; t += 2) {
            const bool last = (t == nt - 2);
            const char* a1 = cA + (size_t)(t + 1) * kstep;
            const char* a2 = last ? nA : cA + (size_t)(t + 2) * kstep; const char* b2 = last ? nB : cB + (size_t)(t + 2) * kstep;
            const char* a3 = a2 + kstep; const char* b3 = b2 + kstep;
            if (last && has_next) S.a_ready(nxt);
            if constexpr (SP2) {
            PG8_LDB(B0, 0, 0); PG8_LDB(B1, 0, 1); PG8_SCHED; PG8_LDA(At, 0, 0); PG8_STAGE(PG8_SA(1, 1), a1 + hstepA, voffA);
            PG8_WAIT_V(8); PG8_WAIT_L(0); PG8_BAR; PG8_MMA(0, 0, At, B0); PG8_MMA(0, 1, At, B1); PG8_BAR; PG8_SCHED;
            PG8_LDA(At, 0, 1); PG8_STAGE(PG8_SB(0, 0), b2, voffB); PG8_STAGE(PG8_SB(0, 1), b2 + hstepB, voffB); PG8_STAGE(PG8_SA(0, 0), a2, voffA);
            PG8_WAIT_V(8); PG8_WAIT_L(0); PG8_BAR; PG8_MMA(1, 0, At, B0); PG8_MMA(1, 1, At, B1); PG8_BAR; PG8_SCHED;
            PG8_LDB(B0, 1, 0); PG8_LDB(B1, 1, 1); PG8_SCHED; PG8_LDA(At, 1, 0); PG8_STAGE(PG8_SA(0, 1), a2 + hstepA, voffA);
            PG8_WAIT_V(8); PG8_WAIT_L(0); PG8_BAR; PG8_MMA(0, 0, At, B0); PG8_MMA(0, 1, At, B1); PG8_BAR; PG8_SCHED;
            PG8_LDA(At, 1, 1); PG8_STAGE(PG8_SB(1, 0), b3, voffB); PG8_STAGE(PG8_SB(1, 1), b3 + hstepB, voffB); PG8_STAGE(PG8_SA(1, 0), a3, voffA);
            PG8_WAIT_V(8); PG8_WAIT_L(0); PG8_BAR; PG8_MMA(1, 0, At, B0); PG8_MMA(1, 1, At, B1); PG8_BAR; PG8_SCHED;
            } else {
            PG8_LDB(B0, 0, 0); PG8_SCHED; PG8_LDA(At, 0, 0); PG8_STAGE(PG8_SA(1, 1), a1 + hstepA, voffA);
            PG8_WAIT_L(8); PG8_BAR; PG8_WAIT_L(0); PG8_MMA(0, 0, At, B0); PG8_BAR; PG8_SCHED;
            PG8_LDB(B1, 0, 1); PG8_STAGE(PG8_SB(0, 0), b2, voffB);
            PG8_BAR; PG8_WAIT_L(0); PG8_MMA(0, 1, At, B1); PG8_BAR;
            PG8_LDA(At, 0, 1); PG8_STAGE(PG8_SA(0, 0), a2, voffA);
            PG8_BAR; PG8_WAIT_L(0); PG8_MMA(1, 0, At, B0); PG8_BAR; PG8_SCHED;
            PG8_STAGE(PG8_SB(0, 1), b2 + hstepB, voffB);
            PG8_WAIT_V(6); PG8_BAR; PG8_MMA(1, 1, At, B1); PG8_BAR;
            PG8_LDB(B0, 1, 0); PG8_SCHED; PG8_LDA(At, 1, 0); PG8_STAGE(PG8_SA(0, 1), a2 + hstepA, voffA);
            PG8_WAIT_L(8); PG8_BAR; PG8_WAIT_L(0); PG8_MMA(0, 0, At, B0); PG8_BAR; PG8_SCHED;
            PG8_LDB(B1, 1, 1); PG8_STAGE(PG8_SB(1, 0), b3, voffB);
            PG8_BAR; PG8_WAIT_L(0); PG8_MMA(0, 1, At, B1); PG8_BAR;
            PG8_LDA(At, 1, 1); PG8_STAGE(PG8_SA(1, 0), a3, voffA);
            PG8_BAR; PG8_WAIT_L(0); PG8_MMA(1, 0, At, B0); PG8_BAR; PG8_SCHED;
            PG8_STAGE(PG8_SB(1, 1), b3 + hstepB, voffB);
            PG8_WAIT_V(6); PG8_BAR; PG8_MMA(1, 1, At, B1); PG8_BAR;
            }
        }
        if constexpr (ALIGN_EPI) { if (wr == 0) PG8_BAR; }
        if constexpr (!Epi::AFTER_DRAIN) { E(acc, cur, wr, wc, fr, fq); S.done(cur); }
        if (!has_next) break;
#pragma unroll
        for (int a = 0; a < 2; ++a)
#pragma unroll
            for (int b = 0; b < 2; ++b)
#pragma unroll
                for (int m = 0; m < 4; ++m)
#pragma unroll
                    for (int n = 0; n < 2; ++n) acc[a][b][m][n] = (f32x4){0.f, 0.f, 0.f, 0.f};
        cur = nxt; cA = nA; cB = nB; ++ui;
        if constexpr (ALIGN_EPI) { if (wr == 1) PG8_BAR; }
    }
    PG8_WAIT_V(0);
    if constexpr (!ALIGN_EPI) { if (wr == 0) PG8_BAR; }
    PG8_BAR;
    if constexpr (Epi::AFTER_DRAIN) { E.fused(acc, cur, wr, wc, fr, fq, lds, wid, lane); S.done(cur); }
#undef PG8_SA
#undef PG8_SB
#undef PG8_STAGE
#undef PG8_LDA
#undef PG8_LDB
#undef PG8_MMA
#undef PG8_WAIT_V
#undef PG8_WAIT_L
#undef PG8_BAR
#undef PG8_SCHED
}
}

typedef const __attribute__((address_space(4))) Args* KArgs;
__device__ __forceinline__ void make_ctx(Ctx& c) {
    KArgs ap = (KArgs)__builtin_amdgcn_kernarg_segment_ptr();
    asm volatile("" : "+s"(ap));
    c.x = ap->in[0]; c.norm_g = ap->in[1]; c.w_in = ap->in[2]; c.w_fourier = ap->in[3]; c.conv_w = ap->in[4]; c.conv_b = ap->in[5]; c.conv_ln_g = ap->in[6]; c.conv_ln_b = ap->in[7];
    c.w_pw = ap->in[8]; c.w_pool = ap->in[9]; c.pool_scale = ap->in[10]; c.w_branch = ap->in[11]; c.w_gate = ap->in[12]; c.b_gate = ap->in[13]; c.w_out = ap->in[14]; c.final_g = ap->in[15];
    c.out = ap->out;
    unsigned char* ws = ap->ws;
    c.WinT = (bf16_t*)(ws + WS_WIN); c.WgT = (bf16_t*)(ws + WS_WG); c.WbT = (bf16_t*)(ws + WS_WB); c.WoT = (bf16_t*)(ws + WS_WO); c.WfT = (bf16_t*)(ws + WS_WF); c.WpwT = (bf16_t*)(ws + WS_WPW); c.WpoolT = (bf16_t*)(ws + WS_WPOOL);
    c.TW = (float2*)(ws + WS_TW); c.RC = (float*)(ws + WS_RC); c.RS = (float*)(ws + WS_RS);
    c.H = (bf16_t*)(ws + WS_H); c.Z = (bf16_t*)(ws + WS_Z); c.P = (bf16_t*)(ws + WS_P); c.FY = (unsigned*)(ws + WS_FY); c.LSE = (float*)(ws + WS_LSE);
}
constexpr int NPHASES = 1 + 7 * DEPTH;

template <int L, int Q>
__device__ __forceinline__ void layer_phase(unsigned char* lds_raw) {
    float* lds = (float*)lds_raw;
    constexpr int l = L;
    constexpr int nrep = (Q == REPQ) ? 2 : 1;
#pragma unroll 1
    for (int rep = 0; rep < nrep; ++rep) {
        Ctx c; make_ctx(c);
        const bool st_ = (rep == 0);
        if constexpr (Q == 0) {
            typedef pg8::GemmT<DM, DM, DM, 0, 0> GT; GT g{c.H, c.WinT + (size_t)l * DIN * DM}; pg8::StaticOrder S; S.init(MT, DIN, (int)gridDim.x, BIDX);
            pg8::EpiBf16<0> E{c.Z, DIN, nullptr, 0, 0, 1.f};
            pg8::gemm_phase<pg8::EpiBf16<0>, pg8::StaticOrder, GT, true, true>((PG8_LAS unsigned char*)lds_raw, g, S, E);
        } else if constexpr (Q == 1) {
            constexpr int NF = NB * 4 * 64, NTK = NB * 64, NAT = NB * 192;
            if (rep == 0 || (REPSUB & 1)) for (int u = BIDX; u < NAT; u += gridDim.x) attn_unit_mfma(c, u, lds_raw, st_);
            __builtin_amdgcn_sched_barrier(0);
            if (rep == 0 || (REPSUB & 2)) for (int u = BIDX; u < NTK; u += gridDim.x) { if (NEW_TOK) tok_unit_mfma(c, l, u, lds_raw); else tok_unit(c, l, u, lds); }
            __builtin_amdgcn_sched_barrier(0);
            if (rep == 0 || (REPSUB & 4)) { if (NEW_FFT1) fft1_phase_mfma(c); else for (int u = BIDX; u < NF; u += gridDim.x) fft1_unit(c, u, lds); }
        } else if constexpr (Q == 2) {
            if (NEW_FFT2) fft2_phase_mfma(c, l, lds_raw); else for (int u = BIDX; u < NB * 64; u += gridDim.x) fft2_unit(c, l, u, lds);
            phase_combine(c);
        } else if constexpr (Q == 3) {
            typedef pg8::GemmT<DM, DM, DM, 0, 0> GT; GT g{c.H, c.WgT + (size_t)l * 4096 * DM}; pg8::StaticOrder S; S.init(MT, 4096, (int)gridDim.x, BIDX);
            pg8::EpiBf16<2> E{c.Z, 4096, c.b_gate + (size_t)l * 4096, 0, 0, 1.f};
            pg8::gemm_phase<pg8::EpiBf16<2>, pg8::StaticOrder, GT, true, true>((PG8_LAS unsigned char*)lds_raw, g, S, E);
        } else if constexpr (Q == 4) {
            typedef pg8::GemmT<DM, 256, 256, 512, 1024 * 256 * 2> GT; GT g{c.P, c.WbT + (size_t)l * 4 * 1024 * 256}; pg8::MergeOrder S; S.init(MT, DM, (int)gridDim.x, BIDX);
            pg8::EpiMerge E{c.Z, c.H};
            pg8::gemm_phase<pg8::EpiMerge, pg8::MergeOrder, GT, true, true>((PG8_LAS unsigned char*)lds_raw, g, S, E);
        } else if constexpr (Q == 5) {
            typedef pg8::GemmT<DM, DM, DM, 0, 0> GT; GT g{c.H, c.WoT + (size_t)l * DM * DM}; pg8::StaticOrder S; S.init(MT, DM, (int)gridDim.x, BIDX);
            pg8::EpiOutF32 E{(l == 0) ? c.x : c.out, c.out};
            pg8::gemm_phase<pg8::EpiOutF32, pg8::StaticOrder, GT, true, true>((PG8_LAS unsigned char*)lds_raw, g, S, E);
        } else {
            if (l + 1 < DEPTH) phase_norm_bf16(c.out, c.norm_g + (size_t)(l + 1) * DM, c.H);
            else phase_norm_final(c.out, c.final_g);
        }
        if (rep + 1 < nrep) __syncthreads();
    }
}

__global__ void __launch_bounds__(NTHREADS, 2) fwd_kernel(Args a) {
    extern __shared__ __attribute__((aligned(16))) unsigned char lds_raw[];
    const int lo = a.ph_lo, hi = a.ph_hi;
#define RUN_PHASE(k, ...) do { if (lo <= (k) && (k) < hi) { __VA_ARGS__; if ((k) + 1 < hi) { asm volatile("s_waitcnt vmcnt(0)" ::: "memory"); cg::this_grid().sync(); } } } while (0)
    RUN_PHASE(0, { Ctx c; make_ctx(c); phase_pre(c, (float*)lds_raw); phase_norm_bf16(c.x, c.norm_g, c.H); });
    RUN_PHASE(1, layer_phase<0, 0>(lds_raw));
    RUN_PHASE(2, layer_phase<0, 1>(lds_raw));
    RUN_PHASE(3, layer_phase<0, 2>(lds_raw));
    RUN_PHASE(4, layer_phase<0, 3>(lds_raw));
    RUN_PHASE(5, layer_phase<0, 4>(lds_raw));
    RUN_PHASE(6, layer_phase<0, 5>(lds_raw));
    RUN_PHASE(7, layer_phase<0, 6>(lds_raw));
    RUN_PHASE(8, layer_phase<1, 0>(lds_raw));
    RUN_PHASE(9, layer_phase<1, 1>(lds_raw));
    RUN_PHASE(10, layer_phase<1, 2>(lds_raw));
    RUN_PHASE(11, layer_phase<1, 3>(lds_raw));
    RUN_PHASE(12, layer_phase<1, 4>(lds_raw));
    RUN_PHASE(13, layer_phase<1, 5>(lds_raw));
    RUN_PHASE(14, layer_phase<1, 6>(lds_raw));
#undef RUN_PHASE
}

extern "C" void kernel_launch(void* const* d_in, const int* in_sizes, int n_in, void* d_out, int out_size, void* d_ws, size_t ws_size, hipStream_t stream) {
    static int grid = 0;
    if (grid == 0) {
        if (n_in != 16 || in_sizes[0] != MT * DM || out_size != MT * DM || ws_size < WS_END) {
            fprintf(stderr, "kernel_launch: unexpected shapes: n_in %d in0 %d out %d ws %zu (need %zu)\n", n_in, n_in > 0 ? in_sizes[0] : -1, out_size, ws_size, (size_t)WS_END);
            grid = -1; return;
        }
        int dev = 0, cus = 0, per_cu = 0;
        hipGetDevice(&dev); hipDeviceGetAttribute(&cus, hipDeviceAttributeMultiprocessorCount, dev);
        if (hipFuncSetAttribute((const void*)fwd_kernel, hipFuncAttributeMaxDynamicSharedMemorySize, LDS_BYTES) != hipSuccess) { fprintf(stderr, "kernel_launch: hipFuncSetAttribute failed\n"); grid = -1; return; }
        hipOccupancyMaxActiveBlocksPerMultiprocessor(&per_cu, (const void*)fwd_kernel, NTHREADS, LDS_BYTES);
        if (per_cu < 1) { fprintf(stderr, "kernel_launch: occupancy query says %d blocks/CU\n", per_cu); per_cu = 1; }
        (void)hipGetLastError();
        grid = cus;
    }
    if (grid < 0) return;
    Args a{};
    for (int i = 0; i < 16; ++i) a.in[i] = (const float*)d_in[i];
    a.out = (float*)d_out; a.ws = (unsigned char*)d_ws;
#if ONE_LAUNCH
    a.ph_lo = 0; a.ph_hi = NPHASES;
    void* args[] = {&a};
    hipError_t e = hipLaunchCooperativeKernel((const void*)fwd_kernel, dim3(grid), dim3(NTHREADS), args, LDS_BYTES, stream);
    if (e != hipSuccess) fprintf(stderr, "kernel_launch: cooperative launch failed: %s (grid %d)\n", hipGetErrorString(e), grid);
#else
    for (int ph = 0; ph < NPHASES; ++ph) {
        a.ph_lo = ph; a.ph_hi = ph + 1;
        hipLaunchKernelGGL(fwd_kernel, dim3(grid), dim3(NTHREADS), LDS_BYTES, stream, a);
    }
#endif
}
```

```cpp
#include <hip/hip_runtime.h>
#include <hip/hip_cooperative_groups.h>
#include <cstdio>
#include <cstdint>
namespace cg = cooperative_groups;

#ifndef NEW_TOK
#define NEW_TOK 1
#endif
#ifndef NEW_FFT1
#define NEW_FFT1 1
#endif
#ifndef NEW_FFT2
#define NEW_FFT2 1
#endif
#ifndef REPQ
#define REPQ -1
#endif
#ifndef REPSUB
#define REPSUB 4
#endif
#ifndef ENG_MASK
#define ENG_MASK 15
#endif
#ifndef ONE_LAUNCH
#define ONE_LAUNCH 1
#endif

typedef unsigned short bf16_t;
typedef short bf16x8 __attribute__((ext_vector_type(8)));
typedef float f32x4 __attribute__((ext_vector_type(4)));
typedef unsigned u32x4 __attribute__((ext_vector_type(4)));

constexpr int NB = 8, SEQ = 4096, DM = 1024, MT = NB * SEQ, DIN = 4352, DEPTH = 2;
constexpr int ZA = 0, ZB = 256, ZQ = 768, ZK = 1536, ZV = 2304, ZD = 3072, ZG = 3328;
constexpr int NTHREADS = 512, NWAVES = 8;
constexpr int LDS_BYTES = 147456;

constexpr size_t WS_CTL = 0;
constexpr size_t WS_WIN = 65536;
constexpr size_t WS_WG = WS_WIN + (size_t)DEPTH * DIN * DM * 2;
constexpr size_t WS_WB = WS_WG + (size_t)DEPTH * 4096 * DM * 2;
constexpr size_t WS_WO = WS_WB + (size_t)DEPTH * 4 * 1024 * 256 * 2;
constexpr size_t WS_WF = WS_WO + (size_t)DEPTH * DM * DM * 2;
constexpr size_t WS_WPW = WS_WF + (size_t)DEPTH * 65536 * 2;
constexpr size_t WS_WPOOL = WS_WPW + (size_t)DEPTH * 65536 * 2;
constexpr size_t WS_TW = WS_WPOOL + (size_t)DEPTH * 4 * 4096 * 2;
constexpr size_t WS_RC = WS_TW + 4096 * 8;
constexpr size_t WS_RS = WS_RC + 4096 * 32 * 4;
constexpr size_t WS_H = WS_RS + 4096 * 32 * 4;
constexpr size_t WS_Z = WS_H + (size_t)MT * DM * 2;
constexpr size_t WS_P = WS_Z + (size_t)MT * DIN * 2;
constexpr size_t WS_FY = WS_P + (size_t)MT * DM * 2;
constexpr size_t WS_LSE = WS_FY + (size_t)NB * 4 * 64 * 64 * 64 * 4;
constexpr size_t WS_END = WS_LSE + (size_t)3 * MT * 4 * 4;

struct Args { const float* in[16]; float* out; unsigned char* ws; int ph_lo, ph_hi; };

__device__ __forceinline__ float bf2f(bf16_t v) { return __uint_as_float((unsigned)v << 16); }
__device__ __forceinline__ float bflo(unsigned w) { return __uint_as_float(w << 16); }
__device__ __forceinline__ float bfhi(unsigned w) { return __uint_as_float(w & 0xffff0000u); }
__device__ __forceinline__ bf16_t f2bf(float f) { unsigned u = __float_as_uint(f); u += 0x7fffu + ((u >> 16) & 1u); return (bf16_t)(u >> 16); }
typedef float f32x2n __attribute__((ext_vector_type(2)));
typedef __bf16 bf16x2n __attribute__((ext_vector_type(2)));
__device__ __forceinline__ unsigned pk2(float lo, float hi) { const f32x2n v = {lo, hi}; return __builtin_bit_cast(unsigned, __builtin_convertvector(v, bf16x2n)); }
__device__ __forceinline__ float sigmoidf_(float x) { return 1.f / (1.f + __expf(-x)); }
__device__ __forceinline__ float siluf_(float x) { return x / (1.f + __expf(-x)); }
__device__ __forceinline__ int opq(int v) { asm volatile("" : "+v"(v)); return v; }
#define TIDX opq((int)threadIdx.x)
__device__ __forceinline__ int opqs(int v) { asm volatile("" : "+s"(v)); return v; }
#define BIDX opqs((int)blockIdx.x)
__device__ __forceinline__ float wave_sum(float v) {
#pragma unroll
    for (int o = 1; o < 64; o <<= 1) v += __shfl_xor(v, o);
    return v;
}

struct Ctx {
    const float *x, *norm_g, *w_in, *w_fourier, *conv_w, *conv_b, *conv_ln_g, *conv_ln_b, *w_pw, *w_pool, *pool_scale, *w_branch, *w_gate, *b_gate, *w_out, *final_g;
    float* out;
    bf16_t *WinT, *WgT, *WbT, *WoT, *WfT, *WpwT, *WpoolT, *H, *Z, *P;
    float2* TW; float *RC, *RS, *LSE; unsigned* FY;
};

__device__ __forceinline__ void transpose_mat(const float* W, int K, int N, bf16_t* WT, float* scr) {
    const int t = TIDX, nkb = K / 64, nnb = N / 64;
    for (int item = BIDX; item < nkb * nnb; item += gridDim.x) {
        const int kb = item / nnb, nb = item % nnb;
#pragma unroll
        for (int i = 0; i < 8; ++i) { const int kk = (t >> 6) + 8 * i, nn = t & 63; scr[kk * 65 + nn] = W[(size_t)(kb * 64 + kk) * N + nb * 64 + nn]; }
        __syncthreads();
#pragma unroll
        for (int i = 0; i < 8; ++i) { const int nn = (t >> 6) + 8 * i, kk = t & 63; WT[(size_t)(nb * 64 + nn) * K + kb * 64 + kk] = f2bf(scr[kk * 65 + nn]); }
        __syncthreads();
    }
}
__device__ __forceinline__ void phase_pre(const Ctx& c, float* lds) {
    for (int l = 0; l < DEPTH; ++l) {
        transpose_mat(c.w_in + (size_t)l * DM * DIN, DM, DIN, c.WinT + (size_t)l * DIN * DM, lds);
        for (int n = 0; n < 4; ++n) {
            transpose_mat(c.w_gate + (size_t)(l * 4 + n) * DM * DM, DM, DM, c.WgT + ((size_t)l * 4096 + n * 1024) * DM, lds);
            transpose_mat(c.w_branch + (size_t)(l * 4 + n) * 256 * DM, 256, DM, c.WbT + (size_t)(l * 4 + n) * 1024 * 256, lds);
        }
        transpose_mat(c.w_out + (size_t)l * DM * DM, DM, DM, c.WoT + (size_t)l * DM * DM, lds);
        transpose_mat(c.w_fourier + (size_t)l * 65536, 256, 256, c.WfT + (size_t)l * 65536, lds);
        transpose_mat(c.w_pw + (size_t)l * 65536, 256, 256, c.WpwT + (size_t)l * 65536, lds);
        for (int n = 0; n < 4; ++n) transpose_mat(c.w_pool + (size_t)(l * 4 + n) * 4096, 64, 64, c.WpoolT + (size_t)(l * 4 + n) * 4096, lds);
    }
    const int gt = BIDX * NTHREADS + TIDX, NT = gridDim.x * NTHREADS;
    for (int i = gt; i < 4096; i += NT) { float s, co; sincospif((float)i / 2048.f, &s, &co); c.TW[i] = make_float2(co, s); }
    for (int i = gt; i < 4096 * 32; i += NT) {
        const int pos = i >> 5, k = i & 31;
        const float inv = exp2f(-(float)k * (13.287712379549449f / 32.0f));
        double tq = (double)pos * (double)inv * 0.3183098861837907;
        tq -= 2.0 * rint(tq * 0.5);
        float s, co; sincospif((float)tq, &s, &co);
        c.RC[i] = co; c.RS[i] = s;
    }
}

__device__ __forceinline__ void phase_norm_bf16(const float* xin, const float* g, bf16_t* H) {
    const int tid_ = TIDX; const int lane = tid_ & 63, wave = tid_ >> 6;
    const int gw = BIDX * NWAVES + wave, NGW = gridDim.x * NWAVES;
    f32x4 gv[4];
#pragma unroll
    for (int j = 0; j < 4; ++j) gv[j] = *(const f32x4*)(g + 4 * (lane + 64 * j));
    for (int m = gw; m < MT; m += NGW) {
        const f32x4* xr = (const f32x4*)(xin + (size_t)m * DM);
        f32x4 v[4]; float s = 0.f;
#pragma unroll
        for (int j = 0; j < 4; ++j) { v[j] = xr[lane + 64 * j]; s += v[j].x * v[j].x + v[j].y * v[j].y + v[j].z * v[j].z + v[j].w * v[j].w; }
        const float rstd = 1.0f / sqrtf(wave_sum(s) * (1.f / DM) + 1e-6f);
        uint2* o = (uint2*)(H + (size_t)m * DM);
#pragma unroll
        for (int j = 0; j < 4; ++j) { const f32x4 y = v[j] * rstd * gv[j]; o[lane + 64 * j] = make_uint2(pk2(y.x, y.y), pk2(y.z, y.w)); }
    }
}
__device__ __forceinline__ void phase_norm_final(float* xio, const float* g) {
    const int tid_ = TIDX; const int lane = tid_ & 63, wave = tid_ >> 6;
    const int gw = BIDX * NWAVES + wave, NGW = gridDim.x * NWAVES;
    f32x4 gv[4];
#pragma unroll
    for (int j = 0; j < 4; ++j) gv[j] = *(const f32x4*)(g + 4 * (lane + 64 * j));
    for (int m = gw; m < MT; m += NGW) {
        f32x4* xr = (f32x4*)(xio + (size_t)m * DM);
        f32x4 v[4]; float s = 0.f;
#pragma unroll
        for (int j = 0; j < 4; ++j) { v[j] = xr[lane + 64 * j]; s += v[j].x * v[j].x + v[j].y * v[j].y + v[j].z * v[j].z + v[j].w * v[j].w; }
        const float rstd = 1.0f / sqrtf(wave_sum(s) * (1.f / DM) + 1e-6f);
#pragma unroll
        for (int j = 0; j < 4; ++j) xr[lane + 64 * j] = v[j] * rstd * gv[j];
    }
}

template <class Epi>
__device__ __forceinline__ void gemm_simple(const bf16_t* A, int lda, const bf16_t* Bt, int ldb, int Mr, int N, int K, const Epi& epi) {
    const int tid_ = TIDX; const int wid = tid_ >> 6, lane = tid_ & 63, fr = lane & 15, fq = lane >> 4;
    const int nM = Mr / 128, nN = N / 64;
    for (int u = BIDX; u < nM * nN; u += gridDim.x) {
        const int pm = u / nN, pn = u % nN;
        const bf16_t* ap = A + (size_t)(pm * 128 + wid * 16 + fr) * lda + fq * 8;
        const bf16_t* bp = Bt + (size_t)(pn * 64 + fr) * ldb + fq * 8;
        f32x4 acc[4];
#pragma unroll
        for (int n = 0; n < 4; ++n) acc[n] = (f32x4){0.f, 0.f, 0.f, 0.f};
        for (int k0 = 0; k0 < K; k0 += 32) {
            const bf16x8 a = *(const bf16x8*)(ap + k0);
#pragma unroll
            for (int n = 0; n < 4; ++n) { const bf16x8 b = *(const bf16x8*)(bp + (size_t)n * 16 * ldb + k0); acc[n] = __builtin_amdgcn_mfma_f32_16x16x32_bf16(a, b, acc[n], 0, 0, 0); }
        }
#pragma unroll
        for (int n = 0; n < 4; ++n)
#pragma unroll
            for (int j = 0; j < 4; ++j) epi(pm * 128 + wid * 16 + fq * 4 + j, pn * 64 + n * 16 + fr, acc[n][j]);
    }
}
struct EpiZ { bf16_t* Z; __device__ __forceinline__ void operator()(int r, int c, float v) const { Z[(size_t)r * DIN + c] = f2bf(v); } };
struct EpiGate { bf16_t* MG; const float* bg; __device__ __forceinline__ void operator()(int r, int c, float v) const { MG[(size_t)r * 4096 + c] = f2bf(sigmoidf_(v + bg[c])); } };
struct EpiOut { const float* xin; float* out; __device__ __forceinline__ void operator()(int r, int c, float v) const { const size_t i = (size_t)r * DM + c; out[i] = xin[i] + v; } };

__device__ __forceinline__ void gemm_merge(const bf16_t* P, const bf16_t* WbT, const bf16_t* MG, bf16_t* MERGED) {
    const int tid_ = TIDX; const int wid = tid_ >> 6, lane = tid_ & 63, fr = lane & 15, fq = lane >> 4;
    const int nM = MT / 128, nN = DM / 64;
    for (int u = BIDX; u < nM * nN; u += gridDim.x) {
        const int pm = u / nN, pn = u % nN;
        f32x4 tot[4];
#pragma unroll
        for (int n = 0; n < 4; ++n) tot[n] = (f32x4){0.f, 0.f, 0.f, 0.f};
        for (int n4 = 0; n4 < 4; ++n4) {
            const bf16_t* ap = P + (size_t)(pm * 128 + wid * 16 + fr) * DM + n4 * 256 + fq * 8;
            const bf16_t* bp = WbT + (size_t)n4 * 1024 * 256 + (size_t)(pn * 64 + fr) * 256 + fq * 8;
            f32x4 acc[4];
#pragma unroll
            for (int n = 0; n < 4; ++n) acc[n] = (f32x4){0.f, 0.f, 0.f, 0.f};
            for (int k0 = 0; k0 < 256; k0 += 32) {
                const bf16x8 a = *(const bf16x8*)(ap + k0);
#pragma unroll
                for (int n = 0; n < 4; ++n) { const bf16x8 b = *(const bf16x8*)(bp + (size_t)n * 16 * 256 + k0); acc[n] = __builtin_amdgcn_mfma_f32_16x16x32_bf16(a, b, acc[n], 0, 0, 0); }
            }
#pragma unroll
            for (int n = 0; n < 4; ++n)
#pragma unroll
                for (int j = 0; j < 4; ++j) { const int r = pm * 128 + wid * 16 + fq * 4 + j, cc = pn * 64 + n * 16 + fr; tot[n][j] += bf2f(MG[(size_t)r * 4096 + n4 * 1024 + cc]) * acc[n][j]; }
        }
#pragma unroll
        for (int n = 0; n < 4; ++n)
#pragma unroll
            for (int j = 0; j < 4; ++j) { const int r = pm * 128 + wid * 16 + fq * 4 + j, cc = pn * 64 + n * 16 + fr; MERGED[(size_t)r * DM + cc] = f2bf(tot[n][j]); }
    }
}

__device__ __forceinline__ void fft1_unit(const Ctx& c, int u, float* lds) {
    const int t = TIDX, s2 = u & 63, bg = u >> 6, g = bg & 3, b = bg >> 2;
    float* U = lds; float* Wre = lds + 64 * 65; float* Wim = Wre + 4096; float* cs = Wim + 4096; float* sn = cs + 64;
    if (t < 64) { float s, co; sincospif((float)t / 32.f, &s, &co); cs[t] = co; sn[t] = s; }
#pragma unroll
    for (int i = 0; i < 8; ++i) { const int s1 = (t >> 6) + 8 * i, ci = t & 63; U[s1 * 65 + ci] = bf2f(c.Z[(size_t)(b * SEQ + 64 * s1 + s2) * DIN + ZA + 64 * g + ci]); }
    __syncthreads();
    const int cp = t & 63;
#pragma unroll 1
    for (int i = 0; i < 8; ++i) {
        const int s1 = (t >> 6) + 8 * i; float re = 0.f, im = 0.f;
        for (int ci = 0; ci < 64; ++ci) { const float x = U[s1 * 65 + ci]; const int e = (ci * cp) & 63; re += x * cs[e]; im -= x * sn[e]; }
        Wre[s1 * 64 + cp] = re; Wim[s1 * 64 + cp] = im;
    }
    __syncthreads();
#pragma unroll 1
    for (int i = 0; i < 8; ++i) {
        const int k1 = (t >> 6) + 8 * i; float yr = 0.f, yi = 0.f;
        for (int s1 = 0; s1 < 64; ++s1) { const int e = (k1 * s1) & 63; const float co = cs[e], si = sn[e], wr = Wre[s1 * 64 + cp], wi = Wim[s1 * 64 + cp]; yr += co * wr + si * wi; yi += co * wi - si * wr; }
        const float2 tw = c.TW[(k1 * s2) & 4095];
        const float zr = yr * tw.x + yi * tw.y, zi = yi * tw.x - yr * tw.y;
        c.FY[((size_t)(bg * 64 + k1) * 64 + s2) * 64 + cp] = pk2(zr, zi);
    }
    __syncthreads();
}

__device__ __forceinline__ void tok_unit(const Ctx& c, int l, int u, float* lds) {
    const int t = TIDX, lane = t & 63, wave = t >> 6, ch = t & 255, half = t >> 8;
    const int b = u >> 6, s0 = (u & 63) * 64, tok0 = b * SEQ + s0;
    float* A = lds;
#pragma unroll 1
    for (int i = 0; i < 47; ++i) {
        const int r = half + 2 * i, s = s0 - 15 + r; float val = 0.f;
        if (s >= 0 && s < SEQ) { const bf16_t* zr = c.Z + (size_t)(b * SEQ + s) * DIN + ZB; val = bf2f(zr[ch]) * sigmoidf_(bf2f(zr[256 + ch])); }
        A[r * 256 + ch] = val;
    }
    __syncthreads();
    float y[32];
    {
        float cw[31];
#pragma unroll
        for (int w = 0; w < 31; ++w) cw[w] = c.conv_w[(size_t)l * 31 * 256 + w * 256 + ch];
        const float cb = c.conv_b[l * 256 + ch];
#pragma unroll
        for (int cc = 0; cc < 4; ++cc) {
            float rows[38];
#pragma unroll
            for (int r = 0; r < 38; ++r) rows[r] = A[(half * 32 + cc * 8 + r) * 256 + ch];
#pragma unroll
            for (int i = 0; i < 8; ++i) {
                float acc = cb;
#pragma unroll
                for (int w = 0; w < 31; ++w) acc += rows[i + w] * cw[w];
                y[cc * 8 + i] = acc;
            }
            __builtin_amdgcn_sched_barrier(0);
        }
    }
    __syncthreads();
#pragma unroll
    for (int i = 0; i < 32; ++i) A[(half * 32 + i) * 256 + ch] = y[i];
    __syncthreads();
    {
        float lg[4], lb[4];
#pragma unroll
        for (int q = 0; q < 4; ++q) { lg[q] = c.conv_ln_g[l * 256 + lane + 64 * q]; lb[q] = c.conv_ln_b[l * 256 + lane + 64 * q]; }
        for (int i = 0; i < 8; ++i) {
            const int tk = wave * 8 + i; float xv[4]; float s = 0.f;
#pragma unroll
            for (int q = 0; q < 4; ++q) { xv[q] = A[tk * 256 + lane + 64 * q]; s += xv[q]; }
            const float mean = wave_sum(s) * (1.f / 256.f); float s2 = 0.f;
#pragma unroll
            for (int q = 0; q < 4; ++q) { xv[q] -= mean; s2 += xv[q] * xv[q]; }
            const float rstd = 1.0f / sqrtf(wave_sum(s2) * (1.f / 256.f) + 1e-5f);
#pragma unroll
            for (int q = 0; q < 4; ++q) { const float yv = xv[q] * rstd * lg[q] + lb[q]; A[tk * 256 + lane + 64 * q] = siluf_(yv); }
        }
    }
    __syncthreads();
    {
        float acc[32];
#pragma unroll
        for (int i = 0; i < 32; ++i) acc[i] = 0.f;
        const float* W = c.w_pw + (size_t)l * 65536;
#pragma unroll 2
        for (int k = 0; k < 256; ++k) {
            const float wv = W[k * 256 + ch];
#pragma unroll
            for (int i = 0; i < 32; ++i) acc[i] += A[(half * 32 + i) * 256 + k] * wv;
        }
        __syncthreads();
#pragma unroll
        for (int i = 0; i < 32; ++i) A[(half * 32 + i) * 256 + ch] = acc[i];
        __syncthreads();
#pragma unroll 1
        for (int i = 0; i < 32; ++i) {
            const size_t tok = tok0 + half * 32 + i;
            const float gp = bf2f(c.Z[tok * DIN + ZG + 256 + ch]);
            c.P[tok * DM + 256 + ch] = f2bf(A[(half * 32 + i) * 256 + ch] * siluf_(gp));
        }
    }
    __syncthreads();
#pragma unroll 1
    for (int i = 0; i < 40; ++i) {
        const int r = half + 2 * i;
        if (r < 79) { const int s = s0 - 8 + r; float val = 0.f; if (s >= 0 && s < SEQ) val = bf2f(c.Z[(size_t)(b * SEQ + s) * DIN + ZD + ch]); A[r * 256 + ch] = val; }
    }
    __syncthreads();
    float* PL = lds + 79 * 256;
    {
        const int gi = ch >> 6, sz = 2 << gi;
#pragma unroll 1
        for (int i = 0; i < 32; ++i) {
            const int tk = half * 32 + i, s = s0 + tk;
            int lo = s - sz / 2; if (lo < 0) lo = 0;
            int hi = s + sz - 1 - sz / 2; if (hi > SEQ - 1) hi = SEQ - 1;
            float sum = 0.f;
            for (int p = lo; p <= hi; ++p) sum += A[(p - s0 + 8) * 256 + ch];
            PL[tk * 256 + ch] = sum / (float)(hi - lo + 1) - A[(tk + 8) * 256 + ch];
        }
    }
    __syncthreads();
    {
        const int gi = ch >> 6, dd = ch & 63;
        float acc[32];
#pragma unroll
        for (int i = 0; i < 32; ++i) acc[i] = 0.f;
        const float* W = c.w_pool + (size_t)(l * 4 + gi) * 4096;
#pragma unroll 2
        for (int k = 0; k < 64; ++k) {
            const float wv = W[k * 64 + dd];
#pragma unroll
            for (int i = 0; i < 32; ++i) acc[i] += PL[(half * 32 + i) * 256 + gi * 64 + k] * wv;
        }
        const float ps = c.pool_scale[l * 256 + ch];
        __syncthreads();
#pragma unroll
        for (int i = 0; i < 32; ++i) A[(half * 32 + i) * 256 + ch] = acc[i];
        __syncthreads();
#pragma unroll 1
        for (int i = 0; i < 32; ++i) {
            const size_t tok = tok0 + half * 32 + i;
            const float gp = bf2f(c.Z[tok * DIN + ZG + 768 + ch]);
            c.P[tok * DM + 768 + ch] = f2bf(A[(half * 32 + i) * 256 + ch] * ps * siluf_(gp));
        }
    }
    __syncthreads();
}

__device__ __forceinline__ void attn_unit(const Ctx& c, int u, float* ldsf, bool do_store = true) {
    unsigned* lds = (unsigned*)ldsf;
    const int t = TIDX;
    const int b = u / 192, rem = u % 192, g = rem >> 6, rem2 = rem & 63, hI = rem2 >> 4, rq = rem2 & 15;
    const int d = 1 << (2 * g), L = SEQ / d, nqb = L / 256, r = rq / nqb, qb = rq % nqb, hh = g * 4 + hI, i0 = qb * 256;
    unsigned* Kt = lds; unsigned* Vt = lds + 384 * 33;
    for (int pass = 0; pass < 2; ++pass) {
        const int jl = pass * 256 + (t >> 1), hf = t & 1, j = i0 - 64 + jl;
        if (jl < 384 && j >= 0 && j < L) {
            const int pos = r + d * j; const size_t tok = (size_t)b * SEQ + pos;
            const u32x4* kr = (const u32x4*)(c.Z + tok * DIN + ZK + hh * 64);
            unsigned kw[32];
#pragma unroll
            for (int q = 0; q < 8; ++q) { const u32x4 v = kr[q]; kw[4 * q] = v.x; kw[4 * q + 1] = v.y; kw[4 * q + 2] = v.z; kw[4 * q + 3] = v.w; }
            const float* rc = c.RC + pos * 32; const float* rs = c.RS + pos * 32;
#pragma unroll
            for (int w = 0; w < 16; ++w) {
                const float lo0 = bflo(kw[w]), lo1 = bfhi(kw[w]), hi0 = bflo(kw[16 + w]), hi1 = bfhi(kw[16 + w]);
                const float c0 = rc[2 * w], c1 = rc[2 * w + 1], s0 = rs[2 * w], s1 = rs[2 * w + 1];
                float o0, o1;
                if (hf == 0) { o0 = lo0 * c0 - hi0 * s0; o1 = lo1 * c1 - hi1 * s1; } else { o0 = hi0 * c0 + lo0 * s0; o1 = hi1 * c1 + lo1 * s1; }
                Kt[jl * 33 + hf * 16 + w] = pk2(o0, o1);
            }
            const u32x4* vr = (const u32x4*)(c.Z + tok * DIN + ZV + hh * 64 + hf * 32);
#pragma unroll
            for (int q = 0; q < 4; ++q) { const u32x4 v = vr[q]; Vt[jl * 33 + hf * 16 + 4 * q] = v.x; Vt[jl * 33 + hf * 16 + 4 * q + 1] = v.y; Vt[jl * 33 + hf * 16 + 4 * q + 2] = v.z; Vt[jl * 33 + hf * 16 + 4 * q + 3] = v.w; }
        }
    }
    const int ql = t >> 1, hf = t & 1, iq = i0 + ql, posq = r + d * iq;
    const size_t tokq = (size_t)b * SEQ + posq;
    bf16_t* qrow = c.Z + tokq * DIN + ZQ + hh * 64;
    float qv[32];
    {
        const u32x4* qr = (const u32x4*)qrow;
        unsigned kw[32];
#pragma unroll
        for (int q = 0; q < 8; ++q) { const u32x4 v = qr[q]; kw[4 * q] = v.x; kw[4 * q + 1] = v.y; kw[4 * q + 2] = v.z; kw[4 * q + 3] = v.w; }
        const float* rc = c.RC + posq * 32; const float* rs = c.RS + posq * 32;
#pragma unroll
        for (int w = 0; w < 16; ++w) {
            const float lo0 = bflo(kw[w]), lo1 = bfhi(kw[w]), hi0 = bflo(kw[16 + w]), hi1 = bfhi(kw[16 + w]);
            const float c0 = rc[2 * w], c1 = rc[2 * w + 1], s0 = rs[2 * w], s1 = rs[2 * w + 1];
            if (hf == 0) { qv[2 * w] = (lo0 * c0 - hi0 * s0) * 0.125f; qv[2 * w + 1] = (lo1 * c1 - hi1 * s1) * 0.125f; }
            else { qv[2 * w] = (hi0 * c0 + lo0 * s0) * 0.125f; qv[2 * w + 1] = (hi1 * c1 + lo1 * s1) * 0.125f; }
        }
    }
    __syncthreads();
    float m = -1e30f, lsum = 0.f, o[32];
#pragma unroll
    for (int w = 0; w < 32; ++w) o[w] = 0.f;
    for (int t2 = 0; t2 <= 128; ++t2) {
        const int j = iq - 64 + t2;
        if (j >= 0 && j < L) {
            const int jl = ql + t2;
            const unsigned* kp = Kt + jl * 33 + hf * 16;
            float sp = 0.f;
#pragma unroll
            for (int w = 0; w < 16; ++w) { const unsigned kwv = kp[w]; sp += qv[2 * w] * bflo(kwv) + qv[2 * w + 1] * bfhi(kwv); }
            const float s = sp + __shfl_xor(sp, 1);
            const float mn = fmaxf(m, s), corr = __expf(m - mn), p = __expf(s - mn);
            lsum = lsum * corr + p; m = mn;
            const unsigned* vp = Vt + jl * 33 + hf * 16;
#pragma unroll
            for (int w = 0; w < 16; ++w) { const unsigned vw = vp[w]; o[2 * w] = o[2 * w] * corr + p * bflo(vw); o[2 * w + 1] = o[2 * w + 1] * corr + p * bfhi(vw); }
        }
    }
    const float inv = 1.f / lsum;
    unsigned* orow = (unsigned*)(qrow + hf * 32);
    if (do_store) {
#pragma unroll
    for (int w = 0; w < 16; ++w) orow[w] = pk2(o[2 * w] * inv, o[2 * w + 1] * inv);
    if (hf == 0) c.LSE[((size_t)g * MT + tokq) * 4 + hI] = m + __logf(lsum);
    }
    __syncthreads();
}


typedef float f32x16 __attribute__((ext_vector_type(16)));
typedef unsigned u32x2 __attribute__((ext_vector_type(2)));
#define LASP __attribute__((address_space(3)))
__device__ __forceinline__ unsigned cvtpk(float lo, float hi) { return pk2(lo, hi); }
__device__ __forceinline__ void attn_unit_mfma(const Ctx& c, int u, unsigned char* lds_raw, bool do_store = true) {
    LASP unsigned char* Kt = (LASP unsigned char*)lds_raw;
    LASP unsigned* Vt = (LASP unsigned*)(lds_raw + 49152);
    const int t = TIDX, lane = t & 63, wave = __builtin_amdgcn_readfirstlane(t >> 6), rq = lane & 31, h = lane >> 5;
    const int b = u / 192, rem = u % 192, g = rem >> 6, rem2 = rem & 63, hI = rem2 >> 4, rqb = rem2 & 15;
    const int d = 1 << (2 * g), L = SEQ / d, nqb = L / 256, r = rqb / nqb, qb = rqb % nqb, hh = g * 4 + hI, i0 = qb * 256;
#pragma unroll
    for (int i = 0; i < 3; ++i) {
        const int id = t + 512 * i, row = id >> 2, dc = id & 3, j = i0 - 64 + row;
        u32x4 olo = (u32x4){0u, 0u, 0u, 0u}, ohi = olo;
        if (j >= 0 && j < L) {
            const int pos = r + d * j;
            const bf16_t* kr = c.Z + ((size_t)b * SEQ + pos) * DIN + ZK + hh * 64 + 8 * dc;
            const u32x4 a = *(const u32x4*)kr, bq = *(const u32x4*)(kr + 32);
            const f32x4 c0 = *(const f32x4*)(c.RC + pos * 32 + 8 * dc), c1 = *(const f32x4*)(c.RC + pos * 32 + 8 * dc + 4);
            const f32x4 s0 = *(const f32x4*)(c.RS + pos * 32 + 8 * dc), s1 = *(const f32x4*)(c.RS + pos * 32 + 8 * dc + 4);
#pragma unroll
            for (int e = 0; e < 4; ++e) {
                const float l0 = bflo(a[e]), l1 = bfhi(a[e]), h0 = bflo(bq[e]), h1 = bfhi(bq[e]);
                const float cc0 = (e < 2) ? c0[2 * e] : c1[2 * e - 4], cc1 = (e < 2) ? c0[2 * e + 1] : c1[2 * e - 3];
                const float ss0 = (e < 2) ? s0[2 * e] : s1[2 * e - 4], ss1 = (e < 2) ? s0[2 * e + 1] : s1[2 * e - 3];
                olo[e] = pk2(l0 * cc0 - h0 * ss0, l1 * cc1 - h1 * ss1);
                ohi[e] = pk2(h0 * cc0 + l0 * ss0, h1 * cc1 + l1 * ss1);
            }
        }
        *(LASP u32x4*)(Kt + row * 128 + ((dc ^ (row & 7)) << 4)) = olo;
        *(LASP u32x4*)(Kt + row * 128 + (((4 + dc) ^ (row & 7)) << 4)) = ohi;
    }
#pragma unroll
    for (int i = 0; i < 3; ++i) {
        const int id = t + 512 * i, rp = id % 192, dc8 = id / 192, j0 = i0 - 64 + 2 * rp;
        u32x4 v0 = (u32x4){0u, 0u, 0u, 0u}, v1 = v0;
        if (j0 >= 0 && j0 < L) v0 = *(const u32x4*)(c.Z + ((size_t)b * SEQ + r + d * j0) * DIN + ZV + hh * 64 + 8 * dc8);
        if (j0 + 1 >= 0 && j0 + 1 < L) v1 = *(const u32x4*)(c.Z + ((size_t)b * SEQ + r + d * (j0 + 1)) * DIN + ZV + hh * 64 + 8 * dc8);
#pragma unroll
        for (int e = 0; e < 4; ++e) {
            Vt[(8 * dc8 + 2 * e) * 194 + rp] = (v0[e] & 0xffffu) | (v1[e] << 16);
            Vt[(8 * dc8 + 2 * e + 1) * 194 + rp] = (v0[e] >> 16) | (v1[e] & 0xffff0000u);
        }
    }
    const int iq = i0 + 32 * wave + rq, posq = r + d * iq;
    const size_t tokq = (size_t)b * SEQ + posq;
    bf16_t* qrow = c.Z + tokq * DIN + ZQ + hh * 64;
    bf16x8 qf[4];
    {
        const u32x4 q0 = *(const u32x4*)(qrow + 8 * h), q1 = *(const u32x4*)(qrow + 16 + 8 * h), q2 = *(const u32x4*)(qrow + 32 + 8 * h), q3 = *(const u32x4*)(qrow + 48 + 8 * h);
        const float* rc = c.RC + posq * 32 + 8 * h; const float* rs = c.RS + posq * 32 + 8 * h;
        const f32x4 ca0 = *(const f32x4*)rc, ca1 = *(const f32x4*)(rc + 4), cb0 = *(const f32x4*)(rc + 16), cb1 = *(const f32x4*)(rc + 20);
        const f32x4 sa0 = *(const f32x4*)rs, sa1 = *(const f32x4*)(rs + 4), sb0 = *(const f32x4*)(rs + 16), sb1 = *(const f32x4*)(rs + 20);
        const float sc = 0.125f * 1.44269504f;
        u32x4 o0, o1, o2, o3;
#pragma unroll
        for (int e = 0; e < 4; ++e) {
            const float ca_0 = (e < 2) ? ca0[2 * e] : ca1[2 * e - 4], ca_1 = (e < 2) ? ca0[2 * e + 1] : ca1[2 * e - 3];
            const float sa_0 = (e < 2) ? sa0[2 * e] : sa1[2 * e - 4], sa_1 = (e < 2) ? sa0[2 * e + 1] : sa1[2 * e - 3];
            const float cb_0 = (e < 2) ? cb0[2 * e] : cb1[2 * e - 4], cb_1 = (e < 2) ? cb0[2 * e + 1] : cb1[2 * e - 3];
            const float sb_0 = (e < 2) ? sb0[2 * e] : sb1[2 * e - 4], sb_1 = (e < 2) ? sb0[2 * e + 1] : sb1[2 * e - 3];
            const float a0 = bflo(q0[e]), a1 = bfhi(q0[e]), b0 = bflo(q2[e]), b1 = bfhi(q2[e]);
            const float e0 = bflo(q1[e]), e1 = bfhi(q1[e]), f0 = bflo(q3[e]), f1 = bfhi(q3[e]);
            o0[e] = pk2((a0 * ca_0 - b0 * sa_0) * sc, (a1 * ca_1 - b1 * sa_1) * sc);
            o2[e] = pk2((b0 * ca_0 + a0 * sa_0) * sc, (b1 * ca_1 + a1 * sa_1) * sc);
            o1[e] = pk2((e0 * cb_0 - f0 * sb_0) * sc, (e1 * cb_1 - f1 * sb_1) * sc);
            o3[e] = pk2((f0 * cb_0 + e0 * sb_0) * sc, (f1 * cb_1 + e1 * sb_1) * sc);
        }
        qf[0] = __builtin_bit_cast(bf16x8, o0); qf[1] = __builtin_bit_cast(bf16x8, o1); qf[2] = __builtin_bit_cast(bf16x8, o2); qf[3] = __builtin_bit_cast(bf16x8, o3);
    }
    __syncthreads();
    f32x16 sacc[5];
#pragma unroll
    for (int kb = 0; kb < 5; ++kb) {
        f32x16 acc;
#pragma unroll
        for (int e = 0; e < 16; ++e) acc[e] = 0.f;
        const int row = 32 * wave + 32 * kb + rq;
#pragma unroll
        for (int s4 = 0; s4 < 4; ++s4) {
            const bf16x8 kf = *(const LASP bf16x8*)(Kt + row * 128 + (((2 * s4 + h) ^ (row & 7)) << 4));
            acc = __builtin_amdgcn_mfma_f32_32x32x16_bf16(kf, qf[s4], acc, 0, 0, 0);
        }
        sacc[kb] = acc;
    }
    const int jbase = i0 - 64 + 32 * wave;
    float mx = -1e30f;
#pragma unroll
    for (int kb = 0; kb < 5; ++kb)
#pragma unroll
        for (int e = 0; e < 16; ++e) {
            const int row = (e & 3) + 8 * (e >> 2) + 4 * h, rel = 32 * kb + row - rq, j = jbase + 32 * kb + row;
            const bool valid = (rel >= 0) && (rel <= 128) && (j >= 0) && (j < L);
            const float sv = valid ? sacc[kb][e] : -1e30f;
            sacc[kb][e] = sv; mx = fmaxf(mx, sv);
        }
    mx = fmaxf(mx, __shfl_xor(mx, 32));
    float lsum = 0.f;
#pragma unroll
    for (int kb = 0; kb < 5; ++kb)
#pragma unroll
        for (int e = 0; e < 16; ++e) { const float p = __builtin_amdgcn_exp2f(sacc[kb][e] - mx); sacc[kb][e] = p; lsum += p; }
    lsum += __shfl_xor(lsum, 32);
    f32x16 oacc[2];
#pragma unroll
    for (int db = 0; db < 2; ++db)
#pragma unroll
        for (int e = 0; e < 16; ++e) oacc[db][e] = 0.f;
#pragma unroll
    for (int kb = 0; kb < 5; ++kb)
#pragma unroll
        for (int s2 = 0; s2 < 2; ++s2) {
            u32x4 pw;
#pragma unroll
            for (int e = 0; e < 4; ++e) pw[e] = cvtpk(sacc[kb][8 * s2 + 2 * e], sacc[kb][8 * s2 + 2 * e + 1]);
            const bf16x8 pf = __builtin_bit_cast(bf16x8, pw);
            const int kp = (32 * wave + 32 * kb + 16 * s2 + 4 * h) >> 1;
#pragma unroll
            for (int db = 0; db < 2; ++db) {
                const LASP unsigned* vp = Vt + (32 * db + rq) * 194 + kp;
                const u32x2 g0 = *(const LASP u32x2*)vp, g1 = *(const LASP u32x2*)(vp + 4);
                const u32x4 aw = (u32x4){g0.x, g0.y, g1.x, g1.y};
                oacc[db] = __builtin_amdgcn_mfma_f32_32x32x16_bf16(__builtin_bit_cast(bf16x8, aw), pf, oacc[db], 0, 0, 0);
            }
        }
    if (do_store) {
        const float inv = 1.f / lsum;
#pragma unroll
        for (int db = 0; db < 2; ++db)
#pragma unroll
            for (int g4 = 0; g4 < 4; ++g4) {
                const u32x2 w = (u32x2){cvtpk(oacc[db][4 * g4] * inv, oacc[db][4 * g4 + 1] * inv), cvtpk(oacc[db][4 * g4 + 2] * inv, oacc[db][4 * g4 + 3] * inv)};
                *(u32x2*)(qrow + 32 * db + 8 * g4 + 4 * h) = w;
            }
        if (h == 0) c.LSE[((size_t)g * MT + tokq) * 4 + hI] = mx * 0.69314718f + __logf(lsum);
    }
    __syncthreads();
}


__device__ __forceinline__ f32x4 mfma16(bf16x8 a, bf16x8 b, f32x4 c) { return __builtin_amdgcn_mfma_f32_16x16x32_bf16(a, b, c, 0, 0, 0); }
template <int KSTEPS>
__device__ __forceinline__ void gemm64(const LASP unsigned char* Y, int kbyte0, const bf16_t* Bt, int ldb, f32x4 (&acc)[4][2], int fr, int fq) {
#pragma unroll 2
    for (int ks = 0; ks < KSTEPS; ++ks) {
        bf16x8 bfr[2], afr[4];
#pragma unroll
        for (int n = 0; n < 2; ++n) bfr[n] = *(const bf16x8*)(Bt + (size_t)(16 * n + fr) * ldb + ks * 32 + 8 * fq);
#pragma unroll
        for (int m = 0; m < 4; ++m) afr[m] = *(const LASP bf16x8*)(Y + (16 * m + fr) * 528 + kbyte0 + (ks * 32 + 8 * fq) * 2);
#pragma unroll
        for (int m = 0; m < 4; ++m)
#pragma unroll
            for (int n = 0; n < 2; ++n) acc[m][n] = mfma16(bfr[n], afr[m], acc[m][n]);
    }
}
__device__ __forceinline__ bf16x8 pack8(f32x4 lo, f32x4 hi) {
    u32x4 w; w.x = cvtpk(lo[0], lo[1]); w.y = cvtpk(lo[2], lo[3]); w.z = cvtpk(hi[0], hi[1]); w.w = cvtpk(hi[2], hi[3]);
    return __builtin_bit_cast(bf16x8, w);
}
__device__ __forceinline__ bf16x8 dft_frag(int rowidx, int kbase, int fq, bool perm, int which  ) {
    float v[8];
#pragma unroll
    for (int j = 0; j < 8; ++j) {
        const int k = kbase + (perm ? (16 * (j >> 2) + 4 * fq + (j & 3)) : (8 * fq + j));
        float sn, cs; sincospif((float)((rowidx * k) & 63) * (1.f / 32.f), &sn, &cs);
        v[j] = which == 0 ? cs : (which == 1 ? sn : -sn);
    }
    u32x4 w; w.x = pk2(v[0], v[1]); w.y = pk2(v[2], v[3]); w.z = pk2(v[4], v[5]); w.w = pk2(v[6], v[7]);
    return __builtin_bit_cast(bf16x8, w);
}

__device__ __forceinline__ void fft1_phase_mfma(const Ctx& c) {
    const int t = TIDX, lane = t & 63, wave = __builtin_amdgcn_readfirstlane(t >> 6), fr = lane & 15, fq = lane >> 4, n = wave & 3, hsel = wave >> 2;
    bf16x8 cA[2], sA[2], cB[2][2], sB[2][2], nsB[2][2];
#pragma unroll
    for (int ks = 0; ks < 2; ++ks) {
        cA[ks] = dft_frag(16 * n + fr, 32 * ks, fq, false, 0); sA[ks] = dft_frag(16 * n + fr, 32 * ks, fq, false, 1);
#pragma unroll
        for (int mbi = 0; mbi < 2; ++mbi) {
            const int k1r = 16 * (2 * hsel + mbi) + fr;
            cB[mbi][ks] = dft_frag(k1r, 32 * ks, fq, true, 0); sB[mbi][ks] = dft_frag(k1r, 32 * ks, fq, true, 1); nsB[mbi][ks] = dft_frag(k1r, 32 * ks, fq, true, 2);
        }
    }
    for (int u = BIDX; u < NB * 4 * 64; u += gridDim.x) {
        const int s2 = u & 63, bg = u >> 6, g = bg & 3, b = bg >> 2;
        f32x4 wre[4], wim[4];
#pragma unroll
        for (int m = 0; m < 4; ++m) { wre[m] = (f32x4){0.f, 0.f, 0.f, 0.f}; wim[m] = wre[m]; }
#pragma unroll
        for (int m = 0; m < 4; ++m)
#pragma unroll
            for (int ks = 0; ks < 2; ++ks) {
                const bf16x8 a = *(const bf16x8*)(c.Z + (size_t)(b * SEQ + 64 * (16 * m + fr) + s2) * DIN + ZA + 64 * g + 32 * ks + 8 * fq);
                wre[m] = mfma16(a, cA[ks], wre[m]); wim[m] = mfma16(a, sA[ks], wim[m]);
                asm volatile("" :: "v"(a), "v"(wre[m]), "v"(wim[m]));
            }
        asm volatile("s_nop 15\n\ts_nop 15" : "+v"(wre[0]), "+v"(wre[1]), "+v"(wre[2]), "+v"(wre[3]), "+v"(wim[0]), "+v"(wim[1]), "+v"(wim[2]), "+v"(wim[3]));
        bf16x8 bre[2], bim[2];
#pragma unroll
        for (int ks = 0; ks < 2; ++ks) { bre[ks] = pack8(wre[2 * ks], wre[2 * ks + 1]); bim[ks] = pack8(wim[2 * ks], wim[2 * ks + 1]); }
        asm volatile("s_nop 7" : "+v"(bre[0]), "+v"(bre[1]), "+v"(bim[0]), "+v"(bim[1]));
#pragma unroll
        for (int mbi = 0; mbi < 2; ++mbi) {
            f32x4 yre = (f32x4){0.f, 0.f, 0.f, 0.f}, yin = yre;
#pragma unroll
            for (int ks = 0; ks < 2; ++ks) {
                yre = mfma16(cB[mbi][ks], bre[ks], yre); yre = mfma16(nsB[mbi][ks], bim[ks], yre);
                yin = mfma16(cB[mbi][ks], bim[ks], yin); yin = mfma16(sB[mbi][ks], bre[ks], yin);
            }
            asm volatile("s_nop 15\n\ts_nop 15" : "+v"(yre), "+v"(yin));
#pragma unroll
            for (int rg = 0; rg < 4; ++rg) {
                const int k1 = 16 * (2 * hsel + mbi) + 4 * fq + rg;
                const float2 tw = c.TW[(k1 * s2) & 4095];
                const float yr = yre[rg], yi = -yin[rg];
                c.FY[((size_t)(bg * 64 + k1) * 64 + s2) * 64 + 16 * n + fr] = pk2(yr * tw.x + yi * tw.y, yi * tw.x - yr * tw.y);
            }
        }
    }
}

__device__ __forceinline__ void fft2_phase_mfma(const Ctx& c, int l, unsigned char* lds_raw) {
    LASP unsigned char* F = (LASP unsigned char*)lds_raw;
    const int t = TIDX, lane = t & 63, wave = __builtin_amdgcn_readfirstlane(t >> 6), fr = lane & 15, fq = lane >> 4, g = wave >> 1, nh = wave & 1;
    bf16x8 cF[4][2], sF[4][2];
#pragma unroll
    for (int m = 0; m < 4; ++m)
#pragma unroll
        for (int ks = 0; ks < 2; ++ks) { cF[m][ks] = dft_frag(16 * m + fr, 32 * ks, fq, false, 0); sF[m][ks] = dft_frag(16 * m + fr, 32 * ks, fq, false, 1); }
    for (int u = BIDX; u < NB * 64; u += gridDim.x) {
        const int b = u >> 6, k1 = u & 63;
        const unsigned* src = c.FY + (size_t)((b * 4 + g) * 64 + k1) * 4096;
#pragma unroll
        for (int nn = 0; nn < 2; ++nn) {
            const int cp = 16 * (2 * nh + nn) + fr;
            bf16x8 bre[2], bim[2];
#pragma unroll
            for (int ks = 0; ks < 2; ++ks) {
                unsigned w[8];
#pragma unroll
                for (int j = 0; j < 8; ++j) w[j] = src[(32 * ks + 8 * fq + j) * 64 + cp];
                u32x4 re, im;
#pragma unroll
                for (int e = 0; e < 4; ++e) { re[e] = (w[2 * e] & 0xffffu) | (w[2 * e + 1] << 16); im[e] = (w[2 * e] >> 16) | (w[2 * e + 1] & 0xffff0000u); }
                bre[ks] = __builtin_bit_cast(bf16x8, re); bim[ks] = __builtin_bit_cast(bf16x8, im);
            }
#pragma unroll
            for (int m = 0; m < 4; ++m) {
                f32x4 acc = (f32x4){0.f, 0.f, 0.f, 0.f};
#pragma unroll
                for (int ks = 0; ks < 2; ++ks) { acc = mfma16(bre[ks], cF[m][ks], acc); acc = mfma16(bim[ks], sF[m][ks], acc); }
                u32x2 wv; wv.x = cvtpk(acc[0] * (1.f / 512.f), acc[1] * (1.f / 512.f)); wv.y = cvtpk(acc[2] * (1.f / 512.f), acc[3] * (1.f / 512.f));
                *(LASP u32x2*)(F + (16 * m + fr) * 528 + (g * 64 + 16 * (2 * nh + nn) + 4 * fq) * 2) = wv;
            }
        }
        __syncthreads();
        f32x4 acc[4][2];
#pragma unroll
        for (int m = 0; m < 4; ++m)
#pragma unroll
            for (int n = 0; n < 2; ++n) acc[m][n] = (f32x4){0.f, 0.f, 0.f, 0.f};
        gemm64<8>(F, 0, c.WfT + (size_t)l * 65536 + (size_t)(32 * wave) * 256, 256, acc, fr, fq);
#pragma unroll
        for (int m = 0; m < 4; ++m)
#pragma unroll
            for (int n = 0; n < 2; ++n) {
                const size_t tok = (size_t)b * SEQ + k1 + 64 * (16 * m + fr); const int col = 32 * wave + 16 * n + 4 * fq;
                const u32x2 gp = *(const u32x2*)(c.Z + tok * DIN + ZG + col);
                u32x2 o; o.x = cvtpk(acc[m][n][0] * siluf_(bflo(gp.x)), acc[m][n][1] * siluf_(bfhi(gp.x))); o.y = cvtpk(acc[m][n][2] * siluf_(bflo(gp.y)), acc[m][n][3] * siluf_(bfhi(gp.y)));
                *(u32x2*)(c.P + tok * DM + col) = o;
            }
        __syncthreads();
    }
}

__device__ __forceinline__ void tok_unit_mfma(const Ctx& c, int l, int u, unsigned char* lds_raw) {
    LASP float* A = (LASP float*)lds_raw;
    LASP unsigned char* Y = (LASP unsigned char*)(lds_raw + 96256);
    const int t = TIDX, lane = t & 63, wave = __builtin_amdgcn_readfirstlane(t >> 6), ch = t & 255, half = t >> 8, fr = lane & 15, fq = lane >> 4;
    const int b = u >> 6, s0 = (u & 63) * 64, tok0 = b * SEQ + s0;
#pragma unroll 2
    for (int i = 0; i < 6; ++i) {
        const int id = t + 512 * i;
        if (id < 94 * 32) {
            const int row = id >> 5, c8 = (id & 31) * 8, sp = s0 - 15 + row;
            f32x4 v0 = (f32x4){0.f, 0.f, 0.f, 0.f}, v1 = v0;
            if (sp >= 0 && sp < SEQ) {
                const bf16_t* zr = c.Z + (size_t)(b * SEQ + sp) * DIN + ZB + c8;
                const u32x4 a = *(const u32x4*)zr, gg = *(const u32x4*)(zr + 256);
                v0[0] = bflo(a.x) * sigmoidf_(bflo(gg.x)); v0[1] = bfhi(a.x) * sigmoidf_(bfhi(gg.x)); v0[2] = bflo(a.y) * sigmoidf_(bflo(gg.y)); v0[3] = bfhi(a.y) * sigmoidf_(bfhi(gg.y));
                v1[0] = bflo(a.z) * sigmoidf_(bflo(gg.z)); v1[1] = bfhi(a.z) * sigmoidf_(bfhi(gg.z)); v1[2] = bflo(a.w) * sigmoidf_(bflo(gg.w)); v1[3] = bfhi(a.w) * sigmoidf_(bfhi(gg.w));
            }
            *(LASP f32x4*)(A + row * 256 + c8) = v0; *(LASP f32x4*)(A + row * 256 + c8 + 4) = v1;
        }
    }
    __syncthreads();
    float y[32];
    {
        float cw[31];
#pragma unroll
        for (int w = 0; w < 31; ++w) cw[w] = c.conv_w[(size_t)l * 31 * 256 + w * 256 + ch];
        const float cb = c.conv_b[l * 256 + ch];
#pragma unroll
        for (int cc = 0; cc < 4; ++cc) {
            float rows[38];
#pragma unroll
            for (int r = 0; r < 38; ++r) rows[r] = A[(half * 32 + cc * 8 + r) * 256 + ch];
#pragma unroll
            for (int i = 0; i < 8; ++i) {
                float acc = cb;
#pragma unroll
                for (int w = 0; w < 31; ++w) acc += rows[i + w] * cw[w];
                y[cc * 8 + i] = acc;
            }
            __builtin_amdgcn_sched_barrier(0);
        }
    }
    __syncthreads();
#pragma unroll
    for (int i = 0; i < 32; ++i) A[(half * 32 + i) * 256 + ch] = y[i];
    __syncthreads();
    {
        const f32x4 lg = *(const f32x4*)(c.conv_ln_g + l * 256 + 4 * lane), lb = *(const f32x4*)(c.conv_ln_b + l * 256 + 4 * lane);
#pragma unroll 2
        for (int i = 0; i < 8; ++i) {
            const int tk = wave * 8 + i;
            f32x4 xv = *(const LASP f32x4*)(A + tk * 256 + 4 * lane);
            const float mean = wave_sum((xv[0] + xv[1]) + (xv[2] + xv[3])) * (1.f / 256.f);
            xv = xv - mean;
            const float rstd = 1.0f / sqrtf(wave_sum((xv[0] * xv[0] + xv[1] * xv[1]) + (xv[2] * xv[2] + xv[3] * xv[3])) * (1.f / 256.f) + 1e-5f);
            const f32x4 yv = xv * rstd * lg + lb;
            u32x2 o; o.x = cvtpk(siluf_(yv[0]), siluf_(yv[1])); o.y = cvtpk(siluf_(yv[2]), siluf_(yv[3]));
            *(LASP u32x2*)(Y + tk * 528 + 8 * lane) = o;
        }
    }
    __syncthreads();
    {
        f32x4 acc[4][2];
#pragma unroll
        for (int m = 0; m < 4; ++m)
#pragma unroll
            for (int n = 0; n < 2; ++n) acc[m][n] = (f32x4){0.f, 0.f, 0.f, 0.f};
        gemm64<8>(Y, 0, c.WpwT + (size_t)l * 65536 + (size_t)(32 * wave) * 256, 256, acc, fr, fq);
#pragma unroll
        for (int m = 0; m < 4; ++m)
#pragma unroll
            for (int n = 0; n < 2; ++n) {
                const size_t tok = (size_t)tok0 + 16 * m + fr; const int col = 32 * wave + 16 * n + 4 * fq;
                const u32x2 gp = *(const u32x2*)(c.Z + tok * DIN + ZG + 256 + col);
                u32x2 o; o.x = cvtpk(acc[m][n][0] * siluf_(bflo(gp.x)), acc[m][n][1] * siluf_(bfhi(gp.x))); o.y = cvtpk(acc[m][n][2] * siluf_(bflo(gp.y)), acc[m][n][3] * siluf_(bfhi(gp.y)));
                *(u32x2*)(c.P + tok * DM + 256 + col) = o;
            }
    }
    __syncthreads();
#pragma unroll 2
    for (int i = 0; i < 5; ++i) {
        const int id = t + 512 * i;
        if (id < 79 * 32) {
            const int row = id >> 5, c8 = (id & 31) * 8, sp = s0 - 8 + row;
            f32x4 v0 = (f32x4){0.f, 0.f, 0.f, 0.f}, v1 = v0;
            if (sp >= 0 && sp < SEQ) {
                const u32x4 a = *(const u32x4*)(c.Z + (size_t)(b * SEQ + sp) * DIN + ZD + c8);
                v0[0] = bflo(a.x); v0[1] = bfhi(a.x); v0[2] = bflo(a.y); v0[3] = bfhi(a.y); v1[0] = bflo(a.z); v1[1] = bfhi(a.z); v1[2] = bflo(a.w); v1[3] = bfhi(a.w);
            }
            *(LASP f32x4*)(A + row * 256 + c8) = v0; *(LASP f32x4*)(A + row * 256 + c8 + 4) = v1;
        }
    }
    __syncthreads();
    {
        const int gi = ch >> 6, sz = 2 << gi;
#pragma unroll 1
        for (int i = 0; i < 32; ++i) {
            const int tk = half * 32 + i, sp = s0 + tk;
            int lo = sp - sz / 2; if (lo < 0) lo = 0;
            int hi = sp + sz - 1 - sz / 2; if (hi > SEQ - 1) hi = SEQ - 1;
            float sum = 0.f;
            for (int p = lo; p <= hi; ++p) sum += A[(p - s0 + 8) * 256 + ch];
            *(LASP bf16_t*)(Y + tk * 528 + ch * 2) = f2bf(sum / (float)(hi - lo + 1) - A[(tk + 8) * 256 + ch]);
        }
    }
    __syncthreads();
    {
        const int gi = wave >> 1, cb = (wave & 1) * 32;
        f32x4 acc[4][2];
#pragma unroll
        for (int m = 0; m < 4; ++m)
#pragma unroll
            for (int n = 0; n < 2; ++n) acc[m][n] = (f32x4){0.f, 0.f, 0.f, 0.f};
        gemm64<2>(Y, gi * 128, c.WpoolT + (size_t)(l * 4 + gi) * 4096 + (size_t)cb * 64, 64, acc, fr, fq);
#pragma unroll
        for (int m = 0; m < 4; ++m)
#pragma unroll
            for (int n = 0; n < 2; ++n) {
                const size_t tok = (size_t)tok0 + 16 * m + fr; const int col = gi * 64 + cb + 16 * n + 4 * fq;
                const u32x2 gp = *(const u32x2*)(c.Z + tok * DIN + ZG + 768 + col);
                const f32x4 ps = *(const f32x4*)(c.pool_scale + l * 256 + col);
                u32x2 o; o.x = cvtpk(acc[m][n][0] * ps[0] * siluf_(bflo(gp.x)), acc[m][n][1] * ps[1] * siluf_(bfhi(gp.x))); o.y = cvtpk(acc[m][n][2] * ps[2] * siluf_(bflo(gp.y)), acc[m][n][3] * ps[3] * siluf_(bfhi(gp.y)));
                *(u32x2*)(c.P + tok * DM + 768 + col) = o;
            }
    }
    __syncthreads();
}

__device__ __forceinline__ void fft2_unit(const Ctx& c, int l, int u, float* lds) {
    const int t = TIDX, b = u >> 6, k1 = u & 63, cp = t & 63;
    float* Ft = lds; float* Yre = lds + 64 * 260; float* Yim = Yre + 4096; float* cs = Yim + 4096; float* sn = cs + 64;
    if (t < 64) { float s, co; sincospif((float)t / 32.f, &s, &co); cs[t] = co; sn[t] = s; }
    for (int g = 0; g < 4; ++g) {
        const unsigned* src = c.FY + (size_t)((b * 4 + g) * 64 + k1) * 4096;
#pragma unroll
        for (int i = 0; i < 8; ++i) { const int idx = t + 512 * i; const unsigned w = src[idx]; Yre[idx] = bflo(w); Yim[idx] = bfhi(w); }
        __syncthreads();
#pragma unroll 1
        for (int i = 0; i < 8; ++i) {
            const int k2 = (t >> 6) + 8 * i; float acc = 0.f;
            for (int s2 = 0; s2 < 64; ++s2) { const int e = (k2 * s2) & 63; acc += cs[e] * Yre[s2 * 64 + cp] + sn[e] * Yim[s2 * 64 + cp]; }
            Ft[k2 * 260 + g * 64 + cp] = acc * (1.f / 512.f);
        }
        __syncthreads();
    }
    const int j = t & 255, half = t >> 8;
    float acc[32];
#pragma unroll
    for (int i = 0; i < 32; ++i) acc[i] = 0.f;
    const float* W = c.w_fourier + (size_t)l * 65536;
#pragma unroll 2
    for (int k = 0; k < 256; ++k) {
        const float wv = W[k * 256 + j];
#pragma unroll
        for (int i = 0; i < 32; ++i) acc[i] += Ft[(half * 32 + i) * 260 + k] * wv;
    }
    __syncthreads();
#pragma unroll
    for (int i = 0; i < 32; ++i) Ft[(half * 32 + i) * 260 + j] = acc[i];
    __syncthreads();
#pragma unroll 1
    for (int i = 0; i < 32; ++i) {
        const size_t tok = (size_t)b * SEQ + k1 + 64 * (half * 32 + i);
        const float gp = bf2f(c.Z[tok * DIN + ZG + j]);
        c.P[tok * DM + j] = f2bf(Ft[(half * 32 + i) * 260 + j] * siluf_(gp));
    }
    __syncthreads();
}

__device__ __forceinline__ void phase_combine(const Ctx& c) {
    const int gt = BIDX * NTHREADS + TIDX, NT = gridDim.x * NTHREADS;
    for (int idx = gt; idx < MT * 32; idx += NT) {
        const size_t m = idx >> 5; const int c8 = (idx & 31) * 8, hI = c8 >> 6;
        const float l0 = c.LSE[((size_t)0 * MT + m) * 4 + hI], l1 = c.LSE[((size_t)1 * MT + m) * 4 + hI], l2 = c.LSE[((size_t)2 * MT + m) * 4 + hI];
        const float mx = fmaxf(l0, fmaxf(l1, l2));
        const float e0 = __expf(l0 - mx), e1 = __expf(l1 - mx), e2 = __expf(l2 - mx), inv = 1.f / (e0 + e1 + e2);
        const float a0 = e0 * inv, a1 = e1 * inv, a2 = e2 * inv;
        const bf16_t* zr = c.Z + m * DIN;
        const u32x4 o0 = *(const u32x4*)(zr + ZQ + (0 * 4 + hI) * 64 + (c8 & 63));
        const u32x4 o1 = *(const u32x4*)(zr + ZQ + (1 * 4 + hI) * 64 + (c8 & 63));
        const u32x4 o2 = *(const u32x4*)(zr + ZQ + (2 * 4 + hI) * 64 + (c8 & 63));
        const u32x4 gp = *(const u32x4*)(zr + ZG + 512 + c8);
        u32x4 res;
#pragma unroll
        for (int q = 0; q < 4; ++q) {
            const float vlo = (a0 * bflo(o0[q]) + a1 * bflo(o1[q]) + a2 * bflo(o2[q])) * siluf_(bflo(gp[q]));
            const float vhi = (a0 * bfhi(o0[q]) + a1 * bfhi(o1[q]) + a2 * bfhi(o2[q])) * siluf_(bfhi(gp[q]));
            res[q] = pk2(vlo, vhi);
        }
        *(u32x4*)(c.P + m * DM + 512 + c8) = res;
    }
}

namespace pg8 {
#define PG8_LAS __attribute__((address_space(3)))
typedef unsigned short bf16_t;
typedef short bf16x8 __attribute__((ext_vector_type(8)));
typedef float f32x4 __attribute__((ext_vector_type(4)));
typedef unsigned u32x4 __attribute__((ext_vector_type(4)));
constexpr int BM = 256, BK = 64, HALF = 128, HTB = HALF * BK * 2  , STAGE_BYTES = 8 * HTB, NXCD = 8, WGM = 8;

__host__ __device__ __forceinline__ int lds_byte(int r, int c) { const int st = (r >> 4) * 2 + (c >> 5), rr = r & 15, cc = c & 31, ob = rr * 64 + cc * 2; return st * 1024 + (ob ^ (((ob >> 9) & 1) << 5)); }
__host__ __device__ __forceinline__ void stage_rc(int b, int& R, int& C) { const int st = b / 1024, sb = b % 1024, swz = sb ^ (((sb >> 9) & 1) << 5); R = (st >> 1) * 16 + swz / 64; C = (st & 1) * 32 + (swz % 64) / 2; }
__host__ __device__ __forceinline__ int perm32(int rho) { const int n = rho >> 4, i = rho & 15; return 8 * (i >> 2) + 4 * n + (i & 3); }

struct Unit { int pm, pn, sub; };
template <int LDA_, int LDB_, int K_, int ASUB_, int BSUB_> struct GemmT { const bf16_t* A; const bf16_t* Bt; static constexpr int lda = LDA_, ldb = LDB_, K = K_; static constexpr size_t a_sub = ASUB_, b_sub = BSUB_; };

struct StaticOrder {
    int nM, nN, nwg, G, c;
    __host__ __device__ void init(int M, int N, int G_, int c_) { nM = M / BM; nN = N / BM; nwg = nM * nN; G = G_; c = c_; }
    __host__ __device__ bool next(int i, Unit& u) const {
        const long L = (long)i * G + c; if (L >= nwg) return false;
        int wgid = (int)L; { const int q = nwg / NXCD, r = nwg % NXCD, xcd = wgid % NXCD, off = wgid / NXCD; wgid = (xcd < r ? xcd * (q + 1) : r * (q + 1) + (xcd - r) * q) + off; }
        const int nig = WGM * nN, gid = wgid / nig, fm = gid * WGM, gsz = (nM - fm) < WGM ? (nM - fm) : WGM;
        u.pm = fm + ((wgid % nig) % gsz); u.pn = (wgid % nig) / gsz; u.sub = 0; return true;
    }
    __device__ __forceinline__ void a_ready(const Unit&) const {}
    __device__ __forceinline__ void done(const Unit&) const {}
};


__device__ __forceinline__ unsigned cvt_pk_bf16(float lo, float hi) { return ::pk2(lo, hi); }
template <int ACT  > struct EpiBf16 {
    static constexpr bool PERM = true, AFTER_DRAIN = false; static_assert(ACT == 0 || ACT == 2, "EpiBf16: ACT is 0 (none) or 2 (sigmoid)");
    bf16_t* O; int ldc; const float* bias; int split_cols; size_t split_stride; float scale0;
    __device__ __forceinline__ void operator()(const f32x4 (&acc)[2][2][4][2], const Unit& u, int wr, int wc, int fr, int fq) const {
        asm volatile("" : "+v"(fr), "+v"(fq));
        const int row0 = u.pm * BM + wr * 64 + fr; int colt = u.pn * BM; bf16_t* base = O;
        float sc = 1.f; if (split_cols) { const int t = colt / split_cols; base += (size_t)t * split_stride; colt -= t * split_cols; if (t == 0) sc = scale0; }
        const int col0 = colt + wc * 32 + 8 * fq, bcol0 = u.pn * BM + wc * 32 + 8 * fq;
        f32x4 bv[2][2];
#pragma unroll
        for (int bj = 0; bj < 2; ++bj)
#pragma unroll
            for (int n = 0; n < 2; ++n) bv[bj][n] = bias ? *(const f32x4*)(bias + bcol0 + bj * HALF + 4 * n) : (f32x4){0.f, 0.f, 0.f, 0.f};
#pragma unroll
        for (int ai = 0; ai < 2; ++ai)
#pragma unroll
            for (int m = 0; m < 4; ++m) { bf16_t* rowp = base + (size_t)(row0 + ai * HALF + m * 16) * ldc + col0;
#pragma unroll
                for (int bj = 0; bj < 2; ++bj) { f32x4 v0 = acc[ai][bj][m][0] + bv[bj][0], v1 = acc[ai][bj][m][1] + bv[bj][1];
                    if (ACT == 2) {
#pragma unroll
                        for (int q = 0; q < 4; ++q) { v0[q] = __builtin_amdgcn_rcpf(1.0f + __builtin_amdgcn_exp2f(v0[q] * -1.44269504f)); v1[q] = __builtin_amdgcn_rcpf(1.0f + __builtin_amdgcn_exp2f(v1[q] * -1.44269504f)); } }
                    v0 = v0 * sc; v1 = v1 * sc; u32x4 w; w.x = cvt_pk_bf16(v0[0], v0[1]); w.y = cvt_pk_bf16(v0[2], v0[3]); w.z = cvt_pk_bf16(v1[0], v1[1]); w.w = cvt_pk_bf16(v1[2], v1[3]);
                    *(u32x4*)(rowp + bj * HALF) = w; } }
    }
};

struct EpiMerge {
    static constexpr bool PERM = true, AFTER_DRAIN = false;
    const bf16_t* MG; bf16_t* O;
    __device__ __forceinline__ void operator()(const f32x4 (&acc)[2][2][4][2], const Unit& u, int wr, int wc, int fr, int fq) const {
        asm volatile("" : "+v"(fr), "+v"(fq));
        const int row0 = u.pm * BM + wr * 64 + fr, col0 = u.pn * BM + wc * 32 + 8 * fq;
#pragma unroll
        for (int ai = 0; ai < 2; ++ai)
#pragma unroll
            for (int m = 0; m < 4; ++m) { const size_t row = (size_t)(row0 + ai * HALF + m * 16);
#pragma unroll
                for (int bj = 0; bj < 2; ++bj) {
                    const u32x4 g = *(const u32x4*)(MG + row * 4096 + u.sub * 1024 + col0 + bj * HALF);
                    bf16_t* op = O + row * 1024 + col0 + bj * HALF;
                    f32x4 v0 = acc[ai][bj][m][0], v1 = acc[ai][bj][m][1];
                    v0[0] *= __uint_as_float(g.x << 16); v0[1] *= __uint_as_float(g.x & 0xffff0000u); v0[2] *= __uint_as_float(g.y << 16); v0[3] *= __uint_as_float(g.y & 0xffff0000u);
                    v1[0] *= __uint_as_float(g.z << 16); v1[1] *= __uint_as_float(g.z & 0xffff0000u); v1[2] *= __uint_as_float(g.w << 16); v1[3] *= __uint_as_float(g.w & 0xffff0000u);
                    if (u.sub != 0) { const u32x4 p = *(const u32x4*)op;
                        v0[0] += __uint_as_float(p.x << 16); v0[1] += __uint_as_float(p.x & 0xffff0000u); v0[2] += __uint_as_float(p.y << 16); v0[3] += __uint_as_float(p.y & 0xffff0000u);
                        v1[0] += __uint_as_float(p.z << 16); v1[1] += __uint_as_float(p.z & 0xffff0000u); v1[2] += __uint_as_float(p.w << 16); v1[3] += __uint_as_float(p.w & 0xffff0000u); }
                    u32x4 w; w.x = cvt_pk_bf16(v0[0], v0[1]); w.y = cvt_pk_bf16(v0[2], v0[3]); w.z = cvt_pk_bf16(v1[0], v1[1]); w.w = cvt_pk_bf16(v1[2], v1[3]);
                    *(u32x4*)op = w; }
                asm volatile("" ::: "memory"); }
    }
};
struct EpiOutF32 {
    static constexpr bool PERM = true, AFTER_DRAIN = false;
    const float* xin; float* out;
    __device__ __forceinline__ void operator()(const f32x4 (&acc)[2][2][4][2], const Unit& u, int wr, int wc, int fr, int fq) const {
        asm volatile("" : "+v"(fr), "+v"(fq));
        const int row0 = u.pm * BM + wr * 64 + fr, col0 = u.pn * BM + wc * 32 + 8 * fq;
#pragma unroll
        for (int ai = 0; ai < 2; ++ai)
#pragma unroll
            for (int m = 0; m < 4; ++m) { const size_t off = (size_t)(row0 + ai * HALF + m * 16) * 1024 + col0;
#pragma unroll
                for (int bj = 0; bj < 2; ++bj) {
                    const f32x4 x0 = *(const f32x4*)(xin + off + bj * HALF), x1 = *(const f32x4*)(xin + off + bj * HALF + 4);
                    *(f32x4*)(out + off + bj * HALF) = x0 + acc[ai][bj][m][0]; *(f32x4*)(out + off + bj * HALF + 4) = x1 + acc[ai][bj][m][1]; }
                asm volatile("" ::: "memory"); }
    }
};
struct MergeOrder : StaticOrder {
    __device__ bool next(int i, Unit& u) const { const bool ok = StaticOrder::next(i >> 2, u); u.sub = i & 3; return ok; }
};

template <class Epi, class Sched, class Gemm, bool ALIGN_EPI = false, bool SP2 = false>
__device__ __forceinline__ void gemm_phase(PG8_LAS unsigned char* lds, const Gemm g, const Sched& S, const Epi& E) {
    const int tid = TIDX, wid = __builtin_amdgcn_readfirstlane(tid >> 6), lane = tid & 63, wr = wid >> 2, wc = wid & 3, fr = lane & 15, fq = lane >> 4;
    constexpr int K = Gemm::K, nt = K / BK, lda = Gemm::lda, ldb = Gemm::ldb;
    unsigned voffA[2], voffB[2];
#pragma unroll
    for (int i = 0; i < 2; ++i) { int R, C; stage_rc(tid * 16 + i * 8192, R, C); const int Rb = Epi::PERM ? ((R & ~31) + perm32(R & 31)) : R;
        voffA[i] = (unsigned)(R * lda + C) * 2u; voffB[i] = (unsigned)(Rb * ldb + C) * 2u; }
    const size_t kstep = (size_t)(BK * 2);
    const size_t hstepA = (size_t)HALF * lda * 2, hstepB = (size_t)HALF * ldb * 2;
    const size_t tstepA = 2 * hstepA, tstepB = 2 * hstepB;
    const unsigned ldsw = (unsigned)wid * 1024u;
    const int aoff = lds_byte(wr * 64 + fr, fq * 8), boff = lds_byte(wc * 32 + fr, fq * 8);
#define PG8_SA(b, h) (((b) * 2 + (h)) * HTB)
#define PG8_SB(b, h) ((4 + (b) * 2 + (h)) * HTB)
#define PG8_STAGE(bufoff, gbase, voff) do { _Pragma("unroll") for (int _i = 0; _i < 2; ++_i) \
        __builtin_amdgcn_global_load_lds((const unsigned*)((const char*)(gbase) + (voff)[_i]), (PG8_LAS unsigned*)(lds + (bufoff) + ldsw + _i * 8192), 16, 0, 0); } while (0)
#define PG8_LDA(dst, b, h) do { _Pragma("unroll") for (int m = 0; m < 4; ++m) _Pragma("unroll") for (int k = 0; k < 2; ++k) dst[m][k] = *(const PG8_LAS bf16x8*)(lds + PG8_SA(b, h) + aoff + m * 2048 + k * 1024); } while (0)
#define PG8_LDB(dst, b, h) do { _Pragma("unroll") for (int n = 0; n < 2; ++n) _Pragma("unroll") for (int k = 0; k < 2; ++k) dst[n][k] = *(const PG8_LAS bf16x8*)(lds + PG8_SB(b, h) + boff + n * 2048 + k * 1024); } while (0)
#define PG8_MMA(ai, bj, At, Bt) do { __builtin_amdgcn_s_setprio(1); _Pragma("unroll") for (int m = 0; m < 4; ++m) _Pragma("unroll") for (int n = 0; n < 2; ++n) _Pragma("unroll") for (int k = 0; k < 2; ++k) \
        acc[ai][bj][m][n] = __builtin_amdgcn_mfma_f32_16x16x32_bf16(Bt[n][k], At[m][k], acc[ai][bj][m][n], 0, 0, 0); __builtin_amdgcn_s_setprio(0); } while (0)
#define PG8_WAIT_V(n) asm volatile("s_waitcnt vmcnt(" #n ")" ::: "memory")
#define PG8_WAIT_L(n) asm volatile("s_waitcnt lgkmcnt(" #n ")" ::: "memory")
#define PG8_BAR __builtin_amdgcn_s_barrier()
#define PG8_SCHED __builtin_amdgcn_sched_barrier(0)
    Unit cur, nxt; int ui = 0;
    if (!S.next(0, cur)) return;
    f32x4 acc[2][2][4][2];
#pragma unroll
    for (int a = 0; a < 2; ++a)
#pragma unroll
        for (int b = 0; b < 2; ++b)
#pragma unroll
            for (int m = 0; m < 4; ++m)
#pragma unroll
                for (int n = 0; n < 2; ++n) acc[a][b][m][n] = (f32x4){0.f, 0.f, 0.f, 0.f};
    bf16x8 At[4][2], B0[2][2], B1[2][2];
    const char* cA = (const char*)g.A + (size_t)cur.pm * tstepA + (size_t)cur.sub * g.a_sub; const char* cB = (const char*)g.Bt + (size_t)cur.pn * tstepB + (size_t)cur.sub * g.b_sub;
    S.a_ready(cur);
    if constexpr (SP2) {
        PG8_STAGE(PG8_SB(0, 0), cB, voffB); PG8_STAGE(PG8_SB(0, 1), cB + hstepB, voffB); PG8_STAGE(PG8_SA(0, 0), cA, voffA); PG8_STAGE(PG8_SA(0, 1), cA + hstepA, voffA);
        if (wr == 1) PG8_BAR;
        PG8_WAIT_V(2); PG8_BAR;
        PG8_STAGE(PG8_SB(1, 0), cB + kstep, voffB); PG8_STAGE(PG8_SA(1, 0), cA + kstep, voffA); PG8_STAGE(PG8_SB(1, 1), cB + hstepB + kstep, voffB);
        PG8_WAIT_V(6); PG8_BAR;
    } else {
        PG8_STAGE(PG8_SB(0, 0), cB, voffB); PG8_STAGE(PG8_SA(0, 0), cA, voffA); PG8_STAGE(PG8_SB(0, 1), cB + hstepB, voffB); PG8_STAGE(PG8_SA(0, 1), cA + hstepA, voffA);
        if (wr == 1) PG8_BAR;
        PG8_WAIT_V(4); PG8_BAR;
        PG8_STAGE(PG8_SB(1, 0), cB + kstep, voffB); PG8_STAGE(PG8_SA(1, 0), cA + kstep, voffA); PG8_STAGE(PG8_SB(1, 1), cB + hstepB + kstep, voffB);
        PG8_WAIT_V(6); PG8_BAR;
    }
    for (;;) {
        const bool has_next = S.next(ui + 1, nxt);
        const char* nA = has_next ? (const char*)g.A + (size_t)nxt.pm * tstepA + (size_t)nxt.sub * g.a_sub : cA; const char* nB = has_next ? (const char*)g.Bt + (size_t)nxt.pn * tstepB + (size_t)nxt.sub * g.b_sub : cB;
        for (int t = 0; t < nt; t += 2) {
            const bool last = (t == nt - 2);
            const char* a1 = cA + (size_t)(t + 1) * kstep;
            const char* a2 = last ? nA : cA + (size_t)(t + 2) * kstep; const char* b2 = last ? nB : cB + (size_t)(t + 2) * kstep;
            const char* a3 = a2 + kstep; const char* b3 = b2 + kstep;
            if (last && has_next) S.a_ready(nxt);
            if constexpr (SP2) {
            PG8_LDB(B0, 0, 0); PG8_LDB(B1, 0, 1); PG8_SCHED; PG8_LDA(At, 0, 0); PG8_STAGE(PG8_SA(1, 1), a1 + hstepA, voffA);
            PG8_WAIT_V(8); PG8_WAIT_L(0); PG8_BAR; PG8_MMA(0, 0, At, B0); PG8_MMA(0, 1, At, B1); PG8_BAR; PG8_SCHED;
            PG8_LDA(At, 0, 1); PG8_STAGE(PG8_SB(0, 0), b2, voffB); PG8_STAGE(PG8_SB(0, 1), b2 + hstepB, voffB); PG8_STAGE(PG8_SA(0, 0), a2, voffA);
            PG8_WAIT_V(8); PG8_WAIT_L(0); PG8_BAR; PG8_MMA(1, 0, At, B0); PG8_MMA(1, 1, At, B1); PG8_BAR; PG8_SCHED;
            PG8_LDB(B0, 1, 0); PG8_LDB(B1, 1, 1); PG8_SCHED; PG8_LDA(At, 1, 0); PG8_STAGE(PG8_SA(0, 1), a2 + hstepA, voffA);
            PG8_WAIT_V(8); PG8_WAIT_L(0); PG8_BAR; PG8_MMA(0, 0, At, B0); PG8_MMA(0, 1, At, B1); PG8_BAR; PG8_SCHED;
            PG8_LDA(At, 1, 1); PG8_STAGE(PG8_SB(1, 0), b3, voffB); PG8_STAGE(PG8_SB(1, 1), b3 + hstepB, voffB); PG8_STAGE(PG8_SA(1, 0), a3, voffA);
            PG8_WAIT_V(8); PG8_WAIT_L(0); PG8_BAR; PG8_MMA(1, 0, At, B0); PG8_MMA(1, 1, At, B1); PG8_BAR; PG8_SCHED;
            } else {
            PG8_LDB(B0, 0, 0); PG8_SCHED; PG8_LDA(At, 0, 0); PG8_STAGE(PG8_SA(1, 1), a1 + hstepA, voffA);
            PG8_WAIT_L(8); PG8_BAR; PG8_WAIT_L(0); PG8_MMA(0, 0, At, B0); PG8_BAR; PG8_SCHED;
            PG8_LDB(B1, 0, 1); PG8_STAGE(PG8_SB(0, 0), b2, voffB);
            PG8_BAR; PG8_WAIT_L(0); PG8_MMA(0, 1, At, B1); PG8_BAR;
            PG8_LDA(At, 0, 1); PG8_STAGE(PG8_SA(0, 0), a2, voffA);
            PG8_BAR; PG8_WAIT_L(0); PG8_MMA(1, 0, At, B0); PG8_BAR; PG8_SCHED;
            PG8_STAGE(PG8_SB(0, 1), b2 + hstepB, voffB);
            PG8_WAIT_V(6); PG8_BAR; PG8_MMA(1, 1, At, B1); PG8_BAR;
            PG8_LDB(B0, 1, 0); PG8_SCHED; PG8_LDA(At, 1, 0); PG8_STAGE(PG8_SA(0, 1), a2 + hstepA, voffA);
            PG8_WAIT_L(8); PG8_BAR; PG8_WAIT_L(0); PG8_MMA(0, 0, At, B0); PG8_BAR; PG8_SCHED;
            PG8_LDB(B1, 1, 1); PG8_STAGE(PG8_SB(1, 0), b3, voffB);
            PG8_BAR; PG8_WAIT_L(0); PG8_MMA(0, 1, At, B1); PG8_BAR;
            PG8_LDA(At, 1, 1); PG8_STAGE(PG8_SA(1, 0), a3, voffA);
            PG8_BAR; PG8_WAIT_L(0); PG8_MMA(1, 0, At, B0); PG8_BAR; PG8_SCHED;
            PG8_STAGE(PG8_SB(1, 1), b3 + hstepB, voffB);
            PG8_WAIT_V(6); PG8_BAR; PG8_MMA(1, 1, At, B1); PG8_BAR;
            }
        }
        if constexpr (ALIGN_EPI) { if (wr == 0) PG8_BAR; }
        if constexpr (!Epi::AFTER_DRAIN) { E(acc, cur, wr, wc, fr, fq); S.done(cur); }
        if (!has_next) break;
#pragma unroll
        for (int a = 0; a < 2; ++a)
#pragma unroll
            for (int b = 0; b < 2; ++b)
#pragma unroll
                for (int m = 0; m < 4; ++m)
#pragma unroll
                    for (int n = 0; n < 2; ++n) acc[a][b][m][n] = (f32x4){0.f, 0.f, 0.f, 0.f};
        cur = nxt; cA = nA; cB = nB; ++ui;
        if constexpr (ALIGN_EPI) { if (wr == 1) PG8_BAR; }
    }
    PG8_WAIT_V(0);
    if constexpr (!ALIGN_EPI) { if (wr == 0) PG8_BAR; }
    PG8_BAR;
    if constexpr (Epi::AFTER_DRAIN) { E.fused(acc, cur, wr, wc, fr, fq, lds, wid, lane); S.done(cur); }
#undef PG8_SA
#undef PG8_SB
#undef PG8_STAGE
#undef PG8_LDA
#undef PG8_LDB
#undef PG8_MMA
#undef PG8_WAIT_V
#undef PG8_WAIT_L
#undef PG8_BAR
#undef PG8_SCHED
}
}

typedef const __attribute__((address_space(4))) Args* KArgs;
__device__ __forceinline__ void make_ctx(Ctx& c) {
    KArgs ap = (KArgs)__builtin_amdgcn_kernarg_segment_ptr();
    asm volatile("" : "+s"(ap));
    c.x = ap->in[0]; c.norm_g = ap->in[1]; c.w_in = ap->in[2]; c.w_fourier = ap->in[3]; c.conv_w = ap->in[4]; c.conv_b = ap->in[5]; c.conv_ln_g = ap->in[6]; c.conv_ln_b = ap->in[7];
    c.w_pw = ap->in[8]; c.w_pool = ap->in[9]; c.pool_scale = ap->in[10]; c.w_branch = ap->in[11]; c.w_gate = ap->in[12]; c.b_gate = ap->in[13]; c.w_out = ap->in[14]; c.final_g = ap->in[15];
    c.out = ap->out;
    unsigned char* ws = ap->ws;
    c.WinT = (bf16_t*)(ws + WS_WIN); c.WgT = (bf16_t*)(ws + WS_WG); c.WbT = (bf16_t*)(ws + WS_WB); c.WoT = (bf16_t*)(ws + WS_WO); c.WfT = (bf16_t*)(ws + WS_WF); c.WpwT = (bf16_t*)(ws + WS_WPW); c.WpoolT = (bf16_t*)(ws + WS_WPOOL);
    c.TW = (float2*)(ws + WS_TW); c.RC = (float*)(ws + WS_RC); c.RS = (float*)(ws + WS_RS);
    c.H = (bf16_t*)(ws + WS_H); c.Z = (bf16_t*)(ws + WS_Z); c.P = (bf16_t*)(ws + WS_P); c.FY = (unsigned*)(ws + WS_FY); c.LSE = (float*)(ws + WS_LSE);
}
constexpr int NPHASES = 1 + 7 * DEPTH;

#define XB_TMO      128
#define XB_XCNT(j)  (256  + 64 * (j))
#define XB_XSUB(j)  (1280 + 64 * (j))
#define XB_XGEN(j)  (2304 + 64 * (j))
#define XB_TOP      3328
#define XB_TOPGEN   3392
#define XCD_BAR_WORDS 3456
#define XB_SPIN_CAP (1u << 18)
#define LAS __attribute__((address_space(3)))

__device__ __forceinline__ unsigned xb_ld(unsigned* p)              { return __hip_atomic_load(p, __ATOMIC_RELAXED, __HIP_MEMORY_SCOPE_AGENT); }
__device__ __forceinline__ unsigned xb_add(unsigned* p, unsigned v) { return __hip_atomic_fetch_add(p, v, __ATOMIC_RELAXED, __HIP_MEMORY_SCOPE_AGENT); }
__device__ __forceinline__ unsigned xb_xcc_id() { return (unsigned)__builtin_amdgcn_s_getreg((3 << 11) | 20) & 0xFu; }
#define XB_SPIN(cond, bar) do { unsigned _sp = 0; while (cond) { __builtin_amdgcn_s_sleep(1); \
    if ((++_sp & 255u) == 0u) { if (xb_ld(&(bar)[XB_TMO])) break; if (_sp > XB_SPIN_CAP) { atomicAdd(&(bar)[XB_TMO], 1u); break; } } } } while (0)

struct XcdBarrier {
    unsigned* bar; unsigned x;
    volatile LAS unsigned* st;
};

__device__ __forceinline__ XcdBarrier xcd_barrier_post(unsigned* bar, volatile LAS unsigned* st) {
    XcdBarrier b; b.bar = bar; b.x = xb_xcc_id(); b.st = st;
    if (threadIdx.x == 0) (void)xb_add(&bar[XB_XCNT(b.x)], 1u);
    return b;
}
__device__ __forceinline__ void xcd_barrier_complete(unsigned* bar, unsigned x, unsigned& nloc, unsigned& nx) {
    const unsigned G = gridDim.x * gridDim.y * gridDim.z;
    unsigned sum, cnt, mine, sp = 0u;
    for (;;) {
        sum = 0u; cnt = 0u; mine = 0u;
#pragma unroll
        for (unsigned j = 0; j < 16; ++j) { const unsigned c = xb_ld(&bar[XB_XCNT(j)]); sum += c; cnt += (c > 0u) ? 1u : 0u; mine = (j == x) ? c : mine; }
        if (sum == G) break;
        __builtin_amdgcn_s_sleep(1);
        if ((++sp & 255u) == 0u) { if (xb_ld(&bar[XB_TMO])) break; if (sp > XB_SPIN_CAP) { atomicAdd(&bar[XB_TMO], 1u); break; } }
    }
    nloc = mine > 0u ? mine : 1u; nx = cnt > 0u ? cnt : 1u;
}

__device__ __forceinline__ void xcd_barrier(const XcdBarrier& b) {
    asm volatile("s_waitcnt vmcnt(0)" ::: "memory");
    __syncthreads();
    if (threadIdx.x == 0) {
        unsigned* bar = b.bar;
        __builtin_amdgcn_s_waitcnt(0);
        unsigned nloc = b.st[0], nx = b.st[1];
        if (nloc == 0u) { xcd_barrier_complete(bar, b.x, nloc, nx); b.st[0] = nloc; b.st[1] = nx; }
        const unsigned old = xb_add(&bar[XB_XSUB(b.x)], 1u);
        const unsigned gen = old / nloc;
        if (old + 1u == (gen + 1u) * nloc) {
            __builtin_amdgcn_fence(__ATOMIC_RELEASE, "agent");
            asm volatile("s_waitcnt vmcnt(0)" ::: "memory");
            const unsigned og = xb_add(&bar[XB_TOP], 1u);
            const unsigned tg = og / nx;
            if (og + 1u == (tg + 1u) * nx) xb_add(&bar[XB_TOPGEN], 1u);
            else XB_SPIN(xb_ld(&bar[XB_TOPGEN]) == tg, bar);
            __builtin_amdgcn_fence(__ATOMIC_ACQUIRE, "agent");
            xb_add(&bar[XB_XGEN(b.x)], 1u);
            asm volatile("s_waitcnt vmcnt(0)" ::: "memory");
        } else {
            XB_SPIN(xb_ld(&bar[XB_XGEN(b.x)]) == gen, bar);
            __builtin_amdgcn_fence(__ATOMIC_ACQUIRE, "agent");
            asm volatile("s_waitcnt vmcnt(0)" ::: "memory");
        }
    }
    __syncthreads();
}


template <int L, int Q>
__device__ __forceinline__ void layer_phase(unsigned char* lds_raw) {
    float* lds = (float*)lds_raw;
    constexpr int l = L;
    constexpr int nrep = (Q == REPQ) ? 2 : 1;
#pragma unroll 1
    for (int rep = 0; rep < nrep; ++rep) {
        Ctx c; make_ctx(c);
        const bool st_ = (rep == 0);
        if constexpr (Q == 0) {
            typedef pg8::GemmT<DM, DM, DM, 0, 0> GT; GT g{c.H, c.WinT + (size_t)l * DIN * DM}; pg8::StaticOrder S; S.init(MT, DIN, (int)gridDim.x, BIDX);
            pg8::EpiBf16<0> E{c.Z, DIN, nullptr, 0, 0, 1.f};
            pg8::gemm_phase<pg8::EpiBf16<0>, pg8::StaticOrder, GT, true, true>((PG8_LAS unsigned char*)lds_raw, g, S, E);
        } else if constexpr (Q == 1) {
            constexpr int NF = NB * 4 * 64, NTK = NB * 64, NAT = NB * 192;
            if (rep == 0 || (REPSUB & 1)) for (int u = BIDX; u < NAT; u += gridDim.x) attn_unit_mfma(c, u, lds_raw, st_);
            __builtin_amdgcn_sched_barrier(0);
            if (rep == 0 || (REPSUB & 2)) for (int u = BIDX; u < NTK; u += gridDim.x) { if (NEW_TOK) tok_unit_mfma(c, l, u, lds_raw); else tok_unit(c, l, u, lds); }
            __builtin_amdgcn_sched_barrier(0);
            if (rep == 0 || (REPSUB & 4)) { if (NEW_FFT1) fft1_phase_mfma(c); else for (int u = BIDX; u < NF; u += gridDim.x) fft1_unit(c, u, lds); }
        } else if constexpr (Q == 2) {
            if (NEW_FFT2) fft2_phase_mfma(c, l, lds_raw); else for (int u = BIDX; u < NB * 64; u += gridDim.x) fft2_unit(c, l, u, lds);
            phase_combine(c);
        } else if constexpr (Q == 3) {
            typedef pg8::GemmT<DM, DM, DM, 0, 0> GT; GT g{c.H, c.WgT + (size_t)l * 4096 * DM}; pg8::StaticOrder S; S.init(MT, 4096, (int)gridDim.x, BIDX);
            pg8::EpiBf16<2> E{c.Z, 4096, c.b_gate + (size_t)l * 4096, 0, 0, 1.f};
            pg8::gemm_phase<pg8::EpiBf16<2>, pg8::StaticOrder, GT, true, true>((PG8_LAS unsigned char*)lds_raw, g, S, E);
        } else if constexpr (Q == 4) {
            typedef pg8::GemmT<DM, 256, 256, 512, 1024 * 256 * 2> GT; GT g{c.P, c.WbT + (size_t)l * 4 * 1024 * 256}; pg8::MergeOrder S; S.init(MT, DM, (int)gridDim.x, BIDX);
            pg8::EpiMerge E{c.Z, c.H};
            pg8::gemm_phase<pg8::EpiMerge, pg8::MergeOrder, GT, true, true>((PG8_LAS unsigned char*)lds_raw, g, S, E);
        } else if constexpr (Q == 5) {
            typedef pg8::GemmT<DM, DM, DM, 0, 0> GT; GT g{c.H, c.WoT + (size_t)l * DM * DM}; pg8::StaticOrder S; S.init(MT, DM, (int)gridDim.x, BIDX);
            pg8::EpiOutF32 E{(l == 0) ? c.x : c.out, c.out};
            pg8::gemm_phase<pg8::EpiOutF32, pg8::StaticOrder, GT, true, true>((PG8_LAS unsigned char*)lds_raw, g, S, E);
        } else {
            if (l + 1 < DEPTH) phase_norm_bf16(c.out, c.norm_g + (size_t)(l + 1) * DM, c.H);
            else phase_norm_final(c.out, c.final_g);
        }
        if (rep + 1 < nrep) __syncthreads();
    }
}

__global__ void __launch_bounds__(NTHREADS, 2) fwd_kernel(Args a) {
    extern __shared__ __attribute__((aligned(16))) unsigned char lds_raw[];
    const int lo = a.ph_lo, hi = a.ph_hi;
    volatile LAS unsigned* bst = (volatile LAS unsigned*)(lds_raw + LDS_BYTES - 16);
    if (threadIdx.x < 4) bst[threadIdx.x] = 0u;
    __syncthreads();
    XcdBarrier bar = xcd_barrier_post((unsigned*)(a.ws + WS_CTL), bst);
#define RUN_PHASE(k, ...) do { if (lo <= (k) && (k) < hi) { __VA_ARGS__; if ((k) + 1 < hi) xcd_barrier(bar); } } while (0)
    RUN_PHASE(0, { Ctx c; make_ctx(c); phase_pre(c, (float*)lds_raw); phase_norm_bf16(c.x, c.norm_g, c.H); });
    RUN_PHASE(1, layer_phase<0, 0>(lds_raw));
    RUN_PHASE(2, layer_phase<0, 1>(lds_raw));
    RUN_PHASE(3, layer_phase<0, 2>(lds_raw));
    RUN_PHASE(4, layer_phase<0, 3>(lds_raw));
    RUN_PHASE(5, layer_phase<0, 4>(lds_raw));
    RUN_PHASE(6, layer_phase<0, 5>(lds_raw));
    RUN_PHASE(7, layer_phase<0, 6>(lds_raw));
    RUN_PHASE(8, layer_phase<1, 0>(lds_raw));
    RUN_PHASE(9, layer_phase<1, 1>(lds_raw));
    RUN_PHASE(10, layer_phase<1, 2>(lds_raw));
    RUN_PHASE(11, layer_phase<1, 3>(lds_raw));
    RUN_PHASE(12, layer_phase<1, 4>(lds_raw));
    RUN_PHASE(13, layer_phase<1, 5>(lds_raw));
    RUN_PHASE(14, layer_phase<1, 6>(lds_raw));
#undef RUN_PHASE
}

extern "C" void kernel_launch(void* const* d_in, const int* in_sizes, int n_in, void* d_out, int out_size, void* d_ws, size_t ws_size, hipStream_t stream) {
    static int grid = 0;
    if (grid == 0) {
        if (n_in != 16 || in_sizes[0] != MT * DM || out_size != MT * DM || ws_size < WS_END) {
            fprintf(stderr, "kernel_launch: unexpected shapes: n_in %d in0 %d out %d ws %zu (need %zu)\n", n_in, n_in > 0 ? in_sizes[0] : -1, out_size, ws_size, (size_t)WS_END);
            grid = -1; return;
        }
        int dev = 0, cus = 0, per_cu = 0;
        hipGetDevice(&dev); hipDeviceGetAttribute(&cus, hipDeviceAttributeMultiprocessorCount, dev);
        if (hipFuncSetAttribute((const void*)fwd_kernel, hipFuncAttributeMaxDynamicSharedMemorySize, LDS_BYTES) != hipSuccess) { fprintf(stderr, "kernel_launch: hipFuncSetAttribute failed\n"); grid = -1; return; }
        hipOccupancyMaxActiveBlocksPerMultiprocessor(&per_cu, (const void*)fwd_kernel, NTHREADS, LDS_BYTES);
        if (per_cu < 1) { fprintf(stderr, "kernel_launch: occupancy query says %d blocks/CU\n", per_cu); per_cu = 1; }
        (void)hipGetLastError();
        grid = cus;
    }
    if (grid < 0) return;
    if (hipMemsetAsync((char*)d_ws + WS_CTL, 0, 16384, stream) != hipSuccess) { fprintf(stderr, "kernel_launch: hipMemsetAsync failed\n"); return; }
    Args a{};
    for (int i = 0; i < 16; ++i) a.in[i] = (const float*)d_in[i];
    a.out = (float*)d_out; a.ws = (unsigned char*)d_ws;
#if ONE_LAUNCH
    a.ph_lo = 0; a.ph_hi = NPHASES;
    void* args[] = {&a};
    hipError_t e = hipLaunchCooperativeKernel((const void*)fwd_kernel, dim3(grid), dim3(NTHREADS), args, LDS_BYTES, stream);
    if (e != hipSuccess) fprintf(stderr, "kernel_launch: cooperative launch failed: %s (grid %d)\n", hipGetErrorString(e), grid);
#else
    for (int ph = 0; ph < NPHASES; ++ph) {
        a.ph_lo = ph; a.ph_hi = ph + 1;
        hipLaunchKernelGGL(fwd_kernel, dim3(grid), dim3(NTHREADS), LDS_BYTES, stream, a);
    }
#endif
}
```

```cpp
#include <hip/hip_runtime.h>
#include <hip/hip_cooperative_groups.h>
#include <cstdio>
#include <cstdint>
namespace cg = cooperative_groups;

#ifndef NEW_TOK
#define NEW_TOK 1
#endif
#ifndef NEW_FFT1
#define NEW_FFT1 1
#endif
#ifndef NEW_FFT2
#define NEW_FFT2 1
#endif
#ifndef TOKREP
#define TOKREP 0
#endif
#ifndef REPQ
#define REPQ -1
#endif
#ifndef REPSUB
#define REPSUB 7
#endif
#ifndef ENG_MASK
#define ENG_MASK 15
#endif
#ifndef ONE_LAUNCH
#define ONE_LAUNCH 1
#endif

typedef unsigned short bf16_t;
typedef short bf16x8 __attribute__((ext_vector_type(8)));
typedef float f32x4 __attribute__((ext_vector_type(4)));
typedef unsigned u32x4 __attribute__((ext_vector_type(4)));

constexpr int NB = 8, SEQ = 4096, DM = 1024, MT = NB * SEQ, DIN = 4352, DEPTH = 2;
constexpr int ZA = 0, ZB = 256, ZQ = 768, ZK = 1536, ZV = 2304, ZD = 3072, ZG = 3328;
constexpr int NTHREADS = 512, NWAVES = 8;
constexpr int LDS_BYTES = 147456;

constexpr size_t WS_CTL = 0;
constexpr size_t WS_WIN = 65536;
constexpr size_t WS_WG = WS_WIN + (size_t)DEPTH * DIN * DM * 2;
constexpr size_t WS_WB = WS_WG + (size_t)DEPTH * 4096 * DM * 2;
constexpr size_t WS_WO = WS_WB + (size_t)DEPTH * 4 * 1024 * 256 * 2;
constexpr size_t WS_WF = WS_WO + (size_t)DEPTH * DM * DM * 2;
constexpr size_t WS_WPW = WS_WF + (size_t)DEPTH * 65536 * 2;
constexpr size_t WS_WPOOL = WS_WPW + (size_t)DEPTH * 65536 * 2;
constexpr size_t WS_TW = WS_WPOOL + (size_t)DEPTH * 4 * 4096 * 2;
constexpr size_t WS_RC = WS_TW + 4096 * 8;
constexpr size_t WS_RS = WS_RC + 4096 * 32 * 4;
constexpr size_t WS_RH = WS_RS + 4096 * 32 * 4;
constexpr size_t WS_H = WS_RH + 4096 * 64 * 2;
constexpr size_t WS_Z = WS_H + (size_t)MT * DM * 2;
constexpr size_t WS_P = WS_Z + (size_t)MT * DIN * 2;
constexpr size_t WS_FY = WS_P + (size_t)MT * DM * 2;
constexpr size_t WS_LSE = WS_FY + (size_t)NB * 4 * 64 * 64 * 64 * 4;
constexpr size_t WS_END = WS_LSE + (size_t)3 * MT * 4 * 4;

struct Args { const float* in[16]; float* out; unsigned char* ws; int ph_lo, ph_hi; };

__device__ __forceinline__ float bf2f(bf16_t v) { return __uint_as_float((unsigned)v << 16); }
__device__ __forceinline__ float bflo(unsigned w) { return __uint_as_float(w << 16); }
__device__ __forceinline__ float bfhi(unsigned w) { return __uint_as_float(w & 0xffff0000u); }
__device__ __forceinline__ bf16_t f2bf(float f) { unsigned u = __float_as_uint(f); u += 0x7fffu + ((u >> 16) & 1u); return (bf16_t)(u >> 16); }
typedef float f32x2n __attribute__((ext_vector_type(2)));
typedef __bf16 bf16x2n __attribute__((ext_vector_type(2)));
__device__ __forceinline__ unsigned pk2(float lo, float hi) { const f32x2n v = {lo, hi}; return __builtin_bit_cast(unsigned, __builtin_convertvector(v, bf16x2n)); }
__device__ __forceinline__ float sigmoidf_(float x) { return 1.f / (1.f + __expf(-x)); }
__device__ __forceinline__ float siluf_(float x) { return x / (1.f + __expf(-x)); }
__device__ __forceinline__ int opq(int v) { asm volatile("" : "+v"(v)); return v; }
#define TIDX opq((int)threadIdx.x)
__device__ __forceinline__ int opqs(int v) { asm volatile("" : "+s"(v)); return v; }
#define BIDX opqs((int)blockIdx.x)
__device__ __forceinline__ float wave_sum(float v) {
#pragma unroll
    for (int o = 1; o < 64; o <<= 1) v += __shfl_xor(v, o);
    return v;
}


typedef float f32x16g __attribute__((ext_vector_type(16)));
__device__ __forceinline__ f32x4 mfma16_g(bf16x8 a, bf16x8 b, f32x4 c) {
    f32x4 d = __builtin_amdgcn_mfma_f32_16x16x32_bf16(a, b, c, 0, 0, 0);
    asm volatile("" :: "v"(a), "v"(b), "v"(d));
    return d;
}
__device__ __forceinline__ f32x16g mfma32_g(bf16x8 a, bf16x8 b, f32x16g c) {
    f32x16g d = __builtin_amdgcn_mfma_f32_32x32x16_bf16(a, b, c, 0, 0, 0);
    asm volatile("" :: "v"(a), "v"(b), "v"(d));
    return d;
}

struct Ctx {
    const float *x, *norm_g, *w_in, *w_fourier, *conv_w, *conv_b, *conv_ln_g, *conv_ln_b, *w_pw, *w_pool, *pool_scale, *w_branch, *w_gate, *b_gate, *w_out, *final_g;
    float* out;
    bf16_t *WinT, *WgT, *WbT, *WoT, *WfT, *WpwT, *WpoolT, *H, *Z, *P;
    float2* TW; float *RC, *RS, *LSE; unsigned* FY; _Float16* RH;
};

__device__ __forceinline__ void transpose_mat(const float* W, int K, int N, bf16_t* WT, float* scr) {
    const int t = TIDX, nkb = K / 64, nnb = N / 64;
    for (int item = BIDX; item < nkb * nnb; item += gridDim.x) {
        const int kb = item / nnb, nb = item % nnb;
#pragma unroll
        for (int i = 0; i < 8; ++i) { const int kk = (t >> 6) + 8 * i, nn = t & 63; scr[kk * 65 + nn] = W[(size_t)(kb * 64 + kk) * N + nb * 64 + nn]; }
        __syncthreads();
#pragma unroll
        for (int i = 0; i < 8; ++i) { const int nn = (t >> 6) + 8 * i, kk = t & 63; WT[(size_t)(nb * 64 + nn) * K + kb * 64 + kk] = f2bf(scr[kk * 65 + nn]); }
        __syncthreads();
    }
}
__device__ __forceinline__ void phase_pre(const Ctx& c, float* lds) {
    for (int l = 0; l < DEPTH; ++l) {
        transpose_mat(c.w_in + (size_t)l * DM * DIN, DM, DIN, c.WinT + (size_t)l * DIN * DM, lds);
        for (int n = 0; n < 4; ++n) {
            transpose_mat(c.w_gate + (size_t)(l * 4 + n) * DM * DM, DM, DM, c.WgT + ((size_t)l * 4096 + n * 1024) * DM, lds);
            transpose_mat(c.w_branch + (size_t)(l * 4 + n) * 256 * DM, 256, DM, c.WbT + (size_t)(l * 4 + n) * 1024 * 256, lds);
        }
        transpose_mat(c.w_out + (size_t)l * DM * DM, DM, DM, c.WoT + (size_t)l * DM * DM, lds);
        transpose_mat(c.w_fourier + (size_t)l * 65536, 256, 256, c.WfT + (size_t)l * 65536, lds);
        transpose_mat(c.w_pw + (size_t)l * 65536, 256, 256, c.WpwT + (size_t)l * 65536, lds);
        for (int n = 0; n < 4; ++n) transpose_mat(c.w_pool + (size_t)(l * 4 + n) * 4096, 64, 64, c.WpoolT + (size_t)(l * 4 + n) * 4096, lds);
    }
    const int gt = BIDX * NTHREADS + TIDX, NT = gridDim.x * NTHREADS;
    for (int i = gt; i < 4096; i += NT) { float s, co; sincospif((float)i / 2048.f, &s, &co); c.TW[i] = make_float2(co, s); }
    for (int i = gt; i < 4096 * 32; i += NT) {
        const int pos = i >> 5, k = i & 31;
        const float inv = exp2f(-(float)k * (13.287712379549449f / 32.0f));
        double tq = (double)pos * (double)inv * 0.3183098861837907;
        tq -= 2.0 * rint(tq * 0.5);
        float s, co; sincospif((float)tq, &s, &co);
        c.RC[i] = co; c.RS[i] = s;
        c.RH[pos * 64 + k] = (_Float16)co; c.RH[pos * 64 + 32 + k] = (_Float16)s;
    }
}

__device__ __forceinline__ void phase_norm_bf16(const float* xin, const float* g, bf16_t* H) {
    const int tid_ = TIDX; const int lane = tid_ & 63, wave = tid_ >> 6;
    const int gw = BIDX * NWAVES + wave, NGW = gridDim.x * NWAVES;
    f32x4 gv[4];
#pragma unroll
    for (int j = 0; j < 4; ++j) gv[j] = *(const f32x4*)(g + 4 * (lane + 64 * j));
    for (int m = gw; m < MT; m += NGW) {
        const f32x4* xr = (const f32x4*)(xin + (size_t)m * DM);
        f32x4 v[4]; float s = 0.f;
#pragma unroll
        for (int j = 0; j < 4; ++j) { v[j] = xr[lane + 64 * j]; s += v[j].x * v[j].x + v[j].y * v[j].y + v[j].z * v[j].z + v[j].w * v[j].w; }
        const float rstd = 1.0f / sqrtf(wave_sum(s) * (1.f / DM) + 1e-6f);
        uint2* o = (uint2*)(H + (size_t)m * DM);
#pragma unroll
        for (int j = 0; j < 4; ++j) { const f32x4 y = v[j] * rstd * gv[j]; o[lane + 64 * j] = make_uint2(pk2(y.x, y.y), pk2(y.z, y.w)); }
    }
}
__device__ __forceinline__ void phase_norm_final(float* xio, const float* g) {
    const int tid_ = TIDX; const int lane = tid_ & 63, wave = tid_ >> 6;
    const int gw = BIDX * NWAVES + wave, NGW = gridDim.x * NWAVES;
    f32x4 gv[4];
#pragma unroll
    for (int j = 0; j < 4; ++j) gv[j] = *(const f32x4*)(g + 4 * (lane + 64 * j));
    for (int m = gw; m < MT; m += NGW) {
        f32x4* xr = (f32x4*)(xio + (size_t)m * DM);
        f32x4 v[4]; float s = 0.f;
#pragma unroll
        for (int j = 0; j < 4; ++j) { v[j] = xr[lane + 64 * j]; s += v[j].x * v[j].x + v[j].y * v[j].y + v[j].z * v[j].z + v[j].w * v[j].w; }
        const float rstd = 1.0f / sqrtf(wave_sum(s) * (1.f / DM) + 1e-6f);
#pragma unroll
        for (int j = 0; j < 4; ++j) xr[lane + 64 * j] = v[j] * rstd * gv[j];
    }
}

template <class Epi>
__device__ __forceinline__ void gemm_simple(const bf16_t* A, int lda, const bf16_t* Bt, int ldb, int Mr, int N, int K, const Epi& epi) {
    const int tid_ = TIDX; const int wid = tid_ >> 6, lane = tid_ & 63, fr = lane & 15, fq = lane >> 4;
    const int nM = Mr / 128, nN = N / 64;
    for (int u = BIDX; u < nM * nN; u += gridDim.x) {
        const int pm = u / nN, pn = u % nN;
        const bf16_t* ap = A + (size_t)(pm * 128 + wid * 16 + fr) * lda + fq * 8;
        const bf16_t* bp = Bt + (size_t)(pn * 64 + fr) * ldb + fq * 8;
        f32x4 acc[4];
#pragma unroll
        for (int n = 0; n < 4; ++n) acc[n] = (f32x4){0.f, 0.f, 0.f, 0.f};
        for (int k0 = 0; k0 < K; k0 += 32) {
            const bf16x8 a = *(const bf16x8*)(ap + k0);
#pragma unroll
            for (int n = 0; n < 4; ++n) { const bf16x8 b = *(const bf16x8*)(bp + (size_t)n * 16 * ldb + k0); acc[n] = mfma16_g(a, b, acc[n]); }
        }
#pragma unroll
        for (int n = 0; n < 4; ++n)
#pragma unroll
            for (int j = 0; j < 4; ++j) epi(pm * 128 + wid * 16 + fq * 4 + j, pn * 64 + n * 16 + fr, acc[n][j]);
    }
}
struct EpiZ { bf16_t* Z; __device__ __forceinline__ void operator()(int r, int c, float v) const { Z[(size_t)r * DIN + c] = f2bf(v); } };
struct EpiGate { bf16_t* MG; const float* bg; __device__ __forceinline__ void operator()(int r, int c, float v) const { MG[(size_t)r * 4096 + c] = f2bf(sigmoidf_(v + bg[c])); } };
struct EpiOut { const float* xin; float* out; __device__ __forceinline__ void operator()(int r, int c, float v) const { const size_t i = (size_t)r * DM + c; out[i] = xin[i] + v; } };

__device__ __forceinline__ void gemm_merge(const bf16_t* P, const bf16_t* WbT, const bf16_t* MG, bf16_t* MERGED) {
    const int tid_ = TIDX; const int wid = tid_ >> 6, lane = tid_ & 63, fr = lane & 15, fq = lane >> 4;
    const int nM = MT / 128, nN = DM / 64;
    for (int u = BIDX; u < nM * nN; u += gridDim.x) {
        const int pm = u / nN, pn = u % nN;
        f32x4 tot[4];
#pragma unroll
        for (int n = 0; n < 4; ++n) tot[n] = (f32x4){0.f, 0.f, 0.f, 0.f};
        for (int n4 = 0; n4 < 4; ++n4) {
            const bf16_t* ap = P + (size_t)(pm * 128 + wid * 16 + fr) * DM + n4 * 256 + fq * 8;
            const bf16_t* bp = WbT + (size_t)n4 * 1024 * 256 + (size_t)(pn * 64 + fr) * 256 + fq * 8;
            f32x4 acc[4];
#pragma unroll
            for (int n = 0; n < 4; ++n) acc[n] = (f32x4){0.f, 0.f, 0.f, 0.f};
            for (int k0 = 0; k0 < 256; k0 += 32) {
                const bf16x8 a = *(const bf16x8*)(ap + k0);
#pragma unroll
                for (int n = 0; n < 4; ++n) { const bf16x8 b = *(const bf16x8*)(bp + (size_t)n * 16 * 256 + k0); acc[n] = mfma16_g(a, b, acc[n]); }
            }
#pragma unroll
            for (int n = 0; n < 4; ++n)
#pragma unroll
                for (int j = 0; j < 4; ++j) { const int r = pm * 128 + wid * 16 + fq * 4 + j, cc = pn * 64 + n * 16 + fr; tot[n][j] += bf2f(MG[(size_t)r * 4096 + n4 * 1024 + cc]) * acc[n][j]; }
        }
#pragma unroll
        for (int n = 0; n < 4; ++n)
#pragma unroll
            for (int j = 0; j < 4; ++j) { const int r = pm * 128 + wid * 16 + fq * 4 + j, cc = pn * 64 + n * 16 + fr; MERGED[(size_t)r * DM + cc] = f2bf(tot[n][j]); }
    }
}

__device__ __forceinline__ void fft1_unit(const Ctx& c, int u, float* lds) {
    const int t = TIDX, s2 = u & 63, bg = u >> 6, g = bg & 3, b = bg >> 2;
    float* U = lds; float* Wre = lds + 64 * 65; float* Wim = Wre + 4096; float* cs = Wim + 4096; float* sn = cs + 64;
    if (t < 64) { float s, co; sincospif((float)t / 32.f, &s, &co); cs[t] = co; sn[t] = s; }
#pragma unroll
    for (int i = 0; i < 8; ++i) { const int s1 = (t >> 6) + 8 * i, ci = t & 63; U[s1 * 65 + ci] = bf2f(c.Z[(size_t)(b * SEQ + 64 * s1 + s2) * DIN + ZA + 64 * g + ci]); }
    __syncthreads();
    const int cp = t & 63;
#pragma unroll 1
    for (int i = 0; i < 8; ++i) {
        const int s1 = (t >> 6) + 8 * i; float re = 0.f, im = 0.f;
        for (int ci = 0; ci < 64; ++ci) { const float x = U[s1 * 65 + ci]; const int e = (ci * cp) & 63; re += x * cs[e]; im -= x * sn[e]; }
        Wre[s1 * 64 + cp] = re; Wim[s1 * 64 + cp] = im;
    }
    __syncthreads();
#pragma unroll 1
    for (int i = 0; i < 8; ++i) {
        const int k1 = (t >> 6) + 8 * i; float yr = 0.f, yi = 0.f;
        for (int s1 = 0; s1 < 64; ++s1) { const int e = (k1 * s1) & 63; const float co = cs[e], si = sn[e], wr = Wre[s1 * 64 + cp], wi = Wim[s1 * 64 + cp]; yr += co * wr + si * wi; yi += co * wi - si * wr; }
        const float2 tw = c.TW[(k1 * s2) & 4095];
        const float zr = yr * tw.x + yi * tw.y, zi = yi * tw.x - yr * tw.y;
        c.FY[((size_t)(bg * 64 + k1) * 64 + s2) * 64 + cp] = pk2(zr, zi);
    }
    __syncthreads();
}

__device__ __forceinline__ void tok_unit(const Ctx& c, int l, int u, float* lds) {
    const int t = TIDX, lane = t & 63, wave = t >> 6, ch = t & 255, half = t >> 8;
    const int b = u >> 6, s0 = (u & 63) * 64, tok0 = b * SEQ + s0;
    float* A = lds;
#pragma unroll 1
    for (int i = 0; i < 47; ++i) {
        const int r = half + 2 * i, s = s0 - 15 + r; float val = 0.f;
        if (s >= 0 && s < SEQ) { const bf16_t* zr = c.Z + (size_t)(b * SEQ + s) * DIN + ZB; val = bf2f(zr[ch]) * sigmoidf_(bf2f(zr[256 + ch])); }
        A[r * 256 + ch] = val;
    }
    __syncthreads();
    float y[32];
    {
        float cw[31];
#pragma unroll
        for (int w = 0; w < 31; ++w) cw[w] = c.conv_w[(size_t)l * 31 * 256 + w * 256 + ch];
        const float cb = c.conv_b[l * 256 + ch];
#pragma unroll
        for (int cc = 0; cc < 4; ++cc) {
            float rows[38];
#pragma unroll
            for (int r = 0; r < 38; ++r) rows[r] = A[(half * 32 + cc * 8 + r) * 256 + ch];
#pragma unroll
            for (int i = 0; i < 8; ++i) {
                float acc = cb;
#pragma unroll
                for (int w = 0; w < 31; ++w) acc += rows[i + w] * cw[w];
                y[cc * 8 + i] = acc;
            }
            __builtin_amdgcn_sched_barrier(0);
        }
    }
    __syncthreads();
#pragma unroll
    for (int i = 0; i < 32; ++i) A[(half * 32 + i) * 256 + ch] = y[i];
    __syncthreads();
    {
        float lg[4], lb[4];
#pragma unroll
        for (int q = 0; q < 4; ++q) { lg[q] = c.conv_ln_g[l * 256 + lane + 64 * q]; lb[q] = c.conv_ln_b[l * 256 + lane + 64 * q]; }
        for (int i = 0; i < 8; ++i) {
            const int tk = wave * 8 + i; float xv[4]; float s = 0.f;
#pragma unroll
            for (int q = 0; q < 4; ++q) { xv[q] = A[tk * 256 + lane + 64 * q]; s += xv[q]; }
            const float mean = wave_sum(s) * (1.f / 256.f); float s2 = 0.f;
#pragma unroll
            for (int q = 0; q < 4; ++q) { xv[q] -= mean; s2 += xv[q] * xv[q]; }
            const float rstd = 1.0f / sqrtf(wave_sum(s2) * (1.f / 256.f) + 1e-5f);
#pragma unroll
            for (int q = 0; q < 4; ++q) { const float yv = xv[q] * rstd * lg[q] + lb[q]; A[tk * 256 + lane + 64 * q] = siluf_(yv); }
        }
    }
    __syncthreads();
    {
        float acc[32];
#pragma unroll
        for (int i = 0; i < 32; ++i) acc[i] = 0.f;
        const float* W = c.w_pw + (size_t)l * 65536;
#pragma unroll 2
        for (int k = 0; k < 256; ++k) {
            const float wv = W[k * 256 + ch];
#pragma unroll
            for (int i = 0; i < 32; ++i) acc[i] += A[(half * 32 + i) * 256 + k] * wv;
        }
        __syncthreads();
#pragma unroll
        for (int i = 0; i < 32; ++i) A[(half * 32 + i) * 256 + ch] = acc[i];
        __syncthreads();
#pragma unroll 1
        for (int i = 0; i < 32; ++i) {
            const size_t tok = tok0 + half * 32 + i;
            const float gp = bf2f(c.Z[tok * DIN + ZG + 256 + ch]);
            c.P[tok * DM + 256 + ch] = f2bf(A[(half * 32 + i) * 256 + ch] * siluf_(gp));
        }
    }
    __syncthreads();
#pragma unroll 1
    for (int i = 0; i < 40; ++i) {
        const int r = half + 2 * i;
        if (r < 79) { const int s = s0 - 8 + r; float val = 0.f; if (s >= 0 && s < SEQ) val = bf2f(c.Z[(size_t)(b * SEQ + s) * DIN + ZD + ch]); A[r * 256 + ch] = val; }
    }
    __syncthreads();
    float* PL = lds + 79 * 256;
    {
        const int gi = ch >> 6, sz = 2 << gi;
#pragma unroll 1
        for (int i = 0; i < 32; ++i) {
            const int tk = half * 32 + i, s = s0 + tk;
            int lo = s - sz / 2; if (lo < 0) lo = 0;
            int hi = s + sz - 1 - sz / 2; if (hi > SEQ - 1) hi = SEQ - 1;
            float sum = 0.f;
            for (int p = lo; p <= hi; ++p) sum += A[(p - s0 + 8) * 256 + ch];
            PL[tk * 256 + ch] = sum / (float)(hi - lo + 1) - A[(tk + 8) * 256 + ch];
        }
    }
    __syncthreads();
    {
        const int gi = ch >> 6, dd = ch & 63;
        float acc[32];
#pragma unroll
        for (int i = 0; i < 32; ++i) acc[i] = 0.f;
        const float* W = c.w_pool + (size_t)(l * 4 + gi) * 4096;
#pragma unroll 2
        for (int k = 0; k < 64; ++k) {
            const float wv = W[k * 64 + dd];
#pragma unroll
            for (int i = 0; i < 32; ++i) acc[i] += PL[(half * 32 + i) * 256 + gi * 64 + k] * wv;
        }
        const float ps = c.pool_scale[l * 256 + ch];
        __syncthreads();
#pragma unroll
        for (int i = 0; i < 32; ++i) A[(half * 32 + i) * 256 + ch] = acc[i];
        __syncthreads();
#pragma unroll 1
        for (int i = 0; i < 32; ++i) {
            const size_t tok = tok0 + half * 32 + i;
            const float gp = bf2f(c.Z[tok * DIN + ZG + 768 + ch]);
            c.P[tok * DM + 768 + ch] = f2bf(A[(half * 32 + i) * 256 + ch] * ps * siluf_(gp));
        }
    }
    __syncthreads();
}

__device__ __forceinline__ void attn_unit(const Ctx& c, int u, float* ldsf, bool do_store = true) {
    unsigned* lds = (unsigned*)ldsf;
    const int t = TIDX;
    const int b = u / 192, rem = u % 192, g = rem >> 6, rem2 = rem & 63, hI = rem2 >> 4, rq = rem2 & 15;
    const int d = 1 << (2 * g), L = SEQ / d, nqb = L / 256, r = rq / nqb, qb = rq % nqb, hh = g * 4 + hI, i0 = qb * 256;
    unsigned* Kt = lds; unsigned* Vt = lds + 384 * 33;
    for (int pass = 0; pass < 2; ++pass) {
        const int jl = pass * 256 + (t >> 1), hf = t & 1, j = i0 - 64 + jl;
        if (jl < 384 && j >= 0 && j < L) {
            const int pos = r + d * j; const size_t tok = (size_t)b * SEQ + pos;
            const u32x4* kr = (const u32x4*)(c.Z + tok * DIN + ZK + hh * 64);
            unsigned kw[32];
#pragma unroll
            for (int q = 0; q < 8; ++q) { const u32x4 v = kr[q]; kw[4 * q] = v.x; kw[4 * q + 1] = v.y; kw[4 * q + 2] = v.z; kw[4 * q + 3] = v.w; }
            const float* rc = c.RC + pos * 32; const float* rs = c.RS + pos * 32;
#pragma unroll
            for (int w = 0; w < 16; ++w) {
                const float lo0 = bflo(kw[w]), lo1 = bfhi(kw[w]), hi0 = bflo(kw[16 + w]), hi1 = bfhi(kw[16 + w]);
                const float c0 = rc[2 * w], c1 = rc[2 * w + 1], s0 = rs[2 * w], s1 = rs[2 * w + 1];
                float o0, o1;
                if (hf == 0) { o0 = lo0 * c0 - hi0 * s0; o1 = lo1 * c1 - hi1 * s1; } else { o0 = hi0 * c0 + lo0 * s0; o1 = hi1 * c1 + lo1 * s1; }
                Kt[jl * 33 + hf * 16 + w] = pk2(o0, o1);
            }
            const u32x4* vr = (const u32x4*)(c.Z + tok * DIN + ZV + hh * 64 + hf * 32);
#pragma unroll
            for (int q = 0; q < 4; ++q) { const u32x4 v = vr[q]; Vt[jl * 33 + hf * 16 + 4 * q] = v.x; Vt[jl * 33 + hf * 16 + 4 * q + 1] = v.y; Vt[jl * 33 + hf * 16 + 4 * q + 2] = v.z; Vt[jl * 33 + hf * 16 + 4 * q + 3] = v.w; }
        }
    }
    const int ql = t >> 1, hf = t & 1, iq = i0 + ql, posq = r + d * iq;
    const size_t tokq = (size_t)b * SEQ + posq;
    bf16_t* qrow = c.Z + tokq * DIN + ZQ + hh * 64;
    float qv[32];
    {
        const u32x4* qr = (const u32x4*)qrow;
        unsigned kw[32];
#pragma unroll
        for (int q = 0; q < 8; ++q) { const u32x4 v = qr[q]; kw[4 * q] = v.x; kw[4 * q + 1] = v.y; kw[4 * q + 2] = v.z; kw[4 * q + 3] = v.w; }
        const float* rc = c.RC + posq * 32; const float* rs = c.RS + posq * 32;
#pragma unroll
        for (int w = 0; w < 16; ++w) {
            const float lo0 = bflo(kw[w]), lo1 = bfhi(kw[w]), hi0 = bflo(kw[16 + w]), hi1 = bfhi(kw[16 + w]);
            const float c0 = rc[2 * w], c1 = rc[2 * w + 1], s0 = rs[2 * w], s1 = rs[2 * w + 1];
            if (hf == 0) { qv[2 * w] = (lo0 * c0 - hi0 * s0) * 0.125f; qv[2 * w + 1] = (lo1 * c1 - hi1 * s1) * 0.125f; }
            else { qv[2 * w] = (hi0 * c0 + lo0 * s0) * 0.125f; qv[2 * w + 1] = (hi1 * c1 + lo1 * s1) * 0.125f; }
        }
    }
    __syncthreads();
    float m = -1e30f, lsum = 0.f, o[32];
#pragma unroll
    for (int w = 0; w < 32; ++w) o[w] = 0.f;
    for (int t2 = 0; t2 <= 128; ++t2) {
        const int j = iq - 64 + t2;
        if (j >= 0 && j < L) {
            const int jl = ql + t2;
            const unsigned* kp = Kt + jl * 33 + hf * 16;
            float sp = 0.f;
#pragma unroll
            for (int w = 0; w < 16; ++w) { const unsigned kwv = kp[w]; sp += qv[2 * w] * bflo(kwv) + qv[2 * w + 1] * bfhi(kwv); }
            const float s = sp + __shfl_xor(sp, 1);
            const float mn = fmaxf(m, s), corr = __expf(m - mn), p = __expf(s - mn);
            lsum = lsum * corr + p; m = mn;
            const unsigned* vp = Vt + jl * 33 + hf * 16;
#pragma unroll
            for (int w = 0; w < 16; ++w) { const unsigned vw = vp[w]; o[2 * w] = o[2 * w] * corr + p * bflo(vw); o[2 * w + 1] = o[2 * w + 1] * corr + p * bfhi(vw); }
        }
    }
    const float inv = 1.f / lsum;
    unsigned* orow = (unsigned*)(qrow + hf * 32);
    if (do_store) {
#pragma unroll
    for (int w = 0; w < 16; ++w) orow[w] = pk2(o[2 * w] * inv, o[2 * w + 1] * inv);
    if (hf == 0) c.LSE[((size_t)g * MT + tokq) * 4 + hI] = m + __logf(lsum);
    }
    __syncthreads();
}


typedef float f32x16 __attribute__((ext_vector_type(16)));
typedef unsigned u32x2 __attribute__((ext_vector_type(2)));
typedef _Float16 h16x8 __attribute__((ext_vector_type(8)));
#define LASP __attribute__((address_space(3)))
__device__ __forceinline__ unsigned cvtpk(float lo, float hi) { return pk2(lo, hi); }
__device__ __forceinline__ void attn_unit_mfma(const Ctx& c, int u, unsigned char* lds_raw, bool do_store = true) {
    LASP unsigned char* Kt = (LASP unsigned char*)lds_raw;
    LASP unsigned* Vt = (LASP unsigned*)(lds_raw + 49152);
    const int t = TIDX, lane = t & 63, wave = __builtin_amdgcn_readfirstlane(t >> 6), rq = lane & 31, h = lane >> 5;
    const int b = u / 192, rem = u % 192, g = rem >> 6, rem2 = rem & 63, hI = rem2 >> 4, rqb = rem2 & 15;
    const int d = 1 << (2 * g), L = SEQ / d, nqb = L / 256, r = rqb / nqb, qb = rqb % nqb, hh = g * 4 + hI, i0 = qb * 256;
#pragma unroll
    for (int i = 0; i < 3; ++i) {
        const int id = t + 512 * i, row = id >> 2, dc = id & 3, j = i0 - 64 + row;
        u32x4 olo = (u32x4){0u, 0u, 0u, 0u}, ohi = olo;
        if (j >= 0 && j < L) {
            const int pos = r + d * j;
            const bf16_t* kr = c.Z + ((size_t)b * SEQ + pos) * DIN + ZK + hh * 64 + 8 * dc;
            const u32x4 a = *(const u32x4*)kr, bq = *(const u32x4*)(kr + 32);
            const h16x8 cv = *(const h16x8*)(c.RH + pos * 64 + 8 * dc), sv = *(const h16x8*)(c.RH + pos * 64 + 32 + 8 * dc);
#pragma unroll
            for (int e = 0; e < 4; ++e) {
                const float l0 = bflo(a[e]), l1 = bfhi(a[e]), h0 = bflo(bq[e]), h1 = bfhi(bq[e]);
                const float cc0 = (float)cv[2 * e], cc1 = (float)cv[2 * e + 1], ss0 = (float)sv[2 * e], ss1 = (float)sv[2 * e + 1];
                olo[e] = pk2(l0 * cc0 - h0 * ss0, l1 * cc1 - h1 * ss1);
                ohi[e] = pk2(h0 * cc0 + l0 * ss0, h1 * cc1 + l1 * ss1);
            }
        }
        *(LASP u32x4*)(Kt + row * 128 + ((dc ^ (row & 7)) << 4)) = olo;
        *(LASP u32x4*)(Kt + row * 128 + (((4 + dc) ^ (row & 7)) << 4)) = ohi;
    }
#pragma unroll
    for (int i = 0; i < 3; ++i) {
        const int id = t + 512 * i, rp = id % 192, dc8 = id / 192, j0 = i0 - 64 + 2 * rp;
        u32x4 v0 = (u32x4){0u, 0u, 0u, 0u}, v1 = v0;
        if (j0 >= 0 && j0 < L) v0 = *(const u32x4*)(c.Z + ((size_t)b * SEQ + r + d * j0) * DIN + ZV + hh * 64 + 8 * dc8);
        if (j0 + 1 >= 0 && j0 + 1 < L) v1 = *(const u32x4*)(c.Z + ((size_t)b * SEQ + r + d * (j0 + 1)) * DIN + ZV + hh * 64 + 8 * dc8);
#pragma unroll
        for (int e = 0; e < 4; ++e) {
            Vt[(8 * dc8 + 2 * e) * 194 + rp] = (v0[e] & 0xffffu) | (v1[e] << 16);
            Vt[(8 * dc8 + 2 * e + 1) * 194 + rp] = (v0[e] >> 16) | (v1[e] & 0xffff0000u);
        }
    }
    const int iq = i0 + 32 * wave + rq, posq = r + d * iq;
    const size_t tokq = (size_t)b * SEQ + posq;
    bf16_t* qrow = c.Z + tokq * DIN + ZQ + hh * 64;
    bf16x8 qf[4];
    {
        const u32x4 q0 = *(const u32x4*)(qrow + 8 * h), q1 = *(const u32x4*)(qrow + 16 + 8 * h), q2 = *(const u32x4*)(qrow + 32 + 8 * h), q3 = *(const u32x4*)(qrow + 48 + 8 * h);
        const _Float16* rh = c.RH + posq * 64 + 8 * h;
        const h16x8 cav = *(const h16x8*)rh, cbv = *(const h16x8*)(rh + 16), sav = *(const h16x8*)(rh + 32), sbv = *(const h16x8*)(rh + 48);
        const float sc = 0.125f * 1.44269504f;
        u32x4 o0, o1, o2, o3;
#pragma unroll
        for (int e = 0; e < 4; ++e) {
            const float ca_0 = (float)cav[2 * e], ca_1 = (float)cav[2 * e + 1], sa_0 = (float)sav[2 * e], sa_1 = (float)sav[2 * e + 1];
            const float cb_0 = (float)cbv[2 * e], cb_1 = (float)cbv[2 * e + 1], sb_0 = (float)sbv[2 * e], sb_1 = (float)sbv[2 * e + 1];
            const float a0 = bflo(q0[e]), a1 = bfhi(q0[e]), b0 = bflo(q2[e]), b1 = bfhi(q2[e]);
            const float e0 = bflo(q1[e]), e1 = bfhi(q1[e]), f0 = bflo(q3[e]), f1 = bfhi(q3[e]);
            o0[e] = pk2((a0 * ca_0 - b0 * sa_0) * sc, (a1 * ca_1 - b1 * sa_1) * sc);
            o2[e] = pk2((b0 * ca_0 + a0 * sa_0) * sc, (b1 * ca_1 + a1 * sa_1) * sc);
            o1[e] = pk2((e0 * cb_0 - f0 * sb_0) * sc, (e1 * cb_1 - f1 * sb_1) * sc);
            o3[e] = pk2((f0 * cb_0 + e0 * sb_0) * sc, (f1 * cb_1 + e1 * sb_1) * sc);
        }
        qf[0] = __builtin_bit_cast(bf16x8, o0); qf[1] = __builtin_bit_cast(bf16x8, o1); qf[2] = __builtin_bit_cast(bf16x8, o2); qf[3] = __builtin_bit_cast(bf16x8, o3);
    }
    __syncthreads();
    f32x16 sacc[5];
#pragma unroll
    for (int kb = 0; kb < 5; ++kb)
#pragma unroll
        for (int e = 0; e < 16; ++e) sacc[kb][e] = 0.f;
#pragma unroll
    for (int s4 = 0; s4 < 4; ++s4) {
#pragma unroll
        for (int kb = 0; kb < 5; ++kb) {
            const int row = 32 * wave + 32 * kb + rq;
            const bf16x8 kf = *(const LASP bf16x8*)(Kt + row * 128 + (((2 * s4 + h) ^ (row & 7)) << 4));
            sacc[kb] = mfma32_g(kf, qf[s4], sacc[kb]);
        }
        __builtin_amdgcn_sched_barrier(0);
    }
    asm volatile("s_nop 15\n\ts_nop 15" : "+v"(sacc[0]), "+v"(sacc[1]), "+v"(sacc[2]), "+v"(sacc[3]), "+v"(sacc[4]));
    const int jbase = i0 - 64 + 32 * wave;
    float mx = -1e30f;
#pragma unroll
    for (int kb = 0; kb < 5; ++kb)
#pragma unroll
        for (int e = 0; e < 16; ++e) {
            const int row = (e & 3) + 8 * (e >> 2) + 4 * h, rel = 32 * kb + row - rq, j = jbase + 32 * kb + row;
            const bool valid = (rel >= 0) && (rel <= 128) && (j >= 0) && (j < L);
            const float sv = valid ? sacc[kb][e] : -1e30f;
            sacc[kb][e] = sv; mx = fmaxf(mx, sv);
        }
    mx = fmaxf(mx, __shfl_xor(mx, 32));
    float lsum = 0.f;
#pragma unroll
    for (int kb = 0; kb < 5; ++kb)
#pragma unroll
        for (int e = 0; e < 16; ++e) { const float p = __builtin_amdgcn_exp2f(sacc[kb][e] - mx); sacc[kb][e] = p; lsum += p; }
    lsum += __shfl_xor(lsum, 32);
    f32x16 oacc[2], oacb[2];
#pragma unroll
    for (int db = 0; db < 2; ++db)
#pragma unroll
        for (int e = 0; e < 16; ++e) { oacc[db][e] = 0.f; oacb[db][e] = 0.f; }
#pragma unroll
    for (int kb = 0; kb < 5; ++kb) {
        bf16x8 pf[2];
#pragma unroll
        for (int s2 = 0; s2 < 2; ++s2) {
            u32x4 pw;
#pragma unroll
            for (int e = 0; e < 4; ++e) pw[e] = cvtpk(sacc[kb][8 * s2 + 2 * e], sacc[kb][8 * s2 + 2 * e + 1]);
            pf[s2] = __builtin_bit_cast(bf16x8, pw);
        }
        bf16x8 af[2][2];
#pragma unroll
        for (int s2 = 0; s2 < 2; ++s2) {
            const int kp = (32 * wave + 32 * kb + 16 * s2 + 4 * h) >> 1;
#pragma unroll
            for (int db = 0; db < 2; ++db) {
                const LASP unsigned* vp = Vt + (32 * db + rq) * 194 + kp;
                const u32x2 g0 = *(const LASP u32x2*)vp, g1 = *(const LASP u32x2*)(vp + 4);
                const u32x4 aw = (u32x4){g0.x, g0.y, g1.x, g1.y};
                af[s2][db] = __builtin_bit_cast(bf16x8, aw);
            }
        }
        oacc[0] = mfma32_g(af[0][0], pf[0], oacc[0]);
        oacc[1] = mfma32_g(af[0][1], pf[0], oacc[1]);
        oacb[0] = mfma32_g(af[1][0], pf[1], oacb[0]);
        oacb[1] = mfma32_g(af[1][1], pf[1], oacb[1]);
        __builtin_amdgcn_sched_barrier(0);
    }
    asm volatile("s_nop 15\n\ts_nop 15" : "+v"(oacc[0]), "+v"(oacc[1]), "+v"(oacb[0]), "+v"(oacb[1]));
#pragma unroll
    for (int db = 0; db < 2; ++db) oacc[db] = oacc[db] + oacb[db];
    if (do_store) {
        const float inv = 1.f / lsum;
#pragma unroll
        for (int db = 0; db < 2; ++db)
#pragma unroll
            for (int g4 = 0; g4 < 4; ++g4) {
                const u32x2 w = (u32x2){cvtpk(oacc[db][4 * g4] * inv, oacc[db][4 * g4 + 1] * inv), cvtpk(oacc[db][4 * g4 + 2] * inv, oacc[db][4 * g4 + 3] * inv)};
                *(u32x2*)(qrow + 32 * db + 8 * g4 + 4 * h) = w;
            }
        if (h == 0) c.LSE[((size_t)g * MT + tokq) * 4 + hI] = mx * 0.69314718f + __logf(lsum);
    }
    __syncthreads();
}


__device__ __forceinline__ void attn_phase_wrap(const Ctx& c, unsigned char* lds_raw, bool do_store) {
    constexpr int NAT = NB * 192;
    const int G = gridDim.x;
    for (int u = BIDX; u < NAT; u += G) attn_unit_mfma(c, u, lds_raw, do_store);
}

struct AttnU { int b, g, hI, d, L, r, hh, i0; };
__device__ __forceinline__ AttnU attn_decode(int u) {
    AttnU a; a.b = u / 192; const int rem = u % 192; a.g = rem >> 6; const int rem2 = rem & 63; a.hI = rem2 >> 4; const int rqb = rem2 & 15;
    a.d = 1 << (2 * a.g); a.L = SEQ / a.d; const int nqb = a.L / 256; a.r = rqb / nqb; a.hh = a.g * 4 + a.hI; a.i0 = (rqb % nqb) * 256; return a;
}
__device__ __forceinline__ void attn_phase_mfma(const Ctx& c, unsigned char* lds_raw, bool do_store) {
    LASP unsigned char* Kt = (LASP unsigned char*)lds_raw;
    LASP unsigned* Vt = (LASP unsigned*)(lds_raw + 49152);
    const int t = TIDX, lane = t & 63, wave = __builtin_amdgcn_readfirstlane(t >> 6), rq = lane & 31, h = lane >> 5;
    constexpr int NAT = NB * 192;
    const int G = gridDim.x;
    int u = BIDX;
    if (u >= NAT) return;
    u32x4 ka[3], kb2[3], va[3], vb[3];
#define ATT_PREFETCH(uu_) do { const AttnU A_ = attn_decode(uu_); \
        _Pragma("unroll") for (int i = 0; i < 3; ++i) { \
            { const int id = t + 512 * i, row = id >> 2, dc = id & 3, j = A_.i0 - 64 + row; \
              ka[i] = (u32x4){0u, 0u, 0u, 0u}; kb2[i] = ka[i]; \
              if (j >= 0 && j < A_.L) { const int pos = A_.r + A_.d * j; const bf16_t* kr = c.Z + ((size_t)A_.b * SEQ + pos) * DIN + ZK + A_.hh * 64 + 8 * dc; \
                  ka[i] = *(const u32x4*)kr; kb2[i] = *(const u32x4*)(kr + 32); } } \
            { const int id = t + 512 * i, rp = id % 192, dc8 = id / 192, j0 = A_.i0 - 64 + 2 * rp; \
              va[i] = (u32x4){0u, 0u, 0u, 0u}; vb[i] = va[i]; \
              if (j0 >= 0 && j0 < A_.L) va[i] = *(const u32x4*)(c.Z + ((size_t)A_.b * SEQ + A_.r + A_.d * j0) * DIN + ZV + A_.hh * 64 + 8 * dc8); \
              if (j0 + 1 >= 0 && j0 + 1 < A_.L) vb[i] = *(const u32x4*)(c.Z + ((size_t)A_.b * SEQ + A_.r + A_.d * (j0 + 1)) * DIN + ZV + A_.hh * 64 + 8 * dc8); } } } while (0)
    ATT_PREFETCH(u);
    for (;;) {
        const AttnU A = attn_decode(u);
        const int b = A.b, g = A.g, hI = A.hI, d = A.d, L = A.L, r = A.r, hh = A.hh, i0 = A.i0;
        const int iq = i0 + 32 * wave + rq, posq = r + d * iq;
        const size_t tokq = (size_t)b * SEQ + posq;
        bf16_t* qrow = c.Z + tokq * DIN + ZQ + hh * 64;
        bf16x8 qf[4];
        {
            const u32x4 q0 = *(const u32x4*)(qrow + 8 * h), q1 = *(const u32x4*)(qrow + 16 + 8 * h), q2 = *(const u32x4*)(qrow + 32 + 8 * h), q3 = *(const u32x4*)(qrow + 48 + 8 * h);
            const _Float16* rh = c.RH + posq * 64 + 8 * h;
            const h16x8 cav = *(const h16x8*)rh, cbv = *(const h16x8*)(rh + 16), sav = *(const h16x8*)(rh + 32), sbv = *(const h16x8*)(rh + 48);
            const float sc = 0.125f * 1.44269504f;
            u32x4 o0, o1, o2, o3;
    #pragma unroll
            for (int e = 0; e < 4; ++e) {
                const float ca_0 = (float)cav[2 * e], ca_1 = (float)cav[2 * e + 1], sa_0 = (float)sav[2 * e], sa_1 = (float)sav[2 * e + 1];
                const float cb_0 = (float)cbv[2 * e], cb_1 = (float)cbv[2 * e + 1], sb_0 = (float)sbv[2 * e], sb_1 = (float)sbv[2 * e + 1];
                const float a0 = bflo(q0[e]), a1 = bfhi(q0[e]), b0 = bflo(q2[e]), b1 = bfhi(q2[e]);
                const float e0 = bflo(q1[e]), e1 = bfhi(q1[e]), f0 = bflo(q3[e]), f1 = bfhi(q3[e]);
                o0[e] = pk2((a0 * ca_0 - b0 * sa_0) * sc, (a1 * ca_1 - b1 * sa_1) * sc);
                o2[e] = pk2((b0 * ca_0 + a0 * sa_0) * sc, (b1 * ca_1 + a1 * sa_1) * sc);
                o1[e] = pk2((e0 * cb_0 - f0 * sb_0) * sc, (e1 * cb_1 - f1 * sb_1) * sc);
                o3[e] = pk2((f0 * cb_0 + e0 * sb_0) * sc, (f1 * cb_1 + e1 * sb_1) * sc);
            }
            qf[0] = __builtin_bit_cast(bf16x8, o0); qf[1] = __builtin_bit_cast(bf16x8, o1); qf[2] = __builtin_bit_cast(bf16x8, o2); qf[3] = __builtin_bit_cast(bf16x8, o3);
        }
#pragma unroll
        for (int i = 0; i < 3; ++i) {
            const int id = t + 512 * i, row = id >> 2, dc = id & 3;
            int posk = r + d * (i0 - 64 + row); posk = posk < 0 ? 0 : (posk > SEQ - 1 ? SEQ - 1 : posk);
            const h16x8 kcv = *(const h16x8*)(c.RH + posk * 64 + 8 * dc), ksv = *(const h16x8*)(c.RH + posk * 64 + 32 + 8 * dc);
            u32x4 olo, ohi;
#pragma unroll
            for (int e = 0; e < 4; ++e) {
                const float l0 = bflo(ka[i][e]), l1 = bfhi(ka[i][e]), h0 = bflo(kb2[i][e]), h1 = bfhi(kb2[i][e]);
                const float cc0 = (float)kcv[2 * e], cc1 = (float)kcv[2 * e + 1], ss0 = (float)ksv[2 * e], ss1 = (float)ksv[2 * e + 1];
                olo[e] = pk2(l0 * cc0 - h0 * ss0, l1 * cc1 - h1 * ss1);
                ohi[e] = pk2(h0 * cc0 + l0 * ss0, h1 * cc1 + l1 * ss1);
            }
            *(LASP u32x4*)(Kt + row * 128 + ((dc ^ (row & 7)) << 4)) = olo;
            *(LASP u32x4*)(Kt + row * 128 + (((4 + dc) ^ (row & 7)) << 4)) = ohi;
            const int rp = id % 192, dc8 = id / 192;
#pragma unroll
            for (int e = 0; e < 4; ++e) {
                Vt[(8 * dc8 + 2 * e) * 194 + rp] = (va[i][e] & 0xffffu) | (vb[i][e] << 16);
                Vt[(8 * dc8 + 2 * e + 1) * 194 + rp] = (va[i][e] >> 16) | (vb[i][e] & 0xffff0000u);
            }
        }
        __syncthreads();
        const int un = u + G;
        if (un < NAT) ATT_PREFETCH(un);
        asm volatile("" ::: "memory");
        f32x16 sacc[5];
    #pragma unroll
        for (int kb = 0; kb < 5; ++kb)
    #pragma unroll
            for (int e = 0; e < 16; ++e) sacc[kb][e] = 0.f;
    #pragma unroll
        for (int s4 = 0; s4 < 4; ++s4) {
    #pragma unroll
            for (int kb = 0; kb < 5; ++kb) {
                const int row = 32 * wave + 32 * kb + rq;
                const bf16x8 kf = *(const LASP bf16x8*)(Kt + row * 128 + (((2 * s4 + h) ^ (row & 7)) << 4));
                sacc[kb] = mfma32_g(kf, qf[s4], sacc[kb]);
            }
            __builtin_amdgcn_sched_barrier(0);
        }
        asm volatile("s_nop 15\n\ts_nop 15" : "+v"(sacc[0]), "+v"(sacc[1]), "+v"(sacc[2]), "+v"(sacc[3]), "+v"(sacc[4]));
        const int jbase = i0 - 64 + 32 * wave;
        float mx = -1e30f;
    #pragma unroll
        for (int kb = 0; kb < 5; ++kb)
    #pragma unroll
            for (int e = 0; e < 16; ++e) {
                const int row = (e & 3) + 8 * (e >> 2) + 4 * h, rel = 32 * kb + row - rq, j = jbase + 32 * kb + row;
                const bool valid = (rel >= 0) && (rel <= 128) && (j >= 0) && (j < L);
                const float sv = valid ? sacc[kb][e] : -1e30f;
                sacc[kb][e] = sv; mx = fmaxf(mx, sv);
            }
        mx = fmaxf(mx, __shfl_xor(mx, 32));
        float lsum = 0.f;
    #pragma unroll
        for (int kb = 0; kb < 5; ++kb)
    #pragma unroll
            for (int e = 0; e < 16; ++e) { const float p = __builtin_amdgcn_exp2f(sacc[kb][e] - mx); sacc[kb][e] = p; lsum += p; }
        lsum += __shfl_xor(lsum, 32);
        f32x16 oacc[2];
    #pragma unroll
        for (int db = 0; db < 2; ++db)
    #pragma unroll
            for (int e = 0; e < 16; ++e) oacc[db][e] = 0.f;
    #pragma unroll
        for (int kb = 0; kb < 5; ++kb)
    #pragma unroll
            for (int s2 = 0; s2 < 2; ++s2) {
                u32x4 pw;
    #pragma unroll
                for (int e = 0; e < 4; ++e) pw[e] = cvtpk(sacc[kb][8 * s2 + 2 * e], sacc[kb][8 * s2 + 2 * e + 1]);
                const bf16x8 pf = __builtin_bit_cast(bf16x8, pw);
                const int kp = (32 * wave + 32 * kb + 16 * s2 + 4 * h) >> 1;
    #pragma unroll
                for (int db = 0; db < 2; ++db) {
                    const LASP unsigned* vp = Vt + (32 * db + rq) * 194 + kp;
                    const u32x2 g0 = *(const LASP u32x2*)vp, g1 = *(const LASP u32x2*)(vp + 4);
                    const u32x4 aw = (u32x4){g0.x, g0.y, g1.x, g1.y};
                    oacc[db] = mfma32_g(__builtin_bit_cast(bf16x8, aw), pf, oacc[db]);
                }
            }
        asm volatile("s_nop 15\n\ts_nop 15" : "+v"(oacc[0]), "+v"(oacc[1]));
        if (do_store) {
            const float inv = 1.f / lsum;
    #pragma unroll
            for (int db = 0; db < 2; ++db)
    #pragma unroll
                for (int g4 = 0; g4 < 4; ++g4) {
                    const u32x2 w = (u32x2){cvtpk(oacc[db][4 * g4] * inv, oacc[db][4 * g4 + 1] * inv), cvtpk(oacc[db][4 * g4 + 2] * inv, oacc[db][4 * g4 + 3] * inv)};
                    *(u32x2*)(qrow + 32 * db + 8 * g4 + 4 * h) = w;
                }
            if (h == 0) c.LSE[((size_t)g * MT + tokq) * 4 + hI] = mx * 0.69314718f + __logf(lsum);
        }
        __syncthreads();
        if (un >= NAT) break;
        u = un;
    }
#undef ATT_PREFETCH
}

__device__ __forceinline__ f32x4 mfma16(bf16x8 a, bf16x8 b, f32x4 c) { return mfma16_g(a, b, c); }
template <int KSTEPS, int UNR = 2>
__device__ __forceinline__ void gemm64(const LASP unsigned char* Y, int kbyte0, const bf16_t* Bt, int ldb, f32x4 (&acc)[4][2], int fr, int fq) {
#pragma unroll UNR
    for (int ks = 0; ks < KSTEPS; ++ks) {
        bf16x8 bfr[2], afr[4];
#pragma unroll
        for (int n = 0; n < 2; ++n) bfr[n] = *(const bf16x8*)(Bt + (size_t)(16 * n + fr) * ldb + ks * 32 + 8 * fq);
#pragma unroll
        for (int m = 0; m < 4; ++m) afr[m] = *(const LASP bf16x8*)(Y + (16 * m + fr) * 528 + kbyte0 + (ks * 32 + 8 * fq) * 2);
#pragma unroll
        for (int m = 0; m < 4; ++m)
#pragma unroll
            for (int n = 0; n < 2; ++n) acc[m][n] = mfma16(bfr[n], afr[m], acc[m][n]);
        __builtin_amdgcn_sched_barrier(0);
    }
}
__device__ __forceinline__ bf16x8 pack8(f32x4 lo, f32x4 hi) {
    u32x4 w; w.x = cvtpk(lo[0], lo[1]); w.y = cvtpk(lo[2], lo[3]); w.z = cvtpk(hi[0], hi[1]); w.w = cvtpk(hi[2], hi[3]);
    return __builtin_bit_cast(bf16x8, w);
}
__device__ __forceinline__ bf16x8 dft_frag(int rowidx, int kbase, int fq, bool perm, int which  ) {
    float v[8];
#pragma unroll
    for (int j = 0; j < 8; ++j) {
        const int k = kbase + (perm ? (16 * (j >> 2) + 4 * fq + (j & 3)) : (8 * fq + j));
        float sn, cs; sincospif((float)((rowidx * k) & 63) * (1.f / 32.f), &sn, &cs);
        v[j] = which == 0 ? cs : (which == 1 ? sn : -sn);
    }
    u32x4 w; w.x = pk2(v[0], v[1]); w.y = pk2(v[2], v[3]); w.z = pk2(v[4], v[5]); w.w = pk2(v[6], v[7]);
    return __builtin_bit_cast(bf16x8, w);
}

__device__ __forceinline__ void fft1_phase_mfma(const Ctx& c) {
    const int t = TIDX, lane = t & 63, wave = __builtin_amdgcn_readfirstlane(t >> 6), fr = lane & 15, fq = lane >> 4, n = wave & 3, hsel = wave >> 2;
    bf16x8 cA[2], sA[2], cB[2][2], sB[2][2], nsB[2][2];
#pragma unroll
    for (int ks = 0; ks < 2; ++ks) {
        cA[ks] = dft_frag(16 * n + fr, 32 * ks, fq, false, 0); sA[ks] = dft_frag(16 * n + fr, 32 * ks, fq, false, 1);
#pragma unroll
        for (int mbi = 0; mbi < 2; ++mbi) {
            const int k1r = 16 * (2 * hsel + mbi) + fr;
            cB[mbi][ks] = dft_frag(k1r, 32 * ks, fq, true, 0); sB[mbi][ks] = dft_frag(k1r, 32 * ks, fq, true, 1); nsB[mbi][ks] = dft_frag(k1r, 32 * ks, fq, true, 2);
        }
    }
    bf16x8 ua[4][2];
#define FFT1_LOAD(uu_) do { const int s2_ = (uu_) & 63, bg_ = (uu_) >> 6, g_ = bg_ & 3, b_ = bg_ >> 2; \
        _Pragma("unroll") for (int m = 0; m < 4; ++m) _Pragma("unroll") for (int ks = 0; ks < 2; ++ks) \
            ua[m][ks] = *(const bf16x8*)(c.Z + (size_t)(b_ * SEQ + 64 * (16 * m + fr) + s2_) * DIN + ZA + 64 * g_ + 32 * ks + 8 * fq); } while (0)
    { const int u0 = BIDX; if (u0 < NB * 4 * 64) FFT1_LOAD(u0); }
    for (int u = BIDX; u < NB * 4 * 64; u += gridDim.x) {
        const int s2 = u & 63, bg = u >> 6;
        f32x4 wre[4], wim[4];
#pragma unroll
        for (int m = 0; m < 4; ++m) { wre[m] = (f32x4){0.f, 0.f, 0.f, 0.f}; wim[m] = wre[m]; }
#pragma unroll
        for (int ks = 0; ks < 2; ++ks) {
#pragma unroll
            for (int m = 0; m < 4; ++m) { wre[m] = mfma16(ua[m][ks], cA[ks], wre[m]); wim[m] = mfma16(ua[m][ks], sA[ks], wim[m]); }
            __builtin_amdgcn_sched_barrier(0);
        }
        asm volatile("" ::: "memory");
        { const int un = u + (int)gridDim.x; if (un < NB * 4 * 64) FFT1_LOAD(un); }
        asm volatile("" ::: "memory");
        asm volatile("s_nop 15\n\ts_nop 15" : "+v"(wre[0]), "+v"(wre[1]), "+v"(wre[2]), "+v"(wre[3]), "+v"(wim[0]), "+v"(wim[1]), "+v"(wim[2]), "+v"(wim[3]));
        bf16x8 bre[2], bim[2];
#pragma unroll
        for (int ks = 0; ks < 2; ++ks) { bre[ks] = pack8(wre[2 * ks], wre[2 * ks + 1]); bim[ks] = pack8(wim[2 * ks], wim[2 * ks + 1]); }
        asm volatile("s_nop 7" : "+v"(bre[0]), "+v"(bre[1]), "+v"(bim[0]), "+v"(bim[1]));
        f32x4 yre[2], yin[2];
#pragma unroll
        for (int mbi = 0; mbi < 2; ++mbi) { yre[mbi] = (f32x4){0.f, 0.f, 0.f, 0.f}; yin[mbi] = yre[mbi]; }
#pragma unroll
        for (int ks = 0; ks < 2; ++ks) {
#pragma unroll
            for (int mbi = 0; mbi < 2; ++mbi) { yre[mbi] = mfma16(cB[mbi][ks], bre[ks], yre[mbi]); yin[mbi] = mfma16(cB[mbi][ks], bim[ks], yin[mbi]); }
            __builtin_amdgcn_sched_barrier(0);
#pragma unroll
            for (int mbi = 0; mbi < 2; ++mbi) { yre[mbi] = mfma16(nsB[mbi][ks], bim[ks], yre[mbi]); yin[mbi] = mfma16(sB[mbi][ks], bre[ks], yin[mbi]); }
            __builtin_amdgcn_sched_barrier(0);
        }
        asm volatile("s_nop 15\n\ts_nop 15" : "+v"(yre[0]), "+v"(yin[0]), "+v"(yre[1]), "+v"(yin[1]));
#pragma unroll
        for (int mbi = 0; mbi < 2; ++mbi) {
#pragma unroll
            for (int rg = 0; rg < 4; ++rg) {
                const int k1 = 16 * (2 * hsel + mbi) + 4 * fq + rg;
                const float2 tw = c.TW[(k1 * s2) & 4095];
                const float yr = yre[mbi][rg], yi = -yin[mbi][rg];
                c.FY[((size_t)(bg * 64 + k1) * 64 + s2) * 64 + 16 * n + fr] = pk2(yr * tw.x + yi * tw.y, yi * tw.x - yr * tw.y);
            }
        }
    }
#undef FFT1_LOAD
}

__device__ __forceinline__ void fft2_phase_mfma(const Ctx& c, int l, unsigned char* lds_raw) {
    LASP unsigned char* F = (LASP unsigned char*)lds_raw;
    const int t = TIDX, lane = t & 63, wave = __builtin_amdgcn_readfirstlane(t >> 6), fr = lane & 15, fq = lane >> 4, g = wave >> 1, nh = wave & 1;
    bf16x8 cF[4][2], sF[4][2];
#pragma unroll
    for (int m = 0; m < 4; ++m)
#pragma unroll
        for (int ks = 0; ks < 2; ++ks) { cF[m][ks] = dft_frag(16 * m + fr, 32 * ks, fq, false, 0); sF[m][ks] = dft_frag(16 * m + fr, 32 * ks, fq, false, 1); }
    for (int u = BIDX; u < NB * 64; u += gridDim.x) {
        const int b = u >> 6, k1 = u & 63;
        const unsigned* src = c.FY + (size_t)((b * 4 + g) * 64 + k1) * 4096;
#pragma unroll
        for (int nn = 0; nn < 2; ++nn) {
            const int cp = 16 * (2 * nh + nn) + fr;
            bf16x8 bre[2], bim[2];
#pragma unroll
            for (int ks = 0; ks < 2; ++ks) {
                unsigned w[8];
#pragma unroll
                for (int j = 0; j < 8; ++j) w[j] = src[(32 * ks + 8 * fq + j) * 64 + cp];
                u32x4 re, im;
#pragma unroll
                for (int e = 0; e < 4; ++e) { re[e] = (w[2 * e] & 0xffffu) | (w[2 * e + 1] << 16); im[e] = (w[2 * e] >> 16) | (w[2 * e + 1] & 0xffff0000u); }
                bre[ks] = __builtin_bit_cast(bf16x8, re); bim[ks] = __builtin_bit_cast(bf16x8, im);
            }
            f32x4 dacc[4];
#pragma unroll
            for (int m = 0; m < 4; ++m) dacc[m] = (f32x4){0.f, 0.f, 0.f, 0.f};
#pragma unroll
            for (int ks = 0; ks < 2; ++ks) {
#pragma unroll
                for (int m = 0; m < 4; ++m) dacc[m] = mfma16(bre[ks], cF[m][ks], dacc[m]);
                __builtin_amdgcn_sched_barrier(0);
#pragma unroll
                for (int m = 0; m < 4; ++m) dacc[m] = mfma16(bim[ks], sF[m][ks], dacc[m]);
                __builtin_amdgcn_sched_barrier(0);
            }
            asm volatile("s_nop 15" : "+v"(dacc[0]), "+v"(dacc[1]), "+v"(dacc[2]), "+v"(dacc[3]));
#pragma unroll
            for (int m = 0; m < 4; ++m) {
                u32x2 wv; wv.x = cvtpk(dacc[m][0] * (1.f / 512.f), dacc[m][1] * (1.f / 512.f)); wv.y = cvtpk(dacc[m][2] * (1.f / 512.f), dacc[m][3] * (1.f / 512.f));
                *(LASP u32x2*)(F + (16 * m + fr) * 528 + (g * 64 + 16 * (2 * nh + nn) + 4 * fq) * 2) = wv;
            }
        }
        __syncthreads();
        f32x4 acc[4][2];
#pragma unroll
        for (int m = 0; m < 4; ++m)
#pragma unroll
            for (int n = 0; n < 2; ++n) acc[m][n] = (f32x4){0.f, 0.f, 0.f, 0.f};
        gemm64<8>(F, 0, c.WfT + (size_t)l * 65536 + (size_t)(32 * wave) * 256, 256, acc, fr, fq);
#pragma unroll
        for (int m = 0; m < 4; ++m)
#pragma unroll
            for (int n = 0; n < 2; ++n) {
                const size_t tok = (size_t)b * SEQ + k1 + 64 * (16 * m + fr); const int col = 32 * wave + 16 * n + 4 * fq;
                const u32x2 gp = *(const u32x2*)(c.Z + tok * DIN + ZG + col);
                u32x2 o; o.x = cvtpk(acc[m][n][0] * siluf_(bflo(gp.x)), acc[m][n][1] * siluf_(bfhi(gp.x))); o.y = cvtpk(acc[m][n][2] * siluf_(bflo(gp.y)), acc[m][n][3] * siluf_(bfhi(gp.y)));
                *(u32x2*)(c.P + tok * DM + col) = o;
            }
        __syncthreads();
    }
}

__device__ __forceinline__ void tok_unit_mfma(const Ctx& c, int l, int u, unsigned char* lds_raw) {
    LASP float* A = (LASP float*)lds_raw;
    LASP unsigned char* Y = (LASP unsigned char*)(lds_raw + 96256);
    const int t = TIDX, lane = t & 63, wave = __builtin_amdgcn_readfirstlane(t >> 6), ch = t & 255, half = t >> 8, fr = lane & 15, fq = lane >> 4;
    const int b = u >> 6, s0 = (u & 63) * 64, tok0 = b * SEQ + s0;
    for (int rp1 = 0; rp1 < (TOKREP == 1 ? 2 : 1); ++rp1) {
#pragma unroll
    for (int i = 0; i < 6; ++i) {
        const int id = t + 512 * i;
        if (id < 94 * 32) {
            const int row = id >> 5, c8 = (id & 31) * 8, sp = s0 - 15 + row;
            f32x4 v0 = (f32x4){0.f, 0.f, 0.f, 0.f}, v1 = v0;
            if (sp >= 0 && sp < SEQ) {
                const bf16_t* zr = c.Z + (size_t)(b * SEQ + sp) * DIN + ZB + c8;
                const u32x4 a = *(const u32x4*)zr, gg = *(const u32x4*)(zr + 256);
                v0[0] = bflo(a.x) * sigmoidf_(bflo(gg.x)); v0[1] = bfhi(a.x) * sigmoidf_(bfhi(gg.x)); v0[2] = bflo(a.y) * sigmoidf_(bflo(gg.y)); v0[3] = bfhi(a.y) * sigmoidf_(bfhi(gg.y));
                v1[0] = bflo(a.z) * sigmoidf_(bflo(gg.z)); v1[1] = bfhi(a.z) * sigmoidf_(bfhi(gg.z)); v1[2] = bflo(a.w) * sigmoidf_(bflo(gg.w)); v1[3] = bfhi(a.w) * sigmoidf_(bfhi(gg.w));
            }
            *(LASP f32x4*)(A + row * 256 + c8) = v0; *(LASP f32x4*)(A + row * 256 + c8 + 4) = v1;
        }
    }
    __syncthreads();
    float y[32];
    {
        float cw[31];
#pragma unroll
        for (int w = 0; w < 31; ++w) cw[w] = c.conv_w[(size_t)l * 31 * 256 + w * 256 + ch];
        const float cb = c.conv_b[l * 256 + ch];
#pragma unroll
        for (int cc = 0; cc < 4; ++cc) {
            float rows[38];
#pragma unroll
            for (int r = 0; r < 38; ++r) rows[r] = A[(half * 32 + cc * 8 + r) * 256 + ch];
#pragma unroll
            for (int i = 0; i < 8; ++i) {
                float acc = cb;
#pragma unroll
                for (int w = 0; w < 31; ++w) acc += rows[i + w] * cw[w];
                y[cc * 8 + i] = acc;
            }
            __builtin_amdgcn_sched_barrier(0);
        }
    }
    __syncthreads();
#pragma unroll
    for (int i = 0; i < 32; ++i) A[(half * 32 + i) * 256 + ch] = y[i];
    __syncthreads();
    {
        const f32x4 lg = *(const f32x4*)(c.conv_ln_g + l * 256 + 4 * lane), lb = *(const f32x4*)(c.conv_ln_b + l * 256 + 4 * lane);
#pragma unroll 2
        for (int i = 0; i < 8; ++i) {
            const int tk = wave * 8 + i;
            f32x4 xv = *(const LASP f32x4*)(A + tk * 256 + 4 * lane);
            const float mean = wave_sum((xv[0] + xv[1]) + (xv[2] + xv[3])) * (1.f / 256.f);
            xv = xv - mean;
            const float rstd = 1.0f / sqrtf(wave_sum((xv[0] * xv[0] + xv[1] * xv[1]) + (xv[2] * xv[2] + xv[3] * xv[3])) * (1.f / 256.f) + 1e-5f);
            const f32x4 yv = xv * rstd * lg + lb;
            u32x2 o; o.x = cvtpk(siluf_(yv[0]), siluf_(yv[1])); o.y = cvtpk(siluf_(yv[2]), siluf_(yv[3]));
            *(LASP u32x2*)(Y + tk * 528 + 8 * lane) = o;
        }
    }
    __syncthreads();
    }
    for (int rp2 = 0; rp2 < (TOKREP == 2 ? 2 : 1); ++rp2) {
        f32x4 acc[4][2];
#pragma unroll
        for (int m = 0; m < 4; ++m)
#pragma unroll
            for (int n = 0; n < 2; ++n) acc[m][n] = (f32x4){0.f, 0.f, 0.f, 0.f};
        gemm64<8, 8>(Y, 0, c.WpwT + (size_t)l * 65536 + (size_t)(32 * wave) * 256, 256, acc, fr, fq);
#pragma unroll
        for (int m = 0; m < 4; ++m)
#pragma unroll
            for (int n = 0; n < 2; ++n) {
                const size_t tok = (size_t)tok0 + 16 * m + fr; const int col = 32 * wave + 16 * n + 4 * fq;
                const u32x2 gp = *(const u32x2*)(c.Z + tok * DIN + ZG + 256 + col);
                u32x2 o; o.x = cvtpk(acc[m][n][0] * siluf_(bflo(gp.x)), acc[m][n][1] * siluf_(bfhi(gp.x))); o.y = cvtpk(acc[m][n][2] * siluf_(bflo(gp.y)), acc[m][n][3] * siluf_(bfhi(gp.y)));
                *(u32x2*)(c.P + tok * DM + 256 + col) = o;
            }
    }
    __syncthreads();
    for (int rp3 = 0; rp3 < (TOKREP == 3 ? 2 : 1); ++rp3) {
#pragma unroll
    for (int i = 0; i < 5; ++i) {
        const int id = t + 512 * i;
        if (id < 79 * 32) {
            const int row = id >> 5, c8 = (id & 31) * 8, sp = s0 - 8 + row;
            f32x4 v0 = (f32x4){0.f, 0.f, 0.f, 0.f}, v1 = v0;
            if (sp >= 0 && sp < SEQ) {
                const u32x4 a = *(const u32x4*)(c.Z + (size_t)(b * SEQ + sp) * DIN + ZD + c8);
                v0[0] = bflo(a.x); v0[1] = bfhi(a.x); v0[2] = bflo(a.y); v0[3] = bfhi(a.y); v1[0] = bflo(a.z); v1[1] = bfhi(a.z); v1[2] = bflo(a.w); v1[3] = bfhi(a.w);
            }
            *(LASP f32x4*)(A + row * 256 + c8) = v0; *(LASP f32x4*)(A + row * 256 + c8 + 4) = v1;
        }
    }
    __syncthreads();
    {
        const int gi = ch >> 6, sz = 2 << gi;
        float xr[47];
#pragma unroll
        for (int r = 0; r < 47; ++r) xr[r] = A[(half * 32 + r) * 256 + ch];
        float w2c[47], w4c[47], w8c[47];
#pragma unroll
        for (int r = 1; r < 47; ++r) w2c[r] = xr[r - 1] + xr[r];
#pragma unroll
        for (int r = 2; r < 46; ++r) w4c[r] = w2c[r - 1] + w2c[r + 1];
#pragma unroll
        for (int r = 4; r < 44; ++r) w8c[r] = w4c[r - 2] + w4c[r + 2];
#pragma unroll
        for (int i = 0; i < 32; ++i) {
            const int r = i + 8, tk = half * 32 + i, sp = s0 + tk;
            const float w16 = w8c[r - 4] + w8c[r + 4];
            const float wsum = gi == 0 ? w2c[r] : (gi == 1 ? w4c[r] : (gi == 2 ? w8c[r] : w16));
            int lo = sp - sz / 2; if (lo < 0) lo = 0;
            int hi = sp + sz - 1 - sz / 2; if (hi > SEQ - 1) hi = SEQ - 1;
            *(LASP bf16_t*)(Y + tk * 528 + ch * 2) = f2bf(wsum / (float)(hi - lo + 1) - xr[r]);
        }
    }
    __syncthreads();
    {
        const int gi = wave >> 1, cb = (wave & 1) * 32;
        f32x4 acc[4][2];
#pragma unroll
        for (int m = 0; m < 4; ++m)
#pragma unroll
            for (int n = 0; n < 2; ++n) acc[m][n] = (f32x4){0.f, 0.f, 0.f, 0.f};
        gemm64<2>(Y, gi * 128, c.WpoolT + (size_t)(l * 4 + gi) * 4096 + (size_t)cb * 64, 64, acc, fr, fq);
#pragma unroll
        for (int m = 0; m < 4; ++m)
#pragma unroll
            for (int n = 0; n < 2; ++n) {
                const size_t tok = (size_t)tok0 + 16 * m + fr; const int col = gi * 64 + cb + 16 * n + 4 * fq;
                const u32x2 gp = *(const u32x2*)(c.Z + tok * DIN + ZG + 768 + col);
                const f32x4 ps = *(const f32x4*)(c.pool_scale + l * 256 + col);
                u32x2 o; o.x = cvtpk(acc[m][n][0] * ps[0] * siluf_(bflo(gp.x)), acc[m][n][1] * ps[1] * siluf_(bfhi(gp.x))); o.y = cvtpk(acc[m][n][2] * ps[2] * siluf_(bflo(gp.y)), acc[m][n][3] * ps[3] * siluf_(bfhi(gp.y)));
                *(u32x2*)(c.P + tok * DM + 768 + col) = o;
            }
    }
    __syncthreads();
    }
}

__device__ __forceinline__ void fft2_unit(const Ctx& c, int l, int u, float* lds) {
    const int t = TIDX, b = u >> 6, k1 = u & 63, cp = t & 63;
    float* Ft = lds; float* Yre = lds + 64 * 260; float* Yim = Yre + 4096; float* cs = Yim + 4096; float* sn = cs + 64;
    if (t < 64) { float s, co; sincospif((float)t / 32.f, &s, &co); cs[t] = co; sn[t] = s; }
    for (int g = 0; g < 4; ++g) {
        const unsigned* src = c.FY + (size_t)((b * 4 + g) * 64 + k1) * 4096;
#pragma unroll
        for (int i = 0; i < 8; ++i) { const int idx = t + 512 * i; const unsigned w = src[idx]; Yre[idx] = bflo(w); Yim[idx] = bfhi(w); }
        __syncthreads();
#pragma unroll 1
        for (int i = 0; i < 8; ++i) {
            const int k2 = (t >> 6) + 8 * i; float acc = 0.f;
            for (int s2 = 0; s2 < 64; ++s2) { const int e = (k2 * s2) & 63; acc += cs[e] * Yre[s2 * 64 + cp] + sn[e] * Yim[s2 * 64 + cp]; }
            Ft[k2 * 260 + g * 64 + cp] = acc * (1.f / 512.f);
        }
        __syncthreads();
    }
    const int j = t & 255, half = t >> 8;
    float acc[32];
#pragma unroll
    for (int i = 0; i < 32; ++i) acc[i] = 0.f;
    const float* W = c.w_fourier + (size_t)l * 65536;
#pragma unroll 2
    for (int k = 0; k < 256; ++k) {
        const float wv = W[k * 256 + j];
#pragma unroll
        for (int i = 0; i < 32; ++i) acc[i] += Ft[(half * 32 + i) * 260 + k] * wv;
    }
    __syncthreads();
#pragma unroll
    for (int i = 0; i < 32; ++i) Ft[(half * 32 + i) * 260 + j] = acc[i];
    __syncthreads();
#pragma unroll 1
    for (int i = 0; i < 32; ++i) {
        const size_t tok = (size_t)b * SEQ + k1 + 64 * (half * 32 + i);
        const float gp = bf2f(c.Z[tok * DIN + ZG + j]);
        c.P[tok * DM + j] = f2bf(Ft[(half * 32 + i) * 260 + j] * siluf_(gp));
    }
    __syncthreads();
}

__device__ __forceinline__ void phase_combine(const Ctx& c) {
    const int gt = BIDX * NTHREADS + TIDX, NT = gridDim.x * NTHREADS;
    for (int idx = gt; idx < MT * 32; idx += NT) {
        const size_t m = idx >> 5; const int c8 = (idx & 31) * 8, hI = c8 >> 6;
        const float l0 = c.LSE[((size_t)0 * MT + m) * 4 + hI], l1 = c.LSE[((size_t)1 * MT + m) * 4 + hI], l2 = c.LSE[((size_t)2 * MT + m) * 4 + hI];
        const float mx = fmaxf(l0, fmaxf(l1, l2));
        const float e0 = __expf(l0 - mx), e1 = __expf(l1 - mx), e2 = __expf(l2 - mx), inv = 1.f / (e0 + e1 + e2);
        const float a0 = e0 * inv, a1 = e1 * inv, a2 = e2 * inv;
        const bf16_t* zr = c.Z + m * DIN;
        const u32x4 o0 = *(const u32x4*)(zr + ZQ + (0 * 4 + hI) * 64 + (c8 & 63));
        const u32x4 o1 = *(const u32x4*)(zr + ZQ + (1 * 4 + hI) * 64 + (c8 & 63));
        const u32x4 o2 = *(const u32x4*)(zr + ZQ + (2 * 4 + hI) * 64 + (c8 & 63));
        const u32x4 gp = *(const u32x4*)(zr + ZG + 512 + c8);
        u32x4 res;
#pragma unroll
        for (int q = 0; q < 4; ++q) {
            const float vlo = (a0 * bflo(o0[q]) + a1 * bflo(o1[q]) + a2 * bflo(o2[q])) * siluf_(bflo(gp[q]));
            const float vhi = (a0 * bfhi(o0[q]) + a1 * bfhi(o1[q]) + a2 * bfhi(o2[q])) * siluf_(bfhi(gp[q]));
            res[q] = pk2(vlo, vhi);
        }
        *(u32x4*)(c.P + m * DM + 512 + c8) = res;
    }
}

namespace pg8 {
#define PG8_LAS __attribute__((address_space(3)))
typedef unsigned short bf16_t;
typedef short bf16x8 __attribute__((ext_vector_type(8)));
typedef float f32x4 __attribute__((ext_vector_type(4)));
typedef unsigned u32x4 __attribute__((ext_vector_type(4)));
constexpr int BM = 256, BK = 64, HALF = 128, HTB = HALF * BK * 2  , STAGE_BYTES = 8 * HTB, NXCD = 8, WGM = 8;

__host__ __device__ __forceinline__ int lds_byte(int r, int c) { const int st = (r >> 4) * 2 + (c >> 5), rr = r & 15, cc = c & 31, ob = rr * 64 + cc * 2; return st * 1024 + (ob ^ (((ob >> 9) & 1) << 5)); }
__host__ __device__ __forceinline__ void stage_rc(int b, int& R, int& C) { const int st = b / 1024, sb = b % 1024, swz = sb ^ (((sb >> 9) & 1) << 5); R = (st >> 1) * 16 + swz / 64; C = (st & 1) * 32 + (swz % 64) / 2; }
__host__ __device__ __forceinline__ int perm32(int rho) { const int n = rho >> 4, i = rho & 15; return 8 * (i >> 2) + 4 * n + (i & 3); }

struct Unit { int pm, pn, sub; };
template <int LDA_, int LDB_, int K_, int ASUB_, int BSUB_> struct GemmT { const bf16_t* A; const bf16_t* Bt; static constexpr int lda = LDA_, ldb = LDB_, K = K_; static constexpr size_t a_sub = ASUB_, b_sub = BSUB_; };

struct StaticOrder {
    int nM, nN, nwg, G, c;
    __host__ __device__ void init(int M, int N, int G_, int c_) { nM = M / BM; nN = N / BM; nwg = nM * nN; G = G_; c = c_; }
    __host__ __device__ bool next(int i, Unit& u) const {
        const long L = (long)i * G + c; if (L >= nwg) return false;
        int wgid = (int)L; { const int q = nwg / NXCD, r = nwg % NXCD, xcd = wgid % NXCD, off = wgid / NXCD; wgid = (xcd < r ? xcd * (q + 1) : r * (q + 1) + (xcd - r) * q) + off; }
        const int nig = WGM * nN, gid = wgid / nig, fm = gid * WGM, gsz = (nM - fm) < WGM ? (nM - fm) : WGM;
        u.pm = fm + ((wgid % nig) % gsz); u.pn = (wgid % nig) / gsz; u.sub = 0; return true;
    }
    __device__ __forceinline__ void a_ready(const Unit&) const {}
    __device__ __forceinline__ void done(const Unit&) const {}
};


__device__ __forceinline__ unsigned cvt_pk_bf16(float lo, float hi) { return ::pk2(lo, hi); }
template <int ACT  > struct EpiBf16 {
    static constexpr bool PERM = true, AFTER_DRAIN = false; static_assert(ACT == 0 || ACT == 2, "EpiBf16: ACT is 0 (none) or 2 (sigmoid)");
    bf16_t* O; int ldc; const float* bias; int split_cols; size_t split_stride; float scale0;
    __device__ __forceinline__ void operator()(const f32x4 (&acc)[2][2][4][2], const Unit& u, int wr, int wc, int fr, int fq) const {
        asm volatile("" : "+v"(fr), "+v"(fq));
        const int row0 = u.pm * BM + wr * 64 + fr; int colt = u.pn * BM; bf16_t* base = O;
        float sc = 1.f; if (split_cols) { const int t = colt / split_cols; base += (size_t)t * split_stride; colt -= t * split_cols; if (t == 0) sc = scale0; }
        const int col0 = colt + wc * 32 + 8 * fq, bcol0 = u.pn * BM + wc * 32 + 8 * fq;
        f32x4 bv[2][2];
#pragma unroll
        for (int bj = 0; bj < 2; ++bj)
#pragma unroll
            for (int n = 0; n < 2; ++n) bv[bj][n] = bias ? *(const f32x4*)(bias + bcol0 + bj * HALF + 4 * n) : (f32x4){0.f, 0.f, 0.f, 0.f};
#pragma unroll
        for (int ai = 0; ai < 2; ++ai)
#pragma unroll
            for (int m = 0; m < 4; ++m) { bf16_t* rowp = base + (size_t)(row0 + ai * HALF + m * 16) * ldc + col0;
#pragma unroll
                for (int bj = 0; bj < 2; ++bj) { f32x4 v0 = acc[ai][bj][m][0] + bv[bj][0], v1 = acc[ai][bj][m][1] + bv[bj][1];
                    if (ACT == 2) {
#pragma unroll
                        for (int q = 0; q < 4; ++q) { v0[q] = __builtin_amdgcn_rcpf(1.0f + __builtin_amdgcn_exp2f(v0[q] * -1.44269504f)); v1[q] = __builtin_amdgcn_rcpf(1.0f + __builtin_amdgcn_exp2f(v1[q] * -1.44269504f)); } }
                    v0 = v0 * sc; v1 = v1 * sc; u32x4 w; w.x = cvt_pk_bf16(v0[0], v0[1]); w.y = cvt_pk_bf16(v0[2], v0[3]); w.z = cvt_pk_bf16(v1[0], v1[1]); w.w = cvt_pk_bf16(v1[2], v1[3]);
                    *(u32x4*)(rowp + bj * HALF) = w; } }
    }
};

struct EpiMerge {
    static constexpr bool PERM = true, AFTER_DRAIN = false;
    const bf16_t* MG; bf16_t* O;
    __device__ __forceinline__ void operator()(const f32x4 (&acc)[2][2][4][2], const Unit& u, int wr, int wc, int fr, int fq) const {
        asm volatile("" : "+v"(fr), "+v"(fq));
        const int row0 = u.pm * BM + wr * 64 + fr, col0 = u.pn * BM + wc * 32 + 8 * fq;
        const bool rmw = (u.sub != 0);
        constexpr int DEPTH = 4;
        u32x4 gq[16], pq[16];
#define EPM_ROW(i) ((size_t)(row0 + ((i) >> 3) * HALF + (((i) >> 1) & 3) * 16))
#define EPM_LOAD(i) do { const size_t row_ = EPM_ROW(i); const int cb_ = col0 + ((i) & 1) * HALF; gq[i] = *(const u32x4*)(MG + row_ * 4096 + u.sub * 1024 + cb_); \
        if (rmw) pq[i] = *(const u32x4*)(O + row_ * 1024 + cb_); } while (0)
#pragma unroll
        for (int i = 0; i < DEPTH; ++i) EPM_LOAD(i);
        asm volatile("" ::: "memory");
#pragma unroll
        for (int i = 0; i < 16; ++i) {
            const int ai = i >> 3, m = (i >> 1) & 3, bj = i & 1;
            const u32x4 g = gq[i];
            f32x4 v0 = acc[ai][bj][m][0], v1 = acc[ai][bj][m][1];
            v0[0] *= __uint_as_float(g.x << 16); v0[1] *= __uint_as_float(g.x & 0xffff0000u); v0[2] *= __uint_as_float(g.y << 16); v0[3] *= __uint_as_float(g.y & 0xffff0000u);
            v1[0] *= __uint_as_float(g.z << 16); v1[1] *= __uint_as_float(g.z & 0xffff0000u); v1[2] *= __uint_as_float(g.w << 16); v1[3] *= __uint_as_float(g.w & 0xffff0000u);
            if (rmw) { const u32x4 p = pq[i];
                v0[0] += __uint_as_float(p.x << 16); v0[1] += __uint_as_float(p.x & 0xffff0000u); v0[2] += __uint_as_float(p.y << 16); v0[3] += __uint_as_float(p.y & 0xffff0000u);
                v1[0] += __uint_as_float(p.z << 16); v1[1] += __uint_as_float(p.z & 0xffff0000u); v1[2] += __uint_as_float(p.w << 16); v1[3] += __uint_as_float(p.w & 0xffff0000u); }
            u32x4 w; w.x = cvt_pk_bf16(v0[0], v0[1]); w.y = cvt_pk_bf16(v0[2], v0[3]); w.z = cvt_pk_bf16(v1[0], v1[1]); w.w = cvt_pk_bf16(v1[2], v1[3]);
            *(u32x4*)(O + EPM_ROW(i) * 1024 + col0 + bj * HALF) = w;
            asm volatile("" ::: "memory");
            if (i + DEPTH < 16) { EPM_LOAD(i + DEPTH); asm volatile("" ::: "memory"); }
        }
#undef EPM_LOAD
#undef EPM_ROW
    }
};
struct EpiOutF32 {
    static constexpr bool PERM = true, AFTER_DRAIN = false;
    const float* xin; float* out;
    __device__ __forceinline__ void operator()(const f32x4 (&acc)[2][2][4][2], const Unit& u, int wr, int wc, int fr, int fq) const {
        asm volatile("" : "+v"(fr), "+v"(fq));
        const int row0 = u.pm * BM + wr * 64 + fr, col0 = u.pn * BM + wc * 32 + 8 * fq;
        constexpr int DEPTH = 4;
        f32x4 x0q[16], x1q[16];
#define EPO_OFF(i) ((size_t)(row0 + ((i) >> 3) * HALF + (((i) >> 1) & 3) * 16) * 1024 + col0 + ((i) & 1) * HALF)
#define EPO_LOAD(i) do { const size_t off_ = EPO_OFF(i); x0q[i] = *(const f32x4*)(xin + off_); x1q[i] = *(const f32x4*)(xin + off_ + 4); } while (0)
#pragma unroll
        for (int i = 0; i < DEPTH; ++i) EPO_LOAD(i);
        asm volatile("" ::: "memory");
#pragma unroll
        for (int i = 0; i < 16; ++i) {
            const int ai = i >> 3, m = (i >> 1) & 3, bj = i & 1;
            const size_t off = EPO_OFF(i);
            *(f32x4*)(out + off) = x0q[i] + acc[ai][bj][m][0]; *(f32x4*)(out + off + 4) = x1q[i] + acc[ai][bj][m][1];
            asm volatile("" ::: "memory");
            if (i + DEPTH < 16) { EPO_LOAD(i + DEPTH); asm volatile("" ::: "memory"); }
        }
#undef EPO_LOAD
#undef EPO_OFF
    }
};
struct MergeOrder : StaticOrder {
    __device__ bool next(int i, Unit& u) const { const bool ok = StaticOrder::next(i >> 2, u); u.sub = i & 3; return ok; }
};

template <class Epi, class Sched, class Gemm, bool ALIGN_EPI = false, bool SP2 = false>
__device__ __forceinline__ void gemm_phase(PG8_LAS unsigned char* lds, const Gemm g, const Sched& S, const Epi& E) {
    const int tid = TIDX, wid = __builtin_amdgcn_readfirstlane(tid >> 6), lane = tid & 63, wr = wid >> 2, wc = wid & 3, fr = lane & 15, fq = lane >> 4;
    constexpr int K = Gemm::K, nt = K / BK, lda = Gemm::lda, ldb = Gemm::ldb;
    unsigned voffA[2], voffB[2];
#pragma unroll
    for (int i = 0; i < 2; ++i) { int R, C; stage_rc(tid * 16 + i * 8192, R, C); const int Rb = Epi::PERM ? ((R & ~31) + perm32(R & 31)) : R;
        voffA[i] = (unsigned)(R * lda + C) * 2u; voffB[i] = (unsigned)(Rb * ldb + C) * 2u; }
    const size_t kstep = (size_t)(BK * 2);
    const size_t hstepA = (size_t)HALF * lda * 2, hstepB = (size_t)HALF * ldb * 2;
    const size_t tstepA = 2 * hstepA, tstepB = 2 * hstepB;
    const unsigned ldsw = (unsigned)wid * 1024u;
    const int aoff = lds_byte(wr * 64 + fr, fq * 8), boff = lds_byte(wc * 32 + fr, fq * 8);
#define PG8_SA(b, h) (((b) * 2 + (h)) * HTB)
#define PG8_SB(b, h) ((4 + (b) * 2 + (h)) * HTB)
#define PG8_STAGE(bufoff, gbase, voff) do { _Pragma("unroll") for (int _i = 0; _i < 2; ++_i) \
        __builtin_amdgcn_global_load_lds((const unsigned*)((const char*)(gbase) + (voff)[_i]), (PG8_LAS unsigned*)(lds + (bufoff) + ldsw + _i * 8192), 16, 0, 0); } while (0)
#define PG8_LDA(dst, b, h) do { _Pragma("unroll") for (int m = 0; m < 4; ++m) _Pragma("unroll") for (int k = 0; k < 2; ++k) dst[m][k] = *(const PG8_LAS bf16x8*)(lds + PG8_SA(b, h) + aoff + m * 2048 + k * 1024); } while (0)
#define PG8_LDB(dst, b, h) do { _Pragma("unroll") for (int n = 0; n < 2; ++n) _Pragma("unroll") for (int k = 0; k < 2; ++k) dst[n][k] = *(const PG8_LAS bf16x8*)(lds + PG8_SB(b, h) + boff + n * 2048 + k * 1024); } while (0)
#define PG8_MMA(ai, bj, At, Bt) do { __builtin_amdgcn_s_setprio(1); _Pragma("unroll") for (int m = 0; m < 4; ++m) _Pragma("unroll") for (int n = 0; n < 2; ++n) _Pragma("unroll") for (int k = 0; k < 2; ++k) \
        acc[ai][bj][m][n] = ::mfma16_g(Bt[n][k], At[m][k], acc[ai][bj][m][n]); __builtin_amdgcn_s_setprio(0); } while (0)
#define PG8_WAIT_V(n) asm volatile("s_waitcnt vmcnt(" #n ")" ::: "memory")
#define PG8_WAIT_L(n) asm volatile("s_waitcnt lgkmcnt(" #n ")" ::: "memory")
#define PG8_BAR __builtin_amdgcn_s_barrier()
#define PG8_SCHED __builtin_amdgcn_sched_barrier(0)
    Unit cur, nxt; int ui = 0;
    if (!S.next(0, cur)) return;
    f32x4 acc[2][2][4][2];
#pragma unroll
    for (int a = 0; a < 2; ++a)
#pragma unroll
        for (int b = 0; b < 2; ++b)
#pragma unroll
            for (int m = 0; m < 4; ++m)
#pragma unroll
                for (int n = 0; n < 2; ++n) acc[a][b][m][n] = (f32x4){0.f, 0.f, 0.f, 0.f};
    bf16x8 At[4][2], B0[2][2], B1[2][2];
    const char* cA = (const char*)g.A + (size_t)cur.pm * tstepA + (size_t)cur.sub * g.a_sub; const char* cB = (const char*)g.Bt + (size_t)cur.pn * tstepB + (size_t)cur.sub * g.b_sub;
    S.a_ready(cur);
    if constexpr (SP2) {
        PG8_STAGE(PG8_SB(0, 0), cB, voffB); PG8_STAGE(PG8_SB(0, 1), cB + hstepB, voffB); PG8_STAGE(PG8_SA(0, 0), cA, voffA); PG8_STAGE(PG8_SA(0, 1), cA + hstepA, voffA);
        if (wr == 1) PG8_BAR;
        PG8_WAIT_V(2); PG8_BAR;
        PG8_STAGE(PG8_SB(1, 0), cB + kstep, voffB); PG8_STAGE(PG8_SA(1, 0), cA + kstep, voffA); PG8_STAGE(PG8_SB(1, 1), cB + hstepB + kstep, voffB);
        PG8_WAIT_V(6); PG8_BAR;
    } else {
        PG8_STAGE(PG8_SB(0, 0), cB, voffB); PG8_STAGE(PG8_SA(0, 0), cA, voffA); PG8_STAGE(PG8_SB(0, 1), cB + hstepB, voffB); PG8_STAGE(PG8_SA(0, 1), cA + hstepA, voffA);
        if (wr == 1) PG8_BAR;
        PG8_WAIT_V(4); PG8_BAR;
        PG8_STAGE(PG8_SB(1, 0), cB + kstep, voffB); PG8_STAGE(PG8_SA(1, 0), cA + kstep, voffA); PG8_STAGE(PG8_SB(1, 1), cB + hstepB + kstep, voffB);
        PG8_WAIT_V(6); PG8_BAR;
    }
    for (;;) {
        const bool has_next = S.next(ui + 1, nxt);
        const char* nA = has_next ? (const char*)g.A + (size_t)nxt.pm * tstepA + (size_t)nxt.sub * g.a_sub : cA; const char* nB = has_next ? (const char*)g.Bt + (size_t)nxt.pn * tstepB + (size_t)nxt.sub * g.b_sub : cB;
        for (int t = 0; t < nt; t += 2) {
            const bool last = (t == nt - 2);
            const char* a1 = cA + (size_t)(t + 1) * kstep;
            const char* a2 = last ? nA : cA + (size_t)(t + 2) * kstep; const char* b2 = last ? nB : cB + (size_t)(t + 2) * kstep;
            const char* a3 = a2 + kstep; const char* b3 = b2 + kstep;
            if (last && has_next) S.a_ready(nxt);
            if constexpr (SP2) {
            PG8_LDB(B0, 0, 0); PG8_LDB(B1, 0, 1); PG8_SCHED; PG8_LDA(At, 0, 0); PG8_STAGE(PG8_SA(1, 1), a1 + hstepA, voffA);
            PG8_WAIT_V(8); PG8_WAIT_L(0); PG8_BAR; PG8_MMA(0, 0, At, B0); PG8_MMA(0, 1, At, B1); PG8_BAR; PG8_SCHED;
            PG8_LDA(At, 0, 1); PG8_STAGE(PG8_SB(0, 0), b2, voffB); PG8_STAGE(PG8_SB(0, 1), b2 + hstepB, voffB); PG8_STAGE(PG8_SA(0, 0), a2, voffA);
            PG8_WAIT_V(8); PG8_WAIT_L(0); PG8_BAR; PG8_MMA(1, 0, At, B0); PG8_MMA(1, 1, At, B1); PG8_BAR; PG8_SCHED;
            PG8_LDB(B0, 1, 0); PG8_LDB(B1, 1, 1); PG8_SCHED; PG8_LDA(At, 1, 0); PG8_STAGE(PG8_SA(0, 1), a2 + hstepA, voffA);
            PG8_WAIT_V(8); PG8_WAIT_L(0); PG8_BAR; PG8_MMA(0, 0, At, B0); PG8_MMA(0, 1, At, B1); PG8_BAR; PG8_SCHED;
            PG8_LDA(At, 1, 1); PG8_STAGE(PG8_SB(1, 0), b3, voffB); PG8_STAGE(PG8_SB(1, 1), b3 + hstepB, voffB); PG8_STAGE(PG8_SA(1, 0), a3, voffA);
            PG8_WAIT_V(8); PG8_WAIT_L(0); PG8_BAR; PG8_MMA(1, 0, At, B0); PG8_MMA(1, 1, At, B1); PG8_BAR; PG8_SCHED;
            } else {
            PG8_LDB(B0, 0, 0); PG8_SCHED; PG8_LDA(At, 0, 0); PG8_STAGE(PG8_SA(1, 1), a1 + hstepA, voffA);
            PG8_WAIT_L(8); PG8_BAR; PG8_WAIT_L(0); PG8_MMA(0, 0, At, B0); PG8_BAR; PG8_SCHED;
            PG8_LDB(B1, 0, 1); PG8_STAGE(PG8_SB(0, 0), b2, voffB);
            PG8_BAR; PG8_WAIT_L(0); PG8_MMA(0, 1, At, B1); PG8_BAR;
            PG8_LDA(At, 0, 1); PG8_STAGE(PG8_SA(0, 0), a2, voffA);
            PG8_BAR; PG8_WAIT_L(0); PG8_MMA(1, 0, At, B0); PG8_BAR; PG8_SCHED;
            PG8_STAGE(PG8_SB(0, 1), b2 + hstepB, voffB);
            PG8_WAIT_V(6); PG8_BAR; PG8_MMA(1, 1, At, B1); PG8_BAR;
            PG8_LDB(B0, 1, 0); PG8_SCHED; PG8_LDA(At, 1, 0); PG8_STAGE(PG8_SA(0, 1), a2 + hstepA, voffA);
            PG8_WAIT_L(8); PG8_BAR; PG8_WAIT_L(0); PG8_MMA(0, 0, At, B0); PG8_BAR; PG8_SCHED;
            PG8_LDB(B1, 1, 1); PG8_STAGE(PG8_SB(1, 0), b3, voffB);
            PG8_BAR; PG8_WAIT_L(0); PG8_MMA(0, 1, At, B1); PG8_BAR;
            PG8_LDA(At, 1, 1); PG8_STAGE(PG8_SA(1, 0), a3, voffA);
            PG8_BAR; PG8_WAIT_L(0); PG8_MMA(1, 0, At, B0); PG8_BAR; PG8_SCHED;
            PG8_STAGE(PG8_SB(1, 1), b3 + hstepB, voffB);
            PG8_WAIT_V(6); PG8_BAR; PG8_MMA(1, 1, At, B1); PG8_BAR;
            }
        }
        if constexpr (ALIGN_EPI) { if (wr == 0) PG8_BAR; }
        if constexpr (!Epi::AFTER_DRAIN) { E(acc, cur, wr, wc, fr, fq); S.done(cur); }
        if (!has_next) break;
#pragma unroll
        for (int a = 0; a < 2; ++a)
#pragma unroll
            for (int b = 0; b < 2; ++b)
#pragma unroll
                for (int m = 0; m < 4; ++m)
#pragma unroll
                    for (int n = 0; n < 2; ++n) acc[a][b][m][n] = (f32x4){0.f, 0.f, 0.f, 0.f};
        cur = nxt; cA = nA; cB = nB; ++ui;
        if constexpr (ALIGN_EPI) { if (wr == 1) PG8_BAR; }
    }
    PG8_WAIT_V(0);
    if constexpr (!ALIGN_EPI) { if (wr == 0) PG8_BAR; }
    PG8_BAR;
    if constexpr (Epi::AFTER_DRAIN) { E.fused(acc, cur, wr, wc, fr, fq, lds, wid, lane); S.done(cur); }
#undef PG8_SA
#undef PG8_SB
#undef PG8_STAGE
#undef PG8_LDA
#undef PG8_LDB
#undef PG8_MMA
#undef PG8_WAIT_V
#undef PG8_WAIT_L
#undef PG8_BAR
#undef PG8_SCHED
}
}

typedef const __attribute__((address_space(4))) Args* KArgs;
__device__ __forceinline__ void make_ctx(Ctx& c) {
    KArgs ap = (KArgs)__builtin_amdgcn_kernarg_segment_ptr();
    asm volatile("" : "+s"(ap));
    c.x = ap->in[0]; c.norm_g = ap->in[1]; c.w_in = ap->in[2]; c.w_fourier = ap->in[3]; c.conv_w = ap->in[4]; c.conv_b = ap->in[5]; c.conv_ln_g = ap->in[6]; c.conv_ln_b = ap->in[7];
    c.w_pw = ap->in[8]; c.w_pool = ap->in[9]; c.pool_scale = ap->in[10]; c.w_branch = ap->in[11]; c.w_gate = ap->in[12]; c.b_gate = ap->in[13]; c.w_out = ap->in[14]; c.final_g = ap->in[15];
    c.out = ap->out;
    unsigned char* ws = ap->ws;
    c.WinT = (bf16_t*)(ws + WS_WIN); c.WgT = (bf16_t*)(ws + WS_WG); c.WbT = (bf16_t*)(ws + WS_WB); c.WoT = (bf16_t*)(ws + WS_WO); c.WfT = (bf16_t*)(ws + WS_WF); c.WpwT = (bf16_t*)(ws + WS_WPW); c.WpoolT = (bf16_t*)(ws + WS_WPOOL);
    c.TW = (float2*)(ws + WS_TW); c.RC = (float*)(ws + WS_RC); c.RS = (float*)(ws + WS_RS); c.RH = (_Float16*)(ws + WS_RH);
    c.H = (bf16_t*)(ws + WS_H); c.Z = (bf16_t*)(ws + WS_Z); c.P = (bf16_t*)(ws + WS_P); c.FY = (unsigned*)(ws + WS_FY); c.LSE = (float*)(ws + WS_LSE);
}
constexpr int NPHASES = 1 + 7 * DEPTH;

#define XB_TMO      128
#define XB_XCNT(j)  (256  + 64 * (j))
#define XB_XSUB(j)  (1280 + 64 * (j))
#define XB_XGEN(j)  (2304 + 64 * (j))
#define XB_TOP      3328
#define XB_TOPGEN   3392
#define XCD_BAR_WORDS 3456
#define XB_SPIN_CAP (1u << 18)
#define LAS __attribute__((address_space(3)))

__device__ __forceinline__ unsigned xb_ld(unsigned* p)              { return __hip_atomic_load(p, __ATOMIC_RELAXED, __HIP_MEMORY_SCOPE_AGENT); }
__device__ __forceinline__ unsigned xb_add(unsigned* p, unsigned v) { return __hip_atomic_fetch_add(p, v, __ATOMIC_RELAXED, __HIP_MEMORY_SCOPE_AGENT); }
__device__ __forceinline__ unsigned xb_xcc_id() { return (unsigned)__builtin_amdgcn_s_getreg((3 << 11) | 20) & 0xFu; }
#define XB_SPIN(cond, bar) do { unsigned _sp = 0; while (cond) { __builtin_amdgcn_s_sleep(1); \
    if ((++_sp & 255u) == 0u) { if (xb_ld(&(bar)[XB_TMO])) break; if (_sp > XB_SPIN_CAP) { atomicAdd(&(bar)[XB_TMO], 1u); break; } } } } while (0)

struct XcdBarrier {
    unsigned* bar; unsigned x;
    volatile LAS unsigned* st;
};

__device__ __forceinline__ XcdBarrier xcd_barrier_post(unsigned* bar, volatile LAS unsigned* st) {
    XcdBarrier b; b.bar = bar; b.x = xb_xcc_id(); b.st = st;
    if (threadIdx.x == 0) (void)xb_add(&bar[XB_XCNT(b.x)], 1u);
    return b;
}
__device__ __forceinline__ void xcd_barrier_complete(unsigned* bar, unsigned x, unsigned& nloc, unsigned& nx) {
    const unsigned G = gridDim.x * gridDim.y * gridDim.z;
    unsigned sum, cnt, mine, sp = 0u;
    for (;;) {
        sum = 0u; cnt = 0u; mine = 0u;
#pragma unroll
        for (unsigned j = 0; j < 16; ++j) { const unsigned c = xb_ld(&bar[XB_XCNT(j)]); sum += c; cnt += (c > 0u) ? 1u : 0u; mine = (j == x) ? c : mine; }
        if (sum == G) break;
        __builtin_amdgcn_s_sleep(1);
        if ((++sp & 255u) == 0u) { if (xb_ld(&bar[XB_TMO])) break; if (sp > XB_SPIN_CAP) { atomicAdd(&bar[XB_TMO], 1u); break; } }
    }
    nloc = mine > 0u ? mine : 1u; nx = cnt > 0u ? cnt : 1u;
}

__device__ __forceinline__ void xcd_barrier(const XcdBarrier& b) {
    asm volatile("s_waitcnt vmcnt(0)" ::: "memory");
    __syncthreads();
    if (threadIdx.x == 0) {
        unsigned* bar = b.bar;
        __builtin_amdgcn_s_waitcnt(0);
        unsigned nloc = b.st[0], nx = b.st[1];
        if (nloc == 0u) { xcd_barrier_complete(bar, b.x, nloc, nx); b.st[0] = nloc; b.st[1] = nx; }
        const unsigned old = xb_add(&bar[XB_XSUB(b.x)], 1u);
        const unsigned gen = old / nloc;
        if (old + 1u == (gen + 1u) * nloc) {
            __builtin_amdgcn_fence(__ATOMIC_RELEASE, "agent");
            asm volatile("s_waitcnt vmcnt(0)" ::: "memory");
            const unsigned og = xb_add(&bar[XB_TOP], 1u);
            const unsigned tg = og / nx;
            if (og + 1u == (tg + 1u) * nx) xb_add(&bar[XB_TOPGEN], 1u);
            else XB_SPIN(xb_ld(&bar[XB_TOPGEN]) == tg, bar);
            __builtin_amdgcn_fence(__ATOMIC_ACQUIRE, "agent");
            xb_add(&bar[XB_XGEN(b.x)], 1u);
            asm volatile("s_waitcnt vmcnt(0)" ::: "memory");
        } else {
            XB_SPIN(xb_ld(&bar[XB_XGEN(b.x)]) == gen, bar);
            __builtin_amdgcn_fence(__ATOMIC_ACQUIRE, "agent");
            asm volatile("s_waitcnt vmcnt(0)" ::: "memory");
        }
    }
    __syncthreads();
}


template <int L, int Q>
__device__ __forceinline__ void layer_phase(unsigned char* lds_raw) {
    float* lds = (float*)lds_raw;
    constexpr int l = L;
    constexpr int nrep = (Q == REPQ && (Q != 5 || L == 0)) ? 2 : 1;
#pragma unroll 1
    for (int rep = 0; rep < nrep; ++rep) {
        Ctx c; make_ctx(c);
        const bool st_ = (rep == 0);
        if constexpr (Q == 0) {
            typedef pg8::GemmT<DM, DM, DM, 0, 0> GT; GT g{c.H, c.WinT + (size_t)l * DIN * DM}; pg8::StaticOrder S; S.init(MT, DIN, (int)gridDim.x, BIDX);
            pg8::EpiBf16<0> E{c.Z, DIN, nullptr, 0, 0, 1.f};
            pg8::gemm_phase<pg8::EpiBf16<0>, pg8::StaticOrder, GT, true, true>((PG8_LAS unsigned char*)lds_raw, g, S, E);
        } else if constexpr (Q == 1) {
            constexpr int NF = NB * 4 * 64, NTK = NB * 64, NAT = NB * 192;
            if (rep == 0 || (REPSUB & 1)) attn_phase_mfma(c, lds_raw, st_);
            __builtin_amdgcn_sched_barrier(0);
            if (rep == 0 || (REPSUB & 2)) for (int u = BIDX; u < NTK; u += gridDim.x) { if (NEW_TOK) tok_unit_mfma(c, l, u, lds_raw); else tok_unit(c, l, u, lds); }
            __builtin_amdgcn_sched_barrier(0);
            if (rep == 0 || (REPSUB & 4)) { if (NEW_FFT1) fft1_phase_mfma(c); else for (int u = BIDX; u < NF; u += gridDim.x) fft1_unit(c, u, lds); }
        } else if constexpr (Q == 2) {
            if (NEW_FFT2) fft2_phase_mfma(c, l, lds_raw); else for (int u = BIDX; u < NB * 64; u += gridDim.x) fft2_unit(c, l, u, lds);
            phase_combine(c);
        } else if constexpr (Q == 3) {
            typedef pg8::GemmT<DM, DM, DM, 0, 0> GT; GT g{c.H, c.WgT + (size_t)l * 4096 * DM}; pg8::StaticOrder S; S.init(MT, 4096, (int)gridDim.x, BIDX);
            pg8::EpiBf16<2> E{c.Z, 4096, c.b_gate + (size_t)l * 4096, 0, 0, 1.f};
            pg8::gemm_phase<pg8::EpiBf16<2>, pg8::StaticOrder, GT, true, true>((PG8_LAS unsigned char*)lds_raw, g, S, E);
        } else if constexpr (Q == 4) {
            typedef pg8::GemmT<DM, 256, 256, 512, 1024 * 256 * 2> GT; GT g{c.P, c.WbT + (size_t)l * 4 * 1024 * 256}; pg8::MergeOrder S; S.init(MT, DM, (int)gridDim.x, BIDX);
            pg8::EpiMerge E{c.Z, c.H};
            pg8::gemm_phase<pg8::EpiMerge, pg8::MergeOrder, GT, true, true>((PG8_LAS unsigned char*)lds_raw, g, S, E);
        } else if constexpr (Q == 5) {
            typedef pg8::GemmT<DM, DM, DM, 0, 0> GT; GT g{c.H, c.WoT + (size_t)l * DM * DM}; pg8::StaticOrder S; S.init(MT, DM, (int)gridDim.x, BIDX);
            pg8::EpiOutF32 E{(l == 0) ? c.x : c.out, c.out};
            pg8::gemm_phase<pg8::EpiOutF32, pg8::StaticOrder, GT, true, true>((PG8_LAS unsigned char*)lds_raw, g, S, E);
        } else {
            if (l + 1 < DEPTH) phase_norm_bf16(c.out, c.norm_g + (size_t)(l + 1) * DM, c.H);
            else phase_norm_final(c.out, c.final_g);
        }
        if (rep + 1 < nrep) __syncthreads();
    }
}

__global__ void __launch_bounds__(NTHREADS, 2) fwd_kernel(Args a) {
    extern __shared__ __attribute__((aligned(16))) unsigned char lds_raw[];
    const int lo = a.ph_lo, hi = a.ph_hi;
    volatile LAS unsigned* bst = (volatile LAS unsigned*)(lds_raw + LDS_BYTES - 16);
    if (threadIdx.x < 4) bst[threadIdx.x] = 0u;
    __syncthreads();
    XcdBarrier bar = xcd_barrier_post((unsigned*)(a.ws + WS_CTL), bst);
#define RUN_PHASE(k, ...) do { if (lo <= (k) && (k) < hi) { __VA_ARGS__; if ((k) + 1 < hi) xcd_barrier(bar); } } while (0)
    RUN_PHASE(0, { Ctx c; make_ctx(c); phase_pre(c, (float*)lds_raw); if (REPQ == 7) { __syncthreads(); phase_pre(c, (float*)lds_raw); } phase_norm_bf16(c.x, c.norm_g, c.H); if (REPQ == 8) phase_norm_bf16(c.x, c.norm_g, c.H); });
    RUN_PHASE(1, layer_phase<0, 0>(lds_raw));
    RUN_PHASE(2, layer_phase<0, 1>(lds_raw));
    RUN_PHASE(3, layer_phase<0, 2>(lds_raw));
    RUN_PHASE(4, layer_phase<0, 3>(lds_raw));
    RUN_PHASE(5, layer_phase<0, 4>(lds_raw));
    RUN_PHASE(6, layer_phase<0, 5>(lds_raw));
    RUN_PHASE(7, layer_phase<0, 6>(lds_raw));
    RUN_PHASE(8, layer_phase<1, 0>(lds_raw));
    RUN_PHASE(9, layer_phase<1, 1>(lds_raw));
    RUN_PHASE(10, layer_phase<1, 2>(lds_raw));
    RUN_PHASE(11, layer_phase<1, 3>(lds_raw));
    RUN_PHASE(12, layer_phase<1, 4>(lds_raw));
    RUN_PHASE(13, layer_phase<1, 5>(lds_raw));
    RUN_PHASE(14, layer_phase<1, 6>(lds_raw));
#undef RUN_PHASE
}

extern "C" void kernel_launch(void* const* d_in, const int* in_sizes, int n_in, void* d_out, int out_size, void* d_ws, size_t ws_size, hipStream_t stream) {
    static int grid = 0;
    if (grid == 0) {
        if (n_in != 16 || in_sizes[0] != MT * DM || out_size != MT * DM || ws_size < WS_END) {
            fprintf(stderr, "kernel_launch: unexpected shapes: n_in %d in0 %d out %d ws %zu (need %zu)\n", n_in, n_in > 0 ? in_sizes[0] : -1, out_size, ws_size, (size_t)WS_END);
            grid = -1; return;
        }
        int dev = 0, cus = 0, per_cu = 0;
        hipGetDevice(&dev); hipDeviceGetAttribute(&cus, hipDeviceAttributeMultiprocessorCount, dev);
        if (hipFuncSetAttribute((const void*)fwd_kernel, hipFuncAttributeMaxDynamicSharedMemorySize, LDS_BYTES) != hipSuccess) { fprintf(stderr, "kernel_launch: hipFuncSetAttribute failed\n"); grid = -1; return; }
        hipOccupancyMaxActiveBlocksPerMultiprocessor(&per_cu, (const void*)fwd_kernel, NTHREADS, LDS_BYTES);
        if (per_cu < 1) { fprintf(stderr, "kernel_launch: occupancy query says %d blocks/CU\n", per_cu); per_cu = 1; }
        (void)hipGetLastError();
        grid = cus;
    }
    if (grid < 0) return;
    if (hipMemsetAsync((char*)d_ws + WS_CTL, 0, 16384, stream) != hipSuccess) { fprintf(stderr, "kernel_launch: hipMemsetAsync failed\n"); return; }
    Args a{};
    for (int i = 0; i < 16; ++i) a.in[i] = (const float*)d_in[i];
    a.out = (float*)d_out; a.ws = (unsigned char*)d_ws;
#if ONE_LAUNCH
    a.ph_lo = 0; a.ph_hi = NPHASES;
    void* args[] = {&a};
    hipError_t e = hipLaunchCooperativeKernel((const void*)fwd_kernel, dim3(grid), dim3(NTHREADS), args, LDS_BYTES, stream);
    if (e != hipSuccess) fprintf(stderr, "kernel_launch: cooperative launch failed: %s (grid %d)\n", hipGetErrorString(e), grid);
#else
    for (int ph = 0; ph < NPHASES; ++ph) {
        a.ph_lo = ph; a.ph_hi = ph + 1;
        hipLaunchKernelGGL(fwd_kernel, dim3(grid), dim3(NTHREADS), LDS_BYTES, stream, a);
    }
#endif
}
```

```cpp
#include <hip/hip_runtime.h>
#include <hip/hip_cooperative_groups.h>
#include <cstdio>
#include <cstdint>
namespace cg = cooperative_groups;

#ifndef NEW_TOK
#define NEW_TOK 1
#endif
#ifndef NEW_FFT1
#define NEW_FFT1 1
#endif
#ifndef NEW_FFT2
#define NEW_FFT2 1
#endif
#ifndef TOKREP
#define TOKREP 0
#endif
#ifndef REPQ
#define REPQ -1
#endif
#ifndef REPSUB
#define REPSUB 7
#endif
#ifndef ENG_MASK
#define ENG_MASK 15
#endif
#ifndef ONE_LAUNCH
#define ONE_LAUNCH 1
#endif

typedef unsigned short bf16_t;
typedef short bf16x8 __attribute__((ext_vector_type(8)));
typedef float f32x4 __attribute__((ext_vector_type(4)));
typedef unsigned u32x4 __attribute__((ext_vector_type(4)));

constexpr int NB = 8, SEQ = 4096, DM = 1024, MT = NB * SEQ, DIN = 4352, DEPTH = 2;
constexpr int ZA = 0, ZB = 256, ZQ = 768, ZK = 1536, ZV = 2304, ZD = 3072, ZG = 3328;
constexpr int NTHREADS = 512, NWAVES = 8;
constexpr int LDS_BYTES = 147456;

constexpr size_t WS_CTL = 0;
constexpr size_t WS_WIN = 65536;
constexpr size_t WS_WG = WS_WIN + (size_t)DEPTH * DIN * DM * 2;
constexpr size_t WS_WB = WS_WG + (size_t)DEPTH * 4096 * DM * 2;
constexpr size_t WS_WO = WS_WB + (size_t)DEPTH * 4 * 1024 * 256 * 2;
constexpr size_t WS_WF = WS_WO + (size_t)DEPTH * DM * DM * 2;
constexpr size_t WS_WPW = WS_WF + (size_t)DEPTH * 65536 * 2;
constexpr size_t WS_WPOOL = WS_WPW + (size_t)DEPTH * 65536 * 2;
constexpr size_t WS_TW = WS_WPOOL + (size_t)DEPTH * 4 * 4096 * 2;
constexpr size_t WS_RC = WS_TW + 4096 * 8;
constexpr size_t WS_RS = WS_RC + 4096 * 32 * 4;
constexpr size_t WS_RH = WS_RS + 4096 * 32 * 4;
constexpr size_t WS_H = WS_RH + 4096 * 64 * 2;
constexpr size_t WS_Z = WS_H + (size_t)MT * DM * 2;
constexpr size_t WS_P = WS_Z + (size_t)MT * DIN * 2;
constexpr size_t WS_FY = WS_P + (size_t)MT * DM * 2;
constexpr size_t WS_LSE = WS_FY + (size_t)NB * 4 * 64 * 64 * 64 * 4;
constexpr size_t WS_END = WS_LSE + (size_t)3 * MT * 4 * 4;

struct Args { const float* in[16]; float* out; unsigned char* ws; int ph_lo, ph_hi; };

__device__ __forceinline__ float bf2f(bf16_t v) { return __uint_as_float((unsigned)v << 16); }
__device__ __forceinline__ float bflo(unsigned w) { return __uint_as_float(w << 16); }
__device__ __forceinline__ float bfhi(unsigned w) { return __uint_as_float(w & 0xffff0000u); }
__device__ __forceinline__ bf16_t f2bf(float f) { unsigned u = __float_as_uint(f); u += 0x7fffu + ((u >> 16) & 1u); return (bf16_t)(u >> 16); }
typedef float f32x2n __attribute__((ext_vector_type(2)));
typedef __bf16 bf16x2n __attribute__((ext_vector_type(2)));
__device__ __forceinline__ unsigned pk2(float lo, float hi) { const f32x2n v = {lo, hi}; return __builtin_bit_cast(unsigned, __builtin_convertvector(v, bf16x2n)); }
__device__ __forceinline__ float sigmoidf_(float x) { return 1.f / (1.f + __expf(-x)); }
__device__ __forceinline__ float siluf_(float x) { return x / (1.f + __expf(-x)); }
__device__ __forceinline__ int opq(int v) { asm volatile("" : "+v"(v)); return v; }
#define TIDX opq((int)threadIdx.x)
__device__ __forceinline__ int opqs(int v) { asm volatile("" : "+s"(v)); return v; }
#define BIDX opqs((int)blockIdx.x)
__device__ __forceinline__ float wave_sum(float v) {
#pragma unroll
    for (int o = 1; o < 64; o <<= 1) v += __shfl_xor(v, o);
    return v;
}


typedef float f32x16g __attribute__((ext_vector_type(16)));
__device__ __forceinline__ f32x4 mfma16_g(bf16x8 a, bf16x8 b, f32x4 c) {
    f32x4 d = __builtin_amdgcn_mfma_f32_16x16x32_bf16(a, b, c, 0, 0, 0);
    asm volatile("" :: "v"(a), "v"(b), "v"(d));
    return d;
}
__device__ __forceinline__ f32x16g mfma32_g(bf16x8 a, bf16x8 b, f32x16g c) {
    f32x16g d = __builtin_amdgcn_mfma_f32_32x32x16_bf16(a, b, c, 0, 0, 0);
    asm volatile("" :: "v"(a), "v"(b), "v"(d));
    return d;
}

struct Ctx {
    const float *x, *norm_g, *w_in, *w_fourier, *conv_w, *conv_b, *conv_ln_g, *conv_ln_b, *w_pw, *w_pool, *pool_scale, *w_branch, *w_gate, *b_gate, *w_out, *final_g;
    float* out;
    bf16_t *WinT, *WgT, *WbT, *WoT, *WfT, *WpwT, *WpoolT, *H, *Z, *P;
    float2* TW; float *RC, *RS, *LSE; unsigned* FY; _Float16* RH;
};

__device__ __forceinline__ void transpose_mat(const float* W, int K, int N, bf16_t* WT, float* scr) {
    const int t = TIDX, nkb = K / 64, nnb = N / 64;
    for (int item = BIDX; item < nkb * nnb; item += gridDim.x) {
        const int kb = item / nnb, nb = item % nnb;
#pragma unroll
        for (int i = 0; i < 8; ++i) { const int kk = (t >> 6) + 8 * i, nn = t & 63; scr[kk * 65 + nn] = W[(size_t)(kb * 64 + kk) * N + nb * 64 + nn]; }
        __syncthreads();
#pragma unroll
        for (int i = 0; i < 8; ++i) { const int nn = (t >> 6) + 8 * i, kk = t & 63; WT[(size_t)(nb * 64 + nn) * K + kb * 64 + kk] = f2bf(scr[kk * 65 + nn]); }
        __syncthreads();
    }
}
__device__ __forceinline__ void phase_pre(const Ctx& c, float* lds) {
    for (int l = 0; l < DEPTH; ++l) {
        transpose_mat(c.w_in + (size_t)l * DM * DIN, DM, DIN, c.WinT + (size_t)l * DIN * DM, lds);
        for (int n = 0; n < 4; ++n) {
            transpose_mat(c.w_gate + (size_t)(l * 4 + n) * DM * DM, DM, DM, c.WgT + ((size_t)l * 4096 + n * 1024) * DM, lds);
            transpose_mat(c.w_branch + (size_t)(l * 4 + n) * 256 * DM, 256, DM, c.WbT + (size_t)(l * 4 + n) * 1024 * 256, lds);
        }
        transpose_mat(c.w_out + (size_t)l * DM * DM, DM, DM, c.WoT + (size_t)l * DM * DM, lds);
        transpose_mat(c.w_fourier + (size_t)l * 65536, 256, 256, c.WfT + (size_t)l * 65536, lds);
        transpose_mat(c.w_pw + (size_t)l * 65536, 256, 256, c.WpwT + (size_t)l * 65536, lds);
        for (int n = 0; n < 4; ++n) transpose_mat(c.w_pool + (size_t)(l * 4 + n) * 4096, 64, 64, c.WpoolT + (size_t)(l * 4 + n) * 4096, lds);
    }
    const int gt = BIDX * NTHREADS + TIDX, NT = gridDim.x * NTHREADS;
    for (int i = gt; i < 4096; i += NT) { float s, co; sincospif((float)i / 2048.f, &s, &co); c.TW[i] = make_float2(co, s); }
    for (int i = gt; i < 4096 * 32; i += NT) {
        const int pos = i >> 5, k = i & 31;
        const float inv = exp2f(-(float)k * (13.287712379549449f / 32.0f));
        double tq = (double)pos * (double)inv * 0.3183098861837907;
        tq -= 2.0 * rint(tq * 0.5);
        float s, co; sincospif((float)tq, &s, &co);
        c.RC[i] = co; c.RS[i] = s;
        c.RH[pos * 64 + k] = (_Float16)co; c.RH[pos * 64 + 32 + k] = (_Float16)s;
    }
}

__device__ __forceinline__ void phase_norm_bf16(const float* xin, const float* g, bf16_t* H) {
    const int tid_ = TIDX; const int lane = tid_ & 63, wave = tid_ >> 6;
    const int gw = BIDX * NWAVES + wave, NGW = gridDim.x * NWAVES;
    f32x4 gv[4];
#pragma unroll
    for (int j = 0; j < 4; ++j) gv[j] = *(const f32x4*)(g + 4 * (lane + 64 * j));
    for (int m = gw; m < MT; m += NGW) {
        const f32x4* xr = (const f32x4*)(xin + (size_t)m * DM);
        f32x4 v[4]; float s = 0.f;
#pragma unroll
        for (int j = 0; j < 4; ++j) { v[j] = xr[lane + 64 * j]; s += v[j].x * v[j].x + v[j].y * v[j].y + v[j].z * v[j].z + v[j].w * v[j].w; }
        const float rstd = 1.0f / sqrtf(wave_sum(s) * (1.f / DM) + 1e-6f);
        uint2* o = (uint2*)(H + (size_t)m * DM);
#pragma unroll
        for (int j = 0; j < 4; ++j) { const f32x4 y = v[j] * rstd * gv[j]; o[lane + 64 * j] = make_uint2(pk2(y.x, y.y), pk2(y.z, y.w)); }
    }
}
__device__ __forceinline__ void phase_norm_final(float* xio, const float* g) {
    const int tid_ = TIDX; const int lane = tid_ & 63, wave = tid_ >> 6;
    const int gw = BIDX * NWAVES + wave, NGW = gridDim.x * NWAVES;
    f32x4 gv[4];
#pragma unroll
    for (int j = 0; j < 4; ++j) gv[j] = *(const f32x4*)(g + 4 * (lane + 64 * j));
    for (int m = gw; m < MT; m += NGW) {
        f32x4* xr = (f32x4*)(xio + (size_t)m * DM);
        f32x4 v[4]; float s = 0.f;
#pragma unroll
        for (int j = 0; j < 4; ++j) { v[j] = xr[lane + 64 * j]; s += v[j].x * v[j].x + v[j].y * v[j].y + v[j].z * v[j].z + v[j].w * v[j].w; }
        const float rstd = 1.0f / sqrtf(wave_sum(s) * (1.f / DM) + 1e-6f);
#pragma unroll
        for (int j = 0; j < 4; ++j) xr[lane + 64 * j] = v[j] * rstd * gv[j];
    }
}

template <class Epi>
__device__ __forceinline__ void gemm_simple(const bf16_t* A, int lda, const bf16_t* Bt, int ldb, int Mr, int N, int K, const Epi& epi) {
    const int tid_ = TIDX; const int wid = tid_ >> 6, lane = tid_ & 63, fr = lane & 15, fq = lane >> 4;
    const int nM = Mr / 128, nN = N / 64;
    for (int u = BIDX; u < nM * nN; u += gridDim.x) {
        const int pm = u / nN, pn = u % nN;
        const bf16_t* ap = A + (size_t)(pm * 128 + wid * 16 + fr) * lda + fq * 8;
        const bf16_t* bp = Bt + (size_t)(pn * 64 + fr) * ldb + fq * 8;
        f32x4 acc[4];
#pragma unroll
        for (int n = 0; n < 4; ++n) acc[n] = (f32x4){0.f, 0.f, 0.f, 0.f};
        for (int k0 = 0; k0 < K; k0 += 32) {
            const bf16x8 a = *(const bf16x8*)(ap + k0);
#pragma unroll
            for (int n = 0; n < 4; ++n) { const bf16x8 b = *(const bf16x8*)(bp + (size_t)n * 16 * ldb + k0); acc[n] = mfma16_g(a, b, acc[n]); }
        }
#pragma unroll
        for (int n = 0; n < 4; ++n)
#pragma unroll
            for (int j = 0; j < 4; ++j) epi(pm * 128 + wid * 16 + fq * 4 + j, pn * 64 + n * 16 + fr, acc[n][j]);
    }
}
struct EpiZ { bf16_t* Z; __device__ __forceinline__ void operator()(int r, int c, float v) const { Z[(size_t)r * DIN + c] = f2bf(v); } };
struct EpiGate { bf16_t* MG; const float* bg; __device__ __forceinline__ void operator()(int r, int c, float v) const { MG[(size_t)r * 4096 + c] = f2bf(sigmoidf_(v + bg[c])); } };
struct EpiOut { const float* xin; float* out; __device__ __forceinline__ void operator()(int r, int c, float v) const { const size_t i = (size_t)r * DM + c; out[i] = xin[i] + v; } };

__device__ __forceinline__ void gemm_merge(const bf16_t* P, const bf16_t* WbT, const bf16_t* MG, bf16_t* MERGED) {
    const int tid_ = TIDX; const int wid = tid_ >> 6, lane = tid_ & 63, fr = lane & 15, fq = lane >> 4;
    const int nM = MT / 128, nN = DM / 64;
    for (int u = BIDX; u < nM * nN; u += gridDim.x) {
        const int pm = u / nN, pn = u % nN;
        f32x4 tot[4];
#pragma unroll
        for (int n = 0; n < 4; ++n) tot[n] = (f32x4){0.f, 0.f, 0.f, 0.f};
        for (int n4 = 0; n4 < 4; ++n4) {
            const bf16_t* ap = P + (size_t)(pm * 128 + wid * 16 + fr) * DM + n4 * 256 + fq * 8;
            const bf16_t* bp = WbT + (size_t)n4 * 1024 * 256 + (size_t)(pn * 64 + fr) * 256 + fq * 8;
            f32x4 acc[4];
#pragma unroll
            for (int n = 0; n < 4; ++n) acc[n] = (f32x4){0.f, 0.f, 0.f, 0.f};
            for (int k0 = 0; k0 < 256; k0 += 32) {
                const bf16x8 a = *(const bf16x8*)(ap + k0);
#pragma unroll
                for (int n = 0; n < 4; ++n) { const bf16x8 b = *(const bf16x8*)(bp + (size_t)n * 16 * 256 + k0); acc[n] = mfma16_g(a, b, acc[n]); }
            }
#pragma unroll
            for (int n = 0; n < 4; ++n)
#pragma unroll
                for (int j = 0; j < 4; ++j) { const int r = pm * 128 + wid * 16 + fq * 4 + j, cc = pn * 64 + n * 16 + fr; tot[n][j] += bf2f(MG[(size_t)r * 4096 + n4 * 1024 + cc]) * acc[n][j]; }
        }
#pragma unroll
        for (int n = 0; n < 4; ++n)
#pragma unroll
            for (int j = 0; j < 4; ++j) { const int r = pm * 128 + wid * 16 + fq * 4 + j, cc = pn * 64 + n * 16 + fr; MERGED[(size_t)r * DM + cc] = f2bf(tot[n][j]); }
    }
}

__device__ __forceinline__ void fft1_unit(const Ctx& c, int u, float* lds) {
    const int t = TIDX, s2 = u & 63, bg = u >> 6, g = bg & 3, b = bg >> 2;
    float* U = lds; float* Wre = lds + 64 * 65; float* Wim = Wre + 4096; float* cs = Wim + 4096; float* sn = cs + 64;
    if (t < 64) { float s, co; sincospif((float)t / 32.f, &s, &co); cs[t] = co; sn[t] = s; }
#pragma unroll
    for (int i = 0; i < 8; ++i) { const int s1 = (t >> 6) + 8 * i, ci = t & 63; U[s1 * 65 + ci] = bf2f(c.Z[(size_t)(b * SEQ + 64 * s1 + s2) * DIN + ZA + 64 * g + ci]); }
    __syncthreads();
    const int cp = t & 63;
#pragma unroll 1
    for (int i = 0; i < 8; ++i) {
        const int s1 = (t >> 6) + 8 * i; float re = 0.f, im = 0.f;
        for (int ci = 0; ci < 64; ++ci) { const float x = U[s1 * 65 + ci]; const int e = (ci * cp) & 63; re += x * cs[e]; im -= x * sn[e]; }
        Wre[s1 * 64 + cp] = re; Wim[s1 * 64 + cp] = im;
    }
    __syncthreads();
#pragma unroll 1
    for (int i = 0; i < 8; ++i) {
        const int k1 = (t >> 6) + 8 * i; float yr = 0.f, yi = 0.f;
        for (int s1 = 0; s1 < 64; ++s1) { const int e = (k1 * s1) & 63; const float co = cs[e], si = sn[e], wr = Wre[s1 * 64 + cp], wi = Wim[s1 * 64 + cp]; yr += co * wr + si * wi; yi += co * wi - si * wr; }
        const float2 tw = c.TW[(k1 * s2) & 4095];
        const float zr = yr * tw.x + yi * tw.y, zi = yi * tw.x - yr * tw.y;
        c.FY[((size_t)(bg * 64 + k1) * 64 + s2) * 64 + cp] = pk2(zr, zi);
    }
    __syncthreads();
}

__device__ __forceinline__ void tok_unit(const Ctx& c, int l, int u, float* lds) {
    const int t = TIDX, lane = t & 63, wave = t >> 6, ch = t & 255, half = t >> 8;
    const int b = u >> 6, s0 = (u & 63) * 64, tok0 = b * SEQ + s0;
    float* A = lds;
#pragma unroll 1
    for (int i = 0; i < 47; ++i) {
        const int r = half + 2 * i, s = s0 - 15 + r; float val = 0.f;
        if (s >= 0 && s < SEQ) { const bf16_t* zr = c.Z + (size_t)(b * SEQ + s) * DIN + ZB; val = bf2f(zr[ch]) * sigmoidf_(bf2f(zr[256 + ch])); }
        A[r * 256 + ch] = val;
    }
    __syncthreads();
    float y[32];
    {
        float cw[31];
#pragma unroll
        for (int w = 0; w < 31; ++w) cw[w] = c.conv_w[(size_t)l * 31 * 256 + w * 256 + ch];
        const float cb = c.conv_b[l * 256 + ch];
#pragma unroll
        for (int cc = 0; cc < 4; ++cc) {
            float rows[38];
#pragma unroll
            for (int r = 0; r < 38; ++r) rows[r] = A[(half * 32 + cc * 8 + r) * 256 + ch];
#pragma unroll
            for (int i = 0; i < 8; ++i) {
                float acc = cb;
#pragma unroll
                for (int w = 0; w < 31; ++w) acc += rows[i + w] * cw[w];
                y[cc * 8 + i] = acc;
            }
            __builtin_amdgcn_sched_barrier(0);
        }
    }
    __syncthreads();
#pragma unroll
    for (int i = 0; i < 32; ++i) A[(half * 32 + i) * 256 + ch] = y[i];
    __syncthreads();
    {
        float lg[4], lb[4];
#pragma unroll
        for (int q = 0; q < 4; ++q) { lg[q] = c.conv_ln_g[l * 256 + lane + 64 * q]; lb[q] = c.conv_ln_b[l * 256 + lane + 64 * q]; }
        for (int i = 0; i < 8; ++i) {
            const int tk = wave * 8 + i; float xv[4]; float s = 0.f;
#pragma unroll
            for (int q = 0; q < 4; ++q) { xv[q] = A[tk * 256 + lane + 64 * q]; s += xv[q]; }
            const float mean = wave_sum(s) * (1.f / 256.f); float s2 = 0.f;
#pragma unroll
            for (int q = 0; q < 4; ++q) { xv[q] -= mean; s2 += xv[q] * xv[q]; }
            const float rstd = 1.0f / sqrtf(wave_sum(s2) * (1.f / 256.f) + 1e-5f);
#pragma unroll
            for (int q = 0; q < 4; ++q) { const float yv = xv[q] * rstd * lg[q] + lb[q]; A[tk * 256 + lane + 64 * q] = siluf_(yv); }
        }
    }
    __syncthreads();
    {
        float acc[32];
#pragma unroll
        for (int i = 0; i < 32; ++i) acc[i] = 0.f;
        const float* W = c.w_pw + (size_t)l * 65536;
#pragma unroll 2
        for (int k = 0; k < 256; ++k) {
            const float wv = W[k * 256 + ch];
#pragma unroll
            for (int i = 0; i < 32; ++i) acc[i] += A[(half * 32 + i) * 256 + k] * wv;
        }
        __syncthreads();
#pragma unroll
        for (int i = 0; i < 32; ++i) A[(half * 32 + i) * 256 + ch] = acc[i];
        __syncthreads();
#pragma unroll 1
        for (int i = 0; i < 32; ++i) {
            const size_t tok = tok0 + half * 32 + i;
            const float gp = bf2f(c.Z[tok * DIN + ZG + 256 + ch]);
            c.P[tok * DM + 256 + ch] = f2bf(A[(half * 32 + i) * 256 + ch] * siluf_(gp));
        }
    }
    __syncthreads();
#pragma unroll 1
    for (int i = 0; i < 40; ++i) {
        const int r = half + 2 * i;
        if (r < 79) { const int s = s0 - 8 + r; float val = 0.f; if (s >= 0 && s < SEQ) val = bf2f(c.Z[(size_t)(b * SEQ + s) * DIN + ZD + ch]); A[r * 256 + ch] = val; }
    }
    __syncthreads();
    float* PL = lds + 79 * 256;
    {
        const int gi = ch >> 6, sz = 2 << gi;
#pragma unroll 1
        for (int i = 0; i < 32; ++i) {
            const int tk = half * 32 + i, s = s0 + tk;
            int lo = s - sz / 2; if (lo < 0) lo = 0;
            int hi = s + sz - 1 - sz / 2; if (hi > SEQ - 1) hi = SEQ - 1;
            float sum = 0.f;
            for (int p = lo; p <= hi; ++p) sum += A[(p - s0 + 8) * 256 + ch];
            PL[tk * 256 + ch] = sum / (float)(hi - lo + 1) - A[(tk + 8) * 256 + ch];
        }
    }
    __syncthreads();
    {
        const int gi = ch >> 6, dd = ch & 63;
        float acc[32];
#pragma unroll
        for (int i = 0; i < 32; ++i) acc[i] = 0.f;
        const float* W = c.w_pool + (size_t)(l * 4 + gi) * 4096;
#pragma unroll 2
        for (int k = 0; k < 64; ++k) {
            const float wv = W[k * 64 + dd];
#pragma unroll
            for (int i = 0; i < 32; ++i) acc[i] += PL[(half * 32 + i) * 256 + gi * 64 + k] * wv;
        }
        const float ps = c.pool_scale[l * 256 + ch];
        __syncthreads();
#pragma unroll
        for (int i = 0; i < 32; ++i) A[(half * 32 + i) * 256 + ch] = acc[i];
        __syncthreads();
#pragma unroll 1
        for (int i = 0; i < 32; ++i) {
            const size_t tok = tok0 + half * 32 + i;
            const float gp = bf2f(c.Z[tok * DIN + ZG + 768 + ch]);
            c.P[tok * DM + 768 + ch] = f2bf(A[(half * 32 + i) * 256 + ch] * ps * siluf_(gp));
        }
    }
    __syncthreads();
}

__device__ __forceinline__ void attn_unit(const Ctx& c, int u, float* ldsf, bool do_store = true) {
    unsigned* lds = (unsigned*)ldsf;
    const int t = TIDX;
    const int b = u / 192, rem = u % 192, g = rem >> 6, rem2 = rem & 63, hI = rem2 >> 4, rq = rem2 & 15;
    const int d = 1 << (2 * g), L = SEQ / d, nqb = L / 256, r = rq / nqb, qb = rq % nqb, hh = g * 4 + hI, i0 = qb * 256;
    unsigned* Kt = lds; unsigned* Vt = lds + 384 * 33;
    for (int pass = 0; pass < 2; ++pass) {
        const int jl = pass * 256 + (t >> 1), hf = t & 1, j = i0 - 64 + jl;
        if (jl < 384 && j >= 0 && j < L) {
            const int pos = r + d * j; const size_t tok = (size_t)b * SEQ + pos;
            const u32x4* kr = (const u32x4*)(c.Z + tok * DIN + ZK + hh * 64);
            unsigned kw[32];
#pragma unroll
            for (int q = 0; q < 8; ++q) { const u32x4 v = kr[q]; kw[4 * q] = v.x; kw[4 * q + 1] = v.y; kw[4 * q + 2] = v.z; kw[4 * q + 3] = v.w; }
            const float* rc = c.RC + pos * 32; const float* rs = c.RS + pos * 32;
#pragma unroll
            for (int w = 0; w < 16; ++w) {
                const float lo0 = bflo(kw[w]), lo1 = bfhi(kw[w]), hi0 = bflo(kw[16 + w]), hi1 = bfhi(kw[16 + w]);
                const float c0 = rc[2 * w], c1 = rc[2 * w + 1], s0 = rs[2 * w], s1 = rs[2 * w + 1];
                float o0, o1;
                if (hf == 0) { o0 = lo0 * c0 - hi0 * s0; o1 = lo1 * c1 - hi1 * s1; } else { o0 = hi0 * c0 + lo0 * s0; o1 = hi1 * c1 + lo1 * s1; }
                Kt[jl * 33 + hf * 16 + w] = pk2(o0, o1);
            }
            const u32x4* vr = (const u32x4*)(c.Z + tok * DIN + ZV + hh * 64 + hf * 32);
#pragma unroll
            for (int q = 0; q < 4; ++q) { const u32x4 v = vr[q]; Vt[jl * 33 + hf * 16 + 4 * q] = v.x; Vt[jl * 33 + hf * 16 + 4 * q + 1] = v.y; Vt[jl * 33 + hf * 16 + 4 * q + 2] = v.z; Vt[jl * 33 + hf * 16 + 4 * q + 3] = v.w; }
        }
    }
    const int ql = t >> 1, hf = t & 1, iq = i0 + ql, posq = r + d * iq;
    const size_t tokq = (size_t)b * SEQ + posq;
    bf16_t* qrow = c.Z + tokq * DIN + ZQ + hh * 64;
    float qv[32];
    {
        const u32x4* qr = (const u32x4*)qrow;
        unsigned kw[32];
#pragma unroll
        for (int q = 0; q < 8; ++q) { const u32x4 v = qr[q]; kw[4 * q] = v.x; kw[4 * q + 1] = v.y; kw[4 * q + 2] = v.z; kw[4 * q + 3] = v.w; }
        const float* rc = c.RC + posq * 32; const float* rs = c.RS + posq * 32;
#pragma unroll
        for (int w = 0; w < 16; ++w) {
            const float lo0 = bflo(kw[w]), lo1 = bfhi(kw[w]), hi0 = bflo(kw[16 + w]), hi1 = bfhi(kw[16 + w]);
            const float c0 = rc[2 * w], c1 = rc[2 * w + 1], s0 = rs[2 * w], s1 = rs[2 * w + 1];
            if (hf == 0) { qv[2 * w] = (lo0 * c0 - hi0 * s0) * 0.125f; qv[2 * w + 1] = (lo1 * c1 - hi1 * s1) * 0.125f; }
            else { qv[2 * w] = (hi0 * c0 + lo0 * s0) * 0.125f; qv[2 * w + 1] = (hi1 * c1 + lo1 * s1) * 0.125f; }
        }
    }
    __syncthreads();
    float m = -1e30f, lsum = 0.f, o[32];
#pragma unroll
    for (int w = 0; w < 32; ++w) o[w] = 0.f;
    for (int t2 = 0; t2 <= 128; ++t2) {
        const int j = iq - 64 + t2;
        if (j >= 0 && j < L) {
            const int jl = ql + t2;
            const unsigned* kp = Kt + jl * 33 + hf * 16;
            float sp = 0.f;
#pragma unroll
            for (int w = 0; w < 16; ++w) { const unsigned kwv = kp[w]; sp += qv[2 * w] * bflo(kwv) + qv[2 * w + 1] * bfhi(kwv); }
            const float s = sp + __shfl_xor(sp, 1);
            const float mn = fmaxf(m, s), corr = __expf(m - mn), p = __expf(s - mn);
            lsum = lsum * corr + p; m = mn;
            const unsigned* vp = Vt + jl * 33 + hf * 16;
#pragma unroll
            for (int w = 0; w < 16; ++w) { const unsigned vw = vp[w]; o[2 * w] = o[2 * w] * corr + p * bflo(vw); o[2 * w + 1] = o[2 * w + 1] * corr + p * bfhi(vw); }
        }
    }
    const float inv = 1.f / lsum;
    unsigned* orow = (unsigned*)(qrow + hf * 32);
    if (do_store) {
#pragma unroll
    for (int w = 0; w < 16; ++w) orow[w] = pk2(o[2 * w] * inv, o[2 * w + 1] * inv);
    if (hf == 0) c.LSE[((size_t)g * MT + tokq) * 4 + hI] = m + __logf(lsum);
    }
    __syncthreads();
}


typedef float f32x16 __attribute__((ext_vector_type(16)));
typedef unsigned u32x2 __attribute__((ext_vector_type(2)));
typedef _Float16 h16x8 __attribute__((ext_vector_type(8)));
#define LASP __attribute__((address_space(3)))
__device__ __forceinline__ unsigned cvtpk(float lo, float hi) { return pk2(lo, hi); }
__device__ __forceinline__ void attn_unit_mfma(const Ctx& c, int u, unsigned char* lds_raw, bool do_store = true) {
    LASP unsigned char* Kt = (LASP unsigned char*)lds_raw;
    LASP unsigned* Vt = (LASP unsigned*)(lds_raw + 49152);
    const int t = TIDX, lane = t & 63, wave = __builtin_amdgcn_readfirstlane(t >> 6), rq = lane & 31, h = lane >> 5;
    const int b = u / 192, rem = u % 192, g = rem >> 6, rem2 = rem & 63, hI = rem2 >> 4, rqb = rem2 & 15;
    const int d = 1 << (2 * g), L = SEQ / d, nqb = L / 256, r = rqb / nqb, qb = rqb % nqb, hh = g * 4 + hI, i0 = qb * 256;
#pragma unroll
    for (int i = 0; i < 3; ++i) {
        const int id = t + 512 * i, row = id >> 2, dc = id & 3, j = i0 - 64 + row;
        u32x4 olo = (u32x4){0u, 0u, 0u, 0u}, ohi = olo;
        if (j >= 0 && j < L) {
            const int pos = r + d * j;
            const bf16_t* kr = c.Z + ((size_t)b * SEQ + pos) * DIN + ZK + hh * 64 + 8 * dc;
            const u32x4 a = *(const u32x4*)kr, bq = *(const u32x4*)(kr + 32);
            const h16x8 cv = *(const h16x8*)(c.RH + pos * 64 + 8 * dc), sv = *(const h16x8*)(c.RH + pos * 64 + 32 + 8 * dc);
#pragma unroll
            for (int e = 0; e < 4; ++e) {
                const float l0 = bflo(a[e]), l1 = bfhi(a[e]), h0 = bflo(bq[e]), h1 = bfhi(bq[e]);
                const float cc0 = (float)cv[2 * e], cc1 = (float)cv[2 * e + 1], ss0 = (float)sv[2 * e], ss1 = (float)sv[2 * e + 1];
                olo[e] = pk2(l0 * cc0 - h0 * ss0, l1 * cc1 - h1 * ss1);
                ohi[e] = pk2(h0 * cc0 + l0 * ss0, h1 * cc1 + l1 * ss1);
            }
        }
        *(LASP u32x4*)(Kt + row * 128 + ((dc ^ (row & 7)) << 4)) = olo;
        *(LASP u32x4*)(Kt + row * 128 + (((4 + dc) ^ (row & 7)) << 4)) = ohi;
    }
#pragma unroll
    for (int i = 0; i < 3; ++i) {
        const int id = t + 512 * i, rp = id % 192, dc8 = id / 192, j0 = i0 - 64 + 2 * rp;
        u32x4 v0 = (u32x4){0u, 0u, 0u, 0u}, v1 = v0;
        if (j0 >= 0 && j0 < L) v0 = *(const u32x4*)(c.Z + ((size_t)b * SEQ + r + d * j0) * DIN + ZV + hh * 64 + 8 * dc8);
        if (j0 + 1 >= 0 && j0 + 1 < L) v1 = *(const u32x4*)(c.Z + ((size_t)b * SEQ + r + d * (j0 + 1)) * DIN + ZV + hh * 64 + 8 * dc8);
#pragma unroll
        for (int e = 0; e < 4; ++e) {
            Vt[(8 * dc8 + 2 * e) * 194 + rp] = (v0[e] & 0xffffu) | (v1[e] << 16);
            Vt[(8 * dc8 + 2 * e + 1) * 194 + rp] = (v0[e] >> 16) | (v1[e] & 0xffff0000u);
        }
    }
    const int iq = i0 + 32 * wave + rq, posq = r + d * iq;
    const size_t tokq = (size_t)b * SEQ + posq;
    bf16_t* qrow = c.Z + tokq * DIN + ZQ + hh * 64;
    bf16x8 qf[4];
    {
        const u32x4 q0 = *(const u32x4*)(qrow + 8 * h), q1 = *(const u32x4*)(qrow + 16 + 8 * h), q2 = *(const u32x4*)(qrow + 32 + 8 * h), q3 = *(const u32x4*)(qrow + 48 + 8 * h);
        const _Float16* rh = c.RH + posq * 64 + 8 * h;
        const h16x8 cav = *(const h16x8*)rh, cbv = *(const h16x8*)(rh + 16), sav = *(const h16x8*)(rh + 32), sbv = *(const h16x8*)(rh + 48);
        const float sc = 0.125f * 1.44269504f;
        u32x4 o0, o1, o2, o3;
#pragma unroll
        for (int e = 0; e < 4; ++e) {
            const float ca_0 = (float)cav[2 * e], ca_1 = (float)cav[2 * e + 1], sa_0 = (float)sav[2 * e], sa_1 = (float)sav[2 * e + 1];
            const float cb_0 = (float)cbv[2 * e], cb_1 = (float)cbv[2 * e + 1], sb_0 = (float)sbv[2 * e], sb_1 = (float)sbv[2 * e + 1];
            const float a0 = bflo(q0[e]), a1 = bfhi(q0[e]), b0 = bflo(q2[e]), b1 = bfhi(q2[e]);
            const float e0 = bflo(q1[e]), e1 = bfhi(q1[e]), f0 = bflo(q3[e]), f1 = bfhi(q3[e]);
            o0[e] = pk2((a0 * ca_0 - b0 * sa_0) * sc, (a1 * ca_1 - b1 * sa_1) * sc);
            o2[e] = pk2((b0 * ca_0 + a0 * sa_0) * sc, (b1 * ca_1 + a1 * sa_1) * sc);
            o1[e] = pk2((e0 * cb_0 - f0 * sb_0) * sc, (e1 * cb_1 - f1 * sb_1) * sc);
            o3[e] = pk2((f0 * cb_0 + e0 * sb_0) * sc, (f1 * cb_1 + e1 * sb_1) * sc);
        }
        qf[0] = __builtin_bit_cast(bf16x8, o0); qf[1] = __builtin_bit_cast(bf16x8, o1); qf[2] = __builtin_bit_cast(bf16x8, o2); qf[3] = __builtin_bit_cast(bf16x8, o3);
    }
    __syncthreads();
    f32x16 sacc[5];
#pragma unroll
    for (int kb = 0; kb < 5; ++kb)
#pragma unroll
        for (int e = 0; e < 16; ++e) sacc[kb][e] = 0.f;
#pragma unroll
    for (int s4 = 0; s4 < 4; ++s4) {
#pragma unroll
        for (int kb = 0; kb < 5; ++kb) {
            const int row = 32 * wave + 32 * kb + rq;
            const bf16x8 kf = *(const LASP bf16x8*)(Kt + row * 128 + (((2 * s4 + h) ^ (row & 7)) << 4));
            sacc[kb] = mfma32_g(kf, qf[s4], sacc[kb]);
        }
        __builtin_amdgcn_sched_barrier(0);
    }
    asm volatile("s_nop 15\n\ts_nop 15" : "+v"(sacc[0]), "+v"(sacc[1]), "+v"(sacc[2]), "+v"(sacc[3]), "+v"(sacc[4]));
    const int jbase = i0 - 64 + 32 * wave;
    float mx = -1e30f;
#pragma unroll
    for (int kb = 0; kb < 5; ++kb)
#pragma unroll
        for (int e = 0; e < 16; ++e) {
            const int row = (e & 3) + 8 * (e >> 2) + 4 * h, rel = 32 * kb + row - rq, j = jbase + 32 * kb + row;
            const bool valid = (rel >= 0) && (rel <= 128) && (j >= 0) && (j < L);
            const float sv = valid ? sacc[kb][e] : -1e30f;
            sacc[kb][e] = sv; mx = fmaxf(mx, sv);
        }
    mx = fmaxf(mx, __shfl_xor(mx, 32));
    float lsum = 0.f;
#pragma unroll
    for (int kb = 0; kb < 5; ++kb)
#pragma unroll
        for (int e = 0; e < 16; ++e) { const float p = __builtin_amdgcn_exp2f(sacc[kb][e] - mx); sacc[kb][e] = p; lsum += p; }
    lsum += __shfl_xor(lsum, 32);
    f32x16 oacc[2], oacb[2];
#pragma unroll
    for (int db = 0; db < 2; ++db)
#pragma unroll
        for (int e = 0; e < 16; ++e) { oacc[db][e] = 0.f; oacb[db][e] = 0.f; }
#pragma unroll
    for (int kb = 0; kb < 5; ++kb) {
        bf16x8 pf[2];
#pragma unroll
        for (int s2 = 0; s2 < 2; ++s2) {
            u32x4 pw;
#pragma unroll
            for (int e = 0; e < 4; ++e) pw[e] = cvtpk(sacc[kb][8 * s2 + 2 * e], sacc[kb][8 * s2 + 2 * e + 1]);
            pf[s2] = __builtin_bit_cast(bf16x8, pw);
        }
        bf16x8 af[2][2];
#pragma unroll
        for (int s2 = 0; s2 < 2; ++s2) {
            const int kp = (32 * wave + 32 * kb + 16 * s2 + 4 * h) >> 1;
#pragma unroll
            for (int db = 0; db < 2; ++db) {
                const LASP unsigned* vp = Vt + (32 * db + rq) * 194 + kp;
                const u32x2 g0 = *(const LASP u32x2*)vp, g1 = *(const LASP u32x2*)(vp + 4);
                const u32x4 aw = (u32x4){g0.x, g0.y, g1.x, g1.y};
                af[s2][db] = __builtin_bit_cast(bf16x8, aw);
            }
        }
        oacc[0] = mfma32_g(af[0][0], pf[0], oacc[0]);
        oacc[1] = mfma32_g(af[0][1], pf[0], oacc[1]);
        oacb[0] = mfma32_g(af[1][0], pf[1], oacb[0]);
        oacb[1] = mfma32_g(af[1][1], pf[1], oacb[1]);
        __builtin_amdgcn_sched_barrier(0);
    }
    asm volatile("s_nop 15\n\ts_nop 15" : "+v"(oacc[0]), "+v"(oacc[1]), "+v"(oacb[0]), "+v"(oacb[1]));
#pragma unroll
    for (int db = 0; db < 2; ++db) oacc[db] = oacc[db] + oacb[db];
    if (do_store) {
        const float inv = 1.f / lsum;
#pragma unroll
        for (int db = 0; db < 2; ++db)
#pragma unroll
            for (int g4 = 0; g4 < 4; ++g4) {
                const u32x2 w = (u32x2){cvtpk(oacc[db][4 * g4] * inv, oacc[db][4 * g4 + 1] * inv), cvtpk(oacc[db][4 * g4 + 2] * inv, oacc[db][4 * g4 + 3] * inv)};
                *(u32x2*)(qrow + 32 * db + 8 * g4 + 4 * h) = w;
            }
        if (h == 0) c.LSE[((size_t)g * MT + tokq) * 4 + hI] = mx * 0.69314718f + __logf(lsum);
    }
    __syncthreads();
}


__device__ __forceinline__ void attn_phase_wrap(const Ctx& c, unsigned char* lds_raw, bool do_store) {
    constexpr int NAT = NB * 192;
    const int G = gridDim.x;
    for (int u = BIDX; u < NAT; u += G) attn_unit_mfma(c, u, lds_raw, do_store);
}

struct AttnU { int b, g, hI, d, L, r, hh, i0; };
__device__ __forceinline__ AttnU attn_decode(int u) {
    AttnU a; a.b = u / 192; const int rem = u % 192; a.g = rem >> 6; const int rem2 = rem & 63; a.hI = rem2 >> 4; const int rqb = rem2 & 15;
    a.d = 1 << (2 * a.g); a.L = SEQ / a.d; const int nqb = a.L / 256; a.r = rqb / nqb; a.hh = a.g * 4 + a.hI; a.i0 = (rqb % nqb) * 256; return a;
}
__device__ __forceinline__ void attn_phase_mfma(const Ctx& c, unsigned char* lds_raw, bool do_store) {
    LASP unsigned char* Kt = (LASP unsigned char*)lds_raw;
    LASP unsigned* Vt = (LASP unsigned*)(lds_raw + 49152);
    const int t = TIDX, lane = t & 63, wave = __builtin_amdgcn_readfirstlane(t >> 6), rq = lane & 31, h = lane >> 5;
    constexpr int NAT = NB * 192;
    const int G = gridDim.x;
    int u = BIDX;
    if (u >= NAT) return;
    u32x4 ka[3], kb2[3], va[3], vb[3];
#define ATT_PREFETCH(uu_) do { const AttnU A_ = attn_decode(uu_); \
        _Pragma("unroll") for (int i = 0; i < 3; ++i) { \
            { const int id = t + 512 * i, row = id >> 2, dc = id & 3, j = A_.i0 - 64 + row; \
              ka[i] = (u32x4){0u, 0u, 0u, 0u}; kb2[i] = ka[i]; \
              if (j >= 0 && j < A_.L) { const int pos = A_.r + A_.d * j; const bf16_t* kr = c.Z + ((size_t)A_.b * SEQ + pos) * DIN + ZK + A_.hh * 64 + 8 * dc; \
                  ka[i] = *(const u32x4*)kr; kb2[i] = *(const u32x4*)(kr + 32); } } \
            { const int id = t + 512 * i, rp = id % 192, dc8 = id / 192, j0 = A_.i0 - 64 + 2 * rp; \
              va[i] = (u32x4){0u, 0u, 0u, 0u}; vb[i] = va[i]; \
              if (j0 >= 0 && j0 < A_.L) va[i] = *(const u32x4*)(c.Z + ((size_t)A_.b * SEQ + A_.r + A_.d * j0) * DIN + ZV + A_.hh * 64 + 8 * dc8); \
              if (j0 + 1 >= 0 && j0 + 1 < A_.L) vb[i] = *(const u32x4*)(c.Z + ((size_t)A_.b * SEQ + A_.r + A_.d * (j0 + 1)) * DIN + ZV + A_.hh * 64 + 8 * dc8); } } } while (0)
    ATT_PREFETCH(u);
    for (;;) {
        const AttnU A = attn_decode(u);
        const int b = A.b, g = A.g, hI = A.hI, d = A.d, L = A.L, r = A.r, hh = A.hh, i0 = A.i0;
        const int iq = i0 + 32 * wave + rq, posq = r + d * iq;
        const size_t tokq = (size_t)b * SEQ + posq;
        bf16_t* qrow = c.Z + tokq * DIN + ZQ + hh * 64;
        bf16x8 qf[4];
        {
            const u32x4 q0 = *(const u32x4*)(qrow + 8 * h), q1 = *(const u32x4*)(qrow + 16 + 8 * h), q2 = *(const u32x4*)(qrow + 32 + 8 * h), q3 = *(const u32x4*)(qrow + 48 + 8 * h);
            const _Float16* rh = c.RH + posq * 64 + 8 * h;
            const h16x8 cav = *(const h16x8*)rh, cbv = *(const h16x8*)(rh + 16), sav = *(const h16x8*)(rh + 32), sbv = *(const h16x8*)(rh + 48);
            const float sc = 0.125f * 1.44269504f;
            u32x4 o0, o1, o2, o3;
    #pragma unroll
            for (int e = 0; e < 4; ++e) {
                const float ca_0 = (float)cav[2 * e], ca_1 = (float)cav[2 * e + 1], sa_0 = (float)sav[2 * e], sa_1 = (float)sav[2 * e + 1];
                const float cb_0 = (float)cbv[2 * e], cb_1 = (float)cbv[2 * e + 1], sb_0 = (float)sbv[2 * e], sb_1 = (float)sbv[2 * e + 1];
                const float a0 = bflo(q0[e]), a1 = bfhi(q0[e]), b0 = bflo(q2[e]), b1 = bfhi(q2[e]);
                const float e0 = bflo(q1[e]), e1 = bfhi(q1[e]), f0 = bflo(q3[e]), f1 = bfhi(q3[e]);
                o0[e] = pk2((a0 * ca_0 - b0 * sa_0) * sc, (a1 * ca_1 - b1 * sa_1) * sc);
                o2[e] = pk2((b0 * ca_0 + a0 * sa_0) * sc, (b1 * ca_1 + a1 * sa_1) * sc);
                o1[e] = pk2((e0 * cb_0 - f0 * sb_0) * sc, (e1 * cb_1 - f1 * sb_1) * sc);
                o3[e] = pk2((f0 * cb_0 + e0 * sb_0) * sc, (f1 * cb_1 + e1 * sb_1) * sc);
            }
            qf[0] = __builtin_bit_cast(bf16x8, o0); qf[1] = __builtin_bit_cast(bf16x8, o1); qf[2] = __builtin_bit_cast(bf16x8, o2); qf[3] = __builtin_bit_cast(bf16x8, o3);
        }
#pragma unroll
        for (int i = 0; i < 3; ++i) {
            const int id = t + 512 * i, row = id >> 2, dc = id & 3;
            int posk = r + d * (i0 - 64 + row); posk = posk < 0 ? 0 : (posk > SEQ - 1 ? SEQ - 1 : posk);
            const h16x8 kcv = *(const h16x8*)(c.RH + posk * 64 + 8 * dc), ksv = *(const h16x8*)(c.RH + posk * 64 + 32 + 8 * dc);
            u32x4 olo, ohi;
#pragma unroll
            for (int e = 0; e < 4; ++e) {
                const float l0 = bflo(ka[i][e]), l1 = bfhi(ka[i][e]), h0 = bflo(kb2[i][e]), h1 = bfhi(kb2[i][e]);
                const float cc0 = (float)kcv[2 * e], cc1 = (float)kcv[2 * e + 1], ss0 = (float)ksv[2 * e], ss1 = (float)ksv[2 * e + 1];
                olo[e] = pk2(l0 * cc0 - h0 * ss0, l1 * cc1 - h1 * ss1);
                ohi[e] = pk2(h0 * cc0 + l0 * ss0, h1 * cc1 + l1 * ss1);
            }
            *(LASP u32x4*)(Kt + row * 128 + ((dc ^ (row & 7)) << 4)) = olo;
            *(LASP u32x4*)(Kt + row * 128 + (((4 + dc) ^ (row & 7)) << 4)) = ohi;
            const int rp = id % 192, dc8 = id / 192;
#pragma unroll
            for (int e = 0; e < 4; ++e) {
                Vt[(8 * dc8 + 2 * e) * 194 + rp] = (va[i][e] & 0xffffu) | (vb[i][e] << 16);
                Vt[(8 * dc8 + 2 * e + 1) * 194 + rp] = (va[i][e] >> 16) | (vb[i][e] & 0xffff0000u);
            }
        }
        __syncthreads();
        const int un = u + G;
        if (un < NAT) ATT_PREFETCH(un);
        asm volatile("" ::: "memory");
        f32x16 sacc[5];
    #pragma unroll
        for (int kb = 0; kb < 5; ++kb)
    #pragma unroll
            for (int e = 0; e < 16; ++e) sacc[kb][e] = 0.f;
    #pragma unroll
        for (int s4 = 0; s4 < 4; ++s4) {
    #pragma unroll
            for (int kb = 0; kb < 5; ++kb) {
                const int row = 32 * wave + 32 * kb + rq;
                const bf16x8 kf = *(const LASP bf16x8*)(Kt + row * 128 + (((2 * s4 + h) ^ (row & 7)) << 4));
                sacc[kb] = mfma32_g(kf, qf[s4], sacc[kb]);
            }
            __builtin_amdgcn_sched_barrier(0);
        }
        asm volatile("s_nop 15\n\ts_nop 15" : "+v"(sacc[0]), "+v"(sacc[1]), "+v"(sacc[2]), "+v"(sacc[3]), "+v"(sacc[4]));
        const int jbase = i0 - 64 + 32 * wave;
        float mx = -1e30f;
    #pragma unroll
        for (int kb = 0; kb < 5; ++kb)
    #pragma unroll
            for (int e = 0; e < 16; ++e) {
                const int row = (e & 3) + 8 * (e >> 2) + 4 * h, rel = 32 * kb + row - rq, j = jbase + 32 * kb + row;
                const bool valid = (rel >= 0) && (rel <= 128) && (j >= 0) && (j < L);
                const float sv = valid ? sacc[kb][e] : -1e30f;
                sacc[kb][e] = sv; mx = fmaxf(mx, sv);
            }
        mx = fmaxf(mx, __shfl_xor(mx, 32));
        float lsum = 0.f;
    #pragma unroll
        for (int kb = 0; kb < 5; ++kb)
    #pragma unroll
            for (int e = 0; e < 16; ++e) { const float p = __builtin_amdgcn_exp2f(sacc[kb][e] - mx); sacc[kb][e] = p; lsum += p; }
        lsum += __shfl_xor(lsum, 32);
        f32x16 oacc[2];
    #pragma unroll
        for (int db = 0; db < 2; ++db)
    #pragma unroll
            for (int e = 0; e < 16; ++e) oacc[db][e] = 0.f;
    #pragma unroll
        for (int kb = 0; kb < 5; ++kb)
    #pragma unroll
            for (int s2 = 0; s2 < 2; ++s2) {
                u32x4 pw;
    #pragma unroll
                for (int e = 0; e < 4; ++e) pw[e] = cvtpk(sacc[kb][8 * s2 + 2 * e], sacc[kb][8 * s2 + 2 * e + 1]);
                const bf16x8 pf = __builtin_bit_cast(bf16x8, pw);
                const int kp = (32 * wave + 32 * kb + 16 * s2 + 4 * h) >> 1;
    #pragma unroll
                for (int db = 0; db < 2; ++db) {
                    const LASP unsigned* vp = Vt + (32 * db + rq) * 194 + kp;
                    const u32x2 g0 = *(const LASP u32x2*)vp, g1 = *(const LASP u32x2*)(vp + 4);
                    const u32x4 aw = (u32x4){g0.x, g0.y, g1.x, g1.y};
                    oacc[db] = mfma32_g(__builtin_bit_cast(bf16x8, aw), pf, oacc[db]);
                }
            }
        asm volatile("s_nop 15\n\ts_nop 15" : "+v"(oacc[0]), "+v"(oacc[1]));
        if (do_store) {
            const float inv = 1.f / lsum;
    #pragma unroll
            for (int db = 0; db < 2; ++db)
    #pragma unroll
                for (int g4 = 0; g4 < 4; ++g4) {
                    const u32x2 w = (u32x2){cvtpk(oacc[db][4 * g4] * inv, oacc[db][4 * g4 + 1] * inv), cvtpk(oacc[db][4 * g4 + 2] * inv, oacc[db][4 * g4 + 3] * inv)};
                    *(u32x2*)(qrow + 32 * db + 8 * g4 + 4 * h) = w;
                }
            if (h == 0) c.LSE[((size_t)g * MT + tokq) * 4 + hI] = mx * 0.69314718f + __logf(lsum);
        }
        __syncthreads();
        if (un >= NAT) break;
        u = un;
    }
#undef ATT_PREFETCH
}

__device__ __forceinline__ f32x4 mfma16(bf16x8 a, bf16x8 b, f32x4 c) { return mfma16_g(a, b, c); }
template <int KSTEPS, int UNR = 2>
__device__ __forceinline__ void gemm64(const LASP unsigned char* Y, int kbyte0, const bf16_t* Bt, int ldb, f32x4 (&acc)[4][2], int fr, int fq) {
#pragma unroll UNR
    for (int ks = 0; ks < KSTEPS; ++ks) {
        bf16x8 bfr[2], afr[4];
#pragma unroll
        for (int n = 0; n < 2; ++n) bfr[n] = *(const bf16x8*)(Bt + (size_t)(16 * n + fr) * ldb + ks * 32 + 8 * fq);
#pragma unroll
        for (int m = 0; m < 4; ++m) afr[m] = *(const LASP bf16x8*)(Y + (16 * m + fr) * 528 + kbyte0 + (ks * 32 + 8 * fq) * 2);
#pragma unroll
        for (int m = 0; m < 4; ++m)
#pragma unroll
            for (int n = 0; n < 2; ++n) acc[m][n] = mfma16(bfr[n], afr[m], acc[m][n]);
        __builtin_amdgcn_sched_barrier(0);
    }
}
__device__ __forceinline__ bf16x8 pack8(f32x4 lo, f32x4 hi) {
    u32x4 w; w.x = cvtpk(lo[0], lo[1]); w.y = cvtpk(lo[2], lo[3]); w.z = cvtpk(hi[0], hi[1]); w.w = cvtpk(hi[2], hi[3]);
    return __builtin_bit_cast(bf16x8, w);
}
__device__ __forceinline__ bf16x8 dft_frag(int rowidx, int kbase, int fq, bool perm, int which  ) {
    float v[8];
#pragma unroll
    for (int j = 0; j < 8; ++j) {
        const int k = kbase + (perm ? (16 * (j >> 2) + 4 * fq + (j & 3)) : (8 * fq + j));
        float sn, cs; sincospif((float)((rowidx * k) & 63) * (1.f / 32.f), &sn, &cs);
        v[j] = which == 0 ? cs : (which == 1 ? sn : -sn);
    }
    u32x4 w; w.x = pk2(v[0], v[1]); w.y = pk2(v[2], v[3]); w.z = pk2(v[4], v[5]); w.w = pk2(v[6], v[7]);
    return __builtin_bit_cast(bf16x8, w);
}

__device__ __forceinline__ void fft1_phase_mfma(const Ctx& c) {
    const int t = TIDX, lane = t & 63, wave = __builtin_amdgcn_readfirstlane(t >> 6), fr = lane & 15, fq = lane >> 4, n = wave & 3, hsel = wave >> 2;
    bf16x8 cA[2], sA[2], cB[2][2], sB[2][2], nsB[2][2];
#pragma unroll
    for (int ks = 0; ks < 2; ++ks) {
        cA[ks] = dft_frag(16 * n + fr, 32 * ks, fq, false, 0); sA[ks] = dft_frag(16 * n + fr, 32 * ks, fq, false, 1);
#pragma unroll
        for (int mbi = 0; mbi < 2; ++mbi) {
            const int k1r = 16 * (2 * hsel + mbi) + fr;
            cB[mbi][ks] = dft_frag(k1r, 32 * ks, fq, true, 0); sB[mbi][ks] = dft_frag(k1r, 32 * ks, fq, true, 1); nsB[mbi][ks] = dft_frag(k1r, 32 * ks, fq, true, 2);
        }
    }
    bf16x8 ua[4][2];
#define FFT1_LOAD(uu_) do { const int s2_ = (uu_) & 63, bg_ = (uu_) >> 6, g_ = bg_ & 3, b_ = bg_ >> 2; \
        _Pragma("unroll") for (int m = 0; m < 4; ++m) _Pragma("unroll") for (int ks = 0; ks < 2; ++ks) \
            ua[m][ks] = *(const bf16x8*)(c.Z + (size_t)(b_ * SEQ + 64 * (16 * m + fr) + s2_) * DIN + ZA + 64 * g_ + 32 * ks + 8 * fq); } while (0)
    { const int u0 = BIDX; if (u0 < NB * 4 * 64) FFT1_LOAD(u0); }
    for (int u = BIDX; u < NB * 4 * 64; u += gridDim.x) {
        const int s2 = u & 63, bg = u >> 6;
        f32x4 wre[4], wim[4];
#pragma unroll
        for (int m = 0; m < 4; ++m) { wre[m] = (f32x4){0.f, 0.f, 0.f, 0.f}; wim[m] = wre[m]; }
#pragma unroll
        for (int ks = 0; ks < 2; ++ks) {
#pragma unroll
            for (int m = 0; m < 4; ++m) { wre[m] = mfma16(ua[m][ks], cA[ks], wre[m]); wim[m] = mfma16(ua[m][ks], sA[ks], wim[m]); }
            __builtin_amdgcn_sched_barrier(0);
        }
        asm volatile("" ::: "memory");
        { const int un = u + (int)gridDim.x; if (un < NB * 4 * 64) FFT1_LOAD(un); }
        asm volatile("" ::: "memory");
        asm volatile("s_nop 15\n\ts_nop 15" : "+v"(wre[0]), "+v"(wre[1]), "+v"(wre[2]), "+v"(wre[3]), "+v"(wim[0]), "+v"(wim[1]), "+v"(wim[2]), "+v"(wim[3]));
        bf16x8 bre[2], bim[2];
#pragma unroll
        for (int ks = 0; ks < 2; ++ks) { bre[ks] = pack8(wre[2 * ks], wre[2 * ks + 1]); bim[ks] = pack8(wim[2 * ks], wim[2 * ks + 1]); }
        asm volatile("s_nop 7" : "+v"(bre[0]), "+v"(bre[1]), "+v"(bim[0]), "+v"(bim[1]));
        f32x4 yre[2], yin[2];
#pragma unroll
        for (int mbi = 0; mbi < 2; ++mbi) { yre[mbi] = (f32x4){0.f, 0.f, 0.f, 0.f}; yin[mbi] = yre[mbi]; }
#pragma unroll
        for (int ks = 0; ks < 2; ++ks) {
#pragma unroll
            for (int mbi = 0; mbi < 2; ++mbi) { yre[mbi] = mfma16(cB[mbi][ks], bre[ks], yre[mbi]); yin[mbi] = mfma16(cB[mbi][ks], bim[ks], yin[mbi]); }
            __builtin_amdgcn_sched_barrier(0);
#pragma unroll
            for (int mbi = 0; mbi < 2; ++mbi) { yre[mbi] = mfma16(nsB[mbi][ks], bim[ks], yre[mbi]); yin[mbi] = mfma16(sB[mbi][ks], bre[ks], yin[mbi]); }
            __builtin_amdgcn_sched_barrier(0);
        }
        asm volatile("s_nop 15\n\ts_nop 15" : "+v"(yre[0]), "+v"(yin[0]), "+v"(yre[1]), "+v"(yin[1]));
#pragma unroll
        for (int mbi = 0; mbi < 2; ++mbi) {
#pragma unroll
            for (int rg = 0; rg < 4; ++rg) {
                const int k1 = 16 * (2 * hsel + mbi) + 4 * fq + rg;
                const float2 tw = c.TW[(k1 * s2) & 4095];
                const float yr = yre[mbi][rg], yi = -yin[mbi][rg];
                c.FY[((size_t)(bg * 64 + k1) * 64 + s2) * 64 + 16 * n + fr] = pk2(yr * tw.x + yi * tw.y, yi * tw.x - yr * tw.y);
            }
        }
    }
#undef FFT1_LOAD
}

__device__ __forceinline__ void fft2_phase_mfma(const Ctx& c, int l, unsigned char* lds_raw) {
    LASP unsigned char* F = (LASP unsigned char*)lds_raw;
    const int t = TIDX, lane = t & 63, wave = __builtin_amdgcn_readfirstlane(t >> 6), fr = lane & 15, fq = lane >> 4, g = wave >> 1, nh = wave & 1;
    bf16x8 cF[4][2], sF[4][2];
#pragma unroll
    for (int m = 0; m < 4; ++m)
#pragma unroll
        for (int ks = 0; ks < 2; ++ks) { cF[m][ks] = dft_frag(16 * m + fr, 32 * ks, fq, false, 0); sF[m][ks] = dft_frag(16 * m + fr, 32 * ks, fq, false, 1); }
    for (int u = BIDX; u < NB * 64; u += gridDim.x) {
        const int b = u >> 6, k1 = u & 63;
        const unsigned* src = c.FY + (size_t)((b * 4 + g) * 64 + k1) * 4096;
#pragma unroll
        for (int nn = 0; nn < 2; ++nn) {
            const int cp = 16 * (2 * nh + nn) + fr;
            bf16x8 bre[2], bim[2];
#pragma unroll
            for (int ks = 0; ks < 2; ++ks) {
                unsigned w[8];
#pragma unroll
                for (int j = 0; j < 8; ++j) w[j] = src[(32 * ks + 8 * fq + j) * 64 + cp];
                u32x4 re, im;
#pragma unroll
                for (int e = 0; e < 4; ++e) { re[e] = (w[2 * e] & 0xffffu) | (w[2 * e + 1] << 16); im[e] = (w[2 * e] >> 16) | (w[2 * e + 1] & 0xffff0000u); }
                bre[ks] = __builtin_bit_cast(bf16x8, re); bim[ks] = __builtin_bit_cast(bf16x8, im);
            }
            f32x4 dacc[4];
#pragma unroll
            for (int m = 0; m < 4; ++m) dacc[m] = (f32x4){0.f, 0.f, 0.f, 0.f};
#pragma unroll
            for (int ks = 0; ks < 2; ++ks) {
#pragma unroll
                for (int m = 0; m < 4; ++m) dacc[m] = mfma16(bre[ks], cF[m][ks], dacc[m]);
                __builtin_amdgcn_sched_barrier(0);
#pragma unroll
                for (int m = 0; m < 4; ++m) dacc[m] = mfma16(bim[ks], sF[m][ks], dacc[m]);
                __builtin_amdgcn_sched_barrier(0);
            }
            asm volatile("s_nop 15" : "+v"(dacc[0]), "+v"(dacc[1]), "+v"(dacc[2]), "+v"(dacc[3]));
#pragma unroll
            for (int m = 0; m < 4; ++m) {
                u32x2 wv; wv.x = cvtpk(dacc[m][0] * (1.f / 512.f), dacc[m][1] * (1.f / 512.f)); wv.y = cvtpk(dacc[m][2] * (1.f / 512.f), dacc[m][3] * (1.f / 512.f));
                *(LASP u32x2*)(F + (16 * m + fr) * 528 + (g * 64 + 16 * (2 * nh + nn) + 4 * fq) * 2) = wv;
            }
        }
        __syncthreads();
        f32x4 acc[4][2];
#pragma unroll
        for (int m = 0; m < 4; ++m)
#pragma unroll
            for (int n = 0; n < 2; ++n) acc[m][n] = (f32x4){0.f, 0.f, 0.f, 0.f};
        gemm64<8>(F, 0, c.WfT + (size_t)l * 65536 + (size_t)(32 * wave) * 256, 256, acc, fr, fq);
#pragma unroll
        for (int m = 0; m < 4; ++m)
#pragma unroll
            for (int n = 0; n < 2; ++n) {
                const size_t tok = (size_t)b * SEQ + k1 + 64 * (16 * m + fr); const int col = 32 * wave + 16 * n + 4 * fq;
                const u32x2 gp = *(const u32x2*)(c.Z + tok * DIN + ZG + col);
                u32x2 o; o.x = cvtpk(acc[m][n][0] * siluf_(bflo(gp.x)), acc[m][n][1] * siluf_(bfhi(gp.x))); o.y = cvtpk(acc[m][n][2] * siluf_(bflo(gp.y)), acc[m][n][3] * siluf_(bfhi(gp.y)));
                *(u32x2*)(c.P + tok * DM + col) = o;
            }
        __syncthreads();
    }
}

__device__ __forceinline__ void tok_unit_mfma(const Ctx& c, int l, int u, unsigned char* lds_raw) {
    LASP float* A = (LASP float*)lds_raw;
    LASP unsigned char* Y = (LASP unsigned char*)(lds_raw + 96256);
    const int t = TIDX, lane = t & 63, wave = __builtin_amdgcn_readfirstlane(t >> 6), ch = t & 255, half = t >> 8, fr = lane & 15, fq = lane >> 4;
    const int b = u >> 6, s0 = (u & 63) * 64, tok0 = b * SEQ + s0;
    for (int rp1 = 0; rp1 < (TOKREP == 1 ? 2 : 1); ++rp1) {
#pragma unroll
    for (int i = 0; i < 6; ++i) {
        const int id = t + 512 * i;
        if (id < 94 * 32) {
            const int row = id >> 5, c8 = (id & 31) * 8, sp = s0 - 15 + row;
            f32x4 v0 = (f32x4){0.f, 0.f, 0.f, 0.f}, v1 = v0;
            if (sp >= 0 && sp < SEQ) {
                const bf16_t* zr = c.Z + (size_t)(b * SEQ + sp) * DIN + ZB + c8;
                const u32x4 a = *(const u32x4*)zr, gg = *(const u32x4*)(zr + 256);
                v0[0] = bflo(a.x) * sigmoidf_(bflo(gg.x)); v0[1] = bfhi(a.x) * sigmoidf_(bfhi(gg.x)); v0[2] = bflo(a.y) * sigmoidf_(bflo(gg.y)); v0[3] = bfhi(a.y) * sigmoidf_(bfhi(gg.y));
                v1[0] = bflo(a.z) * sigmoidf_(bflo(gg.z)); v1[1] = bfhi(a.z) * sigmoidf_(bfhi(gg.z)); v1[2] = bflo(a.w) * sigmoidf_(bflo(gg.w)); v1[3] = bfhi(a.w) * sigmoidf_(bfhi(gg.w));
            }
            *(LASP f32x4*)(A + row * 256 + c8) = v0; *(LASP f32x4*)(A + row * 256 + c8 + 4) = v1;
        }
    }
    __syncthreads();
    float y[32];
    {
        float cw[31];
#pragma unroll
        for (int w = 0; w < 31; ++w) cw[w] = c.conv_w[(size_t)l * 31 * 256 + w * 256 + ch];
        const float cb = c.conv_b[l * 256 + ch];
#pragma unroll
        for (int cc = 0; cc < 4; ++cc) {
            float rows[38];
#pragma unroll
            for (int r = 0; r < 38; ++r) rows[r] = A[(half * 32 + cc * 8 + r) * 256 + ch];
#pragma unroll
            for (int i = 0; i < 8; ++i) {
                float acc = cb;
#pragma unroll
                for (int w = 0; w < 31; ++w) acc += rows[i + w] * cw[w];
                y[cc * 8 + i] = acc;
            }
            __builtin_amdgcn_sched_barrier(0);
        }
    }
    __syncthreads();
#pragma unroll
    for (int i = 0; i < 32; ++i) A[(half * 32 + i) * 256 + ch] = y[i];
    __syncthreads();
    {
        const f32x4 lg = *(const f32x4*)(c.conv_ln_g + l * 256 + 4 * lane), lb = *(const f32x4*)(c.conv_ln_b + l * 256 + 4 * lane);
#pragma unroll 2
        for (int i = 0; i < 8; ++i) {
            const int tk = wave * 8 + i;
            f32x4 xv = *(const LASP f32x4*)(A + tk * 256 + 4 * lane);
            const float mean = wave_sum((xv[0] + xv[1]) + (xv[2] + xv[3])) * (1.f / 256.f);
            xv = xv - mean;
            const float rstd = 1.0f / sqrtf(wave_sum((xv[0] * xv[0] + xv[1] * xv[1]) + (xv[2] * xv[2] + xv[3] * xv[3])) * (1.f / 256.f) + 1e-5f);
            const f32x4 yv = xv * rstd * lg + lb;
            u32x2 o; o.x = cvtpk(siluf_(yv[0]), siluf_(yv[1])); o.y = cvtpk(siluf_(yv[2]), siluf_(yv[3]));
            *(LASP u32x2*)(Y + tk * 528 + 8 * lane) = o;
        }
    }
    __syncthreads();
    }
    for (int rp2 = 0; rp2 < (TOKREP == 2 ? 2 : 1); ++rp2) {
        f32x4 acc[4][2];
#pragma unroll
        for (int m = 0; m < 4; ++m)
#pragma unroll
            for (int n = 0; n < 2; ++n) acc[m][n] = (f32x4){0.f, 0.f, 0.f, 0.f};
        gemm64<8, 8>(Y, 0, c.WpwT + (size_t)l * 65536 + (size_t)(32 * wave) * 256, 256, acc, fr, fq);
#pragma unroll
        for (int m = 0; m < 4; ++m)
#pragma unroll
            for (int n = 0; n < 2; ++n) {
                const size_t tok = (size_t)tok0 + 16 * m + fr; const int col = 32 * wave + 16 * n + 4 * fq;
                const u32x2 gp = *(const u32x2*)(c.Z + tok * DIN + ZG + 256 + col);
                u32x2 o; o.x = cvtpk(acc[m][n][0] * siluf_(bflo(gp.x)), acc[m][n][1] * siluf_(bfhi(gp.x))); o.y = cvtpk(acc[m][n][2] * siluf_(bflo(gp.y)), acc[m][n][3] * siluf_(bfhi(gp.y)));
                *(u32x2*)(c.P + tok * DM + 256 + col) = o;
            }
    }
    __syncthreads();
    for (int rp3 = 0; rp3 < (TOKREP == 3 ? 2 : 1); ++rp3) {
#pragma unroll
    for (int i = 0; i < 5; ++i) {
        const int id = t + 512 * i;
        if (id < 79 * 32) {
            const int row = id >> 5, c8 = (id & 31) * 8, sp = s0 - 8 + row;
            f32x4 v0 = (f32x4){0.f, 0.f, 0.f, 0.f}, v1 = v0;
            if (sp >= 0 && sp < SEQ) {
                const u32x4 a = *(const u32x4*)(c.Z + (size_t)(b * SEQ + sp) * DIN + ZD + c8);
                v0[0] = bflo(a.x); v0[1] = bfhi(a.x); v0[2] = bflo(a.y); v0[3] = bfhi(a.y); v1[0] = bflo(a.z); v1[1] = bfhi(a.z); v1[2] = bflo(a.w); v1[3] = bfhi(a.w);
            }
            *(LASP f32x4*)(A + row * 256 + c8) = v0; *(LASP f32x4*)(A + row * 256 + c8 + 4) = v1;
        }
    }
    __syncthreads();
    {
        const int gi = ch >> 6, sz = 2 << gi;
        float xr[47];
#pragma unroll
        for (int r = 0; r < 47; ++r) xr[r] = A[(half * 32 + r) * 256 + ch];
        float w2c[47], w4c[47], w8c[47];
#pragma unroll
        for (int r = 1; r < 47; ++r) w2c[r] = xr[r - 1] + xr[r];
#pragma unroll
        for (int r = 2; r < 46; ++r) w4c[r] = w2c[r - 1] + w2c[r + 1];
#pragma unroll
        for (int r = 4; r < 44; ++r) w8c[r] = w4c[r - 2] + w4c[r + 2];
#pragma unroll
        for (int i = 0; i < 32; ++i) {
            const int r = i + 8, tk = half * 32 + i, sp = s0 + tk;
            const float w16 = w8c[r - 4] + w8c[r + 4];
            const float wsum = gi == 0 ? w2c[r] : (gi == 1 ? w4c[r] : (gi == 2 ? w8c[r] : w16));
            int lo = sp - sz / 2; if (lo < 0) lo = 0;
            int hi = sp + sz - 1 - sz / 2; if (hi > SEQ - 1) hi = SEQ - 1;
            *(LASP bf16_t*)(Y + tk * 528 + ch * 2) = f2bf(wsum / (float)(hi - lo + 1) - xr[r]);
        }
    }
    __syncthreads();
    {
        const int gi = wave >> 1, cb = (wave & 1) * 32;
        f32x4 acc[4][2];
#pragma unroll
        for (int m = 0; m < 4; ++m)
#pragma unroll
            for (int n = 0; n < 2; ++n) acc[m][n] = (f32x4){0.f, 0.f, 0.f, 0.f};
        gemm64<2>(Y, gi * 128, c.WpoolT + (size_t)(l * 4 + gi) * 4096 + (size_t)cb * 64, 64, acc, fr, fq);
#pragma unroll
        for (int m = 0; m < 4; ++m)
#pragma unroll
            for (int n = 0; n < 2; ++n) {
                const size_t tok = (size_t)tok0 + 16 * m + fr; const int col = gi * 64 + cb + 16 * n + 4 * fq;
                const u32x2 gp = *(const u32x2*)(c.Z + tok * DIN + ZG + 768 + col);
                const f32x4 ps = *(const f32x4*)(c.pool_scale + l * 256 + col);
                u32x2 o; o.x = cvtpk(acc[m][n][0] * ps[0] * siluf_(bflo(gp.x)), acc[m][n][1] * ps[1] * siluf_(bfhi(gp.x))); o.y = cvtpk(acc[m][n][2] * ps[2] * siluf_(bflo(gp.y)), acc[m][n][3] * ps[3] * siluf_(bfhi(gp.y)));
                *(u32x2*)(c.P + tok * DM + 768 + col) = o;
            }
    }
    __syncthreads();
    }
}

__device__ __forceinline__ void fft2_unit(const Ctx& c, int l, int u, float* lds) {
    const int t = TIDX, b = u >> 6, k1 = u & 63, cp = t & 63;
    float* Ft = lds; float* Yre = lds + 64 * 260; float* Yim = Yre + 4096; float* cs = Yim + 4096; float* sn = cs + 64;
    if (t < 64) { float s, co; sincospif((float)t / 32.f, &s, &co); cs[t] = co; sn[t] = s; }
    for (int g = 0; g < 4; ++g) {
        const unsigned* src = c.FY + (size_t)((b * 4 + g) * 64 + k1) * 4096;
#pragma unroll
        for (int i = 0; i < 8; ++i) { const int idx = t + 512 * i; const unsigned w = src[idx]; Yre[idx] = bflo(w); Yim[idx] = bfhi(w); }
        __syncthreads();
#pragma unroll 1
        for (int i = 0; i < 8; ++i) {
            const int k2 = (t >> 6) + 8 * i; float acc = 0.f;
            for (int s2 = 0; s2 < 64; ++s2) { const int e = (k2 * s2) & 63; acc += cs[e] * Yre[s2 * 64 + cp] + sn[e] * Yim[s2 * 64 + cp]; }
            Ft[k2 * 260 + g * 64 + cp] = acc * (1.f / 512.f);
        }
        __syncthreads();
    }
    const int j = t & 255, half = t >> 8;
    float acc[32];
#pragma unroll
    for (int i = 0; i < 32; ++i) acc[i] = 0.f;
    const float* W = c.w_fourier + (size_t)l * 65536;
#pragma unroll 2
    for (int k = 0; k < 256; ++k) {
        const float wv = W[k * 256 + j];
#pragma unroll
        for (int i = 0; i < 32; ++i) acc[i] += Ft[(half * 32 + i) * 260 + k] * wv;
    }
    __syncthreads();
#pragma unroll
    for (int i = 0; i < 32; ++i) Ft[(half * 32 + i) * 260 + j] = acc[i];
    __syncthreads();
#pragma unroll 1
    for (int i = 0; i < 32; ++i) {
        const size_t tok = (size_t)b * SEQ + k1 + 64 * (half * 32 + i);
        const float gp = bf2f(c.Z[tok * DIN + ZG + j]);
        c.P[tok * DM + j] = f2bf(Ft[(half * 32 + i) * 260 + j] * siluf_(gp));
    }
    __syncthreads();
}

__device__ __forceinline__ void phase_combine(const Ctx& c) {
    const int gt = BIDX * NTHREADS + TIDX, NT = gridDim.x * NTHREADS;
    for (int idx = gt; idx < MT * 32; idx += NT) {
        const size_t m = idx >> 5; const int c8 = (idx & 31) * 8, hI = c8 >> 6;
        const float l0 = c.LSE[((size_t)0 * MT + m) * 4 + hI], l1 = c.LSE[((size_t)1 * MT + m) * 4 + hI], l2 = c.LSE[((size_t)2 * MT + m) * 4 + hI];
        const float mx = fmaxf(l0, fmaxf(l1, l2));
        const float e0 = __expf(l0 - mx), e1 = __expf(l1 - mx), e2 = __expf(l2 - mx), inv = 1.f / (e0 + e1 + e2);
        const float a0 = e0 * inv, a1 = e1 * inv, a2 = e2 * inv;
        const bf16_t* zr = c.Z + m * DIN;
        const u32x4 o0 = *(const u32x4*)(zr + ZQ + (0 * 4 + hI) * 64 + (c8 & 63));
        const u32x4 o1 = *(const u32x4*)(zr + ZQ + (1 * 4 + hI) * 64 + (c8 & 63));
        const u32x4 o2 = *(const u32x4*)(zr + ZQ + (2 * 4 + hI) * 64 + (c8 & 63));
        const u32x4 gp = *(const u32x4*)(zr + ZG + 512 + c8);
        u32x4 res;
#pragma unroll
        for (int q = 0; q < 4; ++q) {
            const float vlo = (a0 * bflo(o0[q]) + a1 * bflo(o1[q]) + a2 * bflo(o2[q])) * siluf_(bflo(gp[q]));
            const float vhi = (a0 * bfhi(o0[q]) + a1 * bfhi(o1[q]) + a2 * bfhi(o2[q])) * siluf_(bfhi(gp[q]));
            res[q] = pk2(vlo, vhi);
        }
        *(u32x4*)(c.P + m * DM + 512 + c8) = res;
    }
}

namespace pg8 {
#define PG8_LAS __attribute__((address_space(3)))
typedef unsigned short bf16_t;
typedef short bf16x8 __attribute__((ext_vector_type(8)));
typedef float f32x4 __attribute__((ext_vector_type(4)));
typedef unsigned u32x4 __attribute__((ext_vector_type(4)));
constexpr int BM = 256, BK = 64, HALF = 128, HTB = HALF * BK * 2  , STAGE_BYTES = 8 * HTB, NXCD = 8, WGM = 8;

__host__ __device__ __forceinline__ int lds_byte(int r, int c) { const int st = (r >> 4) * 2 + (c >> 5), rr = r & 15, cc = c & 31, ob = rr * 64 + cc * 2; return st * 1024 + (ob ^ (((ob >> 9) & 1) << 5)); }
__host__ __device__ __forceinline__ void stage_rc(int b, int& R, int& C) { const int st = b / 1024, sb = b % 1024, swz = sb ^ (((sb >> 9) & 1) << 5); R = (st >> 1) * 16 + swz / 64; C = (st & 1) * 32 + (swz % 64) / 2; }
__host__ __device__ __forceinline__ int perm32(int rho) { const int n = rho >> 4, i = rho & 15; return 8 * (i >> 2) + 4 * n + (i & 3); }

struct Unit { int pm, pn, sub; };
template <int LDA_, int LDB_, int K_, int ASUB_, int BSUB_> struct GemmT { const bf16_t* A; const bf16_t* Bt; static constexpr int lda = LDA_, ldb = LDB_, K = K_; static constexpr size_t a_sub = ASUB_, b_sub = BSUB_; };

struct StaticOrder {
    int nM, nN, nwg, G, c;
    __host__ __device__ void init(int M, int N, int G_, int c_) { nM = M / BM; nN = N / BM; nwg = nM * nN; G = G_; c = c_; }
    __host__ __device__ bool next(int i, Unit& u) const {
        const long L = (long)i * G + c; if (L >= nwg) return false;
        int wgid = (int)L; { const int q = nwg / NXCD, r = nwg % NXCD, xcd = wgid % NXCD, off = wgid / NXCD; wgid = (xcd < r ? xcd * (q + 1) : r * (q + 1) + (xcd - r) * q) + off; }
        const int nig = WGM * nN, gid = wgid / nig, fm = gid * WGM, gsz = (nM - fm) < WGM ? (nM - fm) : WGM;
        u.pm = fm + ((wgid % nig) % gsz); u.pn = (wgid % nig) / gsz; u.sub = 0; return true;
    }
    __device__ __forceinline__ void a_ready(const Unit&) const {}
    __device__ __forceinline__ void done(const Unit&) const {}
};


__device__ __forceinline__ unsigned cvt_pk_bf16(float lo, float hi) { return ::pk2(lo, hi); }
template <int ACT  > struct EpiBf16 {
    static constexpr bool PERM = true, AFTER_DRAIN = false; static_assert(ACT == 0 || ACT == 2, "EpiBf16: ACT is 0 (none) or 2 (sigmoid)");
    bf16_t* O; int ldc; const float* bias; int split_cols; size_t split_stride; float scale0;
    __device__ __forceinline__ void operator()(const f32x4 (&acc)[2][2][4][2], const Unit& u, int wr, int wc, int fr, int fq) const {
        asm volatile("" : "+v"(fr), "+v"(fq));
        const int row0 = u.pm * BM + wr * 64 + fr; int colt = u.pn * BM; bf16_t* base = O;
        float sc = 1.f; if (split_cols) { const int t = colt / split_cols; base += (size_t)t * split_stride; colt -= t * split_cols; if (t == 0) sc = scale0; }
        const int col0 = colt + wc * 32 + 8 * fq, bcol0 = u.pn * BM + wc * 32 + 8 * fq;
        f32x4 bv[2][2];
#pragma unroll
        for (int bj = 0; bj < 2; ++bj)
#pragma unroll
            for (int n = 0; n < 2; ++n) bv[bj][n] = bias ? *(const f32x4*)(bias + bcol0 + bj * HALF + 4 * n) : (f32x4){0.f, 0.f, 0.f, 0.f};
#pragma unroll
        for (int ai = 0; ai < 2; ++ai)
#pragma unroll
            for (int m = 0; m < 4; ++m) { bf16_t* rowp = base + (size_t)(row0 + ai * HALF + m * 16) * ldc + col0;
#pragma unroll
                for (int bj = 0; bj < 2; ++bj) { f32x4 v0 = acc[ai][bj][m][0] + bv[bj][0], v1 = acc[ai][bj][m][1] + bv[bj][1];
                    if (ACT == 2) {
#pragma unroll
                        for (int q = 0; q < 4; ++q) { v0[q] = __builtin_amdgcn_rcpf(1.0f + __builtin_amdgcn_exp2f(v0[q] * -1.44269504f)); v1[q] = __builtin_amdgcn_rcpf(1.0f + __builtin_amdgcn_exp2f(v1[q] * -1.44269504f)); } }
                    v0 = v0 * sc; v1 = v1 * sc; u32x4 w; w.x = cvt_pk_bf16(v0[0], v0[1]); w.y = cvt_pk_bf16(v0[2], v0[3]); w.z = cvt_pk_bf16(v1[0], v1[1]); w.w = cvt_pk_bf16(v1[2], v1[3]);
                    *(u32x4*)(rowp + bj * HALF) = w; } }
    }
};


struct EpiGateU8 {
    static constexpr bool PERM = true, AFTER_DRAIN = false;
    unsigned char* O; const float* bias;
    __device__ __forceinline__ void operator()(const f32x4 (&acc)[2][2][4][2], const Unit& u, int wr, int wc, int fr, int fq) const {
        asm volatile("" : "+v"(fr), "+v"(fq));
        const int row0 = u.pm * BM + wr * 64 + fr, col0 = u.pn * BM + wc * 32 + 8 * fq;
        f32x4 bv[2][2];
#pragma unroll
        for (int bj = 0; bj < 2; ++bj)
#pragma unroll
            for (int n = 0; n < 2; ++n) bv[bj][n] = *(const f32x4*)(bias + col0 + bj * HALF + 4 * n);
#pragma unroll
        for (int ai = 0; ai < 2; ++ai)
#pragma unroll
            for (int m = 0; m < 4; ++m) { unsigned char* rowp = O + (size_t)(row0 + ai * HALF + m * 16) * 4096 + col0;
#pragma unroll
                for (int bj = 0; bj < 2; ++bj) { const f32x4 v0 = acc[ai][bj][m][0] + bv[bj][0], v1 = acc[ai][bj][m][1] + bv[bj][1];
                    unsigned q[8];
#pragma unroll
                    for (int e = 0; e < 4; ++e) {
                        q[e] = (unsigned)(255.0f * __builtin_amdgcn_rcpf(1.0f + __builtin_amdgcn_exp2f(v0[e] * -1.44269504f)) + 0.5f);
                        q[4 + e] = (unsigned)(255.0f * __builtin_amdgcn_rcpf(1.0f + __builtin_amdgcn_exp2f(v1[e] * -1.44269504f)) + 0.5f);
                    }
                    u32x2 w; w.x = q[0] | (q[1] << 8) | (q[2] << 16) | (q[3] << 24); w.y = q[4] | (q[5] << 8) | (q[6] << 16) | (q[7] << 24);
                    *(u32x2*)(rowp + bj * HALF) = w; } }
    }
};
struct EpiMerge {
    static constexpr bool PERM = true, AFTER_DRAIN = false;
    const unsigned char* MG; bf16_t* O;
    __device__ __forceinline__ void operator()(const f32x4 (&acc)[2][2][4][2], const Unit& u, int wr, int wc, int fr, int fq) const {
        asm volatile("" : "+v"(fr), "+v"(fq));
        const int row0 = u.pm * BM + wr * 64 + fr, col0 = u.pn * BM + wc * 32 + 8 * fq;
        const bool rmw = (u.sub != 0);
        constexpr int DEPTH = 4;
        u32x2 gq[16]; u32x4 pq[16];
#define EPM_ROW(i) ((size_t)(row0 + ((i) >> 3) * HALF + (((i) >> 1) & 3) * 16))
#define EPM_LOAD(i) do { const size_t row_ = EPM_ROW(i); const int cb_ = col0 + ((i) & 1) * HALF; gq[i] = *(const u32x2*)(MG + row_ * 4096 + u.sub * 1024 + cb_); \
        if (rmw) pq[i] = *(const u32x4*)(O + row_ * 1024 + cb_); } while (0)
#pragma unroll
        for (int i = 0; i < DEPTH; ++i) EPM_LOAD(i);
        asm volatile("" ::: "memory");
#pragma unroll
        for (int i = 0; i < 16; ++i) {
            const int ai = i >> 3, m = (i >> 1) & 3, bj = i & 1;
            const u32x2 g = gq[i];
            f32x4 v0 = acc[ai][bj][m][0] * (1.0f / 255.0f), v1 = acc[ai][bj][m][1] * (1.0f / 255.0f);
            v0[0] *= (float)(g.x & 0xffu); v0[1] *= (float)((g.x >> 8) & 0xffu); v0[2] *= (float)((g.x >> 16) & 0xffu); v0[3] *= (float)(g.x >> 24);
            v1[0] *= (float)(g.y & 0xffu); v1[1] *= (float)((g.y >> 8) & 0xffu); v1[2] *= (float)((g.y >> 16) & 0xffu); v1[3] *= (float)(g.y >> 24);
            if (rmw) { const u32x4 p = pq[i];
                v0[0] += __uint_as_float(p.x << 16); v0[1] += __uint_as_float(p.x & 0xffff0000u); v0[2] += __uint_as_float(p.y << 16); v0[3] += __uint_as_float(p.y & 0xffff0000u);
                v1[0] += __uint_as_float(p.z << 16); v1[1] += __uint_as_float(p.z & 0xffff0000u); v1[2] += __uint_as_float(p.w << 16); v1[3] += __uint_as_float(p.w & 0xffff0000u); }
            u32x4 w; w.x = cvt_pk_bf16(v0[0], v0[1]); w.y = cvt_pk_bf16(v0[2], v0[3]); w.z = cvt_pk_bf16(v1[0], v1[1]); w.w = cvt_pk_bf16(v1[2], v1[3]);
            *(u32x4*)(O + EPM_ROW(i) * 1024 + col0 + bj * HALF) = w;
            asm volatile("" ::: "memory");
            if (i + DEPTH < 16) { EPM_LOAD(i + DEPTH); asm volatile("" ::: "memory"); }
        }
#undef EPM_LOAD
#undef EPM_ROW
    }
};
struct EpiOutF32 {
    static constexpr bool PERM = true, AFTER_DRAIN = false;
    const float* xin; float* out;
    __device__ __forceinline__ void operator()(const f32x4 (&acc)[2][2][4][2], const Unit& u, int wr, int wc, int fr, int fq) const {
        asm volatile("" : "+v"(fr), "+v"(fq));
        const int row0 = u.pm * BM + wr * 64 + fr, col0 = u.pn * BM + wc * 32 + 8 * fq;
        constexpr int DEPTH = 4;
        f32x4 x0q[16], x1q[16];
#define EPO_OFF(i) ((size_t)(row0 + ((i) >> 3) * HALF + (((i) >> 1) & 3) * 16) * 1024 + col0 + ((i) & 1) * HALF)
#define EPO_LOAD(i) do { const size_t off_ = EPO_OFF(i); x0q[i] = *(const f32x4*)(xin + off_); x1q[i] = *(const f32x4*)(xin + off_ + 4); } while (0)
#pragma unroll
        for (int i = 0; i < DEPTH; ++i) EPO_LOAD(i);
        asm volatile("" ::: "memory");
#pragma unroll
        for (int i = 0; i < 16; ++i) {
            const int ai = i >> 3, m = (i >> 1) & 3, bj = i & 1;
            const size_t off = EPO_OFF(i);
            *(f32x4*)(out + off) = x0q[i] + acc[ai][bj][m][0]; *(f32x4*)(out + off + 4) = x1q[i] + acc[ai][bj][m][1];
            asm volatile("" ::: "memory");
            if (i + DEPTH < 16) { EPO_LOAD(i + DEPTH); asm volatile("" ::: "memory"); }
        }
#undef EPO_LOAD
#undef EPO_OFF
    }
};
struct MergeOrder : StaticOrder {
    __device__ bool next(int i, Unit& u) const { const bool ok = StaticOrder::next(i >> 2, u); u.sub = i & 3; return ok; }
};

template <class Epi, class Sched, class Gemm, bool ALIGN_EPI = false, bool SP2 = false>
__device__ __forceinline__ void gemm_phase(PG8_LAS unsigned char* lds, const Gemm g, const Sched& S, const Epi& E) {
    const int tid = TIDX, wid = __builtin_amdgcn_readfirstlane(tid >> 6), lane = tid & 63, wr = wid >> 2, wc = wid & 3, fr = lane & 15, fq = lane >> 4;
    constexpr int K = Gemm::K, nt = K / BK, lda = Gemm::lda, ldb = Gemm::ldb;
    unsigned voffA[2], voffB[2];
#pragma unroll
    for (int i = 0; i < 2; ++i) { int R, C; stage_rc(tid * 16 + i * 8192, R, C); const int Rb = Epi::PERM ? ((R & ~31) + perm32(R & 31)) : R;
        voffA[i] = (unsigned)(R * lda + C) * 2u; voffB[i] = (unsigned)(Rb * ldb + C) * 2u; }
    const size_t kstep = (size_t)(BK * 2);
    const size_t hstepA = (size_t)HALF * lda * 2, hstepB = (size_t)HALF * ldb * 2;
    const size_t tstepA = 2 * hstepA, tstepB = 2 * hstepB;
    const unsigned ldsw = (unsigned)wid * 1024u;
    const int aoff = lds_byte(wr * 64 + fr, fq * 8), boff = lds_byte(wc * 32 + fr, fq * 8);
#define PG8_SA(b, h) (((b) * 2 + (h)) * HTB)
#define PG8_SB(b, h) ((4 + (b) * 2 + (h)) * HTB)
#define PG8_STAGE(bufoff, gbase, voff) do { _Pragma("unroll") for (int _i = 0; _i < 2; ++_i) \
        __builtin_amdgcn_global_load_lds((const unsigned*)((const char*)(gbase) + (voff)[_i]), (PG8_LAS unsigned*)(lds + (bufoff) + ldsw + _i * 8192), 16, 0, 0); } while (0)
#define PG8_LDA(dst, b, h) do { _Pragma("unroll") for (int m = 0; m < 4; ++m) _Pragma("unroll") for (int k = 0; k < 2; ++k) dst[m][k] = *(const PG8_LAS bf16x8*)(lds + PG8_SA(b, h) + aoff + m * 2048 + k * 1024); } while (0)
#define PG8_LDB(dst, b, h) do { _Pragma("unroll") for (int n = 0; n < 2; ++n) _Pragma("unroll") for (int k = 0; k < 2; ++k) dst[n][k] = *(const PG8_LAS bf16x8*)(lds + PG8_SB(b, h) + boff + n * 2048 + k * 1024); } while (0)
#define PG8_MMA(ai, bj, At, Bt) do { __builtin_amdgcn_s_setprio(1); _Pragma("unroll") for (int m = 0; m < 4; ++m) _Pragma("unroll") for (int n = 0; n < 2; ++n) _Pragma("unroll") for (int k = 0; k < 2; ++k) \
        acc[ai][bj][m][n] = ::mfma16_g(Bt[n][k], At[m][k], acc[ai][bj][m][n]); __builtin_amdgcn_s_setprio(0); } while (0)
#define PG8_WAIT_V(n) asm volatile("s_waitcnt vmcnt(" #n ")" ::: "memory")
#define PG8_WAIT_L(n) asm volatile("s_waitcnt lgkmcnt(" #n ")" ::: "memory")
#define PG8_BAR __builtin_amdgcn_s_barrier()
#define PG8_SCHED __builtin_amdgcn_sched_barrier(0)
    Unit cur, nxt; int ui = 0;
    if (!S.next(0, cur)) return;
    f32x4 acc[2][2][4][2];
#pragma unroll
    for (int a = 0; a < 2; ++a)
#pragma unroll
        for (int b = 0; b < 2; ++b)
#pragma unroll
            for (int m = 0; m < 4; ++m)
#pragma unroll
                for (int n = 0; n < 2; ++n) acc[a][b][m][n] = (f32x4){0.f, 0.f, 0.f, 0.f};
    bf16x8 At[4][2], B0[2][2], B1[2][2];
    const char* cA = (const char*)g.A + (size_t)cur.pm * tstepA + (size_t)cur.sub * g.a_sub; const char* cB = (const char*)g.Bt + (size_t)cur.pn * tstepB + (size_t)cur.sub * g.b_sub;
    S.a_ready(cur);
    if constexpr (SP2) {
        PG8_STAGE(PG8_SB(0, 0), cB, voffB); PG8_STAGE(PG8_SB(0, 1), cB + hstepB, voffB); PG8_STAGE(PG8_SA(0, 0), cA, voffA); PG8_STAGE(PG8_SA(0, 1), cA + hstepA, voffA);
        if (wr == 1) PG8_BAR;
        PG8_WAIT_V(2); PG8_BAR;
        PG8_STAGE(PG8_SB(1, 0), cB + kstep, voffB); PG8_STAGE(PG8_SA(1, 0), cA + kstep, voffA); PG8_STAGE(PG8_SB(1, 1), cB + hstepB + kstep, voffB);
        PG8_WAIT_V(6); PG8_BAR;
    } else {
        PG8_STAGE(PG8_SB(0, 0), cB, voffB); PG8_STAGE(PG8_SA(0, 0), cA, voffA); PG8_STAGE(PG8_SB(0, 1), cB + hstepB, voffB); PG8_STAGE(PG8_SA(0, 1), cA + hstepA, voffA);
        if (wr == 1) PG8_BAR;
        PG8_WAIT_V(4); PG8_BAR;
        PG8_STAGE(PG8_SB(1, 0), cB + kstep, voffB); PG8_STAGE(PG8_SA(1, 0), cA + kstep, voffA); PG8_STAGE(PG8_SB(1, 1), cB + hstepB + kstep, voffB);
        PG8_WAIT_V(6); PG8_BAR;
    }
    for (;;) {
        const bool has_next = S.next(ui + 1, nxt);
        const char* nA = has_next ? (const char*)g.A + (size_t)nxt.pm * tstepA + (size_t)nxt.sub * g.a_sub : cA; const char* nB = has_next ? (const char*)g.Bt + (size_t)nxt.pn * tstepB + (size_t)nxt.sub * g.b_sub : cB;
        for (int t = 0; t < nt; t += 2) {
            const bool last = (t == nt - 2);
            const char* a1 = cA + (size_t)(t + 1) * kstep;
            const char* a2 = last ? nA : cA + (size_t)(t + 2) * kstep; const char* b2 = last ? nB : cB + (size_t)(t + 2) * kstep;
            const char* a3 = a2 + kstep; const char* b3 = b2 + kstep;
            if (last && has_next) S.a_ready(nxt);
            if constexpr (SP2) {
            PG8_LDB(B0, 0, 0); PG8_LDB(B1, 0, 1); PG8_SCHED; PG8_LDA(At, 0, 0); PG8_STAGE(PG8_SA(1, 1), a1 + hstepA, voffA);
            PG8_WAIT_V(8); PG8_WAIT_L(0); PG8_BAR; PG8_MMA(0, 0, At, B0); PG8_MMA(0, 1, At, B1); PG8_BAR; PG8_SCHED;
            PG8_LDA(At, 0, 1); PG8_STAGE(PG8_SB(0, 0), b2, voffB); PG8_STAGE(PG8_SB(0, 1), b2 + hstepB, voffB); PG8_STAGE(PG8_SA(0, 0), a2, voffA);
            PG8_WAIT_V(8); PG8_WAIT_L(0); PG8_BAR; PG8_MMA(1, 0, At, B0); PG8_MMA(1, 1, At, B1); PG8_BAR; PG8_SCHED;
            PG8_LDB(B0, 1, 0); PG8_LDB(B1, 1, 1); PG8_SCHED; PG8_LDA(At, 1, 0); PG8_STAGE(PG8_SA(0, 1), a2 + hstepA, voffA);
            PG8_WAIT_V(8); PG8_WAIT_L(0); PG8_BAR; PG8_MMA(0, 0, At, B0); PG8_MMA(0, 1, At, B1); PG8_BAR; PG8_SCHED;
            PG8_LDA(At, 1, 1); PG8_STAGE(PG8_SB(1, 0), b3, voffB); PG8_STAGE(PG8_SB(1, 1), b3 + hstepB, voffB); PG8_STAGE(PG8_SA(1, 0), a3, voffA);
            PG8_WAIT_V(8); PG8_WAIT_L(0); PG8_BAR; PG8_MMA(1, 0, At, B0); PG8_MMA(1, 1, At, B1); PG8_BAR; PG8_SCHED;
            } else {
            PG8_LDB(B0, 0, 0); PG8_SCHED; PG8_LDA(At, 0, 0); PG8_STAGE(PG8_SA(1, 1), a1 + hstepA, voffA);
            PG8_WAIT_L(8); PG8_BAR; PG8_WAIT_L(0); PG8_MMA(0, 0, At, B0); PG8_BAR; PG8_SCHED;
            PG8_LDB(B1, 0, 1); PG8_STAGE(PG8_SB(0, 0), b2, voffB);
            PG8_BAR; PG8_WAIT_L(0); PG8_MMA(0, 1, At, B1); PG8_BAR;
            PG8_LDA(At, 0, 1); PG8_STAGE(PG8_SA(0, 0), a2, voffA);
            PG8_BAR; PG8_WAIT_L(0); PG8_MMA(1, 0, At, B0); PG8_BAR; PG8_SCHED;
            PG8_STAGE(PG8_SB(0, 1), b2 + hstepB, voffB);
            PG8_WAIT_V(6); PG8_BAR; PG8_MMA(1, 1, At, B1); PG8_BAR;
            PG8_LDB(B0, 1, 0); PG8_SCHED; PG8_LDA(At, 1, 0); PG8_STAGE(PG8_SA(0, 1), a2 + hstepA, voffA);
            PG8_WAIT_L(8); PG8_BAR; PG8_WAIT_L(0); PG8_MMA(0, 0, At, B0); PG8_BAR; PG8_SCHED;
            PG8_LDB(B1, 1, 1); PG8_STAGE(PG8_SB(1, 0), b3, voffB);
            PG8_BAR; PG8_WAIT_L(0); PG8_MMA(0, 1, At, B1); PG8_BAR;
            PG8_LDA(At, 1, 1); PG8_STAGE(PG8_SA(1, 0), a3, voffA);
            PG8_BAR; PG8_WAIT_L(0); PG8_MMA(1, 0, At, B0); PG8_BAR; PG8_SCHED;
            PG8_STAGE(PG8_SB(1, 1), b3 + hstepB, voffB);
            PG8_WAIT_V(6); PG8_BAR; PG8_MMA(1, 1, At, B1); PG8_BAR;
            }
        }
        if constexpr (ALIGN_EPI) { if (wr == 0) PG8_BAR; }
        if constexpr (!Epi::AFTER_DRAIN) { E(acc, cur, wr, wc, fr, fq); S.done(cur); }
        if (!has_next) break;
#pragma unroll
        for (int a = 0; a < 2; ++a)
#pragma unroll
            for (int b = 0; b < 2; ++b)
#pragma unroll
                for (int m = 0; m < 4; ++m)
#pragma unroll
                    for (int n = 0; n < 2; ++n) acc[a][b][m][n] = (f32x4){0.f, 0.f, 0.f, 0.f};
        cur = nxt; cA = nA; cB = nB; ++ui;
        if constexpr (ALIGN_EPI) { if (wr == 1) PG8_BAR; }
    }
    PG8_WAIT_V(0);
    if constexpr (!ALIGN_EPI) { if (wr == 0) PG8_BAR; }
    PG8_BAR;
    if constexpr (Epi::AFTER_DRAIN) { E.fused(acc, cur, wr, wc, fr, fq, lds, wid, lane); S.done(cur); }
#undef PG8_SA
#undef PG8_SB
#undef PG8_STAGE
#undef PG8_LDA
#undef PG8_LDB
#undef PG8_MMA
#undef PG8_WAIT_V
#undef PG8_WAIT_L
#undef PG8_BAR
#undef PG8_SCHED
}
}

typedef const __attribute__((address_space(4))) Args* KArgs;
__device__ __forceinline__ void make_ctx(Ctx& c) {
    KArgs ap = (KArgs)__builtin_amdgcn_kernarg_segment_ptr();
    asm volatile("" : "+s"(ap));
    c.x = ap->in[0]; c.norm_g = ap->in[1]; c.w_in = ap->in[2]; c.w_fourier = ap->in[3]; c.conv_w = ap->in[4]; c.conv_b = ap->in[5]; c.conv_ln_g = ap->in[6]; c.conv_ln_b = ap->in[7];
    c.w_pw = ap->in[8]; c.w_pool = ap->in[9]; c.pool_scale = ap->in[10]; c.w_branch = ap->in[11]; c.w_gate = ap->in[12]; c.b_gate = ap->in[13]; c.w_out = ap->in[14]; c.final_g = ap->in[15];
    c.out = ap->out;
    unsigned char* ws = ap->ws;
    c.WinT = (bf16_t*)(ws + WS_WIN); c.WgT = (bf16_t*)(ws + WS_WG); c.WbT = (bf16_t*)(ws + WS_WB); c.WoT = (bf16_t*)(ws + WS_WO); c.WfT = (bf16_t*)(ws + WS_WF); c.WpwT = (bf16_t*)(ws + WS_WPW); c.WpoolT = (bf16_t*)(ws + WS_WPOOL);
    c.TW = (float2*)(ws + WS_TW); c.RC = (float*)(ws + WS_RC); c.RS = (float*)(ws + WS_RS); c.RH = (_Float16*)(ws + WS_RH);
    c.H = (bf16_t*)(ws + WS_H); c.Z = (bf16_t*)(ws + WS_Z); c.P = (bf16_t*)(ws + WS_P); c.FY = (unsigned*)(ws + WS_FY); c.LSE = (float*)(ws + WS_LSE);
}
constexpr int NPHASES = 1 + 7 * DEPTH;

#define XB_TMO      128
#define XB_XCNT(j)  (256  + 64 * (j))
#define XB_XSUB(j)  (1280 + 64 * (j))
#define XB_XGEN(j)  (2304 + 64 * (j))
#define XB_TOP      3328
#define XB_TOPGEN   3392
#define XCD_BAR_WORDS 3456
#define XB_SPIN_CAP (1u << 18)
#define LAS __attribute__((address_space(3)))

__device__ __forceinline__ unsigned xb_ld(unsigned* p)              { return __hip_atomic_load(p, __ATOMIC_RELAXED, __HIP_MEMORY_SCOPE_AGENT); }
__device__ __forceinline__ unsigned xb_add(unsigned* p, unsigned v) { return __hip_atomic_fetch_add(p, v, __ATOMIC_RELAXED, __HIP_MEMORY_SCOPE_AGENT); }
__device__ __forceinline__ unsigned xb_xcc_id() { return (unsigned)__builtin_amdgcn_s_getreg((3 << 11) | 20) & 0xFu; }
#define XB_SPIN(cond, bar) do { unsigned _sp = 0; while (cond) { __builtin_amdgcn_s_sleep(1); \
    if ((++_sp & 255u) == 0u) { if (xb_ld(&(bar)[XB_TMO])) break; if (_sp > XB_SPIN_CAP) { atomicAdd(&(bar)[XB_TMO], 1u); break; } } } } while (0)

struct XcdBarrier {
    unsigned* bar; unsigned x;
    volatile LAS unsigned* st;
};

__device__ __forceinline__ XcdBarrier xcd_barrier_post(unsigned* bar, volatile LAS unsigned* st) {
    XcdBarrier b; b.bar = bar; b.x = xb_xcc_id(); b.st = st;
    if (threadIdx.x == 0) (void)xb_add(&bar[XB_XCNT(b.x)], 1u);
    return b;
}
__device__ __forceinline__ void xcd_barrier_complete(unsigned* bar, unsigned x, unsigned& nloc, unsigned& nx) {
    const unsigned G = gridDim.x * gridDim.y * gridDim.z;
    unsigned sum, cnt, mine, sp = 0u;
    for (;;) {
        sum = 0u; cnt = 0u; mine = 0u;
#pragma unroll
        for (unsigned j = 0; j < 16; ++j) { const unsigned c = xb_ld(&bar[XB_XCNT(j)]); sum += c; cnt += (c > 0u) ? 1u : 0u; mine = (j == x) ? c : mine; }
        if (sum == G) break;
        __builtin_amdgcn_s_sleep(1);
        if ((++sp & 255u) == 0u) { if (xb_ld(&bar[XB_TMO])) break; if (sp > XB_SPIN_CAP) { atomicAdd(&bar[XB_TMO], 1u); break; } }
    }
    nloc = mine > 0u ? mine : 1u; nx = cnt > 0u ? cnt : 1u;
}

__device__ __forceinline__ void xcd_barrier(const XcdBarrier& b) {
    asm volatile("s_waitcnt vmcnt(0)" ::: "memory");
    __syncthreads();
    if (threadIdx.x == 0) {
        unsigned* bar = b.bar;
        __builtin_amdgcn_s_waitcnt(0);
        unsigned nloc = b.st[0], nx = b.st[1];
        if (nloc == 0u) { xcd_barrier_complete(bar, b.x, nloc, nx); b.st[0] = nloc; b.st[1] = nx; }
        const unsigned old = xb_add(&bar[XB_XSUB(b.x)], 1u);
        const unsigned gen = old / nloc;
        if (old + 1u == (gen + 1u) * nloc) {
            __builtin_amdgcn_fence(__ATOMIC_RELEASE, "agent");
            asm volatile("s_waitcnt vmcnt(0)" ::: "memory");
            const unsigned og = xb_add(&bar[XB_TOP], 1u);
            const unsigned tg = og / nx;
            if (og + 1u == (tg + 1u) * nx) xb_add(&bar[XB_TOPGEN], 1u);
            else XB_SPIN(xb_ld(&bar[XB_TOPGEN]) == tg, bar);
            __builtin_amdgcn_fence(__ATOMIC_ACQUIRE, "agent");
            xb_add(&bar[XB_XGEN(b.x)], 1u);
            asm volatile("s_waitcnt vmcnt(0)" ::: "memory");
        } else {
            XB_SPIN(xb_ld(&bar[XB_XGEN(b.x)]) == gen, bar);
            __builtin_amdgcn_fence(__ATOMIC_ACQUIRE, "agent");
            asm volatile("s_waitcnt vmcnt(0)" ::: "memory");
        }
    }
    __syncthreads();
}


template <int L, int Q>
__device__ __forceinline__ void layer_phase(unsigned char* lds_raw) {
    float* lds = (float*)lds_raw;
    constexpr int l = L;
    constexpr int nrep = (Q == REPQ && (Q != 5 || L == 0)) ? 2 : 1;
#pragma unroll 1
    for (int rep = 0; rep < nrep; ++rep) {
        Ctx c; make_ctx(c);
        const bool st_ = (rep == 0);
        if constexpr (Q == 0) {
            typedef pg8::GemmT<DM, DM, DM, 0, 0> GT; GT g{c.H, c.WinT + (size_t)l * DIN * DM}; pg8::StaticOrder S; S.init(MT, DIN, (int)gridDim.x, BIDX);
            pg8::EpiBf16<0> E{c.Z, DIN, nullptr, 0, 0, 1.f};
            pg8::gemm_phase<pg8::EpiBf16<0>, pg8::StaticOrder, GT, true, true>((PG8_LAS unsigned char*)lds_raw, g, S, E);
        } else if constexpr (Q == 1) {
            constexpr int NF = NB * 4 * 64, NTK = NB * 64, NAT = NB * 192;
            if (rep == 0 || (REPSUB & 1)) attn_phase_mfma(c, lds_raw, st_);
            __builtin_amdgcn_sched_barrier(0);
            if (rep == 0 || (REPSUB & 2)) for (int u = BIDX; u < NTK; u += gridDim.x) { if (NEW_TOK) tok_unit_mfma(c, l, u, lds_raw); else tok_unit(c, l, u, lds); }
            __builtin_amdgcn_sched_barrier(0);
            if (rep == 0 || (REPSUB & 4)) { if (NEW_FFT1) fft1_phase_mfma(c); else for (int u = BIDX; u < NF; u += gridDim.x) fft1_unit(c, u, lds); }
        } else if constexpr (Q == 2) {
            if (NEW_FFT2) fft2_phase_mfma(c, l, lds_raw); else for (int u = BIDX; u < NB * 64; u += gridDim.x) fft2_unit(c, l, u, lds);
            phase_combine(c);
        } else if constexpr (Q == 3) {
            typedef pg8::GemmT<DM, DM, DM, 0, 0> GT; GT g{c.H, c.WgT + (size_t)l * 4096 * DM}; pg8::StaticOrder S; S.init(MT, 4096, (int)gridDim.x, BIDX);
            pg8::EpiGateU8 E{(unsigned char*)c.Z, c.b_gate + (size_t)l * 4096};
            pg8::gemm_phase<pg8::EpiGateU8, pg8::StaticOrder, GT, true, true>((PG8_LAS unsigned char*)lds_raw, g, S, E);
        } else if constexpr (Q == 4) {
            typedef pg8::GemmT<DM, 256, 256, 512, 1024 * 256 * 2> GT; GT g{c.P, c.WbT + (size_t)l * 4 * 1024 * 256}; pg8::MergeOrder S; S.init(MT, DM, (int)gridDim.x, BIDX);
            pg8::EpiMerge E{(const unsigned char*)c.Z, c.H};
            pg8::gemm_phase<pg8::EpiMerge, pg8::MergeOrder, GT, true, true>((PG8_LAS unsigned char*)lds_raw, g, S, E);
        } else if constexpr (Q == 5) {
            typedef pg8::GemmT<DM, DM, DM, 0, 0> GT; GT g{c.H, c.WoT + (size_t)l * DM * DM}; pg8::StaticOrder S; S.init(MT, DM, (int)gridDim.x, BIDX);
            pg8::EpiOutF32 E{(l == 0) ? c.x : c.out, c.out};
            pg8::gemm_phase<pg8::EpiOutF32, pg8::StaticOrder, GT, true, true>((PG8_LAS unsigned char*)lds_raw, g, S, E);
        } else {
            if (l + 1 < DEPTH) phase_norm_bf16(c.out, c.norm_g + (size_t)(l + 1) * DM, c.H);
            else phase_norm_final(c.out, c.final_g);
        }
        if (rep + 1 < nrep) __syncthreads();
    }
}

__global__ void __launch_bounds__(NTHREADS, 2) fwd_kernel(Args a) {
    extern __shared__ __attribute__((aligned(16))) unsigned char lds_raw[];
    const int lo = a.ph_lo, hi = a.ph_hi;
    volatile LAS unsigned* bst = (volatile LAS unsigned*)(lds_raw + LDS_BYTES - 16);
    if (threadIdx.x < 4) bst[threadIdx.x] = 0u;
    __syncthreads();
    XcdBarrier bar = xcd_barrier_post((unsigned*)(a.ws + WS_CTL), bst);
#define RUN_PHASE(k, ...) do { if (lo <= (k) && (k) < hi) { __VA_ARGS__; if ((k) + 1 < hi) xcd_barrier(bar); } } while (0)
    RUN_PHASE(0, { Ctx c; make_ctx(c); phase_pre(c, (float*)lds_raw); if (REPQ == 7) { __syncthreads(); phase_pre(c, (float*)lds_raw); } phase_norm_bf16(c.x, c.norm_g, c.H); if (REPQ == 8) phase_norm_bf16(c.x, c.norm_g, c.H); });
    RUN_PHASE(1, layer_phase<0, 0>(lds_raw));
    RUN_PHASE(2, layer_phase<0, 1>(lds_raw));
    RUN_PHASE(3, layer_phase<0, 2>(lds_raw));
    RUN_PHASE(4, layer_phase<0, 3>(lds_raw));
    RUN_PHASE(5, layer_phase<0, 4>(lds_raw));
    RUN_PHASE(6, layer_phase<0, 5>(lds_raw));
    RUN_PHASE(7, layer_phase<0, 6>(lds_raw));
    RUN_PHASE(8, layer_phase<1, 0>(lds_raw));
    RUN_PHASE(9, layer_phase<1, 1>(lds_raw));
    RUN_PHASE(10, layer_phase<1, 2>(lds_raw));
    RUN_PHASE(11, layer_phase<1, 3>(lds_raw));
    RUN_PHASE(12, layer_phase<1, 4>(lds_raw));
    RUN_PHASE(13, layer_phase<1, 5>(lds_raw));
    RUN_PHASE(14, layer_phase<1, 6>(lds_raw));
#undef RUN_PHASE
}

extern "C" void kernel_launch(void* const* d_in, const int* in_sizes, int n_in, void* d_out, int out_size, void* d_ws, size_t ws_size, hipStream_t stream) {
    static int grid = 0;
    if (grid == 0) {
        if (n_in != 16 || in_sizes[0] != MT * DM || out_size != MT * DM || ws_size < WS_END) {
            fprintf(stderr, "kernel_launch: unexpected shapes: n_in %d in0 %d out %d ws %zu (need %zu)\n", n_in, n_in > 0 ? in_sizes[0] : -1, out_size, ws_size, (size_t)WS_END);
            grid = -1; return;
        }
        int dev = 0, cus = 0, per_cu = 0;
        hipGetDevice(&dev); hipDeviceGetAttribute(&cus, hipDeviceAttributeMultiprocessorCount, dev);
        if (hipFuncSetAttribute((const void*)fwd_kernel, hipFuncAttributeMaxDynamicSharedMemorySize, LDS_BYTES) != hipSuccess) { fprintf(stderr, "kernel_launch: hipFuncSetAttribute failed\n"); grid = -1; return; }
        hipOccupancyMaxActiveBlocksPerMultiprocessor(&per_cu, (const void*)fwd_kernel, NTHREADS, LDS_BYTES);
        if (per_cu < 1) { fprintf(stderr, "kernel_launch: occupancy query says %d blocks/CU\n", per_cu); per_cu = 1; }
        (void)hipGetLastError();
        grid = cus;
    }
    if (grid < 0) return;
    if (hipMemsetAsync((char*)d_ws + WS_CTL, 0, 16384, stream) != hipSuccess) { fprintf(stderr, "kernel_launch: hipMemsetAsync failed\n"); return; }
    Args a{};
    for (int i = 0; i < 16; ++i) a.in[i] = (const float*)d_in[i];
    a.out = (float*)d_out; a.ws = (unsigned char*)d_ws;
#if ONE_LAUNCH
    a.ph_lo = 0; a.ph_hi = NPHASES;
    void* args[] = {&a};
    hipError_t e = hipLaunchCooperativeKernel((const void*)fwd_kernel, dim3(grid), dim3(NTHREADS), args, LDS_BYTES, stream);
    if (e != hipSuccess) fprintf(stderr, "kernel_launch: cooperative launch failed: %s (grid %d)\n", hipGetErrorString(e), grid);
#else
    for (int ph = 0; ph < NPHASES; ++ph) {
        a.ph_lo = ph; a.ph_hi = ph + 1;
        hipLaunchKernelGGL(fwd_kernel, dim3(grid), dim3(NTHREADS), LDS_BYTES, stream, a);
    }
#endif
}
```

```cpp
#include <hip/hip_runtime.h>
#include <hip/hip_cooperative_groups.h>
#include <cstdio>
#include <cstdint>
namespace cg = cooperative_groups;

#ifndef ONE_LAUNCH
#define ONE_LAUNCH 1
#endif

typedef unsigned short bf16_t;
typedef short bf16x8 __attribute__((ext_vector_type(8)));
typedef float f32x4 __attribute__((ext_vector_type(4)));
typedef float f32x2 __attribute__((ext_vector_type(2)));
typedef unsigned u32x4 __attribute__((ext_vector_type(4)));
typedef unsigned u32x2 __attribute__((ext_vector_type(2)));

constexpr int NB = 8, SEQ = 4096, DM = 1024, MT = NB * SEQ, DIN = 4352, DEPTH = 2;
constexpr int ZA = 0, ZB = 256, ZQ = 768, ZK = 1536, ZV = 2304, ZD = 3072, ZG = 3328;
constexpr int NTHREADS = 512, NWAVES = 8;
constexpr int LDS_BYTES = 147456;

constexpr size_t WS_CTL = 0;
constexpr size_t WS_WIN = 65536;
constexpr size_t WS_WG = WS_WIN + (size_t)DEPTH * DIN * DM * 2;
constexpr size_t WS_WB = WS_WG + (size_t)DEPTH * 4096 * DM * 2;
constexpr size_t WS_WO = WS_WB + (size_t)DEPTH * 4 * 1024 * 256 * 2;
constexpr size_t WS_WF = WS_WO + (size_t)DEPTH * DM * DM * 2;
constexpr size_t WS_WPW = WS_WF + (size_t)DEPTH * 65536 * 2;
constexpr size_t WS_WPOOL = WS_WPW + (size_t)DEPTH * 65536 * 2;
constexpr size_t WS_TW = WS_WPOOL + (size_t)DEPTH * 4 * 4096 * 2;
constexpr size_t WS_RC = WS_TW + 4096 * 8;
constexpr size_t WS_RS = WS_RC + 4096 * 32 * 4;
constexpr size_t WS_RH = WS_RS + 4096 * 32 * 4;
constexpr size_t WS_H = WS_RH + 4096 * 64 * 2;
constexpr size_t WS_Z = WS_H + (size_t)MT * DM * 2;
constexpr size_t WS_P = WS_Z + (size_t)MT * DIN * 2;
constexpr size_t WS_FY = WS_P + (size_t)MT * DM * 2;
constexpr size_t WS_LSE = WS_FY + (size_t)NB * 4 * 64 * 64 * 64 * 4;
constexpr size_t WS_SS = WS_LSE + (size_t)3 * MT * 4 * 4;
constexpr size_t WS_AM = WS_SS + (size_t)DEPTH * MT * 4;
constexpr size_t WS_SH = WS_AM + (size_t)MT * 4;
constexpr size_t WS_SW = WS_SH + (size_t)MT * 4;
constexpr size_t WS_SWI = WS_SW + (size_t)DEPTH * 4096 * 4;
constexpr size_t WS_H8 = WS_SWI + (size_t)DEPTH * DIN * 4;
constexpr size_t WS_END = WS_H8 + (size_t)MT * DM;
constexpr size_t WS_FF = WS_CTL + 49152;
constexpr size_t WS_CNT = WS_CTL + 16384;

struct Args { const float* in[16]; float* out; unsigned char* ws; int ph_lo, ph_hi; };

__device__ __forceinline__ float bf2f(bf16_t v) { return __uint_as_float((unsigned)v << 16); }
__device__ __forceinline__ float bflo(unsigned w) { return __uint_as_float(w << 16); }
__device__ __forceinline__ float bfhi(unsigned w) { return __uint_as_float(w & 0xffff0000u); }
__device__ __forceinline__ bf16_t f2bf(float f) { unsigned u = __float_as_uint(f); u += 0x7fffu + ((u >> 16) & 1u); return (bf16_t)(u >> 16); }
typedef float f32x2n __attribute__((ext_vector_type(2)));
typedef __bf16 bf16x2n __attribute__((ext_vector_type(2)));
__device__ __forceinline__ unsigned pk2(float lo, float hi) { const f32x2n v = {lo, hi}; return __builtin_bit_cast(unsigned, __builtin_convertvector(v, bf16x2n)); }
__device__ __forceinline__ float sigmoidf_(float x) { return __builtin_amdgcn_rcpf(1.f + __builtin_amdgcn_exp2f(x * -1.44269504f)); }
__device__ __forceinline__ float siluf_(float x) { return x * sigmoidf_(x); }
__device__ __forceinline__ int opq(int v) { asm volatile("" : "+v"(v)); return v; }
#define TIDX opq((int)threadIdx.x)
__device__ __forceinline__ int opqs(int v) { asm volatile("" : "+s"(v)); return v; }
#define BIDX opqs((int)blockIdx.x)
__device__ __forceinline__ float row16_sum(float v) {
    v += __builtin_bit_cast(float, __builtin_amdgcn_update_dpp(0, __builtin_bit_cast(int, v), 0x128, 0xf, 0xf, false));
    v += __builtin_bit_cast(float, __builtin_amdgcn_update_dpp(0, __builtin_bit_cast(int, v), 0x124, 0xf, 0xf, false));
    v += __builtin_bit_cast(float, __builtin_amdgcn_update_dpp(0, __builtin_bit_cast(int, v), 0x122, 0xf, 0xf, false));
    v += __builtin_bit_cast(float, __builtin_amdgcn_update_dpp(0, __builtin_bit_cast(int, v), 0x121, 0xf, 0xf, false));
    return v;
}
__device__ __forceinline__ float wave_sum(float v) {
    v = row16_sum(v);
    const int vi = __builtin_bit_cast(int, v);
    return (__builtin_bit_cast(float, __builtin_amdgcn_readlane(vi, 0)) + __builtin_bit_cast(float, __builtin_amdgcn_readlane(vi, 16))) +
           (__builtin_bit_cast(float, __builtin_amdgcn_readlane(vi, 32)) + __builtin_bit_cast(float, __builtin_amdgcn_readlane(vi, 48)));
}


typedef float f32x16g __attribute__((ext_vector_type(16)));
typedef int i32x4 __attribute__((ext_vector_type(4)));
__device__ __forceinline__ f32x4 mfma16i8_g(bf16x8 a, bf16x8 b, f32x4 c) {
    i32x4 d = __builtin_amdgcn_mfma_i32_16x16x64_i8(__builtin_bit_cast(i32x4, a), __builtin_bit_cast(i32x4, b), __builtin_bit_cast(i32x4, c), 0, 0, 0);
    asm volatile("" :: "v"(a), "v"(b), "v"(d));
    return __builtin_bit_cast(f32x4, d);
}
__device__ __forceinline__ f32x4 mfma16_g(bf16x8 a, bf16x8 b, f32x4 c) {
    f32x4 d = __builtin_amdgcn_mfma_f32_16x16x32_bf16(a, b, c, 0, 0, 0);
    asm volatile("" :: "v"(a), "v"(b), "v"(d));
    return d;
}
__device__ __forceinline__ f32x16g mfma32_g(bf16x8 a, bf16x8 b, f32x16g c) {
    f32x16g d = __builtin_amdgcn_mfma_f32_32x32x16_bf16(a, b, c, 0, 0, 0);
    asm volatile("" :: "v"(a), "v"(b), "v"(d));
    return d;
}

struct Ctx {
    const float *x, *norm_g, *w_in, *w_fourier, *conv_w, *conv_b, *conv_ln_g, *conv_ln_b, *w_pw, *w_pool, *pool_scale, *w_branch, *w_gate, *b_gate, *w_out, *final_g;
    float* out;
    bf16_t *WinT, *WgT, *WbT, *WoT, *WfT, *WpwT, *WpoolT, *H, *Z, *P;
    float2* TW; float *RC, *RS, *LSE, *SS; unsigned* FY; unsigned* CNT; _Float16* RH; unsigned char* FF; unsigned* AM; float *SH, *SW; signed char *H8, *Wg8, *Win8; float* SWI;
};

constexpr int TR_WIN = (DM / 64) * (DIN / 64), TR_PER_LAYER = TR_WIN + 4 * 64 + 256 + 16 + 16 + 4;
struct TrItem { const float* W; bf16_t* WT; int K, N, kb, nb; };
__device__ __forceinline__ TrItem tr_decode(const Ctx& c, int G) {
    TrItem it; const int l = G / TR_PER_LAYER; int r = G % TR_PER_LAYER;
    if (r < TR_WIN) { it.W = c.w_in + (size_t)l * DM * DIN; it.WT = c.WinT + (size_t)l * DIN * DM; it.K = DM; it.N = DIN; }
    else { r -= TR_WIN;
        {
            if (r < 256) { const int n = r >> 6; r &= 63; it.W = c.w_branch + (size_t)(l * 4 + n) * 256 * DM; it.WT = c.WbT + (size_t)(l * 4 + n) * 1024 * 256; it.K = 256; it.N = DM; }
            else { r -= 256;
                if (r < 256) { it.W = c.w_out + (size_t)l * DM * DM; it.WT = c.WoT + (size_t)l * DM * DM; it.K = DM; it.N = DM; }
                else { r -= 256;
                    if (r < 16) { it.W = c.w_fourier + (size_t)l * 65536; it.WT = c.WfT + (size_t)l * 65536; it.K = 256; it.N = 256; }
                    else { r -= 16;
                        if (r < 16) { it.W = c.w_pw + (size_t)l * 65536; it.WT = c.WpwT + (size_t)l * 65536; it.K = 256; it.N = 256; }
                        else { r -= 16; it.W = c.w_pool + (size_t)(l * 4 + r) * 4096; it.WT = c.WpoolT + (size_t)(l * 4 + r) * 4096; it.K = 64; it.N = 64; r = 0; } } } } } }
    const int nnb = it.N / 64; it.kb = r / nnb; it.nb = r % nnb; return it;
}
__device__ __forceinline__ void convert_i8_strip(const float* W, int ldw, signed char* WT, float* SWp, float* scr) {
    const int t = TIDX, kg = t >> 6, nn = t & 63;
    float am = 0.f;
#pragma unroll 1
    for (int i0 = 0; i0 < 128; i0 += 64) {
        float v[64];
#pragma unroll
        for (int i = 0; i < 64; ++i) v[i] = W[(size_t)(kg + 8 * (i0 + i)) * ldw + nn];
#pragma unroll
        for (int i = 0; i < 64; ++i) am = fmaxf(am, fabsf(v[i]));
    }
    scr[kg * 64 + nn] = am;
    __syncthreads();
    if (t < 64) { float m = scr[t];
#pragma unroll
        for (int k = 1; k < 8; ++k) m = fmaxf(m, scr[k * 64 + t]);
        scr[512 + t] = m; SWp[t] = m * (1.f / 127.f); }
    __syncthreads();
    const float cm = scr[512 + nn], inv = cm > 0.f ? 127.f / cm : 0.f;
    __syncthreads();
    float r[8];
#pragma unroll
    for (int i = 0; i < 8; ++i) r[i] = W[(size_t)(kg + 8 * i) * ldw + nn];
#pragma unroll 1
    for (int kb = 0; kb < 16; ++kb) {
#pragma unroll
        for (int i = 0; i < 8; ++i) scr[1024 + (kg + 8 * i) * 65 + nn] = r[i] * inv + 12582912.0f;
        __syncthreads();
        if (kb + 1 < 16) {
#pragma unroll
            for (int i = 0; i < 8; ++i) r[i] = W[(size_t)((kb + 1) * 64 + kg + 8 * i) * ldw + nn]; }
        { const int on = t >> 3, kc = t & 7;
          const unsigned* sp = (const unsigned*)(scr + 1024 + (8 * kc) * 65 + on);
          u32x2 o; o.x = (sp[0] & 0xffu) | ((sp[65] & 0xffu) << 8) | ((sp[2 * 65] & 0xffu) << 16) | (sp[3 * 65] << 24);
          o.y = (sp[4 * 65] & 0xffu) | ((sp[5 * 65] & 0xffu) << 8) | ((sp[6 * 65] & 0xffu) << 16) | (sp[7 * 65] << 24);
          *(u32x2*)(WT + (size_t)on * DM + kb * 64 + 8 * kc) = o; }
        __syncthreads();
    }
}
__device__ __forceinline__ void convert_strip(const Ctx& c, float* scr, int l, int s) {
    if (s < 64) { const int n = s >> 4, cs = (s & 15) * 64;
        convert_i8_strip(c.w_gate + (size_t)(l * 4 + n) * DM * DM + cs, DM, c.Wg8 + ((size_t)l * 4096 + n * 1024 + cs) * DM, c.SW + (size_t)l * 4096 + n * 1024 + cs, scr); }
    else { const int cs = (s - 64) * 64;
        convert_i8_strip(c.w_in + (size_t)l * DM * DIN + cs, DIN, c.Win8 + ((size_t)l * DIN + cs) * DM, c.SWI + (size_t)l * DIN + cs, scr); }
}
__device__ __forceinline__ void convert_items(const Ctx& c, float* scr, int g_lo, int g_hi, int first, int stride) {
    const int t = TIDX, kk0 = t >> 6, nn = t & 63;
    int G = g_lo + first;
    if (G >= g_hi) return;
    float r[8];
    TrItem it = tr_decode(c, G);
#pragma unroll
    for (int i = 0; i < 8; ++i) r[i] = it.W[(size_t)(it.kb * 64 + kk0 + 8 * i) * it.N + it.nb * 64 + nn];
    for (;;) {
#pragma unroll
        for (int i = 0; i < 8; ++i) scr[(kk0 + 8 * i) * 65 + nn] = r[i];
        __syncthreads();
        const int Gn = G + stride; const bool more = Gn < g_hi;
        TrItem nx = it;
        if (more) { nx = tr_decode(c, Gn);
#pragma unroll
            for (int i = 0; i < 8; ++i) r[i] = nx.W[(size_t)(nx.kb * 64 + kk0 + 8 * i) * nx.N + nx.nb * 64 + nn]; }
        { const int on = t >> 3, kc = t & 7;
          const float* sp = scr + (8 * kc) * 65 + on;
          u32x4 o; o.x = pk2(sp[0], sp[65]); o.y = pk2(sp[2 * 65], sp[3 * 65]); o.z = pk2(sp[4 * 65], sp[5 * 65]); o.w = pk2(sp[6 * 65], sp[7 * 65]);
          *(u32x4*)(it.WT + (size_t)(it.nb * 64 + on) * it.K + it.kb * 64 + 8 * kc) = o; }
        __syncthreads();
        if (!more) break;
        it = nx; G = Gn;
    }
}
__device__ __forceinline__ void phase_pre(const Ctx& c, float* lds) {
    for (int s_ = BIDX; s_ < DIN / 64; s_ += gridDim.x) convert_strip(c, lds, 0, 64 + s_);
    const int gt = BIDX * NTHREADS + TIDX, NT = gridDim.x * NTHREADS;
    for (int i = gt; i < DEPTH * MT; i += NT) c.SS[i] = 0.f;
    for (int i = gt; i < MT; i += NT) c.AM[i] = 0u;
    if (gt < 4) ((unsigned*)c.FF)[gt] = 0xffffffffu;
    for (int i = gt; i < DEPTH * 128 * 16; i += NT) c.CNT[i] = 0u;
    for (int i = gt; i < 4096; i += NT) { float s, co; sincospif((float)i / 2048.f, &s, &co); c.TW[i] = make_float2(co, s); }
    for (int i = gt; i < 4096 * 32; i += NT) {
        const int pos = i >> 5, k = i & 31;
        const float inv = exp2f(-(float)k * (13.287712379549449f / 32.0f));
        double tq = (double)pos * (double)inv * 0.3183098861837907;
        tq -= 2.0 * rint(tq * 0.5);
        float s, co; sincospif((float)tq, &s, &co);
        c.RH[pos * 64 + k] = (_Float16)co; c.RH[pos * 64 + 32 + k] = (_Float16)s;
    }
}

__device__ __forceinline__ float row16_max(float v) {
    v = fmaxf(v, __builtin_bit_cast(float, __builtin_amdgcn_update_dpp(0, __builtin_bit_cast(int, v), 0x128, 0xf, 0xf, false)));
    v = fmaxf(v, __builtin_bit_cast(float, __builtin_amdgcn_update_dpp(0, __builtin_bit_cast(int, v), 0x124, 0xf, 0xf, false)));
    v = fmaxf(v, __builtin_bit_cast(float, __builtin_amdgcn_update_dpp(0, __builtin_bit_cast(int, v), 0x122, 0xf, 0xf, false)));
    v = fmaxf(v, __builtin_bit_cast(float, __builtin_amdgcn_update_dpp(0, __builtin_bit_cast(int, v), 0x121, 0xf, 0xf, false)));
    return v;
}
__device__ __forceinline__ float wave_max(float v) {
    v = row16_max(v);
    const int vi = __builtin_bit_cast(int, v);
    return fmaxf(fmaxf(__builtin_bit_cast(float, __builtin_amdgcn_readlane(vi, 0)), __builtin_bit_cast(float, __builtin_amdgcn_readlane(vi, 16))),
                 fmaxf(__builtin_bit_cast(float, __builtin_amdgcn_readlane(vi, 32)), __builtin_bit_cast(float, __builtin_amdgcn_readlane(vi, 48))));
}
__device__ __forceinline__ unsigned q8x4(f32x4 y, float inv) {
    const f32x4 m = y * inv + 12582912.0f;
    return (__float_as_uint(m[0]) & 0xffu) | ((__float_as_uint(m[1]) & 0xffu) << 8) | ((__float_as_uint(m[2]) & 0xffu) << 16) | (__float_as_uint(m[3]) << 24);
}
__device__ __forceinline__ void phase_norm_bf16(const float* xin, const float* g, bf16_t* H, signed char* H8, float* SH) {
    const int tid_ = TIDX; const int lane = tid_ & 63, wave = tid_ >> 6;
    const int gw = BIDX * NWAVES + wave, NGW = gridDim.x * NWAVES;
    f32x4 gv[4];
#pragma unroll
    for (int j = 0; j < 4; ++j) gv[j] = *(const f32x4*)(g + 4 * (lane + 64 * j));
    for (int m = gw; m < MT; m += 2 * NGW) {
        const int m2 = (m + NGW < MT) ? m + NGW : m;
        const f32x4* xr = (const f32x4*)(xin + (size_t)m * DM); const f32x4* xr2 = (const f32x4*)(xin + (size_t)m2 * DM);
        f32x4 v[4], w[4]; float s = 0.f, s2 = 0.f;
#pragma unroll
        for (int j = 0; j < 4; ++j) { v[j] = xr[lane + 64 * j]; w[j] = xr2[lane + 64 * j]; }
#pragma unroll
        for (int j = 0; j < 4; ++j) { s += v[j].x * v[j].x + v[j].y * v[j].y + v[j].z * v[j].z + v[j].w * v[j].w; s2 += w[j].x * w[j].x + w[j].y * w[j].y + w[j].z * w[j].z + w[j].w * w[j].w; }
        const float rstd = 1.0f / sqrtf(wave_sum(s) * (1.f / DM) + 1e-6f), rstd2 = 1.0f / sqrtf(wave_sum(s2) * (1.f / DM) + 1e-6f);
        float a1 = 0.f, a2 = 0.f;
#pragma unroll
        for (int j = 0; j < 4; ++j) { v[j] = v[j] * rstd * gv[j]; w[j] = w[j] * rstd2 * gv[j];
            a1 = fmaxf(a1, fmaxf(fmaxf(fabsf(v[j].x), fabsf(v[j].y)), fmaxf(fabsf(v[j].z), fabsf(v[j].w)))); a2 = fmaxf(a2, fmaxf(fmaxf(fabsf(w[j].x), fabsf(w[j].y)), fmaxf(fabsf(w[j].z), fabsf(w[j].w)))); }
        a1 = wave_max(a1); a2 = wave_max(a2);
        const float i1 = a1 > 0.f ? 127.f / a1 : 0.f, i2 = a2 > 0.f ? 127.f / a2 : 0.f;
        unsigned* q = (unsigned*)(H8 + (size_t)m * DM); unsigned* q2 = (unsigned*)(H8 + (size_t)m2 * DM);
#pragma unroll
        for (int j = 0; j < 4; ++j) q[lane + 64 * j] = q8x4(v[j], i1);
#pragma unroll
        for (int j = 0; j < 4; ++j) q2[lane + 64 * j] = q8x4(w[j], i2);
        if (lane == 0) { SH[m] = a1 * (1.f / 127.f); SH[m2] = a2 * (1.f / 127.f); }
    }
}
__device__ __forceinline__ void phase_norm_final(float* xio, const float* g) {
    const int tid_ = TIDX; const int lane = tid_ & 63, wave = tid_ >> 6;
    const int gw = BIDX * NWAVES + wave, NGW = gridDim.x * NWAVES;
    f32x4 gv[4];
#pragma unroll
    for (int j = 0; j < 4; ++j) gv[j] = *(const f32x4*)(g + 4 * (lane + 64 * j));
    for (int m = gw; m < MT; m += NGW) {
        f32x4* xr = (f32x4*)(xio + (size_t)m * DM);
        f32x4 v[4]; float s = 0.f;
#pragma unroll
        for (int j = 0; j < 4; ++j) { v[j] = xr[lane + 64 * j]; s += v[j].x * v[j].x + v[j].y * v[j].y + v[j].z * v[j].z + v[j].w * v[j].w; }
        const float rstd = 1.0f / sqrtf(wave_sum(s) * (1.f / DM) + 1e-6f);
#pragma unroll
        for (int j = 0; j < 4; ++j) xr[lane + 64 * j] = v[j] * rstd * gv[j];
    }
}

typedef float f32x16 __attribute__((ext_vector_type(16)));
typedef _Float16 h16x8 __attribute__((ext_vector_type(8)));
#define LASP __attribute__((address_space(3)))
__device__ __forceinline__ unsigned cvtpk(float lo, float hi) { return pk2(lo, hi); }
struct AttnU { int b, g, hI, d, L, r, hh, i0; };
__device__ __forceinline__ AttnU attn_decode(int u) {
    AttnU a; a.b = u / 192; const int rem = u % 192; a.g = rem >> 6; const int rem2 = rem & 63; a.hI = rem2 >> 4; const int rqb = rem2 & 15;
    a.d = 1 << (2 * a.g); a.L = SEQ / a.d; const int nqb = a.L / 256; a.r = rqb / nqb; a.hh = a.g * 4 + a.hI; a.i0 = (rqb % nqb) * 256; return a;
}
__device__ __forceinline__ void attn_phase_mfma(const Ctx& c, unsigned char* lds_raw, bool do_store) {
    LASP unsigned char* Kt = (LASP unsigned char*)lds_raw;
    LASP unsigned* Vt = (LASP unsigned*)(lds_raw + 49152);
    const int t = TIDX, lane = t & 63, wave = __builtin_amdgcn_readfirstlane(t >> 6), rq = lane & 31, h = lane >> 5;
    constexpr int NAT = NB * 192;
    const int G = gridDim.x;
    int u = BIDX;
    if (u >= NAT) return;
    u32x4 ka[3], kb2[3], va[3], vb[3], qn[4];
    h16x8 tq[4], tkc[3], tks[3];
#define ATT_PREFETCH(uu_) do { const AttnU A_ = attn_decode(uu_); \
        { const bf16_t* qr_ = c.Z + ((size_t)A_.b * SEQ + A_.r + A_.d * (A_.i0 + 32 * wave + rq)) * DIN + ZQ + A_.hh * 64 + 8 * h; \
          qn[0] = *(const u32x4*)qr_; qn[1] = *(const u32x4*)(qr_ + 16); qn[2] = *(const u32x4*)(qr_ + 32); qn[3] = *(const u32x4*)(qr_ + 48); } \
        _Pragma("unroll") for (int i = 0; i < 3; ++i) { \
            { const int id = t + 512 * i, row = id >> 2, dc = id & 3, j = A_.i0 - 64 + row; \
              ka[i] = (u32x4){0u, 0u, 0u, 0u}; kb2[i] = ka[i]; \
              if (j >= 0 && j < A_.L) { const int pos = A_.r + A_.d * j; const bf16_t* kr = c.Z + ((size_t)A_.b * SEQ + pos) * DIN + ZK + A_.hh * 64 + 8 * dc; \
                  ka[i] = *(const u32x4*)kr; kb2[i] = *(const u32x4*)(kr + 32); } } \
            { const int id = t + 512 * i, rp = id % 192, dc8 = id / 192, j0 = A_.i0 - 64 + 2 * rp; \
              va[i] = (u32x4){0u, 0u, 0u, 0u}; vb[i] = va[i]; \
              if (j0 >= 0 && j0 < A_.L) va[i] = *(const u32x4*)(c.Z + ((size_t)A_.b * SEQ + A_.r + A_.d * j0) * DIN + ZV + A_.hh * 64 + 8 * dc8); \
              if (j0 + 1 >= 0 && j0 + 1 < A_.L) vb[i] = *(const u32x4*)(c.Z + ((size_t)A_.b * SEQ + A_.r + A_.d * (j0 + 1)) * DIN + ZV + A_.hh * 64 + 8 * dc8); } } } while (0)
#define ATT_TABLES(uu_) do { const AttnU A_ = attn_decode(uu_); \
        { const _Float16* rh_ = c.RH + (A_.r + A_.d * (A_.i0 + 32 * wave + rq)) * 64 + 8 * h; \
          tq[0] = *(const h16x8*)rh_; tq[1] = *(const h16x8*)(rh_ + 16); tq[2] = *(const h16x8*)(rh_ + 32); tq[3] = *(const h16x8*)(rh_ + 48); } \
        _Pragma("unroll") for (int i = 0; i < 3; ++i) { const int id = t + 512 * i, row = id >> 2, dc = id & 3; \
            int posk = A_.r + A_.d * (A_.i0 - 64 + row); posk = posk < 0 ? 0 : (posk > SEQ - 1 ? SEQ - 1 : posk);         \
            tkc[i] = *(const h16x8*)(c.RH + posk * 64 + 8 * dc); tks[i] = *(const h16x8*)(c.RH + posk * 64 + 32 + 8 * dc); } } while (0)
    ATT_PREFETCH(u);
    for (;;) {
        ATT_TABLES(u);
        asm volatile("" ::: "memory");
        const AttnU A = attn_decode(u);
        const int b = A.b, g = A.g, hI = A.hI, d = A.d, L = A.L, r = A.r, hh = A.hh, i0 = A.i0;
        const int iq = i0 + 32 * wave + rq, posq = r + d * iq;
        const size_t tokq = (size_t)b * SEQ + posq;
        bf16_t* qrow = c.Z + tokq * DIN + ZQ + hh * 64;
        bf16x8 qf[4];
        {
            const u32x4 q0 = qn[0], q1 = qn[1], q2 = qn[2], q3 = qn[3];
            const h16x8 cav = tq[0], cbv = tq[1], sav = tq[2], sbv = tq[3];
            const float sc = 0.125f * 1.44269504f;
            u32x4 o0, o1, o2, o3;
    #pragma unroll
            for (int e = 0; e < 4; ++e) {
                const float ca_0 = (float)cav[2 * e], ca_1 = (float)cav[2 * e + 1], sa_0 = (float)sav[2 * e], sa_1 = (float)sav[2 * e + 1];
                const float cb_0 = (float)cbv[2 * e], cb_1 = (float)cbv[2 * e + 1], sb_0 = (float)sbv[2 * e], sb_1 = (float)sbv[2 * e + 1];
                const float a0 = bflo(q0[e]), a1 = bfhi(q0[e]), b0 = bflo(q2[e]), b1 = bfhi(q2[e]);
                const float e0 = bflo(q1[e]), e1 = bfhi(q1[e]), f0 = bflo(q3[e]), f1 = bfhi(q3[e]);
                o0[e] = pk2((a0 * ca_0 - b0 * sa_0) * sc, (a1 * ca_1 - b1 * sa_1) * sc);
                o2[e] = pk2((b0 * ca_0 + a0 * sa_0) * sc, (b1 * ca_1 + a1 * sa_1) * sc);
                o1[e] = pk2((e0 * cb_0 - f0 * sb_0) * sc, (e1 * cb_1 - f1 * sb_1) * sc);
                o3[e] = pk2((f0 * cb_0 + e0 * sb_0) * sc, (f1 * cb_1 + e1 * sb_1) * sc);
            }
            qf[0] = __builtin_bit_cast(bf16x8, o0); qf[1] = __builtin_bit_cast(bf16x8, o1); qf[2] = __builtin_bit_cast(bf16x8, o2); qf[3] = __builtin_bit_cast(bf16x8, o3);
        }
#pragma unroll
        for (int i = 0; i < 3; ++i) {
            const int id = t + 512 * i, row = id >> 2, dc = id & 3;
            const h16x8 kcv = tkc[i], ksv = tks[i];
            u32x4 olo, ohi;
#pragma unroll
            for (int e = 0; e < 4; ++e) {
                const float l0 = bflo(ka[i][e]), l1 = bfhi(ka[i][e]), h0 = bflo(kb2[i][e]), h1 = bfhi(kb2[i][e]);
                const float cc0 = (float)kcv[2 * e], cc1 = (float)kcv[2 * e + 1], ss0 = (float)ksv[2 * e], ss1 = (float)ksv[2 * e + 1];
                olo[e] = pk2(l0 * cc0 - h0 * ss0, l1 * cc1 - h1 * ss1);
                ohi[e] = pk2(h0 * cc0 + l0 * ss0, h1 * cc1 + l1 * ss1);
            }
            *(LASP u32x4*)(Kt + row * 128 + ((dc ^ (row & 7)) << 4)) = olo;
            *(LASP u32x4*)(Kt + row * 128 + (((4 + dc) ^ (row & 7)) << 4)) = ohi;
            const int rp = id % 192, dc8 = id / 192;
#pragma unroll
            for (int e = 0; e < 4; ++e) {
                Vt[(8 * dc8 + 2 * e) * 194 + rp] = (va[i][e] & 0xffffu) | (vb[i][e] << 16);
                Vt[(8 * dc8 + 2 * e + 1) * 194 + rp] = (va[i][e] >> 16) | (vb[i][e] & 0xffff0000u);
            }
        }
        __syncthreads();
        const int un = u + G;
        if (un < NAT) ATT_PREFETCH(un);
        asm volatile("" ::: "memory");
        f32x16 sacc[5];
    #pragma unroll
        for (int kb = 0; kb < 5; ++kb)
    #pragma unroll
            for (int e = 0; e < 16; ++e) sacc[kb][e] = 0.f;
    #pragma unroll
        for (int s4 = 0; s4 < 4; ++s4) {
    #pragma unroll
            for (int kb = 0; kb < 5; ++kb) {
                const int row = 32 * wave + 32 * kb + rq;
                const bf16x8 kf = *(const LASP bf16x8*)(Kt + row * 128 + (((2 * s4 + h) ^ (row & 7)) << 4));
                sacc[kb] = mfma32_g(kf, qf[s4], sacc[kb]);
            }
            __builtin_amdgcn_sched_barrier(0);
        }
        asm volatile("s_nop 15\n\ts_nop 15" : "+v"(sacc[0]), "+v"(sacc[1]), "+v"(sacc[2]), "+v"(sacc[3]), "+v"(sacc[4]));
        const int jbase = i0 - 64 + 32 * wave;
        float mx = -1e30f;
    #pragma unroll
        for (int kb = 0; kb < 5; ++kb)
    #pragma unroll
            for (int e = 0; e < 16; ++e) {
                const int row = (e & 3) + 8 * (e >> 2) + 4 * h, rel = 32 * kb + row - rq, j = jbase + 32 * kb + row;
                const bool valid = (rel >= 0) && (rel <= 128) && (j >= 0) && (j < L);
                const float sv = valid ? sacc[kb][e] : -1e30f;
                sacc[kb][e] = sv; mx = fmaxf(mx, sv);
            }
        mx = fmaxf(mx, __shfl_xor(mx, 32));
        float lsum = 0.f;
    #pragma unroll
        for (int kb = 0; kb < 5; ++kb)
    #pragma unroll
            for (int e = 0; e < 16; ++e) { const float p = __builtin_amdgcn_exp2f(sacc[kb][e] - mx); sacc[kb][e] = p; lsum += p; }
        lsum += __shfl_xor(lsum, 32);
        f32x16 oacc[2];
    #pragma unroll
        for (int db = 0; db < 2; ++db)
    #pragma unroll
            for (int e = 0; e < 16; ++e) oacc[db][e] = 0.f;
    #pragma unroll
        for (int kb = 0; kb < 5; ++kb)
    #pragma unroll
            for (int s2 = 0; s2 < 2; ++s2) {
                u32x4 pw;
    #pragma unroll
                for (int e = 0; e < 4; ++e) pw[e] = cvtpk(sacc[kb][8 * s2 + 2 * e], sacc[kb][8 * s2 + 2 * e + 1]);
                const bf16x8 pf = __builtin_bit_cast(bf16x8, pw);
                const int kp = (32 * wave + 32 * kb + 16 * s2 + 4 * h) >> 1;
    #pragma unroll
                for (int db = 0; db < 2; ++db) {
                    const LASP unsigned* vp = Vt + (32 * db + rq) * 194 + kp;
                    const u32x2 g0 = *(const LASP u32x2*)vp, g1 = *(const LASP u32x2*)(vp + 4);
                    const u32x4 aw = (u32x4){g0.x, g0.y, g1.x, g1.y};
                    oacc[db] = mfma32_g(__builtin_bit_cast(bf16x8, aw), pf, oacc[db]);
                }
            }
        asm volatile("s_nop 15\n\ts_nop 15" : "+v"(oacc[0]), "+v"(oacc[1]));
        if (do_store) {
            const float inv = 1.f / lsum;
    #pragma unroll
            for (int db = 0; db < 2; ++db)
    #pragma unroll
                for (int g4 = 0; g4 < 4; ++g4) {
                    const u32x2 w = (u32x2){cvtpk(oacc[db][4 * g4] * inv, oacc[db][4 * g4 + 1] * inv), cvtpk(oacc[db][4 * g4 + 2] * inv, oacc[db][4 * g4 + 3] * inv)};
                    *(u32x2*)(qrow + 32 * db + 8 * g4 + 4 * h) = w;
                }
            if (h == 0) c.LSE[((size_t)g * MT + tokq) * 4 + hI] = mx * 0.69314718f + __logf(lsum);
        }
        __syncthreads();
        if (un >= NAT) break;
        u = un;
    }
#undef ATT_PREFETCH
#undef ATT_TABLES
}

__device__ __forceinline__ f32x4 mfma16(bf16x8 a, bf16x8 b, f32x4 c) { return mfma16_g(a, b, c); }
template <int KSTEPS, int UNR = 2>
__device__ __forceinline__ void gemm64(const LASP unsigned char* Y, int kbyte0, const bf16_t* Bt, int ldb, f32x4 (&acc)[4][2], int fr, int fq) {
#pragma unroll UNR
    for (int ks = 0; ks < KSTEPS; ++ks) {
        bf16x8 bfr[2], afr[4];
#pragma unroll
        for (int n = 0; n < 2; ++n) bfr[n] = *(const bf16x8*)(Bt + (size_t)(16 * n + fr) * ldb + ks * 32 + 8 * fq);
#pragma unroll
        for (int m = 0; m < 4; ++m) afr[m] = *(const LASP bf16x8*)(Y + (16 * m + fr) * 528 + kbyte0 + (ks * 32 + 8 * fq) * 2);
#pragma unroll
        for (int m = 0; m < 4; ++m)
#pragma unroll
            for (int n = 0; n < 2; ++n) acc[m][n] = mfma16(bfr[n], afr[m], acc[m][n]);
        __builtin_amdgcn_sched_barrier(0);
    }
}
__device__ __forceinline__ bf16x8 pack8(f32x4 lo, f32x4 hi) {
    u32x4 w; w.x = cvtpk(lo[0], lo[1]); w.y = cvtpk(lo[2], lo[3]); w.z = cvtpk(hi[0], hi[1]); w.w = cvtpk(hi[2], hi[3]);
    return __builtin_bit_cast(bf16x8, w);
}
__device__ __forceinline__ bf16x8 dft_frag(int rowidx, int kbase, int fq, bool perm, int which  ) {
    float v[8];
#pragma unroll
    for (int j = 0; j < 8; ++j) {
        const int k = kbase + (perm ? (16 * (j >> 2) + 4 * fq + (j & 3)) : (8 * fq + j));
        float sn, cs; sincospif((float)((rowidx * k) & 63) * (1.f / 32.f), &sn, &cs);
        v[j] = which == 0 ? cs : (which == 1 ? sn : -sn);
    }
    u32x4 w; w.x = pk2(v[0], v[1]); w.y = pk2(v[2], v[3]); w.z = pk2(v[4], v[5]); w.w = pk2(v[6], v[7]);
    return __builtin_bit_cast(bf16x8, w);
}

__device__ __forceinline__ void fft1_phase_wave(const Ctx& c, unsigned char* lds_raw) {
    LASP unsigned char* TB = (LASP unsigned char*)lds_raw;
    LASP unsigned char* TA = (LASP unsigned char*)(lds_raw + 16384);
    const int t = TIDX, lane = t & 63, wave = __builtin_amdgcn_readfirstlane(t >> 6), fr = lane & 15, fq = lane >> 4;
#pragma unroll 1
    for (int i = 0; i < 5; ++i) {
        const int ft = wave * 5 + i;
        if (ft < 16) { const int ks = ft >> 3, n = (ft >> 1) & 3, which = ft & 1;
            *(LASP bf16x8*)(TB + (ft * 64 + lane) * 16) = dft_frag(16 * n + fr, 32 * ks, fq, false, which); }
        else { const int f2 = ft - 16, mb = f2 / 6, r6 = f2 % 6, ks = r6 / 3, which = r6 % 3;
            *(LASP bf16x8*)(TA + (f2 * 64 + lane) * 16) = dft_frag(16 * mb + fr, 32 * ks, fq, true, which); }
    }
    __syncthreads();
#define FT_B(ks_, n_, w_) (*(const LASP bf16x8*)(TB + ((((ks_) * 4 + (n_)) * 2 + (w_)) * 64 + lane) * 16))
#define FT_A(mb_, ks_, w_) (*(const LASP bf16x8*)(TA + ((((mb_) * 2 + (ks_)) * 3 + (w_)) * 64 + lane) * 16))
    const int nunits = NB * 4 * 64;
    for (int u = (int)BIDX * 8 + wave; u < nunits; u += (int)gridDim.x * 8) {
        const int s2 = u & 63, bg = u >> 6, g = bg & 3, b = bg >> 2;
        bf16x8 ua[4][2];
#pragma unroll
        for (int m = 0; m < 4; ++m)
#pragma unroll
            for (int ks = 0; ks < 2; ++ks) ua[m][ks] = *(const bf16x8*)(c.Z + (size_t)(b * SEQ + 64 * (16 * m + fr) + s2) * DIN + ZA + 64 * g + 32 * ks + 8 * fq);
        float2 twv[2][2];
#pragma unroll
        for (int mp = 0; mp < 2; ++mp)
#pragma unroll
            for (int q = 0; q < 2; ++q) twv[mp][q] = c.TW[((16 * (2 * mp + q) + fr) * s2) & 4095];
#pragma unroll 1
        for (int n = 0; n < 4; ++n) {
            f32x4 wre[4], wim[4];
#pragma unroll
            for (int m = 0; m < 4; ++m) { wre[m] = (f32x4){0.f, 0.f, 0.f, 0.f}; wim[m] = wre[m]; }
#pragma unroll
            for (int ks = 0; ks < 2; ++ks) {
                const bf16x8 cb = FT_B(ks, n, 0), sb = FT_B(ks, n, 1);
#pragma unroll
                for (int m = 0; m < 4; ++m) { wre[m] = mfma16(ua[m][ks], cb, wre[m]); wim[m] = mfma16(ua[m][ks], sb, wim[m]); }
                __builtin_amdgcn_sched_barrier(0);
            }
            asm volatile("s_nop 15\n\ts_nop 15" : "+v"(wre[0]), "+v"(wre[1]), "+v"(wre[2]), "+v"(wre[3]), "+v"(wim[0]), "+v"(wim[1]), "+v"(wim[2]), "+v"(wim[3]));
            bf16x8 bre[2], bim[2];
#pragma unroll
            for (int ks = 0; ks < 2; ++ks) { bre[ks] = pack8(wre[2 * ks], wre[2 * ks + 1]); bim[ks] = pack8(wim[2 * ks], wim[2 * ks + 1]); }
            asm volatile("s_nop 7" : "+v"(bre[0]), "+v"(bre[1]), "+v"(bim[0]), "+v"(bim[1]));
#pragma unroll
            for (int mp = 0; mp < 2; ++mp) {
                f32x4 yre[2], yin[2];
#pragma unroll
                for (int q = 0; q < 2; ++q) { yre[q] = (f32x4){0.f, 0.f, 0.f, 0.f}; yin[q] = yre[q]; }
#pragma unroll
                for (int ks = 0; ks < 2; ++ks) {
#pragma unroll
                    for (int q = 0; q < 2; ++q) { const bf16x8 ca = FT_A(2 * mp + q, ks, 0); yre[q] = mfma16(bre[ks], ca, yre[q]); yin[q] = mfma16(bim[ks], ca, yin[q]); }
                    __builtin_amdgcn_sched_barrier(0);
#pragma unroll
                    for (int q = 0; q < 2; ++q) { yre[q] = mfma16(bim[ks], FT_A(2 * mp + q, ks, 2), yre[q]); yin[q] = mfma16(bre[ks], FT_A(2 * mp + q, ks, 1), yin[q]); }
                    __builtin_amdgcn_sched_barrier(0);
                }
                asm volatile("s_nop 15\n\ts_nop 15" : "+v"(yre[0]), "+v"(yin[0]), "+v"(yre[1]), "+v"(yin[1]));
#pragma unroll
                for (int q = 0; q < 2; ++q) {
                    const int k1 = 16 * (2 * mp + q) + fr;
                    const float2 tw = twv[mp][q];
                    u32x4 wv;
#pragma unroll
                    for (int rg = 0; rg < 4; ++rg) { const float yr = yre[q][rg], yi = -yin[q][rg]; wv[rg] = pk2(yr * tw.x + yi * tw.y, yi * tw.x - yr * tw.y); }
                    *(u32x4*)(c.FY + ((size_t)(bg * 64 + k1) * 64 + s2) * 64 + 16 * n + 4 * fq) = wv;
                }
            }
        }
    }
#undef FT_A
#undef FT_B
    __syncthreads();
}

template <int KSTEPS>
__device__ __forceinline__ void gemm64_ldb(const bf16_t* Bt, int ldb, bf16x8 (&bfr)[KSTEPS][2], int fr, int fq) {
#pragma unroll
    for (int ks = 0; ks < KSTEPS; ++ks)
#pragma unroll
        for (int n = 0; n < 2; ++n) bfr[ks][n] = *(const bf16x8*)(Bt + (size_t)(16 * n + fr) * ldb + ks * 32 + 8 * fq);
}
template <int KSTEPS>
__device__ __forceinline__ void gemm64_pre(const LASP unsigned char* Y, int kbyte0, const bf16x8 (&bfr)[KSTEPS][2], f32x4 (&acc)[4][2], int fr, int fq) {
#pragma unroll
    for (int ks = 0; ks < KSTEPS; ++ks) {
        bf16x8 afr[4];
#pragma unroll
        for (int m = 0; m < 4; ++m) afr[m] = *(const LASP bf16x8*)(Y + (16 * m + fr) * 528 + kbyte0 + (ks * 32 + 8 * fq) * 2);
#pragma unroll
        for (int m = 0; m < 4; ++m)
#pragma unroll
            for (int n = 0; n < 2; ++n) acc[m][n] = mfma16(bfr[ks][n], afr[m], acc[m][n]);
        __builtin_amdgcn_sched_barrier(0);
    }
}
__device__ __forceinline__ void fft2_phase_mfma(const Ctx& c, int l, unsigned char* lds_raw) {
    LASP unsigned char* F = (LASP unsigned char*)lds_raw;
    const int t = TIDX, lane = t & 63, wave = __builtin_amdgcn_readfirstlane(t >> 6), fr = lane & 15, fq = lane >> 4, g = wave >> 1, nh = wave & 1;
    bf16x8 cF[4][2], sF[4][2];
#pragma unroll
    for (int m = 0; m < 4; ++m)
#pragma unroll
        for (int ks = 0; ks < 2; ++ks) { cF[m][ks] = dft_frag(16 * m + fr, 32 * ks, fq, false, 0); sF[m][ks] = dft_frag(16 * m + fr, 32 * ks, fq, false, 1); }
    bf16x8 bwf[8][2];
    gemm64_ldb<8>(c.WfT + (size_t)l * 65536 + (size_t)(32 * wave) * 256, 256, bwf, fr, fq);
    for (int u = BIDX; u < NB * 64; u += gridDim.x) {
        const int b = u >> 6, k1 = u & 63;
        const unsigned* src = c.FY + (size_t)((b * 4 + g) * 64 + k1) * 4096;
        u32x2 gpq[4][2];
#pragma unroll
        for (int m = 0; m < 4; ++m)
#pragma unroll
            for (int n = 0; n < 2; ++n) gpq[m][n] = *(const u32x2*)(c.Z + ((size_t)b * SEQ + k1 + 64 * (16 * m + fr)) * DIN + ZG + 32 * wave + 16 * n + 4 * fq);
#pragma unroll
        for (int nn = 0; nn < 2; ++nn) {
            const int cp = 16 * (2 * nh + nn) + fr;
            bf16x8 bre[2], bim[2];
#pragma unroll
            for (int ks = 0; ks < 2; ++ks) {
                unsigned w[8];
#pragma unroll
                for (int j = 0; j < 8; ++j) w[j] = src[(32 * ks + 8 * fq + j) * 64 + cp];
                u32x4 re, im;
#pragma unroll
                for (int e = 0; e < 4; ++e) { re[e] = (w[2 * e] & 0xffffu) | (w[2 * e + 1] << 16); im[e] = (w[2 * e] >> 16) | (w[2 * e + 1] & 0xffff0000u); }
                bre[ks] = __builtin_bit_cast(bf16x8, re); bim[ks] = __builtin_bit_cast(bf16x8, im);
            }
            f32x4 dacc[4];
#pragma unroll
            for (int m = 0; m < 4; ++m) dacc[m] = (f32x4){0.f, 0.f, 0.f, 0.f};
#pragma unroll
            for (int ks = 0; ks < 2; ++ks) {
#pragma unroll
                for (int m = 0; m < 4; ++m) dacc[m] = mfma16(bre[ks], cF[m][ks], dacc[m]);
                __builtin_amdgcn_sched_barrier(0);
#pragma unroll
                for (int m = 0; m < 4; ++m) dacc[m] = mfma16(bim[ks], sF[m][ks], dacc[m]);
                __builtin_amdgcn_sched_barrier(0);
            }
            asm volatile("s_nop 15" : "+v"(dacc[0]), "+v"(dacc[1]), "+v"(dacc[2]), "+v"(dacc[3]));
#pragma unroll
            for (int m = 0; m < 4; ++m) {
                u32x2 wv; wv.x = cvtpk(dacc[m][0] * (1.f / 512.f), dacc[m][1] * (1.f / 512.f)); wv.y = cvtpk(dacc[m][2] * (1.f / 512.f), dacc[m][3] * (1.f / 512.f));
                *(LASP u32x2*)(F + (16 * m + fr) * 528 + (g * 64 + 16 * (2 * nh + nn) + 4 * fq) * 2) = wv;
            }
        }
        __syncthreads();
        f32x4 acc[4][2];
#pragma unroll
        for (int m = 0; m < 4; ++m)
#pragma unroll
            for (int n = 0; n < 2; ++n) acc[m][n] = (f32x4){0.f, 0.f, 0.f, 0.f};
        gemm64_pre<8>(F, 0, bwf, acc, fr, fq);
#pragma unroll
        for (int m = 0; m < 4; ++m)
#pragma unroll
            for (int n = 0; n < 2; ++n) {
                const size_t tok = (size_t)b * SEQ + k1 + 64 * (16 * m + fr); const int col = 32 * wave + 16 * n + 4 * fq;
                const u32x2 gp = gpq[m][n];
                u32x2 o; o.x = cvtpk(acc[m][n][0] * siluf_(bflo(gp.x)), acc[m][n][1] * siluf_(bfhi(gp.x))); o.y = cvtpk(acc[m][n][2] * siluf_(bflo(gp.y)), acc[m][n][3] * siluf_(bfhi(gp.y)));
                *(u32x2*)(c.P + tok * DM + col) = o;
            }
        __syncthreads();
    }
}

__device__ __forceinline__ void tok_unit_mfma(const Ctx& c, int l, int u, unsigned char* lds_raw) {
    LASP float* A = (LASP float*)lds_raw;
    LASP unsigned char* Y = (LASP unsigned char*)(lds_raw + 96256);
    const int t = TIDX, lane = t & 63, wave = __builtin_amdgcn_readfirstlane(t >> 6), ch = t & 255, half = t >> 8, fr = lane & 15, fq = lane >> 4;
    const int b = u >> 6, s0 = (u & 63) * 64, tok0 = b * SEQ + s0;
    u32x4 ga[6], gg[6];
#pragma unroll
    for (int i = 0; i < 6; ++i) {
        const int id = t + 512 * i, row = id >> 5, c8 = (id & 31) * 8, sp = s0 - 15 + row;
        ga[i] = (u32x4){0u, 0u, 0u, 0u}; gg[i] = ga[i];
        if (id < 94 * 32 && sp >= 0 && sp < SEQ) { const bf16_t* zr = c.Z + (size_t)(b * SEQ + sp) * DIN + ZB + c8; ga[i] = *(const u32x4*)zr; gg[i] = *(const u32x4*)(zr + 256); }
    }
    const int cp2 = 2 * (t & 127), tg16 = (t >> 7) * 16;
    f32x2 cw[31];
#pragma unroll
    for (int w = 0; w < 31; ++w) cw[w] = *(const f32x2*)(c.conv_w + (size_t)l * 31 * 256 + w * 256 + cp2);
    const f32x2 cb = *(const f32x2*)(c.conv_b + l * 256 + cp2);
    u32x4 pr[5];
#pragma unroll
    for (int i = 0; i < 5; ++i) {
        const int id = t + 512 * i, row = id >> 5, c8 = (id & 31) * 8, sp = s0 - 8 + row;
        pr[i] = (u32x4){0u, 0u, 0u, 0u};
        if (id < 79 * 32 && sp >= 0 && sp < SEQ) pr[i] = *(const u32x4*)(c.Z + (size_t)(b * SEQ + sp) * DIN + ZD + c8);
    }
    asm volatile("" ::: "memory");
#pragma unroll
    for (int i = 0; i < 6; ++i) {
        const int id = t + 512 * i;
        if (id < 94 * 32) {
            const int row = id >> 5, c8 = (id & 31) * 8;
            const u32x4 a = ga[i], g4 = gg[i];
            f32x4 v0, v1;
            v0[0] = bflo(a.x) * sigmoidf_(bflo(g4.x)); v0[1] = bfhi(a.x) * sigmoidf_(bfhi(g4.x)); v0[2] = bflo(a.y) * sigmoidf_(bflo(g4.y)); v0[3] = bfhi(a.y) * sigmoidf_(bfhi(g4.y));
            v1[0] = bflo(a.z) * sigmoidf_(bflo(g4.z)); v1[1] = bfhi(a.z) * sigmoidf_(bfhi(g4.z)); v1[2] = bflo(a.w) * sigmoidf_(bflo(g4.w)); v1[3] = bfhi(a.w) * sigmoidf_(bfhi(g4.w));
            *(LASP f32x4*)(A + row * 256 + c8) = v0; *(LASP f32x4*)(A + row * 256 + c8 + 4) = v1;
        }
    }
    __syncthreads();
    f32x2 y[16];
#pragma unroll
    for (int cc = 0; cc < 2; ++cc) {
        f32x2 rows[38];
#pragma unroll
        for (int r = 0; r < 38; ++r) rows[r] = *(const LASP f32x2*)(A + (tg16 + cc * 8 + r) * 256 + cp2);
#pragma unroll
        for (int i = 0; i < 8; ++i) {
            f32x2 acc = cb;
#pragma unroll
            for (int w = 0; w < 31; ++w) acc = __builtin_elementwise_fma(rows[i + w], cw[w], acc);
            y[cc * 8 + i] = acc;
        }
        __builtin_amdgcn_sched_barrier(0);
    }
    bf16x8 bw[8][2];
    gemm64_ldb<8>(c.WpwT + (size_t)l * 65536 + (size_t)(32 * wave) * 256, 256, bw, fr, fq);
    u32x2 gp1[4][2];
#pragma unroll
    for (int m = 0; m < 4; ++m)
#pragma unroll
        for (int n = 0; n < 2; ++n) gp1[m][n] = *(const u32x2*)(c.Z + ((size_t)tok0 + 16 * m + fr) * DIN + ZG + 256 + 32 * wave + 16 * n + 4 * fq);
    __syncthreads();
#pragma unroll
    for (int i = 0; i < 16; ++i) *(LASP f32x2*)(A + (tg16 + i) * 256 + cp2) = y[i];
    __syncthreads();
    {
        const int seg = lane >> 4, sl = lane & 15;
        f32x4 lg[4], lb[4];
#pragma unroll
        for (int j = 0; j < 4; ++j) { lg[j] = *(const f32x4*)(c.conv_ln_g + l * 256 + 64 * j + 4 * sl); lb[j] = *(const f32x4*)(c.conv_ln_b + l * 256 + 64 * j + 4 * sl); }
#pragma unroll
        for (int it = 0; it < 2; ++it) {
            const int tk = wave * 8 + it * 4 + seg;
            f32x4 xv[4];
#pragma unroll
            for (int j = 0; j < 4; ++j) xv[j] = *(const LASP f32x4*)(A + tk * 256 + 64 * j + 4 * sl);
            const f32x4 s4 = (xv[0] + xv[1]) + (xv[2] + xv[3]);
            const float mean = row16_sum((s4[0] + s4[1]) + (s4[2] + s4[3])) * (1.f / 256.f);
#pragma unroll
            for (int j = 0; j < 4; ++j) xv[j] = xv[j] - mean;
            const f32x4 q4 = (xv[0] * xv[0] + xv[1] * xv[1]) + (xv[2] * xv[2] + xv[3] * xv[3]);
            const float rstd = __builtin_amdgcn_rsqf(row16_sum((q4[0] + q4[1]) + (q4[2] + q4[3])) * (1.f / 256.f) + 1e-5f);
#pragma unroll
            for (int j = 0; j < 4; ++j) {
                const f32x4 yv = xv[j] * rstd * lg[j] + lb[j];
                u32x2 o; o.x = cvtpk(siluf_(yv[0]), siluf_(yv[1])); o.y = cvtpk(siluf_(yv[2]), siluf_(yv[3]));
                *(LASP u32x2*)(Y + tk * 528 + (64 * j + 4 * sl) * 2) = o;
            }
        }
    }
    __syncthreads();
#pragma unroll
    for (int i = 0; i < 5; ++i) {
        const int id = t + 512 * i;
        if (id < 79 * 32) {
            const int row = id >> 5, c8 = (id & 31) * 8; const u32x4 a = pr[i];
            f32x4 v0, v1;
            v0[0] = bflo(a.x); v0[1] = bfhi(a.x); v0[2] = bflo(a.y); v0[3] = bfhi(a.y); v1[0] = bflo(a.z); v1[1] = bfhi(a.z); v1[2] = bflo(a.w); v1[3] = bfhi(a.w);
            *(LASP f32x4*)(A + row * 256 + c8) = v0; *(LASP f32x4*)(A + row * 256 + c8 + 4) = v1;
        }
    }
    const int pgi = wave >> 1, pcb = (wave & 1) * 32;
    bf16x8 pw[2][2];
    gemm64_ldb<2>(c.WpoolT + (size_t)(l * 4 + pgi) * 4096 + (size_t)pcb * 64, 64, pw, fr, fq);
    u32x2 gp3[4][2]; f32x4 psc[2];
#pragma unroll
    for (int n = 0; n < 2; ++n) {
        psc[n] = *(const f32x4*)(c.pool_scale + l * 256 + pgi * 64 + pcb + 16 * n + 4 * fq);
#pragma unroll
        for (int m = 0; m < 4; ++m) gp3[m][n] = *(const u32x2*)(c.Z + ((size_t)tok0 + 16 * m + fr) * DIN + ZG + 768 + pgi * 64 + pcb + 16 * n + 4 * fq);
    }
    {
        f32x4 acc[4][2];
#pragma unroll
        for (int m = 0; m < 4; ++m)
#pragma unroll
            for (int n = 0; n < 2; ++n) acc[m][n] = (f32x4){0.f, 0.f, 0.f, 0.f};
        gemm64_pre<8>(Y, 0, bw, acc, fr, fq);
#pragma unroll
        for (int m = 0; m < 4; ++m)
#pragma unroll
            for (int n = 0; n < 2; ++n) {
                const size_t tok = (size_t)tok0 + 16 * m + fr; const int col = 32 * wave + 16 * n + 4 * fq;
                const u32x2 gp = gp1[m][n];
                u32x2 o; o.x = cvtpk(acc[m][n][0] * siluf_(bflo(gp.x)), acc[m][n][1] * siluf_(bfhi(gp.x))); o.y = cvtpk(acc[m][n][2] * siluf_(bflo(gp.y)), acc[m][n][3] * siluf_(bfhi(gp.y)));
                *(u32x2*)(c.P + tok * DM + 256 + col) = o;
            }
    }
    __syncthreads();
    {
        const int gi = ch >> 6, sz = 2 << gi;
        float xr[47];
#pragma unroll
        for (int r = 0; r < 47; ++r) xr[r] = A[(half * 32 + r) * 256 + ch];
        float w2c[47], w4c[47], w8c[47];
#pragma unroll
        for (int r = 1; r < 47; ++r) w2c[r] = xr[r - 1] + xr[r];
#pragma unroll
        for (int r = 2; r < 46; ++r) w4c[r] = w2c[r - 1] + w2c[r + 1];
#pragma unroll
        for (int r = 4; r < 44; ++r) w8c[r] = w4c[r - 2] + w4c[r + 2];
        if (s0 == 0 || s0 == SEQ - 64) {
#pragma unroll
            for (int i = 0; i < 32; ++i) {
                const int r = i + 8, tk = half * 32 + i, sp = s0 + tk;
                const float w16 = w8c[r - 4] + w8c[r + 4];
                const float wsum = gi == 0 ? w2c[r] : (gi == 1 ? w4c[r] : (gi == 2 ? w8c[r] : w16));
                int lo = sp - sz / 2; if (lo < 0) lo = 0;
                int hi = sp + sz - 1 - sz / 2; if (hi > SEQ - 1) hi = SEQ - 1;
                *(LASP bf16_t*)(Y + tk * 528 + ch * 2) = f2bf(wsum * __builtin_amdgcn_rcpf((float)(hi - lo + 1)) - xr[r]);
            }
        } else {
            const float invsz = __uint_as_float((unsigned)(126 - gi) << 23);
#pragma unroll
            for (int i = 0; i < 32; ++i) {
                const int r = i + 8, tk = half * 32 + i;
                const float w16 = w8c[r - 4] + w8c[r + 4];
                const float wsum = gi == 0 ? w2c[r] : (gi == 1 ? w4c[r] : (gi == 2 ? w8c[r] : w16));
                *(LASP bf16_t*)(Y + tk * 528 + ch * 2) = f2bf(wsum * invsz - xr[r]);
            }
        }
    }
    __syncthreads();
    {
        f32x4 acc[4][2];
#pragma unroll
        for (int m = 0; m < 4; ++m)
#pragma unroll
            for (int n = 0; n < 2; ++n) acc[m][n] = (f32x4){0.f, 0.f, 0.f, 0.f};
        gemm64_pre<2>(Y, pgi * 128, pw, acc, fr, fq);
#pragma unroll
        for (int m = 0; m < 4; ++m)
#pragma unroll
            for (int n = 0; n < 2; ++n) {
                const size_t tok = (size_t)tok0 + 16 * m + fr; const int col = pgi * 64 + pcb + 16 * n + 4 * fq;
                const u32x2 gp = gp3[m][n]; const f32x4 ps = psc[n];
                u32x2 o; o.x = cvtpk(acc[m][n][0] * ps[0] * siluf_(bflo(gp.x)), acc[m][n][1] * ps[1] * siluf_(bfhi(gp.x))); o.y = cvtpk(acc[m][n][2] * ps[2] * siluf_(bflo(gp.y)), acc[m][n][3] * ps[3] * siluf_(bfhi(gp.y)));
                *(u32x2*)(c.P + tok * DM + 768 + col) = o;
            }
    }
    __syncthreads();
}

__device__ __forceinline__ void phase_combine(const Ctx& c) {
    const int gt = BIDX * NTHREADS + TIDX, NT = gridDim.x * NTHREADS;
    for (int idx = gt; idx < MT * 32; idx += NT) {
        const size_t m = idx >> 5; const int c8 = (idx & 31) * 8, hI = c8 >> 6;
        const float l0 = c.LSE[((size_t)0 * MT + m) * 4 + hI], l1 = c.LSE[((size_t)1 * MT + m) * 4 + hI], l2 = c.LSE[((size_t)2 * MT + m) * 4 + hI];
        const float mx = fmaxf(l0, fmaxf(l1, l2));
        const float e0 = __expf(l0 - mx), e1 = __expf(l1 - mx), e2 = __expf(l2 - mx), inv = __builtin_amdgcn_rcpf(e0 + e1 + e2);
        const float a0 = e0 * inv, a1 = e1 * inv, a2 = e2 * inv;
        const bf16_t* zr = c.Z + m * DIN;
        const u32x4 o0 = *(const u32x4*)(zr + ZQ + (0 * 4 + hI) * 64 + (c8 & 63));
        const u32x4 o1 = *(const u32x4*)(zr + ZQ + (1 * 4 + hI) * 64 + (c8 & 63));
        const u32x4 o2 = *(const u32x4*)(zr + ZQ + (2 * 4 + hI) * 64 + (c8 & 63));
        const u32x4 gp = *(const u32x4*)(zr + ZG + 512 + c8);
        u32x4 res;
#pragma unroll
        for (int q = 0; q < 4; ++q) {
            const float vlo = (a0 * bflo(o0[q]) + a1 * bflo(o1[q]) + a2 * bflo(o2[q])) * siluf_(bflo(gp[q]));
            const float vhi = (a0 * bfhi(o0[q]) + a1 * bfhi(o1[q]) + a2 * bfhi(o2[q])) * siluf_(bfhi(gp[q]));
            res[q] = pk2(vlo, vhi);
        }
        *(u32x4*)(c.P + m * DM + 512 + c8) = res;
    }
}

namespace pg8 {
#define PG8_LAS __attribute__((address_space(3)))
typedef unsigned short bf16_t;
typedef short bf16x8 __attribute__((ext_vector_type(8)));
typedef float f32x4 __attribute__((ext_vector_type(4)));
typedef unsigned u32x4 __attribute__((ext_vector_type(4)));
constexpr int BM = 256, BK = 64, HALF = 128, HTB = HALF * BK * 2  , STAGE_BYTES = 8 * HTB, NXCD = 8, WGM = 8;

__host__ __device__ __forceinline__ int lds_byte(int r, int c) { const int st = (r >> 4) * 2 + (c >> 5), rr = r & 15, cc = c & 31, ob = rr * 64 + cc * 2; return st * 1024 + (ob ^ (((ob >> 9) & 1) << 5)); }
__host__ __device__ __forceinline__ void stage_rc(int b, int& R, int& C) { const int st = b / 1024, sb = b % 1024, swz = sb ^ (((sb >> 9) & 1) << 5); R = (st >> 1) * 16 + swz / 64; C = (st & 1) * 32 + (swz % 64) / 2; }
__host__ __device__ __forceinline__ int perm32(int rho) { const int n = rho >> 4, i = rho & 15; return 8 * (i >> 2) + 4 * n + (i & 3); }

struct Unit { int pm, pn, sub; };
template <int LDA_, int LDB_, int K_, int ASUB_, int BSUB_, bool I8_ = false> struct GemmT { const bf16_t* A; const bf16_t* Bt; static constexpr int lda = LDA_, ldb = LDB_, K = K_; static constexpr size_t a_sub = ASUB_, b_sub = BSUB_; static constexpr bool i8 = I8_; };

struct StaticOrder {
    int nM, nN, nwg, G, c;
    __host__ __device__ void init(int M, int N, int G_, int c_) { nM = M / BM; nN = N / BM; nwg = nM * nN; G = G_; c = c_; }
    __host__ __device__ bool next(int i, Unit& u) const {
        const long L = (long)i * G + c; if (L >= nwg) return false;
        int wgid = (int)L; { const int q = nwg / NXCD, r = nwg % NXCD, xcd = wgid % NXCD, off = wgid / NXCD; wgid = (xcd < r ? xcd * (q + 1) : r * (q + 1) + (xcd - r) * q) + off; }
        const int nig = WGM * nN, gid = wgid / nig, fm = gid * WGM, gsz = (nM - fm) < WGM ? (nM - fm) : WGM;
        u.pm = fm + ((wgid % nig) % gsz); u.pn = (wgid % nig) / gsz; u.sub = 0; return true;
    }
    __device__ __forceinline__ void a_ready(const Unit&) const {}
    __device__ __forceinline__ void done(const Unit&) const {}
};


__device__ __forceinline__ unsigned cvt_pk_bf16(float lo, float hi) { return ::pk2(lo, hi); }
template <int ACT  > struct EpiBf16 {
    static constexpr bool PERM = true, AFTER_DRAIN = false; static_assert(ACT == 0 || ACT == 2, "EpiBf16: ACT is 0 (none) or 2 (sigmoid)");
    bf16_t* O; int ldc; const float* bias; int split_cols; size_t split_stride; float scale0;
    __device__ __forceinline__ void operator()(const f32x4 (&acc)[2][2][4][2], const Unit& u, int wr, int wc, int fr, int fq) const {
        asm volatile("" : "+v"(fr), "+v"(fq));
        const int row0 = u.pm * BM + wr * 64 + fr; int colt = u.pn * BM; bf16_t* base = O;
        float sc = 1.f; if (split_cols) { const int t = colt / split_cols; base += (size_t)t * split_stride; colt -= t * split_cols; if (t == 0) sc = scale0; }
        const int col0 = colt + wc * 32 + 8 * fq, bcol0 = u.pn * BM + wc * 32 + 8 * fq;
        f32x4 bv[2][2];
#pragma unroll
        for (int bj = 0; bj < 2; ++bj)
#pragma unroll
            for (int n = 0; n < 2; ++n) bv[bj][n] = bias ? *(const f32x4*)(bias + bcol0 + bj * HALF + 4 * n) : (f32x4){0.f, 0.f, 0.f, 0.f};
#pragma unroll
        for (int ai = 0; ai < 2; ++ai)
#pragma unroll
            for (int m = 0; m < 4; ++m) { bf16_t* rowp = base + (size_t)(row0 + ai * HALF + m * 16) * ldc + col0;
#pragma unroll
                for (int bj = 0; bj < 2; ++bj) { f32x4 v0 = acc[ai][bj][m][0] + bv[bj][0], v1 = acc[ai][bj][m][1] + bv[bj][1];
                    if (ACT == 2) {
#pragma unroll
                        for (int q = 0; q < 4; ++q) { v0[q] = __builtin_amdgcn_rcpf(1.0f + __builtin_amdgcn_exp2f(v0[q] * -1.44269504f)); v1[q] = __builtin_amdgcn_rcpf(1.0f + __builtin_amdgcn_exp2f(v1[q] * -1.44269504f)); } }
                    v0 = v0 * sc; v1 = v1 * sc; u32x4 w; w.x = cvt_pk_bf16(v0[0], v0[1]); w.y = cvt_pk_bf16(v0[2], v0[3]); w.z = cvt_pk_bf16(v1[0], v1[1]); w.w = cvt_pk_bf16(v1[2], v1[3]);
                    *(u32x4*)(rowp + bj * HALF) = w; } }
    }
};


struct EpiZI8 {
    static constexpr bool PERM = true, AFTER_DRAIN = false;
    bf16_t* O; int ldc; const float* SH; const float* SW;
    __device__ __forceinline__ void operator()(const f32x4 (&acc)[2][2][4][2], const Unit& u, int wr, int wc, int fr, int fq) const {
        asm volatile("" : "+v"(fr), "+v"(fq));
        const int row0 = u.pm * BM + wr * 64 + fr, col0 = u.pn * BM + wc * 32 + 8 * fq;
        f32x4 wv[2][2];
#pragma unroll
        for (int bj = 0; bj < 2; ++bj)
#pragma unroll
            for (int n = 0; n < 2; ++n) wv[bj][n] = *(const f32x4*)(SW + col0 + bj * HALF + 4 * n);
#pragma unroll
        for (int ai = 0; ai < 2; ++ai)
#pragma unroll
            for (int m = 0; m < 4; ++m) { bf16_t* rowp = O + (size_t)(row0 + ai * HALF + m * 16) * ldc + col0;
                const float rs = SH[row0 + ai * HALF + m * 16];
#pragma unroll
                for (int bj = 0; bj < 2; ++bj) {
                    const f32x4 v0 = (__builtin_convertvector(__builtin_bit_cast(i32x4, acc[ai][bj][m][0]), f32x4) * wv[bj][0]) * rs, v1 = (__builtin_convertvector(__builtin_bit_cast(i32x4, acc[ai][bj][m][1]), f32x4) * wv[bj][1]) * rs;
                    u32x4 w; w.x = cvt_pk_bf16(v0[0], v0[1]); w.y = cvt_pk_bf16(v0[2], v0[3]); w.z = cvt_pk_bf16(v1[0], v1[1]); w.w = cvt_pk_bf16(v1[2], v1[3]);
                    *(u32x4*)(rowp + bj * HALF) = w; } }
    }
};
struct EpiGateU8 {
    static constexpr bool PERM = true, AFTER_DRAIN = false; static constexpr int BPERM = 2;
    unsigned char* O; const float* bias; const float* SH; const float* SW;
    __device__ __forceinline__ void operator()(const f32x4 (&acc)[2][2][4][2], const Unit& u, int wr, int wc, int fr, int fq) const {
        asm volatile("" : "+v"(fr), "+v"(fq));
        const int row0 = u.pm * BM + wr * 64 + fr, col0 = u.pn * BM + wc * 64 + 16 * fq;
        const int gn = u.pn >> 2, gbase = (gn < 3) ? 3072 + 1024 * gn : 0;
        f32x4 bv[2][2];
#pragma unroll
        for (int bj = 0; bj < 2; ++bj)
#pragma unroll
            for (int n = 0; n < 2; ++n) bv[bj][n] = *(const f32x4*)(bias + col0 + 8 * bj + 4 * n) * -1.44269504f;
        f32x4 wv[2][2];
#pragma unroll
        for (int bj = 0; bj < 2; ++bj)
#pragma unroll
            for (int n = 0; n < 2; ++n) wv[bj][n] = *(const f32x4*)(SW + col0 + 8 * bj + 4 * n) * -1.44269504f;
        float rsv[8];
#pragma unroll
        for (int i = 0; i < 8; ++i) rsv[i] = SH[row0 + (i >> 2) * HALF + (i & 3) * 16];
#define EPG_Q4(dst_, a_, w_, rs_, b_) do { const f32x4 x_ = (__builtin_convertvector(__builtin_bit_cast(i32x4, a_), f32x4) * (w_)) * (rs_) + (b_); f32x4 e_; e_[0] = __builtin_amdgcn_exp2f(x_[0]); e_[1] = __builtin_amdgcn_exp2f(x_[1]); e_[2] = __builtin_amdgcn_exp2f(x_[2]); e_[3] = __builtin_amdgcn_exp2f(x_[3]); \
            e_ = e_ + 1.0f; f32x4 r_; r_[0] = __builtin_amdgcn_rcpf(e_[0]); r_[1] = __builtin_amdgcn_rcpf(e_[1]); r_[2] = __builtin_amdgcn_rcpf(e_[2]); r_[3] = __builtin_amdgcn_rcpf(e_[3]); \
            r_ = r_ * 255.0f + 8388608.0f; \
            const unsigned t01_ = __builtin_amdgcn_perm(__float_as_uint(fmaxf(r_[1], 8388609.0f)), __float_as_uint(fmaxf(r_[0], 8388609.0f)), 0x0c0c0400u), t23_ = __builtin_amdgcn_perm(__float_as_uint(fmaxf(r_[3], 8388609.0f)), __float_as_uint(fmaxf(r_[2], 8388609.0f)), 0x0c0c0400u); \
            dst_ = t01_ | (t23_ << 16); } while (0)
#pragma unroll
        for (int ai = 0; ai < 2; ++ai)
#pragma unroll
            for (int m = 0; m < 4; ++m) { unsigned char* rowp = O + (size_t)(row0 + ai * HALF + m * 16) * 8704 + gbase + (col0 & 1023);
                const float rs = rsv[ai * 4 + m];
                u32x4 w; EPG_Q4(w.x, acc[ai][0][m][0], wv[0][0], rs, bv[0][0]); EPG_Q4(w.y, acc[ai][0][m][1], wv[0][1], rs, bv[0][1]);
                EPG_Q4(w.z, acc[ai][1][m][0], wv[1][0], rs, bv[1][0]); EPG_Q4(w.w, acc[ai][1][m][1], wv[1][1], rs, bv[1][1]);
                *(u32x4*)rowp = w; }
#undef EPG_Q4
    }
};
struct EpiMerge {
    static constexpr bool PERM = true, AFTER_DRAIN = false;
    const unsigned char* MG; bf16_t* O;
    __device__ __forceinline__ void operator()(const f32x4 (&acc)[2][2][4][2], const Unit& u, int wr, int wc, int fr, int fq) const {
        asm volatile("" : "+v"(fr), "+v"(fq));
        const int row0 = u.pm * BM + wr * 64 + fr, col0 = u.pn * BM + wc * 32 + 8 * fq;
        const bool rmw = (u.sub != 0);
        constexpr int DEPTH = 8;
        u32x2 gq[16]; u32x4 pq[16];
#define EPM_ROW(i) ((size_t)(row0 + ((i) >> 3) * HALF + (((i) >> 1) & 3) * 16))
#define EPM_LOAD(i) do { const size_t row_ = EPM_ROW(i); const int cb_ = col0 + ((i) & 1) * HALF; gq[i] = *(const u32x2*)(MG + row_ * 8704 + ((u.sub < 3) ? 3072 + 1024 * u.sub : 0) + cb_); \
        if (rmw) pq[i] = *(const u32x4*)(O + row_ * 1024 + cb_); } while (0)
#pragma unroll
        for (int i = 0; i < DEPTH; ++i) EPM_LOAD(i);
        asm volatile("" ::: "memory");
#pragma unroll
        for (int i = 0; i < 16; ++i) {
            const int ai = i >> 3, m = (i >> 1) & 3, bj = i & 1;
            const u32x2 g = gq[i];
            f32x4 v0 = acc[ai][bj][m][0] * (1.0f / 255.0f), v1 = acc[ai][bj][m][1] * (1.0f / 255.0f);
            v0[0] *= (float)(g.x & 0xffu); v0[1] *= (float)((g.x >> 8) & 0xffu); v0[2] *= (float)((g.x >> 16) & 0xffu); v0[3] *= (float)(g.x >> 24);
            v1[0] *= (float)(g.y & 0xffu); v1[1] *= (float)((g.y >> 8) & 0xffu); v1[2] *= (float)((g.y >> 16) & 0xffu); v1[3] *= (float)(g.y >> 24);
            if (rmw) { const u32x4 p = pq[i];
                v0[0] += __uint_as_float(p.x << 16); v0[1] += __uint_as_float(p.x & 0xffff0000u); v0[2] += __uint_as_float(p.y << 16); v0[3] += __uint_as_float(p.y & 0xffff0000u);
                v1[0] += __uint_as_float(p.z << 16); v1[1] += __uint_as_float(p.z & 0xffff0000u); v1[2] += __uint_as_float(p.w << 16); v1[3] += __uint_as_float(p.w & 0xffff0000u); }
            u32x4 w; w.x = cvt_pk_bf16(v0[0], v0[1]); w.y = cvt_pk_bf16(v0[2], v0[3]); w.z = cvt_pk_bf16(v1[0], v1[1]); w.w = cvt_pk_bf16(v1[2], v1[3]);
            *(u32x4*)(O + EPM_ROW(i) * 1024 + col0 + bj * HALF) = w;
            asm volatile("" ::: "memory");
            if (i + DEPTH < 16) { EPM_LOAD(i + DEPTH); asm volatile("" ::: "memory"); }
        }
#undef EPM_LOAD
#undef EPM_ROW
    }
};
struct EpiMergeChain {
    static constexpr bool PERM = true, AFTER_DRAIN = false, CHAIN = true; static constexpr int BPERM = 2;
    const unsigned char* MG; bf16_t* O; const unsigned char* FF;
    __device__ __forceinline__ void chain(f32x4 (&acc)[2][2][4][2], const Unit& u, int wr, int wc, int fr, int fq) const {
        constexpr int DEPTH = 4;
#define EPC_GOFF(i) ((unsigned)((((i) >> 2) * HALF + ((i) & 3) * 16) * 8704))
#define EPC_OOFF(i) ((unsigned)((((i) >> 2) * HALF + ((i) & 3) * 16) * 1024))
        asm volatile("" : "+v"(fr), "+v"(fq));
        const bool last = (u.sub == 3);
        const unsigned gbase = (unsigned)(u.pm * BM + wr * 64 + fr) * 8704u + (unsigned)(u.pn * BM + wc * 64 + 16 * fq);
        const unsigned obase = (unsigned)(u.pm * BM + wr * 64 + fr) * 1024u + (unsigned)(u.pn * BM + wc * 64 + 16 * fq);
        const unsigned go = last ? 0u : 3072u + 1024u * (unsigned)u.sub;
        const unsigned gn = (u.sub < 2) ? go + 1024u : 0u, nmask = last ? 0u : 0xffffffffu;
        const unsigned char* nbase = last ? FF : MG;
        const float keep = last ? 0.f : 1.f;
        u32x4 gq[8], gr[8];
#define EPC_LOAD(i) do { const unsigned o_ = gbase + EPC_GOFF(i); gq[i] = *(const u32x4*)(MG + (o_ + go)); gr[i] = *(const u32x4*)(nbase + ((o_ + gn) & nmask)); } while (0)
#define EPC_S4(dst_, g_, r_) do { dst_[0] = (float)((g_) & 0xffu) * __builtin_amdgcn_rcpf((float)((r_) & 0xffu)); dst_[1] = (float)(((g_) >> 8) & 0xffu) * __builtin_amdgcn_rcpf((float)(((r_) >> 8) & 0xffu)); \
        dst_[2] = (float)(((g_) >> 16) & 0xffu) * __builtin_amdgcn_rcpf((float)(((r_) >> 16) & 0xffu)); dst_[3] = (float)((g_) >> 24) * __builtin_amdgcn_rcpf((float)((r_) >> 24)); } while (0)
#pragma unroll
        for (int i = 0; i < DEPTH; ++i) EPC_LOAD(i);
        asm volatile("" ::: "memory");
#pragma unroll
        for (int i = 0; i < 8; ++i) {
            const int ai = i >> 2, m = i & 3;
            const u32x4 g = gq[i], r = gr[i];
            f32x4 s0, s1, s2, s3;
            EPC_S4(s0, g.x, r.x); EPC_S4(s1, g.y, r.y); EPC_S4(s2, g.z, r.z); EPC_S4(s3, g.w, r.w);
            const f32x4 v0 = acc[ai][0][m][0] * s0, v1 = acc[ai][0][m][1] * s1, v2 = acc[ai][1][m][0] * s2, v3 = acc[ai][1][m][1] * s3;
            if (last) {
                u32x4 w0, w1; w0.x = cvt_pk_bf16(v0[0], v0[1]); w0.y = cvt_pk_bf16(v0[2], v0[3]); w0.z = cvt_pk_bf16(v1[0], v1[1]); w0.w = cvt_pk_bf16(v1[2], v1[3]);
                w1.x = cvt_pk_bf16(v2[0], v2[1]); w1.y = cvt_pk_bf16(v2[2], v2[3]); w1.z = cvt_pk_bf16(v3[0], v3[1]); w1.w = cvt_pk_bf16(v3[2], v3[3]);
                *(u32x4*)(O + (obase + EPC_OOFF(i))) = w0; *(u32x4*)(O + (obase + EPC_OOFF(i)) + 8) = w1;
            }
            acc[ai][0][m][0] = v0 * keep; acc[ai][0][m][1] = v1 * keep; acc[ai][1][m][0] = v2 * keep; acc[ai][1][m][1] = v3 * keep;
            asm volatile("" : "+v"(acc[ai][0][m][0]), "+v"(acc[ai][0][m][1]), "+v"(acc[ai][1][m][0]), "+v"(acc[ai][1][m][1]) :: "memory");
            if (i + DEPTH < 8) { EPC_LOAD(i + DEPTH); asm volatile("" ::: "memory"); }
        }
#undef EPC_LOAD
#undef EPC_S4
#undef EPC_GOFF
#undef EPC_OOFF
    }
};
struct EpiOutF32 {
    static constexpr bool PERM = true, AFTER_DRAIN = false;
    const float* xin; float* out;
    __device__ __forceinline__ void operator()(const f32x4 (&acc)[2][2][4][2], const Unit& u, int wr, int wc, int fr, int fq) const {
        asm volatile("" : "+v"(fr), "+v"(fq));
        const int row0 = u.pm * BM + wr * 64 + fr, col0 = u.pn * BM + wc * 32 + 8 * fq;
        constexpr int DEPTH = 8;
        f32x4 x0q[16], x1q[16];
#define EPO_OFF(i) ((size_t)(row0 + ((i) >> 3) * HALF + (((i) >> 1) & 3) * 16) * 1024 + col0 + ((i) & 1) * HALF)
#define EPO_LOAD(i) do { const size_t off_ = EPO_OFF(i); x0q[i] = *(const f32x4*)(xin + off_); x1q[i] = *(const f32x4*)(xin + off_ + 4); } while (0)
#pragma unroll
        for (int i = 0; i < DEPTH; ++i) EPO_LOAD(i);
        asm volatile("" ::: "memory");
#pragma unroll
        for (int i = 0; i < 16; ++i) {
            const int ai = i >> 3, m = (i >> 1) & 3, bj = i & 1;
            const size_t off = EPO_OFF(i);
            *(f32x4*)(out + off) = x0q[i] + acc[ai][bj][m][0]; *(f32x4*)(out + off + 4) = x1q[i] + acc[ai][bj][m][1];
            asm volatile("" ::: "memory");
            if (i + DEPTH < 16) { EPO_LOAD(i + DEPTH); asm volatile("" ::: "memory"); }
        }
#undef EPO_LOAD
#undef EPO_OFF
    }
};

template <bool FINAL> struct EpiOutNorm {
    static constexpr bool PERM = true, AFTER_DRAIN = false;
    const float* xin; float* out; const float* g; float* SS; unsigned* CNT; bf16_t* Hn; unsigned* AM; signed char* H8; float* SH;
    __device__ __forceinline__ void operator()(f32x4 (&acc)[2][2][4][2], const Unit& u, int wr, int wc, int fr, int fq) const {
        asm volatile("" : "+v"(fr), "+v"(fq));
        const int row0 = u.pm * BM + wr * 64 + fr, col0 = u.pn * BM + wc * 32 + 8 * fq;
        constexpr int DEPTH = FINAL ? 8 : 4;
        f32x4 gv[2][2];
        if constexpr (!FINAL) {
#pragma unroll
            for (int bj = 0; bj < 2; ++bj)
#pragma unroll
                for (int n = 0; n < 2; ++n) gv[bj][n] = *(const f32x4*)(g + col0 + bj * HALF + 4 * n);
        }
        f32x4 x0q[16], x1q[16];
#define EPN_OFF(i) ((size_t)(row0 + ((i) >> 3) * HALF + (((i) >> 1) & 3) * 16) * 1024 + col0 + ((i) & 1) * HALF)
#define EPN_LOAD(i) do { const size_t off_ = EPN_OFF(i); x0q[i] = *(const f32x4*)(xin + off_); x1q[i] = *(const f32x4*)(xin + off_ + 4); } while (0)
#pragma unroll
        for (int i = 0; i < DEPTH; ++i) EPN_LOAD(i);
        asm volatile("" ::: "memory");
#pragma unroll
        for (int i = 0; i < 16; ++i) {
            const int ai = i >> 3, m = (i >> 1) & 3, bj = i & 1;
            acc[ai][bj][m][0] += x0q[i]; acc[ai][bj][m][1] += x1q[i];
            asm volatile("" ::: "memory");
            if (i + DEPTH < 16) { EPN_LOAD(i + DEPTH); asm volatile("" ::: "memory"); }
            if (bj == 1) {
                float q = 0.f;
#pragma unroll
                for (int b2 = 0; b2 < 2; ++b2)
#pragma unroll
                    for (int n = 0; n < 2; ++n) { const f32x4 v = acc[ai][b2][m][n]; q += (v[0] * v[0] + v[1] * v[1]) + (v[2] * v[2] + v[3] * v[3]); }
                q += __shfl_xor(q, 16); q += __shfl_xor(q, 32);
                if (fq == 0) atomicAdd(SS + row0 + ai * HALF + m * 16, q);
                if constexpr (!FINAL) {
                    float am = 0.f;
#pragma unroll
                    for (int b2 = 0; b2 < 2; ++b2)
#pragma unroll
                        for (int n = 0; n < 2; ++n) { const f32x4 v = acc[ai][b2][m][n] * gv[b2][n]; am = fmaxf(am, fmaxf(fmaxf(fabsf(v[0]), fabsf(v[1])), fmaxf(fabsf(v[2]), fabsf(v[3])))); }
                    am = fmaxf(am, __shfl_xor(am, 16)); am = fmaxf(am, __shfl_xor(am, 32));
                    if (fq == 0) atomicMax(AM + row0 + ai * HALF + m * 16, __float_as_uint(am));
                }
            }
        }
        asm volatile("s_waitcnt vmcnt(0)" ::: "memory");
        unsigned* cnt = CNT + 16 * u.pm;
        if (fr == 0 && fq == 0) {
            __hip_atomic_fetch_add(cnt, 1u, __ATOMIC_RELAXED, __HIP_MEMORY_SCOPE_AGENT);
            unsigned spins = 0;
            while (__hip_atomic_load(cnt, __ATOMIC_RELAXED, __HIP_MEMORY_SCOPE_AGENT) < 32u) { __builtin_amdgcn_s_sleep(2); if (++spins > (1u << 20)) break; }
        }
        asm volatile("" ::: "memory");
        if constexpr (FINAL) {
#pragma unroll
            for (int bj = 0; bj < 2; ++bj)
#pragma unroll
                for (int n = 0; n < 2; ++n) gv[bj][n] = *(const f32x4*)(g + col0 + bj * HALF + 4 * n);
        } else asm volatile("" : "+v"(gv[0][0]), "+v"(gv[0][1]), "+v"(gv[1][0]), "+v"(gv[1][1]));
#pragma unroll
        for (int ai = 0; ai < 2; ++ai)
#pragma unroll
            for (int m = 0; m < 4; ++m) {
                const int row = row0 + ai * HALF + m * 16;
                const float ss = __hip_atomic_load(SS + row, __ATOMIC_RELAXED, __HIP_MEMORY_SCOPE_AGENT);
                const float rstd = 1.0f / sqrtf(ss * (1.f / 1024.f) + 1e-6f);
                float qs = 0.f;
                if constexpr (!FINAL) {
                    const float am = __uint_as_float(__hip_atomic_load(AM + row, __ATOMIC_RELAXED, __HIP_MEMORY_SCOPE_AGENT));
                    qs = am > 0.f ? 127.f / am : 0.f;
                    if (u.pn == 0 && wc == 0 && fq == 0) SH[row] = am * rstd * (1.f / 127.f);
                }
#pragma unroll
                for (int bj = 0; bj < 2; ++bj) {
                    const size_t off = (size_t)row * 1024 + col0 + bj * HALF;
                    const f32x4 y0 = acc[ai][bj][m][0] * rstd * gv[bj][0], y1 = acc[ai][bj][m][1] * rstd * gv[bj][1];
                    if constexpr (FINAL) { *(f32x4*)(out + off) = y0; *(f32x4*)(out + off + 4) = y1; }
                    else {
                        *(f32x4*)(out + off) = acc[ai][bj][m][0]; *(f32x4*)(out + off + 4) = acc[ai][bj][m][1];
                        u32x2 q8; q8.x = q8x4(acc[ai][bj][m][0] * gv[bj][0], qs); q8.y = q8x4(acc[ai][bj][m][1] * gv[bj][1], qs);
                        *(u32x2*)(H8 + off) = q8;
                    }
                }
            }
#undef EPN_LOAD
#undef EPN_OFF
    }
};
struct MergeOrder : StaticOrder {
    __device__ bool next(int i, Unit& u) const { const bool ok = StaticOrder::next(i >> 2, u); u.sub = i & 3; return ok; }
};

template <class E, class = void> struct epi_bperm { static constexpr int value = E::PERM ? 1 : 0; };
template <class E> struct epi_bperm<E, decltype((void)E::BPERM)> { static constexpr int value = E::BPERM; };
template <class E, class = void> struct epi_chain { static constexpr bool value = false; };
template <class E> struct epi_chain<E, decltype((void)E::CHAIN)> { static constexpr bool value = E::CHAIN; };
template <class Epi, class Sched, class Gemm, bool ALIGN_EPI = false, bool SP2 = false>
__device__ __forceinline__ void gemm_phase(PG8_LAS unsigned char* lds, const Gemm g, const Sched& S, const Epi& E) {
    const int tid = TIDX, wid = __builtin_amdgcn_readfirstlane(tid >> 6), lane = tid & 63, wr = wid >> 2, wc = wid & 3, fr = lane & 15, fq = lane >> 4;
    constexpr int K = Gemm::K, nt = K / BK, lda = Gemm::lda, ldb = Gemm::ldb;
    constexpr int BP = epi_bperm<Epi>::value;
    unsigned voffA[2], voffB[2], voffB1[2];
#pragma unroll
    for (int i = 0; i < 2; ++i) { int R, C; stage_rc(tid * 16 + i * 8192, R, C);
        voffA[i] = (unsigned)(R * lda + C) * 2u;
        if constexpr (BP == 2) { const int w_ = R >> 5, n_ = (R >> 4) & 1, j_ = R & 15, cb_ = w_ * 64 + 16 * (j_ >> 2) + 4 * n_ + (j_ & 3);
            voffB[i] = (unsigned)(cb_ * ldb + C) * 2u; voffB1[i] = voffB[i]; }
        else { const int Rb = (BP == 1) ? ((R & ~31) + perm32(R & 31)) : R; voffB[i] = (unsigned)(Rb * ldb + C) * 2u; voffB1[i] = voffB[i]; } }
    const size_t kstep = (size_t)(BK * 2);
    const size_t hstepA = (size_t)HALF * lda * 2, hstepB = (size_t)HALF * ldb * 2, hB1 = (BP == 2) ? (size_t)8 * ldb * 2 : hstepB;
    const size_t tstepA = 2 * hstepA, tstepB = 2 * hstepB;
    const unsigned ldsw = (unsigned)wid * 1024u;
    const int aoff = lds_byte(wr * 64 + fr, fq * 8), boff = lds_byte(wc * 32 + fr, fq * 8);
#define PG8_SA(b, h) (((b) * 2 + (h)) * HTB)
#define PG8_SB(b, h) ((4 + (b) * 2 + (h)) * HTB)
#define PG8_STAGE(bufoff, gbase, voff) do { _Pragma("unroll") for (int _i = 0; _i < 2; ++_i) \
        __builtin_amdgcn_global_load_lds((const unsigned*)((const char*)(gbase) + (voff)[_i]), (PG8_LAS unsigned*)(lds + (bufoff) + ldsw + _i * 8192), 16, 0, 0); } while (0)
#define PG8_LDA(dst, b, h) do { _Pragma("unroll") for (int m = 0; m < 4; ++m) _Pragma("unroll") for (int k = 0; k < 2; ++k) dst[m][k] = *(const PG8_LAS bf16x8*)(lds + PG8_SA(b, h) + aoff + m * 2048 + k * 1024); } while (0)
#define PG8_LDB(dst, b, h) do { _Pragma("unroll") for (int n = 0; n < 2; ++n) _Pragma("unroll") for (int k = 0; k < 2; ++k) dst[n][k] = *(const PG8_LAS bf16x8*)(lds + PG8_SB(b, h) + boff + n * 2048 + k * 1024); } while (0)
#define PG8_MMA(ai, bj, At, Bt) do { __builtin_amdgcn_s_setprio(1); _Pragma("unroll") for (int m = 0; m < 4; ++m) _Pragma("unroll") for (int n = 0; n < 2; ++n) _Pragma("unroll") for (int k = 0; k < 2; ++k) \
        acc[ai][bj][m][n] = Gemm::i8 ? ::mfma16i8_g(Bt[n][k], At[m][k], acc[ai][bj][m][n]) : ::mfma16_g(Bt[n][k], At[m][k], acc[ai][bj][m][n]); __builtin_amdgcn_s_setprio(0); } while (0)
#define PG8_WAIT_V(n) asm volatile("s_waitcnt vmcnt(" #n ")" ::: "memory")
#define PG8_WAIT_L(n) asm volatile("s_waitcnt lgkmcnt(" #n ")" ::: "memory")
#define PG8_BAR __builtin_amdgcn_s_barrier()
#define PG8_SCHED __builtin_amdgcn_sched_barrier(0)
    Unit cur, nxt; int ui = 0;
    if (!S.next(0, cur)) return;
    f32x4 acc[2][2][4][2];
#pragma unroll
    for (int a = 0; a < 2; ++a)
#pragma unroll
        for (int b = 0; b < 2; ++b)
#pragma unroll
            for (int m = 0; m < 4; ++m)
#pragma unroll
                for (int n = 0; n < 2; ++n) acc[a][b][m][n] = (f32x4){0.f, 0.f, 0.f, 0.f};
    bf16x8 At[4][2], B0[2][2], B1[2][2];
    const char* cA = (const char*)g.A + (size_t)cur.pm * tstepA + (size_t)cur.sub * g.a_sub; const char* cB = (const char*)g.Bt + (size_t)cur.pn * tstepB + (size_t)cur.sub * g.b_sub;
    S.a_ready(cur);
    if constexpr (SP2) {
        PG8_STAGE(PG8_SB(0, 0), cB, voffB); PG8_STAGE(PG8_SB(0, 1), cB + hB1, voffB1); PG8_STAGE(PG8_SA(0, 0), cA, voffA); PG8_STAGE(PG8_SA(0, 1), cA + hstepA, voffA);
        if (wr == 1) PG8_BAR;
        PG8_WAIT_V(2); PG8_BAR;
        PG8_STAGE(PG8_SB(1, 0), cB + kstep, voffB); PG8_STAGE(PG8_SA(1, 0), cA + kstep, voffA); PG8_STAGE(PG8_SB(1, 1), cB + hB1 + kstep, voffB1);
        PG8_WAIT_V(6); PG8_BAR;
    } else {
        PG8_STAGE(PG8_SB(0, 0), cB, voffB); PG8_STAGE(PG8_SA(0, 0), cA, voffA); PG8_STAGE(PG8_SB(0, 1), cB + hB1, voffB1); PG8_STAGE(PG8_SA(0, 1), cA + hstepA, voffA);
        if (wr == 1) PG8_BAR;
        PG8_WAIT_V(4); PG8_BAR;
        PG8_STAGE(PG8_SB(1, 0), cB + kstep, voffB); PG8_STAGE(PG8_SA(1, 0), cA + kstep, voffA); PG8_STAGE(PG8_SB(1, 1), cB + hB1 + kstep, voffB1);
        PG8_WAIT_V(6); PG8_BAR;
    }
    for (;;) {
        const bool has_next = S.next(ui + 1, nxt);
        const char* nA = has_next ? (const char*)g.A + (size_t)nxt.pm * tstepA + (size_t)nxt.sub * g.a_sub : cA; const char* nB = has_next ? (const char*)g.Bt + (size_t)nxt.pn * tstepB + (size_t)nxt.sub * g.b_sub : cB;
        for (int t = 0; t < nt; t += 2) {
            const bool last = (t == nt - 2);
            const char* a1 = cA + (size_t)(t + 1) * kstep;
            const char* a2 = last ? nA : cA + (size_t)(t + 2) * kstep; const char* b2 = last ? nB : cB + (size_t)(t + 2) * kstep;
            const char* a3 = a2 + kstep; const char* b3 = b2 + kstep;
            if (last && has_next) S.a_ready(nxt);
            if constexpr (SP2) {
            PG8_LDB(B0, 0, 0); PG8_LDB(B1, 0, 1); PG8_SCHED; PG8_LDA(At, 0, 0); PG8_STAGE(PG8_SA(1, 1), a1 + hstepA, voffA);
            PG8_WAIT_V(8); PG8_WAIT_L(0); PG8_BAR; PG8_MMA(0, 0, At, B0); PG8_MMA(0, 1, At, B1); PG8_BAR; PG8_SCHED;
            PG8_LDA(At, 0, 1); PG8_STAGE(PG8_SB(0, 0), b2, voffB); PG8_STAGE(PG8_SB(0, 1), b2 + hB1, voffB1); PG8_STAGE(PG8_SA(0, 0), a2, voffA);
            PG8_WAIT_V(8); PG8_WAIT_L(0); PG8_BAR; PG8_MMA(1, 0, At, B0); PG8_MMA(1, 1, At, B1); PG8_BAR; PG8_SCHED;
            PG8_LDB(B0, 1, 0); PG8_LDB(B1, 1, 1); PG8_SCHED; PG8_LDA(At, 1, 0); PG8_STAGE(PG8_SA(0, 1), a2 + hstepA, voffA);
            PG8_WAIT_V(8); PG8_WAIT_L(0); PG8_BAR; PG8_MMA(0, 0, At, B0); PG8_MMA(0, 1, At, B1); PG8_BAR; PG8_SCHED;
            PG8_LDA(At, 1, 1); PG8_STAGE(PG8_SB(1, 0), b3, voffB); PG8_STAGE(PG8_SB(1, 1), b3 + hB1, voffB1); PG8_STAGE(PG8_SA(1, 0), a3, voffA);
            PG8_WAIT_V(8); PG8_WAIT_L(0); PG8_BAR; PG8_MMA(1, 0, At, B0); PG8_MMA(1, 1, At, B1); PG8_BAR; PG8_SCHED;
            } else {
            PG8_LDB(B0, 0, 0); PG8_SCHED; PG8_LDA(At, 0, 0); PG8_STAGE(PG8_SA(1, 1), a1 + hstepA, voffA);
            PG8_WAIT_L(8); PG8_BAR; PG8_WAIT_L(0); PG8_MMA(0, 0, At, B0); PG8_BAR; PG8_SCHED;
            PG8_LDB(B1, 0, 1); PG8_STAGE(PG8_SB(0, 0), b2, voffB);
            PG8_BAR; PG8_WAIT_L(0); PG8_MMA(0, 1, At, B1); PG8_BAR;
            PG8_LDA(At, 0, 1); PG8_STAGE(PG8_SA(0, 0), a2, voffA);
            PG8_BAR; PG8_WAIT_L(0); PG8_MMA(1, 0, At, B0); PG8_BAR; PG8_SCHED;
            PG8_STAGE(PG8_SB(0, 1), b2 + hB1, voffB1);
            PG8_WAIT_V(6); PG8_BAR; PG8_MMA(1, 1, At, B1); PG8_BAR;
            PG8_LDB(B0, 1, 0); PG8_SCHED; PG8_LDA(At, 1, 0); PG8_STAGE(PG8_SA(0, 1), a2 + hstepA, voffA);
            PG8_WAIT_L(8); PG8_BAR; PG8_WAIT_L(0); PG8_MMA(0, 0, At, B0); PG8_BAR; PG8_SCHED;
            PG8_LDB(B1, 1, 1); PG8_STAGE(PG8_SB(1, 0), b3, voffB);
            PG8_BAR; PG8_WAIT_L(0); PG8_MMA(0, 1, At, B1); PG8_BAR;
            PG8_LDA(At, 1, 1); PG8_STAGE(PG8_SA(1, 0), a3, voffA);
            PG8_BAR; PG8_WAIT_L(0); PG8_MMA(1, 0, At, B0); PG8_BAR; PG8_SCHED;
            PG8_STAGE(PG8_SB(1, 1), b3 + hB1, voffB1);
            PG8_WAIT_V(6); PG8_BAR; PG8_MMA(1, 1, At, B1); PG8_BAR;
            }
        }
        if constexpr (ALIGN_EPI) { if (wr == 0) PG8_BAR; }
        if constexpr (epi_chain<Epi>::value) { E.chain(acc, cur, wr, wc, fr, fq); S.done(cur); }
        else if constexpr (!Epi::AFTER_DRAIN) { E(acc, cur, wr, wc, fr, fq); S.done(cur); }
        if (!has_next) break;
        if constexpr (!epi_chain<Epi>::value) {
#pragma unroll
        for (int a = 0; a < 2; ++a)
#pragma unroll
            for (int b = 0; b < 2; ++b)
#pragma unroll
                for (int m = 0; m < 4; ++m)
#pragma unroll
                    for (int n = 0; n < 2; ++n) acc[a][b][m][n] = (f32x4){0.f, 0.f, 0.f, 0.f};
        }
        cur = nxt; cA = nA; cB = nB; ++ui;
        if constexpr (ALIGN_EPI) { if (wr == 1) PG8_BAR; }
    }
    PG8_WAIT_V(0);
    if constexpr (!ALIGN_EPI) { if (wr == 0) PG8_BAR; }
    PG8_BAR;
    if constexpr (Epi::AFTER_DRAIN) { E.fused(acc, cur, wr, wc, fr, fq, lds, wid, lane); S.done(cur); }
#undef PG8_SA
#undef PG8_SB
#undef PG8_STAGE
#undef PG8_LDA
#undef PG8_LDB
#undef PG8_MMA
#undef PG8_WAIT_V
#undef PG8_WAIT_L
#undef PG8_BAR
#undef PG8_SCHED
}
}

typedef const __attribute__((address_space(4))) Args* KArgs;
__device__ __forceinline__ void make_ctx(Ctx& c) {
    KArgs ap = (KArgs)__builtin_amdgcn_kernarg_segment_ptr();
    asm volatile("" : "+s"(ap));
    c.x = ap->in[0]; c.norm_g = ap->in[1]; c.w_in = ap->in[2]; c.w_fourier = ap->in[3]; c.conv_w = ap->in[4]; c.conv_b = ap->in[5]; c.conv_ln_g = ap->in[6]; c.conv_ln_b = ap->in[7];
    c.w_pw = ap->in[8]; c.w_pool = ap->in[9]; c.pool_scale = ap->in[10]; c.w_branch = ap->in[11]; c.w_gate = ap->in[12]; c.b_gate = ap->in[13]; c.w_out = ap->in[14]; c.final_g = ap->in[15];
    c.out = ap->out;
    unsigned char* ws = ap->ws;
    c.WinT = (bf16_t*)(ws + WS_WIN); c.WgT = (bf16_t*)(ws + WS_WG); c.WbT = (bf16_t*)(ws + WS_WB); c.WoT = (bf16_t*)(ws + WS_WO); c.WfT = (bf16_t*)(ws + WS_WF); c.WpwT = (bf16_t*)(ws + WS_WPW); c.WpoolT = (bf16_t*)(ws + WS_WPOOL);
    c.TW = (float2*)(ws + WS_TW); c.RC = (float*)(ws + WS_RC); c.RS = (float*)(ws + WS_RS); c.RH = (_Float16*)(ws + WS_RH);
    c.H = (bf16_t*)(ws + WS_H); c.Z = (bf16_t*)(ws + WS_Z); c.P = (bf16_t*)(ws + WS_P); c.FY = (unsigned*)(ws + WS_FY); c.LSE = (float*)(ws + WS_LSE); c.SS = (float*)(ws + WS_SS); c.CNT = (unsigned*)(ws + WS_CNT); c.FF = ws + WS_FF;
    c.AM = (unsigned*)(ws + WS_AM); c.SH = (float*)(ws + WS_SH); c.SW = (float*)(ws + WS_SW); c.H8 = (signed char*)(ws + WS_H8); c.Wg8 = (signed char*)(ws + WS_WG); c.Win8 = (signed char*)(ws + WS_WIN) + (size_t)DEPTH * DIN * DM; c.SWI = (float*)(ws + WS_SWI);
}
constexpr int NPHASES = 1 + 5 * DEPTH;

#define XB_TMO      128
#define XB_XCNT(j)  (256  + 64 * (j))
#define XB_XSUB(j)  (1280 + 64 * (j))
#define XB_XGEN(j)  (2304 + 64 * (j))
#define XB_TOP      3328
#define XB_TOPGEN   3392
#define XCD_BAR_WORDS 3456
#define XB_SPIN_CAP (1u << 18)
#define LAS __attribute__((address_space(3)))

__device__ __forceinline__ unsigned xb_ld(unsigned* p)              { return __hip_atomic_load(p, __ATOMIC_RELAXED, __HIP_MEMORY_SCOPE_AGENT); }
__device__ __forceinline__ unsigned xb_add(unsigned* p, unsigned v) { return __hip_atomic_fetch_add(p, v, __ATOMIC_RELAXED, __HIP_MEMORY_SCOPE_AGENT); }
__device__ __forceinline__ unsigned xb_xcc_id() { return (unsigned)__builtin_amdgcn_s_getreg((3 << 11) | 20) & 0xFu; }
#define XB_SPIN(cond, bar) do { unsigned _sp = 0; while (cond) { __builtin_amdgcn_s_sleep(1); \
    if ((++_sp & 255u) == 0u) { if (xb_ld(&(bar)[XB_TMO])) break; if (_sp > XB_SPIN_CAP) { atomicAdd(&(bar)[XB_TMO], 1u); break; } } } } while (0)

struct XcdBarrier {
    unsigned* bar; unsigned x;
    volatile LAS unsigned* st;
};

__device__ __forceinline__ XcdBarrier xcd_barrier_post(unsigned* bar, volatile LAS unsigned* st) {
    XcdBarrier b; b.bar = bar; b.x = xb_xcc_id(); b.st = st;
    if (threadIdx.x == 0) (void)xb_add(&bar[XB_XCNT(b.x)], 1u);
    return b;
}
__device__ __forceinline__ void xcd_barrier_complete(unsigned* bar, unsigned x, unsigned& nloc, unsigned& nx) {
    const unsigned G = gridDim.x * gridDim.y * gridDim.z;
    unsigned sum, cnt, mine, sp = 0u;
    for (;;) {
        sum = 0u; cnt = 0u; mine = 0u;
#pragma unroll
        for (unsigned j = 0; j < 16; ++j) { const unsigned c = xb_ld(&bar[XB_XCNT(j)]); sum += c; cnt += (c > 0u) ? 1u : 0u; mine = (j == x) ? c : mine; }
        if (sum == G) break;
        __builtin_amdgcn_s_sleep(1);
        if ((++sp & 255u) == 0u) { if (xb_ld(&bar[XB_TMO])) break; if (sp > XB_SPIN_CAP) { atomicAdd(&bar[XB_TMO], 1u); break; } }
    }
    nloc = mine > 0u ? mine : 1u; nx = cnt > 0u ? cnt : 1u;
}

__device__ __forceinline__ void xcd_barrier(const XcdBarrier& b) {
    asm volatile("s_waitcnt vmcnt(0)" ::: "memory");
    __syncthreads();
    if (threadIdx.x == 0) {
        unsigned* bar = b.bar;
        __builtin_amdgcn_s_waitcnt(0);
        unsigned nloc = b.st[0], nx = b.st[1];
        if (nloc == 0u) { xcd_barrier_complete(bar, b.x, nloc, nx); b.st[0] = nloc; b.st[1] = nx; }
        const unsigned old = xb_add(&bar[XB_XSUB(b.x)], 1u);
        const unsigned gen = old / nloc;
        if (old + 1u == (gen + 1u) * nloc) {
            __builtin_amdgcn_fence(__ATOMIC_RELEASE, "agent");
            asm volatile("s_waitcnt vmcnt(0)" ::: "memory");
            const unsigned og = xb_add(&bar[XB_TOP], 1u);
            const unsigned tg = og / nx;
            if (og + 1u == (tg + 1u) * nx) xb_add(&bar[XB_TOPGEN], 1u);
            else XB_SPIN(xb_ld(&bar[XB_TOPGEN]) == tg, bar);
            __builtin_amdgcn_fence(__ATOMIC_ACQUIRE, "agent");
            xb_add(&bar[XB_XGEN(b.x)], 1u);
            asm volatile("s_waitcnt vmcnt(0)" ::: "memory");
        } else {
            XB_SPIN(xb_ld(&bar[XB_XGEN(b.x)]) == gen, bar);
            __builtin_amdgcn_fence(__ATOMIC_ACQUIRE, "agent");
            asm volatile("s_waitcnt vmcnt(0)" ::: "memory");
        }
    }
    __syncthreads();
}


template <int L, int Q>
__device__ __forceinline__ void layer_phase(unsigned char* lds_raw) {
    constexpr int l = L;
    Ctx c; make_ctx(c);
    if constexpr (Q == 0) {
        pg8::StaticOrder S; S.init(MT, DIN, (int)gridDim.x, BIDX);
        {
            typedef pg8::GemmT<DM / 2, DM / 2, DM / 2, 0, 0, true> GT; GT g{(const bf16_t*)c.H8, (const bf16_t*)(c.Win8 + (size_t)l * DIN * DM)};
            pg8::EpiZI8 E{c.Z, DIN, c.SH, c.SWI + (size_t)l * DIN};
            pg8::gemm_phase<pg8::EpiZI8, pg8::StaticOrder, GT, true, true>((PG8_LAS unsigned char*)lds_raw, g, S, E);
        }
        {
            const int G_ = (int)gridDim.x, c_ = BIDX, nfull = (MT / 256) * (DIN / 256) % G_;
            const int nidle = (nfull == 0) ? G_ : G_ - nfull, j_ = (nfull == 0) ? c_ : c_ - nfull;
            constexpr int g_lo = (l == 0) ? TR_WIN : TR_PER_LAYER + TR_WIN, g_hi = (l == 0) ? TR_PER_LAYER : 2 * TR_PER_LAYER;
            constexpr int nstrips = (l == 0) ? 64 + DIN / 64 : 64;
            if (l < 2 && j_ >= 0) {
                for (int s_ = j_; s_ < nstrips; s_ += nidle) { if (s_ < 64) convert_strip(c, (float*)lds_raw, l, s_); else convert_strip(c, (float*)lds_raw, 1, s_); }
                const int jf = (nstrips % nidle == 0 || nstrips % nidle > nidle - 8) ? 0 : nstrips % nidle;
                if (j_ >= jf) convert_items(c, (float*)lds_raw, g_lo, g_hi, j_ - jf, nidle - jf);
            }
        }
    } else if constexpr (Q == 1) {
        constexpr int NTK = NB * 64;
        attn_phase_mfma(c, lds_raw, true);
        __builtin_amdgcn_sched_barrier(0);
        for (int u = BIDX; u < NTK; u += gridDim.x) tok_unit_mfma(c, l, u, lds_raw);
        __builtin_amdgcn_sched_barrier(0);
        fft1_phase_wave(c, lds_raw);
    } else if constexpr (Q == 3) {
        fft2_phase_mfma(c, l, lds_raw);
        phase_combine(c);
        __syncthreads();
        typedef pg8::GemmT<DM / 2, DM / 2, DM / 2, 0, 0, true> GT; GT g{(const bf16_t*)c.H8, (const bf16_t*)(c.Wg8 + (size_t)l * 4096 * DM)}; pg8::StaticOrder S; S.init(MT, 4096, (int)gridDim.x, BIDX);
        pg8::EpiGateU8 E{(unsigned char*)c.Z, c.b_gate + (size_t)l * 4096, c.SH, c.SW + (size_t)l * 4096};
        pg8::gemm_phase<pg8::EpiGateU8, pg8::StaticOrder, GT, true, true>((PG8_LAS unsigned char*)lds_raw, g, S, E);
    } else if constexpr (Q == 4) {
        typedef pg8::GemmT<DM, 256, 256, 512, 1024 * 256 * 2> GT; GT g{c.P, c.WbT + (size_t)l * 4 * 1024 * 256}; pg8::MergeOrder S; S.init(MT, DM, (int)gridDim.x, BIDX);
        pg8::EpiMergeChain E{(const unsigned char*)c.Z, c.H, c.FF};
        pg8::gemm_phase<pg8::EpiMergeChain, pg8::MergeOrder, GT, true, true>((PG8_LAS unsigned char*)lds_raw, g, S, E);
    } else if constexpr (Q == 5) {
        typedef pg8::GemmT<DM, DM, DM, 0, 0> GT; GT g{c.H, c.WoT + (size_t)l * DM * DM}; pg8::StaticOrder S; S.init(MT, DM, (int)gridDim.x, BIDX);
        typedef pg8::EpiOutNorm<(l + 1 == DEPTH)> EP;
        EP E{(l == 0) ? c.x : c.out, c.out, (l + 1 < DEPTH) ? c.norm_g + (size_t)(l + 1) * DM : c.final_g, c.SS + (size_t)l * MT, c.CNT + (size_t)l * 128 * 16, c.H, c.AM, c.H8, c.SH};
        pg8::gemm_phase<EP, pg8::StaticOrder, GT, true, true>((PG8_LAS unsigned char*)lds_raw, g, S, E);
    }
}

__global__ void __launch_bounds__(NTHREADS, 2) fwd_kernel(Args a) {
    extern __shared__ __attribute__((aligned(16))) unsigned char lds_raw[];
    const int lo = a.ph_lo, hi = a.ph_hi;
    volatile LAS unsigned* bst = (volatile LAS unsigned*)(lds_raw + LDS_BYTES - 16);
    if (threadIdx.x < 4) bst[threadIdx.x] = 0u;
    __syncthreads();
    XcdBarrier bar = xcd_barrier_post((unsigned*)(a.ws + WS_CTL), bst);
#define RUN_PHASE(k, ...) do { if (lo <= (k) && (k) < hi) { __VA_ARGS__; if ((k) + 1 < hi) xcd_barrier(bar); } } while (0)
    RUN_PHASE(0, { Ctx c; make_ctx(c); phase_pre(c, (float*)lds_raw); phase_norm_bf16(c.x, c.norm_g, c.H, c.H8, c.SH); });
    RUN_PHASE(1, layer_phase<0, 0>(lds_raw));
    RUN_PHASE(2, layer_phase<0, 1>(lds_raw));
    RUN_PHASE(3, layer_phase<0, 3>(lds_raw));
    RUN_PHASE(4, layer_phase<0, 4>(lds_raw));
    RUN_PHASE(5, layer_phase<0, 5>(lds_raw));
    RUN_PHASE(6, layer_phase<1, 0>(lds_raw));
    RUN_PHASE(7, layer_phase<1, 1>(lds_raw));
    RUN_PHASE(8, layer_phase<1, 3>(lds_raw));
    RUN_PHASE(9, layer_phase<1, 4>(lds_raw));
    RUN_PHASE(10, layer_phase<1, 5>(lds_raw));
#undef RUN_PHASE
}

extern "C" void kernel_launch(void* const* d_in, const int* in_sizes, int n_in, void* d_out, int out_size, void* d_ws, size_t ws_size, hipStream_t stream) {
    static int grid = 0;
    if (grid == 0) {
        if (n_in != 16 || in_sizes[0] != MT * DM || out_size != MT * DM || ws_size < WS_END) {
            fprintf(stderr, "kernel_launch: unexpected shapes: n_in %d in0 %d out %d ws %zu (need %zu)\n", n_in, n_in > 0 ? in_sizes[0] : -1, out_size, ws_size, (size_t)WS_END);
            grid = -1; return;
        }
        int dev = 0, cus = 0, per_cu = 0;
        hipGetDevice(&dev); hipDeviceGetAttribute(&cus, hipDeviceAttributeMultiprocessorCount, dev);
        if (hipFuncSetAttribute((const void*)fwd_kernel, hipFuncAttributeMaxDynamicSharedMemorySize, LDS_BYTES) != hipSuccess) { fprintf(stderr, "kernel_launch: hipFuncSetAttribute failed\n"); grid = -1; return; }
        hipOccupancyMaxActiveBlocksPerMultiprocessor(&per_cu, (const void*)fwd_kernel, NTHREADS, LDS_BYTES);
        if (per_cu < 1) { fprintf(stderr, "kernel_launch: occupancy query says %d blocks/CU\n", per_cu); per_cu = 1; }
        (void)hipGetLastError();
        grid = cus;
    }
    if (grid < 0) return;
    if (hipMemsetAsync((char*)d_ws + WS_CTL, 0, 16384, stream) != hipSuccess) { fprintf(stderr, "kernel_launch: hipMemsetAsync failed\n"); return; }
    Args a{};
    for (int i = 0; i < 16; ++i) a.in[i] = (const float*)d_in[i];
    a.out = (float*)d_out; a.ws = (unsigned char*)d_ws;
#if ONE_LAUNCH
    a.ph_lo = 0; a.ph_hi = NPHASES;
    void* args[] = {&a};
    hipError_t e = hipLaunchCooperativeKernel((const void*)fwd_kernel, dim3(grid), dim3(NTHREADS), args, LDS_BYTES, stream);
    if (e != hipSuccess) fprintf(stderr, "kernel_launch: cooperative launch failed: %s (grid %d)\n", hipGetErrorString(e), grid);
#else
    for (int ph = 0; ph < NPHASES; ++ph) {
        a.ph_lo = ph; a.ph_hi = ph + 1;
        hipLaunchKernelGGL(fwd_kernel, dim3(grid), dim3(NTHREADS), LDS_BYTES, stream, a);
    }
#endif
}
```

```cpp
#include <hip/hip_runtime.h>
#include <hip/hip_cooperative_groups.h>
#include <cstdio>
#include <cstdint>
namespace cg = cooperative_groups;

#ifndef ONE_LAUNCH
#define ONE_LAUNCH 1
#endif

typedef unsigned short bf16_t;
typedef short bf16x8 __attribute__((ext_vector_type(8)));
typedef float f32x4 __attribute__((ext_vector_type(4)));
typedef float f32x2 __attribute__((ext_vector_type(2)));
typedef unsigned u32x4 __attribute__((ext_vector_type(4)));
typedef unsigned u32x2 __attribute__((ext_vector_type(2)));

constexpr int NB = 8, SEQ = 4096, DM = 1024, MT = NB * SEQ, DIN = 4352, DEPTH = 2;
constexpr int ZA = 0, ZB = 256, ZQ = 768, ZK = 1536, ZV = 2304, ZD = 3072, ZG = 3328;
constexpr int NTHREADS = 512, NWAVES = 8;
constexpr int LDS_BYTES = 147456;

constexpr size_t WS_CTL = 0;
constexpr size_t WS_WIN = 65536;
constexpr size_t WS_WG = WS_WIN + (size_t)DEPTH * DIN * DM * 2;
constexpr size_t WS_WB = WS_WG + (size_t)DEPTH * 4096 * DM * 2;
constexpr size_t WS_WO = WS_WB + (size_t)DEPTH * 4 * 1024 * 256 * 2;
constexpr size_t WS_WF = WS_WO + (size_t)DEPTH * DM * DM * 2;
constexpr size_t WS_WPW = WS_WF + (size_t)DEPTH * 65536 * 2;
constexpr size_t WS_WPOOL = WS_WPW + (size_t)DEPTH * 65536 * 2;
constexpr size_t WS_TW = WS_WPOOL + (size_t)DEPTH * 4 * 4096 * 2;
constexpr size_t WS_RC = WS_TW + 4096 * 8;
constexpr size_t WS_RS = WS_RC + 4096 * 32 * 4;
constexpr size_t WS_RH = WS_RS + 4096 * 32 * 4;
constexpr size_t WS_H = WS_RH + 4096 * 64 * 2;
constexpr size_t WS_Z = WS_H + (size_t)MT * DM * 2;
constexpr size_t WS_P = WS_Z + (size_t)MT * DIN * 2;
constexpr size_t WS_FY = WS_P + (size_t)MT * DM * 2;
constexpr size_t WS_LSE = WS_FY + (size_t)NB * 4 * 64 * 64 * 64 * 4;
constexpr size_t WS_SS = WS_LSE + (size_t)3 * MT * 4 * 4;
constexpr size_t WS_AM = WS_SS + (size_t)DEPTH * MT * 4;
constexpr size_t WS_SH = WS_AM + (size_t)MT * 4;
constexpr size_t WS_SW = WS_SH + (size_t)MT * 4;
constexpr size_t WS_SWI = WS_SW + (size_t)DEPTH * 4096 * 4;
constexpr size_t WS_H8 = WS_SWI + (size_t)DEPTH * DIN * 4;
constexpr size_t WS_END = WS_H8 + (size_t)MT * DM;
constexpr size_t WS_FF = WS_CTL + 49152;
constexpr size_t WS_CNT = WS_CTL + 16384;

struct Args { const float* in[16]; float* out; unsigned char* ws; int ph_lo, ph_hi; };

__device__ __forceinline__ float bf2f(bf16_t v) { return __uint_as_float((unsigned)v << 16); }
__device__ __forceinline__ float bflo(unsigned w) { return __uint_as_float(w << 16); }
__device__ __forceinline__ float bfhi(unsigned w) { return __uint_as_float(w & 0xffff0000u); }
__device__ __forceinline__ bf16_t f2bf(float f) { unsigned u = __float_as_uint(f); u += 0x7fffu + ((u >> 16) & 1u); return (bf16_t)(u >> 16); }
typedef float f32x2n __attribute__((ext_vector_type(2)));
typedef __bf16 bf16x2n __attribute__((ext_vector_type(2)));
__device__ __forceinline__ unsigned pk2(float lo, float hi) { const f32x2n v = {lo, hi}; return __builtin_bit_cast(unsigned, __builtin_convertvector(v, bf16x2n)); }
__device__ __forceinline__ float sigmoidf_(float x) { return __builtin_amdgcn_rcpf(1.f + __builtin_amdgcn_exp2f(x * -1.44269504f)); }
__device__ __forceinline__ float siluf_(float x) { return x * sigmoidf_(x); }
__device__ __forceinline__ int opq(int v) { asm volatile("" : "+v"(v)); return v; }
#define TIDX opq((int)threadIdx.x)
__device__ __forceinline__ int opqs(int v) { asm volatile("" : "+s"(v)); return v; }
#define BIDX opqs((int)blockIdx.x)
__device__ __forceinline__ float row16_sum(float v) {
    v += __builtin_bit_cast(float, __builtin_amdgcn_update_dpp(0, __builtin_bit_cast(int, v), 0x128, 0xf, 0xf, false));
    v += __builtin_bit_cast(float, __builtin_amdgcn_update_dpp(0, __builtin_bit_cast(int, v), 0x124, 0xf, 0xf, false));
    v += __builtin_bit_cast(float, __builtin_amdgcn_update_dpp(0, __builtin_bit_cast(int, v), 0x122, 0xf, 0xf, false));
    v += __builtin_bit_cast(float, __builtin_amdgcn_update_dpp(0, __builtin_bit_cast(int, v), 0x121, 0xf, 0xf, false));
    return v;
}
__device__ __forceinline__ float wave_sum(float v) {
    v = row16_sum(v);
    const int vi = __builtin_bit_cast(int, v);
    return (__builtin_bit_cast(float, __builtin_amdgcn_readlane(vi, 0)) + __builtin_bit_cast(float, __builtin_amdgcn_readlane(vi, 16))) +
           (__builtin_bit_cast(float, __builtin_amdgcn_readlane(vi, 32)) + __builtin_bit_cast(float, __builtin_amdgcn_readlane(vi, 48)));
}


typedef float f32x16g __attribute__((ext_vector_type(16)));
typedef int i32x4 __attribute__((ext_vector_type(4)));
__device__ __forceinline__ f32x4 mfma16i8_g(bf16x8 a, bf16x8 b, f32x4 c) {
    i32x4 d = __builtin_amdgcn_mfma_i32_16x16x64_i8(__builtin_bit_cast(i32x4, a), __builtin_bit_cast(i32x4, b), __builtin_bit_cast(i32x4, c), 0, 0, 0);
    asm volatile("" :: "v"(a), "v"(b), "v"(d));
    return __builtin_bit_cast(f32x4, d);
}
__device__ __forceinline__ f32x4 mfma16_g(bf16x8 a, bf16x8 b, f32x4 c) {
    f32x4 d = __builtin_amdgcn_mfma_f32_16x16x32_bf16(a, b, c, 0, 0, 0);
    asm volatile("" :: "v"(a), "v"(b), "v"(d));
    return d;
}
__device__ __forceinline__ f32x16g mfma32_g(bf16x8 a, bf16x8 b, f32x16g c) {
    f32x16g d = __builtin_amdgcn_mfma_f32_32x32x16_bf16(a, b, c, 0, 0, 0);
    asm volatile("" :: "v"(a), "v"(b), "v"(d));
    return d;
}

struct Ctx {
    const float *x, *norm_g, *w_in, *w_fourier, *conv_w, *conv_b, *conv_ln_g, *conv_ln_b, *w_pw, *w_pool, *pool_scale, *w_branch, *w_gate, *b_gate, *w_out, *final_g;
    float* out;
    bf16_t *WinT, *WgT, *WbT, *WoT, *WfT, *WpwT, *WpoolT, *H, *Z, *P;
    float2* TW; float *RC, *RS, *LSE, *SS; unsigned* FY; unsigned* CNT; _Float16* RH; unsigned char* FF; unsigned* AM; float *SH, *SW; signed char *H8, *Wg8, *Win8; float* SWI;
};

constexpr int TR_WIN = (DM / 64) * (DIN / 64), TR_PER_LAYER = TR_WIN + 4 * 64 + 256 + 16 + 16 + 4;
struct TrItem { const float* W; bf16_t* WT; int K, N, kb, nb; };
__device__ __forceinline__ TrItem tr_decode(const Ctx& c, int G) {
    TrItem it; const int l = G / TR_PER_LAYER; int r = G % TR_PER_LAYER;
    if (r < TR_WIN) { it.W = c.w_in + (size_t)l * DM * DIN; it.WT = c.WinT + (size_t)l * DIN * DM; it.K = DM; it.N = DIN; }
    else { r -= TR_WIN;
        {
            if (r < 256) { const int n = r >> 6; r &= 63; it.W = c.w_branch + (size_t)(l * 4 + n) * 256 * DM; it.WT = c.WbT + (size_t)(l * 4 + n) * 1024 * 256; it.K = 256; it.N = DM; }
            else { r -= 256;
                if (r < 256) { it.W = c.w_out + (size_t)l * DM * DM; it.WT = c.WoT + (size_t)l * DM * DM; it.K = DM; it.N = DM; }
                else { r -= 256;
                    if (r < 16) { it.W = c.w_fourier + (size_t)l * 65536; it.WT = c.WfT + (size_t)l * 65536; it.K = 256; it.N = 256; }
                    else { r -= 16;
                        if (r < 16) { it.W = c.w_pw + (size_t)l * 65536; it.WT = c.WpwT + (size_t)l * 65536; it.K = 256; it.N = 256; }
                        else { r -= 16; it.W = c.w_pool + (size_t)(l * 4 + r) * 4096; it.WT = c.WpoolT + (size_t)(l * 4 + r) * 4096; it.K = 64; it.N = 64; r = 0; } } } } } }
    const int nnb = it.N / 64; it.kb = r / nnb; it.nb = r % nnb; return it;
}
__device__ __forceinline__ void convert_i8_strip(const float* W, int ldw, signed char* WT, float* SWp, float* scr, int rmul, int radd) {
    const int t = TIDX, kg = t >> 6, nn = t & 63;
    float am = 0.f;
#pragma unroll 1
    for (int i0 = 0; i0 < 128; i0 += 64) {
        float v[64];
#pragma unroll
        for (int i = 0; i < 64; ++i) v[i] = W[(size_t)(kg + 8 * (i0 + i)) * ldw + nn];
#pragma unroll
        for (int i = 0; i < 64; ++i) am = fmaxf(am, fabsf(v[i]));
    }
    scr[kg * 64 + nn] = am;
    __syncthreads();
    if (t < 64) { float m = scr[t];
#pragma unroll
        for (int k = 1; k < 8; ++k) m = fmaxf(m, scr[k * 64 + t]);
        scr[512 + t] = m; SWp[rmul * t + radd] = m * (1.f / 127.f); }
    __syncthreads();
    const float cm = scr[512 + nn], inv = cm > 0.f ? 127.f / cm : 0.f;
    __syncthreads();
    float r[8];
#pragma unroll
    for (int i = 0; i < 8; ++i) r[i] = W[(size_t)(kg + 8 * i) * ldw + nn];
#pragma unroll 1
    for (int kb = 0; kb < 16; ++kb) {
#pragma unroll
        for (int i = 0; i < 8; ++i) scr[1024 + (kg + 8 * i) * 65 + nn] = r[i] * inv + 12582912.0f;
        __syncthreads();
        if (kb + 1 < 16) {
#pragma unroll
            for (int i = 0; i < 8; ++i) r[i] = W[(size_t)((kb + 1) * 64 + kg + 8 * i) * ldw + nn]; }
        { const int on = t >> 3, kc = t & 7;
          const unsigned* sp = (const unsigned*)(scr + 1024 + (8 * kc) * 65 + on);
          u32x2 o; o.x = (sp[0] & 0xffu) | ((sp[65] & 0xffu) << 8) | ((sp[2 * 65] & 0xffu) << 16) | (sp[3 * 65] << 24);
          o.y = (sp[4 * 65] & 0xffu) | ((sp[5 * 65] & 0xffu) << 8) | ((sp[6 * 65] & 0xffu) << 16) | (sp[7 * 65] << 24);
          *(u32x2*)(WT + (ptrdiff_t)(rmul * on + radd) * DM + kb * 64 + 8 * kc) = o; }
        __syncthreads();
    }
}
__device__ __forceinline__ void convert_strip(const Ctx& c, float* scr, int l, int s) {
    if (s < 64) { const int n = s >> 4, cs = (s & 15) * 64;
        convert_i8_strip(c.w_gate + (size_t)(l * 4 + n) * DM * DM + cs, DM, c.Wg8 + ((size_t)l * 4096 + n * 1024 + cs) * DM, c.SW + (size_t)l * 4096 + n * 1024 + cs, scr, 1, 0); }
    else { const int cs = (s - 64) * 64;
        const int rmul = (cs >= ZB && cs < ZQ) ? 2 : 1, radd = (cs >= ZB && cs < ZB + 256) ? cs - ZB : ((cs >= ZB + 256 && cs < ZQ) ? cs - ZB - 511 : 0);
        convert_i8_strip(c.w_in + (size_t)l * DM * DIN + cs, DIN, c.Win8 + ((size_t)l * DIN + cs) * DM, c.SWI + (size_t)l * DIN + cs, scr, rmul, radd); }
}
__device__ __forceinline__ void convert_items(const Ctx& c, float* scr, int g_lo, int g_hi, int first, int stride) {
    const int t = TIDX, kk0 = t >> 6, nn = t & 63;
    int G = g_lo + first;
    if (G >= g_hi) return;
    float r[8];
    TrItem it = tr_decode(c, G);
#pragma unroll
    for (int i = 0; i < 8; ++i) r[i] = it.W[(size_t)(it.kb * 64 + kk0 + 8 * i) * it.N + it.nb * 64 + nn];
    for (;;) {
#pragma unroll
        for (int i = 0; i < 8; ++i) scr[(kk0 + 8 * i) * 65 + nn] = r[i];
        __syncthreads();
        const int Gn = G + stride; const bool more = Gn < g_hi;
        TrItem nx = it;
        if (more) { nx = tr_decode(c, Gn);
#pragma unroll
            for (int i = 0; i < 8; ++i) r[i] = nx.W[(size_t)(nx.kb * 64 + kk0 + 8 * i) * nx.N + nx.nb * 64 + nn]; }
        { const int on = t >> 3, kc = t & 7;
          const float* sp = scr + (8 * kc) * 65 + on;
          u32x4 o; o.x = pk2(sp[0], sp[65]); o.y = pk2(sp[2 * 65], sp[3 * 65]); o.z = pk2(sp[4 * 65], sp[5 * 65]); o.w = pk2(sp[6 * 65], sp[7 * 65]);
          *(u32x4*)(it.WT + (size_t)(it.nb * 64 + on) * it.K + it.kb * 64 + 8 * kc) = o; }
        __syncthreads();
        if (!more) break;
        it = nx; G = Gn;
    }
}
__device__ __forceinline__ void phase_pre(const Ctx& c, float* lds) {
    for (int s_ = BIDX; s_ < DIN / 64; s_ += gridDim.x) convert_strip(c, lds, 0, 64 + s_);
    const int gt = BIDX * NTHREADS + TIDX, NT = gridDim.x * NTHREADS;
    for (int i = gt; i < DEPTH * MT; i += NT) c.SS[i] = 0.f;
    for (int i = gt; i < MT; i += NT) c.AM[i] = 0u;
    if (gt < 4) ((unsigned*)c.FF)[gt] = 0xffffffffu;
    for (int i = gt; i < DEPTH * 128 * 16; i += NT) c.CNT[i] = 0u;
    for (int i = gt; i < 4096; i += NT) { float s, co; sincospif((float)i / 2048.f, &s, &co); c.TW[i] = make_float2(co, s); }
    for (int i = gt; i < 4096 * 32; i += NT) {
        const int pos = i >> 5, k = i & 31;
        const float inv = exp2f(-(float)k * (13.287712379549449f / 32.0f));
        double tq = (double)pos * (double)inv * 0.3183098861837907;
        tq -= 2.0 * rint(tq * 0.5);
        float s, co; sincospif((float)tq, &s, &co);
        c.RH[pos * 64 + k] = (_Float16)co; c.RH[pos * 64 + 32 + k] = (_Float16)s;
    }
}

__device__ __forceinline__ float row16_max(float v) {
    v = fmaxf(v, __builtin_bit_cast(float, __builtin_amdgcn_update_dpp(0, __builtin_bit_cast(int, v), 0x128, 0xf, 0xf, false)));
    v = fmaxf(v, __builtin_bit_cast(float, __builtin_amdgcn_update_dpp(0, __builtin_bit_cast(int, v), 0x124, 0xf, 0xf, false)));
    v = fmaxf(v, __builtin_bit_cast(float, __builtin_amdgcn_update_dpp(0, __builtin_bit_cast(int, v), 0x122, 0xf, 0xf, false)));
    v = fmaxf(v, __builtin_bit_cast(float, __builtin_amdgcn_update_dpp(0, __builtin_bit_cast(int, v), 0x121, 0xf, 0xf, false)));
    return v;
}
__device__ __forceinline__ float wave_max(float v) {
    v = row16_max(v);
    const int vi = __builtin_bit_cast(int, v);
    return fmaxf(fmaxf(__builtin_bit_cast(float, __builtin_amdgcn_readlane(vi, 0)), __builtin_bit_cast(float, __builtin_amdgcn_readlane(vi, 16))),
                 fmaxf(__builtin_bit_cast(float, __builtin_amdgcn_readlane(vi, 32)), __builtin_bit_cast(float, __builtin_amdgcn_readlane(vi, 48))));
}
__device__ __forceinline__ unsigned q8x4(f32x4 y, float inv) {
    const f32x4 m = y * inv + 12582912.0f;
    return (__float_as_uint(m[0]) & 0xffu) | ((__float_as_uint(m[1]) & 0xffu) << 8) | ((__float_as_uint(m[2]) & 0xffu) << 16) | (__float_as_uint(m[3]) << 24);
}
__device__ __forceinline__ void phase_norm_bf16(const float* xin, const float* g, bf16_t* H, signed char* H8, float* SH) {
    const int tid_ = TIDX; const int lane = tid_ & 63, wave = tid_ >> 6;
    const int gw = BIDX * NWAVES + wave, NGW = gridDim.x * NWAVES;
    f32x4 gv[4];
#pragma unroll
    for (int j = 0; j < 4; ++j) gv[j] = *(const f32x4*)(g + 4 * (lane + 64 * j));
    for (int m = gw; m < MT; m += 2 * NGW) {
        const int m2 = (m + NGW < MT) ? m + NGW : m;
        const f32x4* xr = (const f32x4*)(xin + (size_t)m * DM); const f32x4* xr2 = (const f32x4*)(xin + (size_t)m2 * DM);
        f32x4 v[4], w[4]; float s = 0.f, s2 = 0.f;
#pragma unroll
        for (int j = 0; j < 4; ++j) { v[j] = xr[lane + 64 * j]; w[j] = xr2[lane + 64 * j]; }
#pragma unroll
        for (int j = 0; j < 4; ++j) { s += v[j].x * v[j].x + v[j].y * v[j].y + v[j].z * v[j].z + v[j].w * v[j].w; s2 += w[j].x * w[j].x + w[j].y * w[j].y + w[j].z * w[j].z + w[j].w * w[j].w; }
        const float rstd = 1.0f / sqrtf(wave_sum(s) * (1.f / DM) + 1e-6f), rstd2 = 1.0f / sqrtf(wave_sum(s2) * (1.f / DM) + 1e-6f);
        float a1 = 0.f, a2 = 0.f;
#pragma unroll
        for (int j = 0; j < 4; ++j) { v[j] = v[j] * rstd * gv[j]; w[j] = w[j] * rstd2 * gv[j];
            a1 = fmaxf(a1, fmaxf(fmaxf(fabsf(v[j].x), fabsf(v[j].y)), fmaxf(fabsf(v[j].z), fabsf(v[j].w)))); a2 = fmaxf(a2, fmaxf(fmaxf(fabsf(w[j].x), fabsf(w[j].y)), fmaxf(fabsf(w[j].z), fabsf(w[j].w)))); }
        a1 = wave_max(a1); a2 = wave_max(a2);
        const float i1 = a1 > 0.f ? 127.f / a1 : 0.f, i2 = a2 > 0.f ? 127.f / a2 : 0.f;
        unsigned* q = (unsigned*)(H8 + (size_t)m * DM); unsigned* q2 = (unsigned*)(H8 + (size_t)m2 * DM);
#pragma unroll
        for (int j = 0; j < 4; ++j) q[lane + 64 * j] = q8x4(v[j], i1);
#pragma unroll
        for (int j = 0; j < 4; ++j) q2[lane + 64 * j] = q8x4(w[j], i2);
        if (lane == 0) { SH[m] = a1 * (1.f / 127.f); SH[m2] = a2 * (1.f / 127.f); }
    }
}
__device__ __forceinline__ void phase_norm_final(float* xio, const float* g) {
    const int tid_ = TIDX; const int lane = tid_ & 63, wave = tid_ >> 6;
    const int gw = BIDX * NWAVES + wave, NGW = gridDim.x * NWAVES;
    f32x4 gv[4];
#pragma unroll
    for (int j = 0; j < 4; ++j) gv[j] = *(const f32x4*)(g + 4 * (lane + 64 * j));
    for (int m = gw; m < MT; m += NGW) {
        f32x4* xr = (f32x4*)(xio + (size_t)m * DM);
        f32x4 v[4]; float s = 0.f;
#pragma unroll
        for (int j = 0; j < 4; ++j) { v[j] = xr[lane + 64 * j]; s += v[j].x * v[j].x + v[j].y * v[j].y + v[j].z * v[j].z + v[j].w * v[j].w; }
        const float rstd = 1.0f / sqrtf(wave_sum(s) * (1.f / DM) + 1e-6f);
#pragma unroll
        for (int j = 0; j < 4; ++j) xr[lane + 64 * j] = v[j] * rstd * gv[j];
    }
}

typedef float f32x16 __attribute__((ext_vector_type(16)));
typedef _Float16 h16x8 __attribute__((ext_vector_type(8)));
#define LASP __attribute__((address_space(3)))
__device__ __forceinline__ unsigned cvtpk(float lo, float hi) { return pk2(lo, hi); }
struct AttnU { int b, g, hI, d, L, r, hh, i0; };
__device__ __forceinline__ AttnU attn_decode(int u) {
    AttnU a; a.b = u / 192; const int rem = u % 192; a.g = rem >> 6; const int rem2 = rem & 63; a.hI = rem2 >> 4; const int rqb = rem2 & 15;
    a.d = 1 << (2 * a.g); a.L = SEQ / a.d; const int nqb = a.L / 256; a.r = rqb / nqb; a.hh = a.g * 4 + a.hI; a.i0 = (rqb % nqb) * 256; return a;
}
__device__ __forceinline__ void attn_phase_mfma(const Ctx& c, unsigned char* lds_raw, bool do_store) {
    LASP unsigned char* Kt = (LASP unsigned char*)lds_raw;
    LASP unsigned* Vt = (LASP unsigned*)(lds_raw + 49152);
    const int t = TIDX, lane = t & 63, wave = __builtin_amdgcn_readfirstlane(t >> 6), rq = lane & 31, h = lane >> 5;
    constexpr int NAT = NB * 192;
    const int G = gridDim.x;
    int u = BIDX;
    if (u >= NAT) return;
    u32x4 ka[3], kb2[3], va[3], vb[3], qn[4];
    h16x8 tq[4], tkc[3], tks[3];
#define ATT_PREFETCH(uu_) do { const AttnU A_ = attn_decode(uu_); \
        { const bf16_t* qr_ = c.Z + ((size_t)A_.b * SEQ + A_.r + A_.d * (A_.i0 + 32 * wave + rq)) * DIN + ZQ + A_.hh * 64 + 8 * h; \
          qn[0] = *(const u32x4*)qr_; qn[1] = *(const u32x4*)(qr_ + 16); qn[2] = *(const u32x4*)(qr_ + 32); qn[3] = *(const u32x4*)(qr_ + 48); } \
        _Pragma("unroll") for (int i = 0; i < 3; ++i) { \
            { const int id = t + 512 * i, row = id >> 2, dc = id & 3, j = A_.i0 - 64 + row; \
              ka[i] = (u32x4){0u, 0u, 0u, 0u}; kb2[i] = ka[i]; \
              if (j >= 0 && j < A_.L) { const int pos = A_.r + A_.d * j; const bf16_t* kr = c.Z + ((size_t)A_.b * SEQ + pos) * DIN + ZK + A_.hh * 64 + 8 * dc; \
                  ka[i] = *(const u32x4*)kr; kb2[i] = *(const u32x4*)(kr + 32); } } \
            { const int id = t + 512 * i, rp = id % 192, dc8 = id / 192, j0 = A_.i0 - 64 + 2 * rp; \
              va[i] = (u32x4){0u, 0u, 0u, 0u}; vb[i] = va[i]; \
              if (j0 >= 0 && j0 < A_.L) va[i] = *(const u32x4*)(c.Z + ((size_t)A_.b * SEQ + A_.r + A_.d * j0) * DIN + ZV + A_.hh * 64 + 8 * dc8); \
              if (j0 + 1 >= 0 && j0 + 1 < A_.L) vb[i] = *(const u32x4*)(c.Z + ((size_t)A_.b * SEQ + A_.r + A_.d * (j0 + 1)) * DIN + ZV + A_.hh * 64 + 8 * dc8); } } } while (0)
#define ATT_TABLES(uu_) do { const AttnU A_ = attn_decode(uu_); \
        { const _Float16* rh_ = c.RH + (A_.r + A_.d * (A_.i0 + 32 * wave + rq)) * 64 + 8 * h; \
          tq[0] = *(const h16x8*)rh_; tq[1] = *(const h16x8*)(rh_ + 16); tq[2] = *(const h16x8*)(rh_ + 32); tq[3] = *(const h16x8*)(rh_ + 48); } \
        _Pragma("unroll") for (int i = 0; i < 3; ++i) { const int id = t + 512 * i, row = id >> 2, dc = id & 3; \
            int posk = A_.r + A_.d * (A_.i0 - 64 + row); posk = posk < 0 ? 0 : (posk > SEQ - 1 ? SEQ - 1 : posk);         \
            tkc[i] = *(const h16x8*)(c.RH + posk * 64 + 8 * dc); tks[i] = *(const h16x8*)(c.RH + posk * 64 + 32 + 8 * dc); } } while (0)
    ATT_PREFETCH(u);
    for (;;) {
        ATT_TABLES(u);
        asm volatile("" ::: "memory");
        const AttnU A = attn_decode(u);
        const int b = A.b, g = A.g, hI = A.hI, d = A.d, L = A.L, r = A.r, hh = A.hh, i0 = A.i0;
        const int iq = i0 + 32 * wave + rq, posq = r + d * iq;
        const size_t tokq = (size_t)b * SEQ + posq;
        bf16_t* qrow = c.Z + tokq * DIN + ZQ + hh * 64;
        bf16x8 qf[4];
        {
            const u32x4 q0 = qn[0], q1 = qn[1], q2 = qn[2], q3 = qn[3];
            const h16x8 cav = tq[0], cbv = tq[1], sav = tq[2], sbv = tq[3];
            const float sc = 0.125f * 1.44269504f;
            u32x4 o0, o1, o2, o3;
    #pragma unroll
            for (int e = 0; e < 4; ++e) {
                const float ca_0 = (float)cav[2 * e], ca_1 = (float)cav[2 * e + 1], sa_0 = (float)sav[2 * e], sa_1 = (float)sav[2 * e + 1];
                const float cb_0 = (float)cbv[2 * e], cb_1 = (float)cbv[2 * e + 1], sb_0 = (float)sbv[2 * e], sb_1 = (float)sbv[2 * e + 1];
                const float a0 = bflo(q0[e]), a1 = bfhi(q0[e]), b0 = bflo(q2[e]), b1 = bfhi(q2[e]);
                const float e0 = bflo(q1[e]), e1 = bfhi(q1[e]), f0 = bflo(q3[e]), f1 = bfhi(q3[e]);
                o0[e] = pk2((a0 * ca_0 - b0 * sa_0) * sc, (a1 * ca_1 - b1 * sa_1) * sc);
                o2[e] = pk2((b0 * ca_0 + a0 * sa_0) * sc, (b1 * ca_1 + a1 * sa_1) * sc);
                o1[e] = pk2((e0 * cb_0 - f0 * sb_0) * sc, (e1 * cb_1 - f1 * sb_1) * sc);
                o3[e] = pk2((f0 * cb_0 + e0 * sb_0) * sc, (f1 * cb_1 + e1 * sb_1) * sc);
            }
            qf[0] = __builtin_bit_cast(bf16x8, o0); qf[1] = __builtin_bit_cast(bf16x8, o1); qf[2] = __builtin_bit_cast(bf16x8, o2); qf[3] = __builtin_bit_cast(bf16x8, o3);
        }
#pragma unroll
        for (int i = 0; i < 3; ++i) {
            const int id = t + 512 * i, row = id >> 2, dc = id & 3;
            const h16x8 kcv = tkc[i], ksv = tks[i];
            u32x4 olo, ohi;
#pragma unroll
            for (int e = 0; e < 4; ++e) {
                const float l0 = bflo(ka[i][e]), l1 = bfhi(ka[i][e]), h0 = bflo(kb2[i][e]), h1 = bfhi(kb2[i][e]);
                const float cc0 = (float)kcv[2 * e], cc1 = (float)kcv[2 * e + 1], ss0 = (float)ksv[2 * e], ss1 = (float)ksv[2 * e + 1];
                olo[e] = pk2(l0 * cc0 - h0 * ss0, l1 * cc1 - h1 * ss1);
                ohi[e] = pk2(h0 * cc0 + l0 * ss0, h1 * cc1 + l1 * ss1);
            }
            *(LASP u32x4*)(Kt + row * 128 + ((dc ^ (row & 7)) << 4)) = olo;
            *(LASP u32x4*)(Kt + row * 128 + (((4 + dc) ^ (row & 7)) << 4)) = ohi;
            const int rp = id % 192, dc8 = id / 192;
#pragma unroll
            for (int e = 0; e < 4; ++e) {
                Vt[(8 * dc8 + 2 * e) * 194 + rp] = __builtin_amdgcn_perm(vb[i][e], va[i][e], 0x05040100u);
                Vt[(8 * dc8 + 2 * e + 1) * 194 + rp] = __builtin_amdgcn_perm(vb[i][e], va[i][e], 0x07060302u);
            }
        }
        __syncthreads();
        const int un = u + G;
        if (un < NAT) ATT_PREFETCH(un);
        asm volatile("" ::: "memory");
        f32x16 sacc[5];
    #pragma unroll
        for (int kb = 0; kb < 5; ++kb)
    #pragma unroll
            for (int e = 0; e < 16; ++e) sacc[kb][e] = 0.f;
    #pragma unroll
        for (int s4 = 0; s4 < 4; ++s4) {
    #pragma unroll
            for (int kb = 0; kb < 5; ++kb) {
                const int row = 32 * wave + 32 * kb + rq;
                const bf16x8 kf = *(const LASP bf16x8*)(Kt + row * 128 + (((2 * s4 + h) ^ (row & 7)) << 4));
                sacc[kb] = mfma32_g(kf, qf[s4], sacc[kb]);
            }
            __builtin_amdgcn_sched_barrier(0);
        }
        asm volatile("s_nop 15\n\ts_nop 15" : "+v"(sacc[0]), "+v"(sacc[1]), "+v"(sacc[2]), "+v"(sacc[3]), "+v"(sacc[4]));
        const int jbase = i0 - 64 + 32 * wave;
        float mx = -1e30f;
    #pragma unroll
        for (int kb = 0; kb < 5; ++kb)
    #pragma unroll
            for (int e = 0; e < 16; ++e) {
                const int row = (e & 3) + 8 * (e >> 2) + 4 * h, rel = 32 * kb + row - rq, j = jbase + 32 * kb + row;
                const bool valid = (rel >= 0) && (rel <= 128) && (j >= 0) && (j < L);
                const float sv = valid ? sacc[kb][e] : -1e30f;
                sacc[kb][e] = sv; mx = fmaxf(mx, sv);
            }
        mx = fmaxf(mx, __shfl_xor(mx, 32));
        float lsum = 0.f;
    #pragma unroll
        for (int kb = 0; kb < 5; ++kb)
    #pragma unroll
            for (int e = 0; e < 16; ++e) { const float p = __builtin_amdgcn_exp2f(sacc[kb][e] - mx); sacc[kb][e] = p; lsum += p; }
        lsum += __shfl_xor(lsum, 32);
        f32x16 oacc[2];
    #pragma unroll
        for (int db = 0; db < 2; ++db)
    #pragma unroll
            for (int e = 0; e < 16; ++e) oacc[db][e] = 0.f;
    #pragma unroll
        for (int kb = 0; kb < 5; ++kb)
    #pragma unroll
            for (int s2 = 0; s2 < 2; ++s2) {
                u32x4 pw;
    #pragma unroll
                for (int e = 0; e < 4; ++e) pw[e] = cvtpk(sacc[kb][8 * s2 + 2 * e], sacc[kb][8 * s2 + 2 * e + 1]);
                const bf16x8 pf = __builtin_bit_cast(bf16x8, pw);
                const int kp = (32 * wave + 32 * kb + 16 * s2 + 4 * h) >> 1;
    #pragma unroll
                for (int db = 0; db < 2; ++db) {
                    const LASP unsigned* vp = Vt + (32 * db + rq) * 194 + kp;
                    const u32x2 g0 = *(const LASP u32x2*)vp, g1 = *(const LASP u32x2*)(vp + 4);
                    const u32x4 aw = (u32x4){g0.x, g0.y, g1.x, g1.y};
                    oacc[db] = mfma32_g(__builtin_bit_cast(bf16x8, aw), pf, oacc[db]);
                }
            }
        asm volatile("s_nop 15\n\ts_nop 15" : "+v"(oacc[0]), "+v"(oacc[1]));
        if (do_store) {
            const float inv = 1.f / lsum;
    #pragma unroll
            for (int db = 0; db < 2; ++db)
    #pragma unroll
                for (int g4 = 0; g4 < 4; ++g4) {
                    const u32x2 w = (u32x2){cvtpk(oacc[db][4 * g4] * inv, oacc[db][4 * g4 + 1] * inv), cvtpk(oacc[db][4 * g4 + 2] * inv, oacc[db][4 * g4 + 3] * inv)};
                    *(u32x2*)(qrow + 32 * db + 8 * g4 + 4 * h) = w;
                }
            if (h == 0) c.LSE[((size_t)g * MT + tokq) * 4 + hI] = mx * 0.69314718f + __logf(lsum);
        }
        __syncthreads();
        if (un >= NAT) break;
        u = un;
    }
#undef ATT_PREFETCH
#undef ATT_TABLES
}

__device__ __forceinline__ f32x4 mfma16(bf16x8 a, bf16x8 b, f32x4 c) { return mfma16_g(a, b, c); }
template <int KSTEPS, int UNR = 2>
__device__ __forceinline__ void gemm64(const LASP unsigned char* Y, int kbyte0, const bf16_t* Bt, int ldb, f32x4 (&acc)[4][2], int fr, int fq) {
#pragma unroll UNR
    for (int ks = 0; ks < KSTEPS; ++ks) {
        bf16x8 bfr[2], afr[4];
#pragma unroll
        for (int n = 0; n < 2; ++n) bfr[n] = *(const bf16x8*)(Bt + (size_t)(16 * n + fr) * ldb + ks * 32 + 8 * fq);
#pragma unroll
        for (int m = 0; m < 4; ++m) afr[m] = *(const LASP bf16x8*)(Y + (16 * m + fr) * 528 + kbyte0 + (ks * 32 + 8 * fq) * 2);
#pragma unroll
        for (int m = 0; m < 4; ++m)
#pragma unroll
            for (int n = 0; n < 2; ++n) acc[m][n] = mfma16(bfr[n], afr[m], acc[m][n]);
        __builtin_amdgcn_sched_barrier(0);
    }
}
__device__ __forceinline__ bf16x8 pack8(f32x4 lo, f32x4 hi) {
    u32x4 w; w.x = cvtpk(lo[0], lo[1]); w.y = cvtpk(lo[2], lo[3]); w.z = cvtpk(hi[0], hi[1]); w.w = cvtpk(hi[2], hi[3]);
    return __builtin_bit_cast(bf16x8, w);
}
__device__ __forceinline__ bf16x8 dft_frag(int rowidx, int kbase, int fq, bool perm, int which  ) {
    float v[8];
#pragma unroll
    for (int j = 0; j < 8; ++j) {
        const int k = kbase + (perm ? (16 * (j >> 2) + 4 * fq + (j & 3)) : (8 * fq + j));
        float sn, cs; sincospif((float)((rowidx * k) & 63) * (1.f / 32.f), &sn, &cs);
        v[j] = which == 0 ? cs : (which == 1 ? sn : -sn);
    }
    u32x4 w; w.x = pk2(v[0], v[1]); w.y = pk2(v[2], v[3]); w.z = pk2(v[4], v[5]); w.w = pk2(v[6], v[7]);
    return __builtin_bit_cast(bf16x8, w);
}

__device__ __forceinline__ void fft1_phase_wave(const Ctx& c, unsigned char* lds_raw) {
    LASP unsigned char* TB = (LASP unsigned char*)lds_raw;
    LASP unsigned char* TA = (LASP unsigned char*)(lds_raw + 16384);
    const int t = TIDX, lane = t & 63, wave = __builtin_amdgcn_readfirstlane(t >> 6), fr = lane & 15, fq = lane >> 4;
    const int nunits = NB * 4 * 64;
    bf16x8 ua[4][2]; float2 twv[2][2];
#define FT_LOAD(uu_) do { const int s2_ = (uu_) & 63, bg_ = (uu_) >> 6, g_ = bg_ & 3, b_ = bg_ >> 2; \
        _Pragma("unroll") for (int m = 0; m < 4; ++m) _Pragma("unroll") for (int ks = 0; ks < 2; ++ks) \
            ua[m][ks] = *(const bf16x8*)(c.Z + (size_t)(b_ * SEQ + 64 * (16 * m + fr) + s2_) * DIN + ZA + 64 * g_ + 32 * ks + 8 * fq); \
        _Pragma("unroll") for (int mp = 0; mp < 2; ++mp) _Pragma("unroll") for (int q = 0; q < 2; ++q) twv[mp][q] = c.TW[((16 * (2 * mp + q) + fr) * s2_) & 4095]; } while (0)
    { const int u0 = (int)BIDX * 8 + wave; if (u0 < nunits) FT_LOAD(u0); }
#pragma unroll 1
    for (int i = 0; i < 5; ++i) {
        const int ft = wave * 5 + i;
        if (ft < 16) { const int ks = ft >> 3, n = (ft >> 1) & 3, which = ft & 1;
            *(LASP bf16x8*)(TB + (ft * 64 + lane) * 16) = dft_frag(16 * n + fr, 32 * ks, fq, false, which); }
        else { const int f2 = ft - 16, mb = f2 / 6, r6 = f2 % 6, ks = r6 / 3, which = r6 % 3;
            *(LASP bf16x8*)(TA + (f2 * 64 + lane) * 16) = dft_frag(16 * mb + fr, 32 * ks, fq, true, which); }
    }
    __syncthreads();
#define FT_B(ks_, n_, w_) (*(const LASP bf16x8*)(TB + ((((ks_) * 4 + (n_)) * 2 + (w_)) * 64 + lane) * 16))
#define FT_A(mb_, ks_, w_) (*(const LASP bf16x8*)(TA + ((((mb_) * 2 + (ks_)) * 3 + (w_)) * 64 + lane) * 16))
    for (int u = (int)BIDX * 8 + wave; u < nunits; u += (int)gridDim.x * 8) {
        const int s2 = u & 63, bg = u >> 6;
        if (u != (int)BIDX * 8 + wave) FT_LOAD(u);
#pragma unroll 1
        for (int n = 0; n < 4; ++n) {
            f32x4 wre[4], wim[4];
#pragma unroll
            for (int m = 0; m < 4; ++m) { wre[m] = (f32x4){0.f, 0.f, 0.f, 0.f}; wim[m] = wre[m]; }
#pragma unroll
            for (int ks = 0; ks < 2; ++ks) {
                const bf16x8 cb = FT_B(ks, n, 0), sb = FT_B(ks, n, 1);
#pragma unroll
                for (int m = 0; m < 4; ++m) { wre[m] = mfma16(ua[m][ks], cb, wre[m]); wim[m] = mfma16(ua[m][ks], sb, wim[m]); }
                __builtin_amdgcn_sched_barrier(0);
            }
            asm volatile("s_nop 15\n\ts_nop 15" : "+v"(wre[0]), "+v"(wre[1]), "+v"(wre[2]), "+v"(wre[3]), "+v"(wim[0]), "+v"(wim[1]), "+v"(wim[2]), "+v"(wim[3]));
            bf16x8 bre[2], bim[2];
#pragma unroll
            for (int ks = 0; ks < 2; ++ks) { bre[ks] = pack8(wre[2 * ks], wre[2 * ks + 1]); bim[ks] = pack8(wim[2 * ks], wim[2 * ks + 1]); }
            asm volatile("s_nop 7" : "+v"(bre[0]), "+v"(bre[1]), "+v"(bim[0]), "+v"(bim[1]));
#pragma unroll
            for (int mp = 0; mp < 2; ++mp) {
                f32x4 yre[2], yin[2];
#pragma unroll
                for (int q = 0; q < 2; ++q) { yre[q] = (f32x4){0.f, 0.f, 0.f, 0.f}; yin[q] = yre[q]; }
#pragma unroll
                for (int ks = 0; ks < 2; ++ks) {
#pragma unroll
                    for (int q = 0; q < 2; ++q) { const bf16x8 ca = FT_A(2 * mp + q, ks, 0); yre[q] = mfma16(bre[ks], ca, yre[q]); yin[q] = mfma16(bim[ks], ca, yin[q]); }
                    __builtin_amdgcn_sched_barrier(0);
#pragma unroll
                    for (int q = 0; q < 2; ++q) { yre[q] = mfma16(bim[ks], FT_A(2 * mp + q, ks, 2), yre[q]); yin[q] = mfma16(bre[ks], FT_A(2 * mp + q, ks, 1), yin[q]); }
                    __builtin_amdgcn_sched_barrier(0);
                }
                asm volatile("s_nop 15\n\ts_nop 15" : "+v"(yre[0]), "+v"(yin[0]), "+v"(yre[1]), "+v"(yin[1]));
#pragma unroll
                for (int q = 0; q < 2; ++q) {
                    const int k1 = 16 * (2 * mp + q) + fr;
                    const float2 tw = twv[mp][q];
                    u32x4 wv;
#pragma unroll
                    for (int rg = 0; rg < 4; ++rg) { const float yr = yre[q][rg], yi = -yin[q][rg]; wv[rg] = pk2(yr * tw.x + yi * tw.y, yi * tw.x - yr * tw.y); }
                    *(u32x4*)(c.FY + ((size_t)(bg * 64 + k1) * 64 + s2) * 64 + 16 * n + 4 * fq) = wv;
                }
            }
        }
    }
#undef FT_A
#undef FT_B
#undef FT_LOAD
    __syncthreads();
}

template <int KSTEPS>
__device__ __forceinline__ void gemm64_ldb(const bf16_t* Bt, int ldb, bf16x8 (&bfr)[KSTEPS][2], int fr, int fq) {
#pragma unroll
    for (int ks = 0; ks < KSTEPS; ++ks)
#pragma unroll
        for (int n = 0; n < 2; ++n) bfr[ks][n] = *(const bf16x8*)(Bt + (size_t)(16 * n + fr) * ldb + ks * 32 + 8 * fq);
}
template <int KSTEPS>
__device__ __forceinline__ void gemm64_pre(const LASP unsigned char* Y, int kbyte0, const bf16x8 (&bfr)[KSTEPS][2], f32x4 (&acc)[4][2], int fr, int fq) {
#pragma unroll
    for (int ks = 0; ks < KSTEPS; ++ks) {
        bf16x8 afr[4];
#pragma unroll
        for (int m = 0; m < 4; ++m) afr[m] = *(const LASP bf16x8*)(Y + (16 * m + fr) * 528 + kbyte0 + (ks * 32 + 8 * fq) * 2);
#pragma unroll
        for (int m = 0; m < 4; ++m)
#pragma unroll
            for (int n = 0; n < 2; ++n) acc[m][n] = mfma16(bfr[ks][n], afr[m], acc[m][n]);
        __builtin_amdgcn_sched_barrier(0);
    }
}
__device__ __forceinline__ void fft2_phase_mfma(const Ctx& c, int l, unsigned char* lds_raw) {
    LASP unsigned char* F = (LASP unsigned char*)lds_raw;
    const int t = TIDX, lane = t & 63, wave = __builtin_amdgcn_readfirstlane(t >> 6), fr = lane & 15, fq = lane >> 4, g = wave >> 1, nh = wave & 1;
    LASP unsigned char* T2 = (LASP unsigned char*)(lds_raw + 36864);
#pragma unroll
    for (int i = 0; i < 2; ++i) { const int ft = wave * 2 + i, m = ft >> 2, ks = (ft >> 1) & 1, which = ft & 1;
        *(LASP bf16x8*)(T2 + (ft * 64 + lane) * 16) = dft_frag(16 * m + fr, 32 * ks, fq, false, which); }
#define FT2(m_, ks_, w_) (*(const LASP bf16x8*)(T2 + ((((m_) * 2 + (ks_)) * 2 + (w_)) * 64 + lane) * 16))
    bf16x8 bwf[8][2];
    gemm64_ldb<8>(c.WfT + (size_t)l * 65536 + (size_t)(32 * wave) * 256, 256, bwf, fr, fq);
    unsigned wq[2][2][8]; u32x2 gpq[4][2];
#define F2_LOADW(uu_) do { const unsigned* src_ = c.FY + (size_t)((((uu_) >> 6) * 4 + g) * 64 + ((uu_) & 63)) * 4096; \
        _Pragma("unroll") for (int nn = 0; nn < 2; ++nn) _Pragma("unroll") for (int ks = 0; ks < 2; ++ks) _Pragma("unroll") for (int j = 0; j < 8; ++j) \
            wq[nn][ks][j] = src_[(32 * ks + 8 * fq + j) * 64 + 16 * (2 * nh + nn) + fr]; } while (0)
#define F2_LOADG(uu_) do { _Pragma("unroll") for (int m = 0; m < 4; ++m) _Pragma("unroll") for (int n = 0; n < 2; ++n) \
            gpq[m][n] = *(const u32x2*)(c.Z + ((size_t)((uu_) >> 6) * SEQ + ((uu_) & 63) + 64 * (16 * m + fr)) * DIN + ZG + 32 * wave + 16 * n + 4 * fq); } while (0)
    { const int u0 = BIDX; if (u0 < NB * 64) { F2_LOADW(u0); F2_LOADG(u0); } }
    __syncthreads();
    for (int u = BIDX; u < NB * 64; u += gridDim.x) {
        const int b = u >> 6, k1 = u & 63, un = u + (int)gridDim.x;
#pragma unroll
        for (int nn = 0; nn < 2; ++nn) {
            bf16x8 bre[2], bim[2];
#pragma unroll
            for (int ks = 0; ks < 2; ++ks) {
                unsigned w[8];
#pragma unroll
                for (int j = 0; j < 8; ++j) w[j] = wq[nn][ks][j];
                u32x4 re, im;
#pragma unroll
                for (int e = 0; e < 4; ++e) { re[e] = (w[2 * e] & 0xffffu) | (w[2 * e + 1] << 16); im[e] = (w[2 * e] >> 16) | (w[2 * e + 1] & 0xffff0000u); }
                bre[ks] = __builtin_bit_cast(bf16x8, re); bim[ks] = __builtin_bit_cast(bf16x8, im);
            }
            f32x4 dacc[4];
#pragma unroll
            for (int m = 0; m < 4; ++m) dacc[m] = (f32x4){0.f, 0.f, 0.f, 0.f};
#pragma unroll
            for (int ks = 0; ks < 2; ++ks) {
#pragma unroll
                for (int m = 0; m < 4; ++m) dacc[m] = mfma16(bre[ks], FT2(m, ks, 0), dacc[m]);
                __builtin_amdgcn_sched_barrier(0);
#pragma unroll
                for (int m = 0; m < 4; ++m) dacc[m] = mfma16(bim[ks], FT2(m, ks, 1), dacc[m]);
                __builtin_amdgcn_sched_barrier(0);
            }
            asm volatile("s_nop 15" : "+v"(dacc[0]), "+v"(dacc[1]), "+v"(dacc[2]), "+v"(dacc[3]));
#pragma unroll
            for (int m = 0; m < 4; ++m) {
                u32x2 wv; wv.x = cvtpk(dacc[m][0] * (1.f / 512.f), dacc[m][1] * (1.f / 512.f)); wv.y = cvtpk(dacc[m][2] * (1.f / 512.f), dacc[m][3] * (1.f / 512.f));
                *(LASP u32x2*)(F + (16 * m + fr) * 528 + (g * 64 + 16 * (2 * nh + nn) + 4 * fq) * 2) = wv;
            }
        }
        if (un < NB * 64) F2_LOADW(un);
        __syncthreads();
        f32x4 acc[4][2];
#pragma unroll
        for (int m = 0; m < 4; ++m)
#pragma unroll
            for (int n = 0; n < 2; ++n) acc[m][n] = (f32x4){0.f, 0.f, 0.f, 0.f};
        gemm64_pre<8>(F, 0, bwf, acc, fr, fq);
#pragma unroll
        for (int m = 0; m < 4; ++m)
#pragma unroll
            for (int n = 0; n < 2; ++n) {
                const size_t tok = (size_t)b * SEQ + k1 + 64 * (16 * m + fr); const int col = 32 * wave + 16 * n + 4 * fq;
                const u32x2 gp = gpq[m][n];
                u32x2 o; o.x = cvtpk(acc[m][n][0] * siluf_(bflo(gp.x)), acc[m][n][1] * siluf_(bfhi(gp.x))); o.y = cvtpk(acc[m][n][2] * siluf_(bflo(gp.y)), acc[m][n][3] * siluf_(bfhi(gp.y)));
                *(u32x2*)(c.P + tok * DM + col) = o;
            }
        if (un < NB * 64) F2_LOADG(un);
        __syncthreads();
    }
#undef F2_LOADW
#undef F2_LOADG
#undef FT2
}

__device__ __forceinline__ void tok_load_glu(const Ctx& c, int u, u32x4 (&ga)[6], u32x4 (&gg)[6]) {
    const int t = TIDX, b = u >> 6, s0 = (u & 63) * 64;
#pragma unroll
    for (int i = 0; i < 6; ++i) {
        const int id = t + 512 * i, row = id >> 5, c8 = (id & 31) * 8, sp = s0 - 15 + row;
        ga[i] = (u32x4){0u, 0u, 0u, 0u}; gg[i] = ga[i];
        if (id < 94 * 32 && sp >= 0 && sp < SEQ) { const bf16_t* zr = c.Z + (size_t)(b * SEQ + sp) * DIN + ZB + c8; ga[i] = *(const u32x4*)zr; }
    }
}
__device__ __forceinline__ void tok_unit_mfma(const Ctx& c, int l, int u, int un, u32x4 (&ga)[6], u32x4 (&gg)[6], unsigned char* lds_raw) {
    LASP float* A = (LASP float*)lds_raw;
    LASP unsigned char* Y = (LASP unsigned char*)(lds_raw + 96256);
    const int t = TIDX, lane = t & 63, wave = __builtin_amdgcn_readfirstlane(t >> 6), ch = t & 255, half = t >> 8, fr = lane & 15, fq = lane >> 4;
    const int b = u >> 6, s0 = (u & 63) * 64, tok0 = b * SEQ + s0;
    const int cp2 = 2 * (t & 127), tg16 = (t >> 7) * 16;
    f32x2 cw[31];
#pragma unroll
    for (int w = 0; w < 31; ++w) cw[w] = *(const f32x2*)(c.conv_w + (size_t)l * 31 * 256 + w * 256 + cp2);
    const f32x2 cb = *(const f32x2*)(c.conv_b + l * 256 + cp2);
    u32x4 pr[5];
#pragma unroll
    for (int i = 0; i < 5; ++i) {
        const int id = t + 512 * i, row = id >> 5, c8 = (id & 31) * 8, sp = s0 - 8 + row;
        pr[i] = (u32x4){0u, 0u, 0u, 0u};
        if (id < 79 * 32 && sp >= 0 && sp < SEQ) pr[i] = *(const u32x4*)(c.Z + (size_t)(b * SEQ + sp) * DIN + ZD + c8);
    }
    asm volatile("" ::: "memory");
#pragma unroll
    for (int i = 0; i < 6; ++i) {
        const int id = t + 512 * i;
        if (id < 94 * 32) {
            const int row = id >> 5, c8 = (id & 31) * 8;
            const u32x4 a = ga[i];
            f32x4 v0, v1;
            v0[0] = bflo(a.x); v0[1] = bfhi(a.x); v0[2] = bflo(a.y); v0[3] = bfhi(a.y);
            v1[0] = bflo(a.z); v1[1] = bfhi(a.z); v1[2] = bflo(a.w); v1[3] = bfhi(a.w);
            *(LASP f32x4*)(A + row * 256 + c8) = v0; *(LASP f32x4*)(A + row * 256 + c8 + 4) = v1;
        }
    }
    __syncthreads();
    f32x2 y[16];
#pragma unroll
    for (int cc = 0; cc < 2; ++cc) {
        f32x2 rows[38];
#pragma unroll
        for (int r = 0; r < 38; ++r) rows[r] = *(const LASP f32x2*)(A + (tg16 + cc * 8 + r) * 256 + cp2);
        f32x2 ca[8];
#pragma unroll
        for (int i = 0; i < 8; ++i) ca[i] = cb;
#pragma unroll
        for (int w = 0; w < 31; ++w) {
#pragma unroll
            for (int i = 0; i < 8; ++i) ca[i] = __builtin_elementwise_fma(rows[i + w], cw[w], ca[i]);
            __builtin_amdgcn_sched_barrier(0);
        }
#pragma unroll
        for (int i = 0; i < 8; ++i) y[cc * 8 + i] = ca[i];
        __builtin_amdgcn_sched_barrier(0);
    }
    bf16x8 bw[8][2];
    gemm64_ldb<8>(c.WpwT + (size_t)l * 65536 + (size_t)(32 * wave) * 256, 256, bw, fr, fq);
    u32x2 gp1[4][2];
#pragma unroll
    for (int m = 0; m < 4; ++m)
#pragma unroll
        for (int n = 0; n < 2; ++n) gp1[m][n] = *(const u32x2*)(c.Z + ((size_t)tok0 + 16 * m + fr) * DIN + ZG + 256 + 32 * wave + 16 * n + 4 * fq);
    __syncthreads();
#pragma unroll
    for (int i = 0; i < 16; ++i) *(LASP f32x2*)(A + (tg16 + i) * 256 + cp2) = y[i];
    __syncthreads();
    {
        const int seg = lane >> 4, sl = lane & 15;
        f32x4 lg[4], lb[4];
#pragma unroll
        for (int j = 0; j < 4; ++j) { lg[j] = *(const f32x4*)(c.conv_ln_g + l * 256 + 64 * j + 4 * sl); lb[j] = *(const f32x4*)(c.conv_ln_b + l * 256 + 64 * j + 4 * sl); }
#pragma unroll
        for (int it = 0; it < 2; ++it) {
            const int tk = wave * 8 + it * 4 + seg;
            f32x4 xv[4];
#pragma unroll
            for (int j = 0; j < 4; ++j) xv[j] = *(const LASP f32x4*)(A + tk * 256 + 64 * j + 4 * sl);
            const f32x4 s4 = (xv[0] + xv[1]) + (xv[2] + xv[3]);
            const float mean = row16_sum((s4[0] + s4[1]) + (s4[2] + s4[3])) * (1.f / 256.f);
#pragma unroll
            for (int j = 0; j < 4; ++j) xv[j] = xv[j] - mean;
            const f32x4 q4 = (xv[0] * xv[0] + xv[1] * xv[1]) + (xv[2] * xv[2] + xv[3] * xv[3]);
            const float rstd = __builtin_amdgcn_rsqf(row16_sum((q4[0] + q4[1]) + (q4[2] + q4[3])) * (1.f / 256.f) + 1e-5f);
#pragma unroll
            for (int j = 0; j < 4; ++j) {
                const f32x4 yv = xv[j] * rstd * lg[j] + lb[j];
                u32x2 o; o.x = cvtpk(siluf_(yv[0]), siluf_(yv[1])); o.y = cvtpk(siluf_(yv[2]), siluf_(yv[3]));
                *(LASP u32x2*)(Y + tk * 528 + (64 * j + 4 * sl) * 2) = o;
            }
        }
    }
    __syncthreads();
#pragma unroll
    for (int i = 0; i < 5; ++i) {
        const int id = t + 512 * i;
        if (id < 79 * 32) {
            const int row = id >> 5, c8 = (id & 31) * 8; const u32x4 a = pr[i];
            f32x4 v0, v1;
            v0[0] = bflo(a.x); v0[1] = bfhi(a.x); v0[2] = bflo(a.y); v0[3] = bfhi(a.y); v1[0] = bflo(a.z); v1[1] = bfhi(a.z); v1[2] = bflo(a.w); v1[3] = bfhi(a.w);
            *(LASP f32x4*)(A + row * 256 + c8) = v0; *(LASP f32x4*)(A + row * 256 + c8 + 4) = v1;
        }
    }
    const int pgi = wave >> 1, pcb = (wave & 1) * 32;
    bf16x8 pw[2][2];
    gemm64_ldb<2>(c.WpoolT + (size_t)(l * 4 + pgi) * 4096 + (size_t)pcb * 64, 64, pw, fr, fq);
    u32x2 gp3[4][2]; f32x4 psc[2];
#pragma unroll
    for (int n = 0; n < 2; ++n) {
        psc[n] = *(const f32x4*)(c.pool_scale + l * 256 + pgi * 64 + pcb + 16 * n + 4 * fq);
#pragma unroll
        for (int m = 0; m < 4; ++m) gp3[m][n] = *(const u32x2*)(c.Z + ((size_t)tok0 + 16 * m + fr) * DIN + ZG + 768 + pgi * 64 + pcb + 16 * n + 4 * fq);
    }
    {
        f32x4 acc[4][2];
#pragma unroll
        for (int m = 0; m < 4; ++m)
#pragma unroll
            for (int n = 0; n < 2; ++n) acc[m][n] = (f32x4){0.f, 0.f, 0.f, 0.f};
        gemm64_pre<8>(Y, 0, bw, acc, fr, fq);
#pragma unroll
        for (int m = 0; m < 4; ++m)
#pragma unroll
            for (int n = 0; n < 2; ++n) {
                const size_t tok = (size_t)tok0 + 16 * m + fr; const int col = 32 * wave + 16 * n + 4 * fq;
                const u32x2 gp = gp1[m][n];
                u32x2 o; o.x = cvtpk(acc[m][n][0] * siluf_(bflo(gp.x)), acc[m][n][1] * siluf_(bfhi(gp.x))); o.y = cvtpk(acc[m][n][2] * siluf_(bflo(gp.y)), acc[m][n][3] * siluf_(bfhi(gp.y)));
                *(u32x2*)(c.P + tok * DM + 256 + col) = o;
            }
    }
    if (un >= 0) tok_load_glu(c, un, ga, gg);
    __syncthreads();
    {
        const int gi = ch >> 6, sz = 2 << gi;
        float xr[47];
#pragma unroll
        for (int r = 0; r < 47; ++r) xr[r] = A[(half * 32 + r) * 256 + ch];
        float w2c[47], w4c[47], w8c[47];
#pragma unroll
        for (int r = 1; r < 47; ++r) w2c[r] = xr[r - 1] + xr[r];
#pragma unroll
        for (int r = 2; r < 46; ++r) w4c[r] = w2c[r - 1] + w2c[r + 1];
#pragma unroll
        for (int r = 4; r < 44; ++r) w8c[r] = w4c[r - 2] + w4c[r + 2];
        if (s0 == 0 || s0 == SEQ - 64) {
#pragma unroll
            for (int i = 0; i < 32; ++i) {
                const int r = i + 8, tk = half * 32 + i, sp = s0 + tk;
                const float w16 = w8c[r - 4] + w8c[r + 4];
                const float wsum = gi == 0 ? w2c[r] : (gi == 1 ? w4c[r] : (gi == 2 ? w8c[r] : w16));
                int lo = sp - sz / 2; if (lo < 0) lo = 0;
                int hi = sp + sz - 1 - sz / 2; if (hi > SEQ - 1) hi = SEQ - 1;
                *(LASP bf16_t*)(Y + tk * 528 + ch * 2) = f2bf(wsum * __builtin_amdgcn_rcpf((float)(hi - lo + 1)) - xr[r]);
            }
        } else {
            const float invsz = __uint_as_float((unsigned)(126 - gi) << 23);
#pragma unroll
            for (int i = 0; i < 32; ++i) {
                const int r = i + 8, tk = half * 32 + i;
                const float w16 = w8c[r - 4] + w8c[r + 4];
                const float wsum = gi == 0 ? w2c[r] : (gi == 1 ? w4c[r] : (gi == 2 ? w8c[r] : w16));
                *(LASP bf16_t*)(Y + tk * 528 + ch * 2) = f2bf(wsum * invsz - xr[r]);
            }
        }
    }
    __syncthreads();
    {
        f32x4 acc[4][2];
#pragma unroll
        for (int m = 0; m < 4; ++m)
#pragma unroll
            for (int n = 0; n < 2; ++n) acc[m][n] = (f32x4){0.f, 0.f, 0.f, 0.f};
        gemm64_pre<2>(Y, pgi * 128, pw, acc, fr, fq);
#pragma unroll
        for (int m = 0; m < 4; ++m)
#pragma unroll
            for (int n = 0; n < 2; ++n) {
                const size_t tok = (size_t)tok0 + 16 * m + fr; const int col = pgi * 64 + pcb + 16 * n + 4 * fq;
                const u32x2 gp = gp3[m][n]; const f32x4 ps = psc[n];
                u32x2 o; o.x = cvtpk(acc[m][n][0] * ps[0] * siluf_(bflo(gp.x)), acc[m][n][1] * ps[1] * siluf_(bfhi(gp.x))); o.y = cvtpk(acc[m][n][2] * ps[2] * siluf_(bflo(gp.y)), acc[m][n][3] * ps[3] * siluf_(bfhi(gp.y)));
                *(u32x2*)(c.P + tok * DM + 768 + col) = o;
            }
    }
    __syncthreads();
}

__device__ __forceinline__ void phase_combine(const Ctx& c) {
    const int gt = BIDX * NTHREADS + TIDX, NT = gridDim.x * NTHREADS;
    constexpr int CU = 4;
    for (int idx0 = gt; idx0 < MT * 32; idx0 += CU * NT) {
        float l0[CU], l1[CU], l2[CU]; u32x4 o0[CU], o1[CU], o2[CU], gp[CU];
#pragma unroll
        for (int k = 0; k < CU; ++k) {
            int idx = idx0 + k * NT; if (idx >= MT * 32) idx = idx0;
            const size_t m = idx >> 5; const int c8 = (idx & 31) * 8, hI = c8 >> 6;
            l0[k] = c.LSE[((size_t)0 * MT + m) * 4 + hI]; l1[k] = c.LSE[((size_t)1 * MT + m) * 4 + hI]; l2[k] = c.LSE[((size_t)2 * MT + m) * 4 + hI];
            const bf16_t* zr = c.Z + m * DIN;
            o0[k] = *(const u32x4*)(zr + ZQ + (0 * 4 + hI) * 64 + (c8 & 63));
            o1[k] = *(const u32x4*)(zr + ZQ + (1 * 4 + hI) * 64 + (c8 & 63));
            o2[k] = *(const u32x4*)(zr + ZQ + (2 * 4 + hI) * 64 + (c8 & 63));
            gp[k] = *(const u32x4*)(zr + ZG + 512 + c8);
        }
#pragma unroll
        for (int k = 0; k < CU; ++k) {
            int idx = idx0 + k * NT; if (idx >= MT * 32) idx = idx0;
            const size_t m = idx >> 5; const int c8 = (idx & 31) * 8;
            const float mx = fmaxf(l0[k], fmaxf(l1[k], l2[k]));
            const float e0 = __expf(l0[k] - mx), e1 = __expf(l1[k] - mx), e2 = __expf(l2[k] - mx), inv = __builtin_amdgcn_rcpf(e0 + e1 + e2);
            const float a0 = e0 * inv, a1 = e1 * inv, a2 = e2 * inv;
            u32x4 res;
#pragma unroll
            for (int q = 0; q < 4; ++q) {
                const float vlo = (a0 * bflo(o0[k][q]) + a1 * bflo(o1[k][q]) + a2 * bflo(o2[k][q])) * siluf_(bflo(gp[k][q]));
                const float vhi = (a0 * bfhi(o0[k][q]) + a1 * bfhi(o1[k][q]) + a2 * bfhi(o2[k][q])) * siluf_(bfhi(gp[k][q]));
                res[q] = pk2(vlo, vhi);
            }
            *(u32x4*)(c.P + m * DM + 512 + c8) = res;
        }
    }
}

namespace pg8 {
#define PG8_LAS __attribute__((address_space(3)))
typedef unsigned short bf16_t;
typedef short bf16x8 __attribute__((ext_vector_type(8)));
typedef float f32x4 __attribute__((ext_vector_type(4)));
typedef unsigned u32x4 __attribute__((ext_vector_type(4)));
constexpr int BM = 256, BK = 64, HALF = 128, HTB = HALF * BK * 2  , STAGE_BYTES = 8 * HTB, NXCD = 8, WGM = 8;

__host__ __device__ __forceinline__ int lds_byte(int r, int c) { const int st = (r >> 4) * 2 + (c >> 5), rr = r & 15, cc = c & 31, ob = rr * 64 + cc * 2; return st * 1024 + (ob ^ (((ob >> 9) & 1) << 5)); }
__host__ __device__ __forceinline__ void stage_rc(int b, int& R, int& C) { const int st = b / 1024, sb = b % 1024, swz = sb ^ (((sb >> 9) & 1) << 5); R = (st >> 1) * 16 + swz / 64; C = (st & 1) * 32 + (swz % 64) / 2; }
__host__ __device__ __forceinline__ int perm32(int rho) { const int n = rho >> 4, i = rho & 15; return 8 * (i >> 2) + 4 * n + (i & 3); }

struct Unit { int pm, pn, sub; };
template <int LDA_, int LDB_, int K_, int ASUB_, int BSUB_, bool I8_ = false> struct GemmT { const bf16_t* A; const bf16_t* Bt; static constexpr int lda = LDA_, ldb = LDB_, K = K_; static constexpr size_t a_sub = ASUB_, b_sub = BSUB_; static constexpr bool i8 = I8_; };

struct StaticOrder {
    int nM, nN, nwg, G, c;
    __host__ __device__ void init(int M, int N, int G_, int c_) { nM = M / BM; nN = N / BM; nwg = nM * nN; G = G_; c = c_; }
    __host__ __device__ bool next(int i, Unit& u) const {
        const long L = (long)i * G + c; if (L >= nwg) return false;
        int wgid = (int)L; { const int q = nwg / NXCD, r = nwg % NXCD, xcd = wgid % NXCD, off = wgid / NXCD; wgid = (xcd < r ? xcd * (q + 1) : r * (q + 1) + (xcd - r) * q) + off; }
        const int nig = WGM * nN, gid = wgid / nig, fm = gid * WGM, gsz = (nM - fm) < WGM ? (nM - fm) : WGM;
        u.pm = fm + ((wgid % nig) % gsz); u.pn = (wgid % nig) / gsz; u.sub = 0; return true;
    }
    __device__ __forceinline__ void a_ready(const Unit&) const {}
    __device__ __forceinline__ void done(const Unit&) const {}
};


__device__ __forceinline__ unsigned cvt_pk_bf16(float lo, float hi) { return ::pk2(lo, hi); }
template <int ACT  > struct EpiBf16 {
    static constexpr bool PERM = true, AFTER_DRAIN = false; static_assert(ACT == 0 || ACT == 2, "EpiBf16: ACT is 0 (none) or 2 (sigmoid)");
    bf16_t* O; int ldc; const float* bias; int split_cols; size_t split_stride; float scale0;
    __device__ __forceinline__ void operator()(const f32x4 (&acc)[2][2][4][2], const Unit& u, int wr, int wc, int fr, int fq) const {
        asm volatile("" : "+v"(fr), "+v"(fq));
        const int row0 = u.pm * BM + wr * 64 + fr; int colt = u.pn * BM; bf16_t* base = O;
        float sc = 1.f; if (split_cols) { const int t = colt / split_cols; base += (size_t)t * split_stride; colt -= t * split_cols; if (t == 0) sc = scale0; }
        const int col0 = colt + wc * 32 + 8 * fq, bcol0 = u.pn * BM + wc * 32 + 8 * fq;
        f32x4 bv[2][2];
#pragma unroll
        for (int bj = 0; bj < 2; ++bj)
#pragma unroll
            for (int n = 0; n < 2; ++n) bv[bj][n] = bias ? *(const f32x4*)(bias + bcol0 + bj * HALF + 4 * n) : (f32x4){0.f, 0.f, 0.f, 0.f};
#pragma unroll
        for (int ai = 0; ai < 2; ++ai)
#pragma unroll
            for (int m = 0; m < 4; ++m) { bf16_t* rowp = base + (size_t)(row0 + ai * HALF + m * 16) * ldc + col0;
#pragma unroll
                for (int bj = 0; bj < 2; ++bj) { f32x4 v0 = acc[ai][bj][m][0] + bv[bj][0], v1 = acc[ai][bj][m][1] + bv[bj][1];
                    if (ACT == 2) {
#pragma unroll
                        for (int q = 0; q < 4; ++q) { v0[q] = __builtin_amdgcn_rcpf(1.0f + __builtin_amdgcn_exp2f(v0[q] * -1.44269504f)); v1[q] = __builtin_amdgcn_rcpf(1.0f + __builtin_amdgcn_exp2f(v1[q] * -1.44269504f)); } }
                    v0 = v0 * sc; v1 = v1 * sc; u32x4 w; w.x = cvt_pk_bf16(v0[0], v0[1]); w.y = cvt_pk_bf16(v0[2], v0[3]); w.z = cvt_pk_bf16(v1[0], v1[1]); w.w = cvt_pk_bf16(v1[2], v1[3]);
                    *(u32x4*)(rowp + bj * HALF) = w; } }
    }
};


struct EpiZI8 {
    static constexpr bool PERM = true, AFTER_DRAIN = false;
    bf16_t* O; int ldc; const float* SH; const float* SW;
    struct Pre { f32x4 wv[2][2]; float rs[8]; };
    __device__ __forceinline__ void pre(Pre& p, const Unit& u, int wr, int wc, int lane) const {
        const int fr = lane & 15, fq = lane >> 4, row0 = u.pm * BM + wr * 64 + fr, col0 = u.pn * BM + wc * 32 + 8 * fq;
#pragma unroll
        for (int bj = 0; bj < 2; ++bj)
#pragma unroll
            for (int n = 0; n < 2; ++n) p.wv[bj][n] = *(const f32x4*)(SW + col0 + bj * HALF + 4 * n);
#pragma unroll
        for (int i = 0; i < 8; ++i) p.rs[i] = SH[row0 + (i >> 2) * HALF + (i & 3) * 16];
    }
    __device__ __forceinline__ void operator()(const f32x4 (&acc)[2][2][4][2], const Pre& p, const Unit& u, int wr, int wc, int fr, int fq) const {
        asm volatile("" : "+v"(fr), "+v"(fq));
        const int row0 = u.pm * BM + wr * 64 + fr, col0 = u.pn * BM + wc * 32 + 8 * fq;
        const bool glu = (u.pn * BM >= ZB) && (u.pn * BM < ZQ);
#pragma unroll
        for (int ai = 0; ai < 2; ++ai)
#pragma unroll
            for (int m = 0; m < 4; ++m) { bf16_t* rowp = O + (size_t)(row0 + ai * HALF + m * 16) * ldc;
                const float rs = p.rs[ai * 4 + m];
#pragma unroll
                for (int bj = 0; bj < 2; ++bj) {
                    const f32x4 v0 = (__builtin_convertvector(__builtin_bit_cast(i32x4, acc[ai][bj][m][0]), f32x4) * p.wv[bj][0]) * rs, v1 = (__builtin_convertvector(__builtin_bit_cast(i32x4, acc[ai][bj][m][1]), f32x4) * p.wv[bj][1]) * rs;
                    if (glu) {
                        const float o0 = v0[0] * __builtin_amdgcn_rcpf(1.f + __builtin_amdgcn_exp2f(v0[1] * -1.44269504f)), o1 = v0[2] * __builtin_amdgcn_rcpf(1.f + __builtin_amdgcn_exp2f(v0[3] * -1.44269504f));
                        const float o2 = v1[0] * __builtin_amdgcn_rcpf(1.f + __builtin_amdgcn_exp2f(v1[1] * -1.44269504f)), o3 = v1[2] * __builtin_amdgcn_rcpf(1.f + __builtin_amdgcn_exp2f(v1[3] * -1.44269504f));
                        u32x2 w; w.x = cvt_pk_bf16(o0, o1); w.y = cvt_pk_bf16(o2, o3);
                        *(u32x2*)(rowp + ZB + ((col0 + bj * HALF - ZB) >> 1)) = w;
                    } else {
                        u32x4 w; w.x = cvt_pk_bf16(v0[0], v0[1]); w.y = cvt_pk_bf16(v0[2], v0[3]); w.z = cvt_pk_bf16(v1[0], v1[1]); w.w = cvt_pk_bf16(v1[2], v1[3]);
                        *(u32x4*)(rowp + col0 + bj * HALF) = w; } } }
    }
};
struct EpiGateU8 {
    static constexpr bool PERM = true, AFTER_DRAIN = false; static constexpr int BPERM = 2;
    unsigned char* O; const float* bias; const float* SH; const float* SW;
    __device__ __forceinline__ void operator()(const f32x4 (&acc)[2][2][4][2], const Unit& u, int wr, int wc, int fr, int fq) const {
        asm volatile("" : "+v"(fr), "+v"(fq));
        const int row0 = u.pm * BM + wr * 64 + fr, col0 = u.pn * BM + wc * 64 + 16 * fq;
        const int gn = u.pn >> 2, gbase = (gn < 3) ? 3072 + 1024 * gn : 0;
        f32x4 bv[2][2];
#pragma unroll
        for (int bj = 0; bj < 2; ++bj)
#pragma unroll
            for (int n = 0; n < 2; ++n) bv[bj][n] = *(const f32x4*)(bias + col0 + 8 * bj + 4 * n) * -1.44269504f;
        f32x4 wv[2][2];
#pragma unroll
        for (int bj = 0; bj < 2; ++bj)
#pragma unroll
            for (int n = 0; n < 2; ++n) wv[bj][n] = *(const f32x4*)(SW + col0 + 8 * bj + 4 * n) * -1.44269504f;
        float rsv[8];
#pragma unroll
        for (int i = 0; i < 8; ++i) rsv[i] = SH[row0 + (i >> 2) * HALF + (i & 3) * 16];
#define EPG_Q4(dst_, a_, w_, rs_, b_) do { const f32x4 x_ = (__builtin_convertvector(__builtin_bit_cast(i32x4, a_), f32x4) * (w_)) * (rs_) + (b_); f32x4 e_; e_[0] = __builtin_amdgcn_exp2f(x_[0]); e_[1] = __builtin_amdgcn_exp2f(x_[1]); e_[2] = __builtin_amdgcn_exp2f(x_[2]); e_[3] = __builtin_amdgcn_exp2f(x_[3]); \
            e_ = e_ + 1.0f; f32x4 r_; r_[0] = __builtin_amdgcn_rcpf(e_[0]); r_[1] = __builtin_amdgcn_rcpf(e_[1]); r_[2] = __builtin_amdgcn_rcpf(e_[2]); r_[3] = __builtin_amdgcn_rcpf(e_[3]); \
            r_ = r_ * 255.0f + 8388608.0f; \
            const unsigned t01_ = __builtin_amdgcn_perm(__float_as_uint(fmaxf(r_[1], 8388609.0f)), __float_as_uint(fmaxf(r_[0], 8388609.0f)), 0x0c0c0400u), t23_ = __builtin_amdgcn_perm(__float_as_uint(fmaxf(r_[3], 8388609.0f)), __float_as_uint(fmaxf(r_[2], 8388609.0f)), 0x0c0c0400u); \
            dst_ = t01_ | (t23_ << 16); } while (0)
#pragma unroll
        for (int ai = 0; ai < 2; ++ai)
#pragma unroll
            for (int m = 0; m < 4; ++m) { unsigned char* rowp = O + (size_t)(row0 + ai * HALF + m * 16) * 8704 + gbase + (col0 & 1023);
                const float rs = rsv[ai * 4 + m];
                u32x4 w; EPG_Q4(w.x, acc[ai][0][m][0], wv[0][0], rs, bv[0][0]); EPG_Q4(w.y, acc[ai][0][m][1], wv[0][1], rs, bv[0][1]);
                EPG_Q4(w.z, acc[ai][1][m][0], wv[1][0], rs, bv[1][0]); EPG_Q4(w.w, acc[ai][1][m][1], wv[1][1], rs, bv[1][1]);
                *(u32x4*)rowp = w; }
#undef EPG_Q4
    }
};
struct EpiMerge {
    static constexpr bool PERM = true, AFTER_DRAIN = false;
    const unsigned char* MG; bf16_t* O;
    __device__ __forceinline__ void operator()(const f32x4 (&acc)[2][2][4][2], const Unit& u, int wr, int wc, int fr, int fq) const {
        asm volatile("" : "+v"(fr), "+v"(fq));
        const int row0 = u.pm * BM + wr * 64 + fr, col0 = u.pn * BM + wc * 32 + 8 * fq;
        const bool rmw = (u.sub != 0);
        constexpr int DEPTH = 8;
        u32x2 gq[16]; u32x4 pq[16];
#define EPM_ROW(i) ((size_t)(row0 + ((i) >> 3) * HALF + (((i) >> 1) & 3) * 16))
#define EPM_LOAD(i) do { const size_t row_ = EPM_ROW(i); const int cb_ = col0 + ((i) & 1) * HALF; gq[i] = *(const u32x2*)(MG + row_ * 8704 + ((u.sub < 3) ? 3072 + 1024 * u.sub : 0) + cb_); \
        if (rmw) pq[i] = *(const u32x4*)(O + row_ * 1024 + cb_); } while (0)
#pragma unroll
        for (int i = 0; i < DEPTH; ++i) EPM_LOAD(i);
        asm volatile("" ::: "memory");
#pragma unroll
        for (int i = 0; i < 16; ++i) {
            const int ai = i >> 3, m = (i >> 1) & 3, bj = i & 1;
            const u32x2 g = gq[i];
            f32x4 v0 = acc[ai][bj][m][0] * (1.0f / 255.0f), v1 = acc[ai][bj][m][1] * (1.0f / 255.0f);
            v0[0] *= (float)(g.x & 0xffu); v0[1] *= (float)((g.x >> 8) & 0xffu); v0[2] *= (float)((g.x >> 16) & 0xffu); v0[3] *= (float)(g.x >> 24);
            v1[0] *= (float)(g.y & 0xffu); v1[1] *= (float)((g.y >> 8) & 0xffu); v1[2] *= (float)((g.y >> 16) & 0xffu); v1[3] *= (float)(g.y >> 24);
            if (rmw) { const u32x4 p = pq[i];
                v0[0] += __uint_as_float(p.x << 16); v0[1] += __uint_as_float(p.x & 0xffff0000u); v0[2] += __uint_as_float(p.y << 16); v0[3] += __uint_as_float(p.y & 0xffff0000u);
                v1[0] += __uint_as_float(p.z << 16); v1[1] += __uint_as_float(p.z & 0xffff0000u); v1[2] += __uint_as_float(p.w << 16); v1[3] += __uint_as_float(p.w & 0xffff0000u); }
            u32x4 w; w.x = cvt_pk_bf16(v0[0], v0[1]); w.y = cvt_pk_bf16(v0[2], v0[3]); w.z = cvt_pk_bf16(v1[0], v1[1]); w.w = cvt_pk_bf16(v1[2], v1[3]);
            *(u32x4*)(O + EPM_ROW(i) * 1024 + col0 + bj * HALF) = w;
            asm volatile("" ::: "memory");
            if (i + DEPTH < 16) { EPM_LOAD(i + DEPTH); asm volatile("" ::: "memory"); }
        }
#undef EPM_LOAD
#undef EPM_ROW
    }
};
struct EpiMergeChain {
    static constexpr bool PERM = true, AFTER_DRAIN = false, CHAIN = true; static constexpr int BPERM = 2;
    const unsigned char* MG; bf16_t* O; const unsigned char* FF;
    __device__ __forceinline__ void chain(f32x4 (&acc)[2][2][4][2], const Unit& u, int wr, int wc, int fr, int fq) const {
        constexpr int DEPTH = 4;
#define EPC_GOFF(i) ((unsigned)((((i) >> 2) * HALF + ((i) & 3) * 16) * 8704))
#define EPC_OOFF(i) ((unsigned)((((i) >> 2) * HALF + ((i) & 3) * 16) * 1024))
        asm volatile("" : "+v"(fr), "+v"(fq));
        const bool last = (u.sub == 3);
        const unsigned gbase = (unsigned)(u.pm * BM + wr * 64 + fr) * 8704u + (unsigned)(u.pn * BM + wc * 64 + 16 * fq);
        const unsigned obase = (unsigned)(u.pm * BM + wr * 64 + fr) * 1024u + (unsigned)(u.pn * BM + wc * 64 + 16 * fq);
        const unsigned go = last ? 0u : 3072u + 1024u * (unsigned)u.sub;
        const unsigned gn = (u.sub < 2) ? go + 1024u : 0u, nmask = last ? 0u : 0xffffffffu;
        const unsigned char* nbase = last ? FF : MG;
        const float keep = last ? 0.f : 1.f;
        u32x4 gq[8], gr[8];
#define EPC_LOAD(i) do { const unsigned o_ = gbase + EPC_GOFF(i); gq[i] = *(const u32x4*)(MG + (o_ + go)); gr[i] = *(const u32x4*)(nbase + ((o_ + gn) & nmask)); } while (0)
#define EPC_S4(dst_, g_, r_) do { dst_[0] = (float)((g_) & 0xffu) * __builtin_amdgcn_rcpf((float)((r_) & 0xffu)); dst_[1] = (float)(((g_) >> 8) & 0xffu) * __builtin_amdgcn_rcpf((float)(((r_) >> 8) & 0xffu)); \
        dst_[2] = (float)(((g_) >> 16) & 0xffu) * __builtin_amdgcn_rcpf((float)(((r_) >> 16) & 0xffu)); dst_[3] = (float)((g_) >> 24) * __builtin_amdgcn_rcpf((float)((r_) >> 24)); } while (0)
#pragma unroll
        for (int i = 0; i < DEPTH; ++i) EPC_LOAD(i);
        asm volatile("" ::: "memory");
#pragma unroll
        for (int i = 0; i < 8; ++i) {
            const int ai = i >> 2, m = i & 3;
            const u32x4 g = gq[i], r = gr[i];
            f32x4 s0, s1, s2, s3;
            EPC_S4(s0, g.x, r.x); EPC_S4(s1, g.y, r.y); EPC_S4(s2, g.z, r.z); EPC_S4(s3, g.w, r.w);
            const f32x4 v0 = acc[ai][0][m][0] * s0, v1 = acc[ai][0][m][1] * s1, v2 = acc[ai][1][m][0] * s2, v3 = acc[ai][1][m][1] * s3;
            if (last) {
                u32x4 w0, w1; w0.x = cvt_pk_bf16(v0[0], v0[1]); w0.y = cvt_pk_bf16(v0[2], v0[3]); w0.z = cvt_pk_bf16(v1[0], v1[1]); w0.w = cvt_pk_bf16(v1[2], v1[3]);
                w1.x = cvt_pk_bf16(v2[0], v2[1]); w1.y = cvt_pk_bf16(v2[2], v2[3]); w1.z = cvt_pk_bf16(v3[0], v3[1]); w1.w = cvt_pk_bf16(v3[2], v3[3]);
                *(u32x4*)(O + (obase + EPC_OOFF(i))) = w0; *(u32x4*)(O + (obase + EPC_OOFF(i)) + 8) = w1;
            }
            acc[ai][0][m][0] = v0 * keep; acc[ai][0][m][1] = v1 * keep; acc[ai][1][m][0] = v2 * keep; acc[ai][1][m][1] = v3 * keep;
            asm volatile("" : "+v"(acc[ai][0][m][0]), "+v"(acc[ai][0][m][1]), "+v"(acc[ai][1][m][0]), "+v"(acc[ai][1][m][1]) :: "memory");
            if (i + DEPTH < 8) { EPC_LOAD(i + DEPTH); asm volatile("" ::: "memory"); }
        }
#undef EPC_LOAD
#undef EPC_S4
#undef EPC_GOFF
#undef EPC_OOFF
    }
};
struct EpiOutF32 {
    static constexpr bool PERM = true, AFTER_DRAIN = false;
    const float* xin; float* out;
    __device__ __forceinline__ void operator()(const f32x4 (&acc)[2][2][4][2], const Unit& u, int wr, int wc, int fr, int fq) const {
        asm volatile("" : "+v"(fr), "+v"(fq));
        const int row0 = u.pm * BM + wr * 64 + fr, col0 = u.pn * BM + wc * 32 + 8 * fq;
        constexpr int DEPTH = 8;
        f32x4 x0q[16], x1q[16];
#define EPO_OFF(i) ((size_t)(row0 + ((i) >> 3) * HALF + (((i) >> 1) & 3) * 16) * 1024 + col0 + ((i) & 1) * HALF)
#define EPO_LOAD(i) do { const size_t off_ = EPO_OFF(i); x0q[i] = *(const f32x4*)(xin + off_); x1q[i] = *(const f32x4*)(xin + off_ + 4); } while (0)
#pragma unroll
        for (int i = 0; i < DEPTH; ++i) EPO_LOAD(i);
        asm volatile("" ::: "memory");
#pragma unroll
        for (int i = 0; i < 16; ++i) {
            const int ai = i >> 3, m = (i >> 1) & 3, bj = i & 1;
            const size_t off = EPO_OFF(i);
            *(f32x4*)(out + off) = x0q[i] + acc[ai][bj][m][0]; *(f32x4*)(out + off + 4) = x1q[i] + acc[ai][bj][m][1];
            asm volatile("" ::: "memory");
            if (i + DEPTH < 16) { EPO_LOAD(i + DEPTH); asm volatile("" ::: "memory"); }
        }
#undef EPO_LOAD
#undef EPO_OFF
    }
};

template <bool FINAL> struct EpiOutNorm {
    static constexpr bool PERM = true, AFTER_DRAIN = false;
    const float* xin; float* out; const float* g; float* SS; unsigned* CNT; bf16_t* Hn; unsigned* AM; signed char* H8; float* SH;
    __device__ __forceinline__ void operator()(f32x4 (&acc)[2][2][4][2], const Unit& u, int wr, int wc, int fr, int fq) const {
        asm volatile("" : "+v"(fr), "+v"(fq));
        const int row0 = u.pm * BM + wr * 64 + fr, col0 = u.pn * BM + wc * 32 + 8 * fq;
        constexpr int DEPTH = FINAL ? 8 : 4;
        f32x4 gv[2][2];
        if constexpr (!FINAL) {
#pragma unroll
            for (int bj = 0; bj < 2; ++bj)
#pragma unroll
                for (int n = 0; n < 2; ++n) gv[bj][n] = *(const f32x4*)(g + col0 + bj * HALF + 4 * n);
        }
        f32x4 x0q[16], x1q[16];
#define EPN_OFF(i) ((size_t)(row0 + ((i) >> 3) * HALF + (((i) >> 1) & 3) * 16) * 1024 + col0 + ((i) & 1) * HALF)
#define EPN_LOAD(i) do { const size_t off_ = EPN_OFF(i); x0q[i] = *(const f32x4*)(xin + off_); x1q[i] = *(const f32x4*)(xin + off_ + 4); } while (0)
#pragma unroll
        for (int i = 0; i < DEPTH; ++i) EPN_LOAD(i);
        asm volatile("" ::: "memory");
#pragma unroll
        for (int i = 0; i < 16; ++i) {
            const int ai = i >> 3, m = (i >> 1) & 3, bj = i & 1;
            acc[ai][bj][m][0] += x0q[i]; acc[ai][bj][m][1] += x1q[i];
            asm volatile("" ::: "memory");
            if (i + DEPTH < 16) { EPN_LOAD(i + DEPTH); asm volatile("" ::: "memory"); }
            if (bj == 1) {
                float q = 0.f;
#pragma unroll
                for (int b2 = 0; b2 < 2; ++b2)
#pragma unroll
                    for (int n = 0; n < 2; ++n) { const f32x4 v = acc[ai][b2][m][n]; q += (v[0] * v[0] + v[1] * v[1]) + (v[2] * v[2] + v[3] * v[3]); }
                q += __shfl_xor(q, 16); q += __shfl_xor(q, 32);
                if (fq == 0) atomicAdd(SS + row0 + ai * HALF + m * 16, q);
                if constexpr (!FINAL) {
                    float am = 0.f;
#pragma unroll
                    for (int b2 = 0; b2 < 2; ++b2)
#pragma unroll
                        for (int n = 0; n < 2; ++n) { const f32x4 v = acc[ai][b2][m][n] * gv[b2][n]; am = fmaxf(am, fmaxf(fmaxf(fabsf(v[0]), fabsf(v[1])), fmaxf(fabsf(v[2]), fabsf(v[3])))); }
                    am = fmaxf(am, __shfl_xor(am, 16)); am = fmaxf(am, __shfl_xor(am, 32));
                    if (fq == 0) atomicMax(AM + row0 + ai * HALF + m * 16, __float_as_uint(am));
                }
            }
        }
        asm volatile("s_waitcnt vmcnt(0)" ::: "memory");
        unsigned* cnt = CNT + 16 * u.pm;
        if (fr == 0 && fq == 0) __hip_atomic_fetch_add(cnt, 1u, __ATOMIC_RELAXED, __HIP_MEMORY_SCOPE_AGENT);
        asm volatile("" ::: "memory");
        float* ob = out + (size_t)row0 * 1024 + col0; asm volatile("" : "+v"(ob));
        if constexpr (!FINAL) {
#pragma unroll
            for (int ai = 0; ai < 2; ++ai)
#pragma unroll
                for (int m = 0; m < 4; ++m)
#pragma unroll
                    for (int bj = 0; bj < 2; ++bj) { float* op = ob + ((ai * HALF + m * 16) * 1024 + bj * HALF);
                        *(f32x4*)op = acc[ai][bj][m][0]; *(f32x4*)(op + 4) = acc[ai][bj][m][1]; asm volatile("" ::: "memory"); }
        }
        if (fr == 0 && fq == 0) {
            unsigned spins = 0;
            while (__hip_atomic_load(cnt, __ATOMIC_RELAXED, __HIP_MEMORY_SCOPE_AGENT) < 32u) { __builtin_amdgcn_s_sleep(2); if (++spins > (1u << 20)) break; }
        }
        asm volatile("" ::: "memory");
        if constexpr (FINAL) {
#pragma unroll
            for (int bj = 0; bj < 2; ++bj)
#pragma unroll
                for (int n = 0; n < 2; ++n) gv[bj][n] = *(const f32x4*)(g + col0 + bj * HALF + 4 * n);
        } else asm volatile("" : "+v"(gv[0][0]), "+v"(gv[0][1]), "+v"(gv[1][0]), "+v"(gv[1][1]));
#pragma unroll
        for (int ai = 0; ai < 2; ++ai)
#pragma unroll
            for (int m = 0; m < 4; ++m) {
                const int row = row0 + ai * HALF + m * 16;
                const float ss = __hip_atomic_load(SS + row, __ATOMIC_RELAXED, __HIP_MEMORY_SCOPE_AGENT);
                const float rstd = 1.0f / sqrtf(ss * (1.f / 1024.f) + 1e-6f);
                float qs = 0.f;
                if constexpr (!FINAL) {
                    const float am = __uint_as_float(__hip_atomic_load(AM + row, __ATOMIC_RELAXED, __HIP_MEMORY_SCOPE_AGENT));
                    qs = am > 0.f ? 127.f / am : 0.f;
                    if (u.pn == 0 && wc == 0 && fq == 0) SH[row] = am * rstd * (1.f / 127.f);
                }
#pragma unroll
                for (int bj = 0; bj < 2; ++bj) {
                    const size_t off = (size_t)row * 1024 + col0 + bj * HALF;
                    const f32x4 y0 = acc[ai][bj][m][0] * rstd * gv[bj][0], y1 = acc[ai][bj][m][1] * rstd * gv[bj][1];
                    if constexpr (FINAL) { *(f32x4*)(out + off) = y0; *(f32x4*)(out + off + 4) = y1; }
                    else {
                        u32x2 q8; q8.x = q8x4(acc[ai][bj][m][0] * gv[bj][0], qs); q8.y = q8x4(acc[ai][bj][m][1] * gv[bj][1], qs);
                        *(u32x2*)(H8 + off) = q8;
                    }
                }
            }
#undef EPN_LOAD
#undef EPN_OFF
    }
};
struct MergeOrder : StaticOrder {
    __device__ bool next(int i, Unit& u) const { const bool ok = StaticOrder::next(i >> 2, u); u.sub = i & 3; return ok; }
};

template <class E, class = void> struct epi_bperm { static constexpr int value = E::PERM ? 1 : 0; };
template <class E> struct epi_bperm<E, decltype((void)E::BPERM)> { static constexpr int value = E::BPERM; };
template <class E, class = void> struct epi_pre { static constexpr bool value = false; struct Pre {}; };
template <class E> struct epi_pre<E, decltype((void)sizeof(typename E::Pre))> { static constexpr bool value = true; typedef typename E::Pre Pre; };
template <class E, class = void> struct epi_chain { static constexpr bool value = false; };
template <class E> struct epi_chain<E, decltype((void)E::CHAIN)> { static constexpr bool value = E::CHAIN; };
template <class Epi, class Sched, class Gemm, bool ALIGN_EPI = false, bool SP2 = false>
__device__ __forceinline__ void gemm_phase(PG8_LAS unsigned char* lds, const Gemm g, const Sched& S, const Epi& E) {
    const int tid = TIDX, wid = __builtin_amdgcn_readfirstlane(tid >> 6), lane = tid & 63, wr = wid >> 2, wc = wid & 3, fr = lane & 15, fq = lane >> 4;
    constexpr int K = Gemm::K, nt = K / BK, lda = Gemm::lda, ldb = Gemm::ldb;
    constexpr int BP = epi_bperm<Epi>::value;
    unsigned voffA[2], voffB[2], voffB1[2];
#pragma unroll
    for (int i = 0; i < 2; ++i) { int R, C; stage_rc(tid * 16 + i * 8192, R, C);
        voffA[i] = (unsigned)(R * lda + C) * 2u;
        if constexpr (BP == 2) { const int w_ = R >> 5, n_ = (R >> 4) & 1, j_ = R & 15, cb_ = w_ * 64 + 16 * (j_ >> 2) + 4 * n_ + (j_ & 3);
            voffB[i] = (unsigned)(cb_ * ldb + C) * 2u; voffB1[i] = voffB[i]; }
        else { const int Rb = (BP == 1) ? ((R & ~31) + perm32(R & 31)) : R; voffB[i] = (unsigned)(Rb * ldb + C) * 2u; voffB1[i] = voffB[i]; } }
    const size_t kstep = (size_t)(BK * 2);
    const size_t hstepA = (size_t)HALF * lda * 2, hstepB = (size_t)HALF * ldb * 2, hB1 = (BP == 2) ? (size_t)8 * ldb * 2 : hstepB;
    const size_t tstepA = 2 * hstepA, tstepB = 2 * hstepB;
    const unsigned ldsw = (unsigned)wid * 1024u;
    const int aoff = lds_byte(wr * 64 + fr, fq * 8), boff = lds_byte(wc * 32 + fr, fq * 8);
#define PG8_SA(b, h) (((b) * 2 + (h)) * HTB)
#define PG8_SB(b, h) ((4 + (b) * 2 + (h)) * HTB)
#define PG8_STAGE(bufoff, gbase, voff) do { _Pragma("unroll") for (int _i = 0; _i < 2; ++_i) \
        __builtin_amdgcn_global_load_lds((const unsigned*)((const char*)(gbase) + (voff)[_i]), (PG8_LAS unsigned*)(lds + (bufoff) + ldsw + _i * 8192), 16, 0, 0); } while (0)
#define PG8_LDA(dst, b, h) do { _Pragma("unroll") for (int m = 0; m < 4; ++m) _Pragma("unroll") for (int k = 0; k < 2; ++k) dst[m][k] = *(const PG8_LAS bf16x8*)(lds + PG8_SA(b, h) + aoff + m * 2048 + k * 1024); } while (0)
#define PG8_LDB(dst, b, h) do { _Pragma("unroll") for (int n = 0; n < 2; ++n) _Pragma("unroll") for (int k = 0; k < 2; ++k) dst[n][k] = *(const PG8_LAS bf16x8*)(lds + PG8_SB(b, h) + boff + n * 2048 + k * 1024); } while (0)
#define PG8_MMA(ai, bj, At, Bt) do { __builtin_amdgcn_s_setprio(1); _Pragma("unroll") for (int m = 0; m < 4; ++m) _Pragma("unroll") for (int n = 0; n < 2; ++n) _Pragma("unroll") for (int k = 0; k < 2; ++k) \
        acc[ai][bj][m][n] = Gemm::i8 ? ::mfma16i8_g(Bt[n][k], At[m][k], acc[ai][bj][m][n]) : ::mfma16_g(Bt[n][k], At[m][k], acc[ai][bj][m][n]); __builtin_amdgcn_s_setprio(0); } while (0)
#define PG8_WAIT_V(n) asm volatile("s_waitcnt vmcnt(" #n ")" ::: "memory")
#define PG8_WAIT_L(n) asm volatile("s_waitcnt lgkmcnt(" #n ")" ::: "memory")
#define PG8_BAR __builtin_amdgcn_s_barrier()
#define PG8_SCHED __builtin_amdgcn_sched_barrier(0)
    Unit cur, nxt; int ui = 0;
    if (!S.next(0, cur)) return;
    typename epi_pre<Epi>::Pre pre;
    f32x4 acc[2][2][4][2];
#pragma unroll
    for (int a = 0; a < 2; ++a)
#pragma unroll
        for (int b = 0; b < 2; ++b)
#pragma unroll
            for (int m = 0; m < 4; ++m)
#pragma unroll
                for (int n = 0; n < 2; ++n) acc[a][b][m][n] = (f32x4){0.f, 0.f, 0.f, 0.f};
    bf16x8 At[4][2], B0[2][2], B1[2][2];
    const char* cA = (const char*)g.A + (size_t)cur.pm * tstepA + (size_t)cur.sub * g.a_sub; const char* cB = (const char*)g.Bt + (size_t)cur.pn * tstepB + (size_t)cur.sub * g.b_sub;
    S.a_ready(cur);
    if constexpr (SP2) {
        PG8_STAGE(PG8_SB(0, 0), cB, voffB); PG8_STAGE(PG8_SB(0, 1), cB + hB1, voffB1); PG8_STAGE(PG8_SA(0, 0), cA, voffA); PG8_STAGE(PG8_SA(0, 1), cA + hstepA, voffA);
        if (wr == 1) PG8_BAR;
        PG8_WAIT_V(2); PG8_BAR;
        PG8_STAGE(PG8_SB(1, 0), cB + kstep, voffB); PG8_STAGE(PG8_SA(1, 0), cA + kstep, voffA); PG8_STAGE(PG8_SB(1, 1), cB + hB1 + kstep, voffB1);
        PG8_WAIT_V(6); PG8_BAR;
    } else {
        PG8_STAGE(PG8_SB(0, 0), cB, voffB); PG8_STAGE(PG8_SA(0, 0), cA, voffA); PG8_STAGE(PG8_SB(0, 1), cB + hB1, voffB1); PG8_STAGE(PG8_SA(0, 1), cA + hstepA, voffA);
        if (wr == 1) PG8_BAR;
        PG8_WAIT_V(4); PG8_BAR;
        PG8_STAGE(PG8_SB(1, 0), cB + kstep, voffB); PG8_STAGE(PG8_SA(1, 0), cA + kstep, voffA); PG8_STAGE(PG8_SB(1, 1), cB + hB1 + kstep, voffB1);
        PG8_WAIT_V(6); PG8_BAR;
    }
    for (;;) {
        const bool has_next = S.next(ui + 1, nxt);
        const char* nA = has_next ? (const char*)g.A + (size_t)nxt.pm * tstepA + (size_t)nxt.sub * g.a_sub : cA; const char* nB = has_next ? (const char*)g.Bt + (size_t)nxt.pn * tstepB + (size_t)nxt.sub * g.b_sub : cB;
        for (int t = 0; t < nt; t += 2) {
            const bool last = (t == nt - 2);
            const char* a1 = cA + (size_t)(t + 1) * kstep;
            const char* a2 = last ? nA : cA + (size_t)(t + 2) * kstep; const char* b2 = last ? nB : cB + (size_t)(t + 2) * kstep;
            const char* a3 = a2 + kstep; const char* b3 = b2 + kstep;
            if (last && has_next) S.a_ready(nxt);
            if constexpr (SP2) {
            PG8_LDB(B0, 0, 0); PG8_LDB(B1, 0, 1); PG8_SCHED; PG8_LDA(At, 0, 0); PG8_STAGE(PG8_SA(1, 1), a1 + hstepA, voffA);
            PG8_WAIT_V(8); PG8_WAIT_L(0); PG8_BAR; PG8_MMA(0, 0, At, B0); PG8_MMA(0, 1, At, B1); PG8_BAR; PG8_SCHED;
            PG8_LDA(At, 0, 1); PG8_STAGE(PG8_SB(0, 0), b2, voffB); PG8_STAGE(PG8_SB(0, 1), b2 + hB1, voffB1); PG8_STAGE(PG8_SA(0, 0), a2, voffA);
            PG8_WAIT_V(8); PG8_WAIT_L(0); PG8_BAR; PG8_MMA(1, 0, At, B0); PG8_MMA(1, 1, At, B1); PG8_BAR; PG8_SCHED;
            PG8_LDB(B0, 1, 0); PG8_LDB(B1, 1, 1); PG8_SCHED; PG8_LDA(At, 1, 0); PG8_STAGE(PG8_SA(0, 1), a2 + hstepA, voffA);
            PG8_WAIT_V(8); PG8_WAIT_L(0); PG8_BAR; PG8_MMA(0, 0, At, B0); PG8_MMA(0, 1, At, B1); PG8_BAR; PG8_SCHED;
            PG8_LDA(At, 1, 1); PG8_STAGE(PG8_SB(1, 0), b3, voffB); PG8_STAGE(PG8_SB(1, 1), b3 + hB1, voffB1); PG8_STAGE(PG8_SA(1, 0), a3, voffA);
            PG8_WAIT_V(8);
            if constexpr (epi_pre<Epi>::value) { if (last) E.pre(pre, cur, wr, wc, lane); }
            PG8_WAIT_L(0); PG8_BAR; PG8_MMA(1, 0, At, B0); PG8_MMA(1, 1, At, B1); PG8_BAR; PG8_SCHED;
            } else {
            PG8_LDB(B0, 0, 0); PG8_SCHED; PG8_LDA(At, 0, 0); PG8_STAGE(PG8_SA(1, 1), a1 + hstepA, voffA);
            PG8_WAIT_L(8); PG8_BAR; PG8_WAIT_L(0); PG8_MMA(0, 0, At, B0); PG8_BAR; PG8_SCHED;
            PG8_LDB(B1, 0, 1); PG8_STAGE(PG8_SB(0, 0), b2, voffB);
            PG8_BAR; PG8_WAIT_L(0); PG8_MMA(0, 1, At, B1); PG8_BAR;
            PG8_LDA(At, 0, 1); PG8_STAGE(PG8_SA(0, 0), a2, voffA);
            PG8_BAR; PG8_WAIT_L(0); PG8_MMA(1, 0, At, B0); PG8_BAR; PG8_SCHED;
            PG8_STAGE(PG8_SB(0, 1), b2 + hB1, voffB1);
            PG8_WAIT_V(6); PG8_BAR; PG8_MMA(1, 1, At, B1); PG8_BAR;
            PG8_LDB(B0, 1, 0); PG8_SCHED; PG8_LDA(At, 1, 0); PG8_STAGE(PG8_SA(0, 1), a2 + hstepA, voffA);
            PG8_WAIT_L(8); PG8_BAR; PG8_WAIT_L(0); PG8_MMA(0, 0, At, B0); PG8_BAR; PG8_SCHED;
            PG8_LDB(B1, 1, 1); PG8_STAGE(PG8_SB(1, 0), b3, voffB);
            PG8_BAR; PG8_WAIT_L(0); PG8_MMA(0, 1, At, B1); PG8_BAR;
            PG8_LDA(At, 1, 1); PG8_STAGE(PG8_SA(1, 0), a3, voffA);
            PG8_BAR; PG8_WAIT_L(0); PG8_MMA(1, 0, At, B0); PG8_BAR; PG8_SCHED;
            PG8_STAGE(PG8_SB(1, 1), b3 + hB1, voffB1);
            PG8_WAIT_V(6); PG8_BAR; PG8_MMA(1, 1, At, B1); PG8_BAR;
            }
        }
        if constexpr (ALIGN_EPI) { if (wr == 0) PG8_BAR; }
        if constexpr (epi_chain<Epi>::value) { E.chain(acc, cur, wr, wc, fr, fq); S.done(cur); }
        else if constexpr (epi_pre<Epi>::value) { E(acc, pre, cur, wr, wc, fr, fq); S.done(cur); }
        else if constexpr (!Epi::AFTER_DRAIN) { E(acc, cur, wr, wc, fr, fq); S.done(cur); }
        if (!has_next) break;
        if constexpr (!epi_chain<Epi>::value) {
#pragma unroll
        for (int a = 0; a < 2; ++a)
#pragma unroll
            for (int b = 0; b < 2; ++b)
#pragma unroll
                for (int m = 0; m < 4; ++m)
#pragma unroll
                    for (int n = 0; n < 2; ++n) acc[a][b][m][n] = (f32x4){0.f, 0.f, 0.f, 0.f};
        }
        cur = nxt; cA = nA; cB = nB; ++ui;
        if constexpr (ALIGN_EPI) { if (wr == 1) PG8_BAR; }
    }
    PG8_WAIT_V(0);
    if constexpr (!ALIGN_EPI) { if (wr == 0) PG8_BAR; }
    PG8_BAR;
    if constexpr (Epi::AFTER_DRAIN) { E.fused(acc, cur, wr, wc, fr, fq, lds, wid, lane); S.done(cur); }
#undef PG8_SA
#undef PG8_SB
#undef PG8_STAGE
#undef PG8_LDA
#undef PG8_LDB
#undef PG8_MMA
#undef PG8_WAIT_V
#undef PG8_WAIT_L
#undef PG8_BAR
#undef PG8_SCHED
}
}

typedef const __attribute__((address_space(4))) Args* KArgs;
__device__ __forceinline__ void make_ctx(Ctx& c) {
    KArgs ap = (KArgs)__builtin_amdgcn_kernarg_segment_ptr();
    asm volatile("" : "+s"(ap));
    c.x = ap->in[0]; c.norm_g = ap->in[1]; c.w_in = ap->in[2]; c.w_fourier = ap->in[3]; c.conv_w = ap->in[4]; c.conv_b = ap->in[5]; c.conv_ln_g = ap->in[6]; c.conv_ln_b = ap->in[7];
    c.w_pw = ap->in[8]; c.w_pool = ap->in[9]; c.pool_scale = ap->in[10]; c.w_branch = ap->in[11]; c.w_gate = ap->in[12]; c.b_gate = ap->in[13]; c.w_out = ap->in[14]; c.final_g = ap->in[15];
    c.out = ap->out;
    unsigned char* ws = ap->ws;
    c.WinT = (bf16_t*)(ws + WS_WIN); c.WgT = (bf16_t*)(ws + WS_WG); c.WbT = (bf16_t*)(ws + WS_WB); c.WoT = (bf16_t*)(ws + WS_WO); c.WfT = (bf16_t*)(ws + WS_WF); c.WpwT = (bf16_t*)(ws + WS_WPW); c.WpoolT = (bf16_t*)(ws + WS_WPOOL);
    c.TW = (float2*)(ws + WS_TW); c.RC = (float*)(ws + WS_RC); c.RS = (float*)(ws + WS_RS); c.RH = (_Float16*)(ws + WS_RH);
    c.H = (bf16_t*)(ws + WS_H); c.Z = (bf16_t*)(ws + WS_Z); c.P = (bf16_t*)(ws + WS_P); c.FY = (unsigned*)(ws + WS_FY); c.LSE = (float*)(ws + WS_LSE); c.SS = (float*)(ws + WS_SS); c.CNT = (unsigned*)(ws + WS_CNT); c.FF = ws + WS_FF;
    c.AM = (unsigned*)(ws + WS_AM); c.SH = (float*)(ws + WS_SH); c.SW = (float*)(ws + WS_SW); c.H8 = (signed char*)(ws + WS_H8); c.Wg8 = (signed char*)(ws + WS_WG); c.Win8 = (signed char*)(ws + WS_WIN) + (size_t)DEPTH * DIN * DM; c.SWI = (float*)(ws + WS_SWI);
}
constexpr int NPHASES = 1 + 5 * DEPTH;

#define XB_TMO      128
#define XB_XCNT(j)  (256  + 64 * (j))
#define XB_XSUB(j)  (1280 + 64 * (j))
#define XB_XGEN(j)  (2304 + 64 * (j))
#define XB_TOP      3328
#define XB_TOPGEN   3392
#define XCD_BAR_WORDS 3456
#define XB_SPIN_CAP (1u << 18)
#define LAS __attribute__((address_space(3)))

__device__ __forceinline__ unsigned xb_ld(unsigned* p)              { return __hip_atomic_load(p, __ATOMIC_RELAXED, __HIP_MEMORY_SCOPE_AGENT); }
__device__ __forceinline__ unsigned xb_add(unsigned* p, unsigned v) { return __hip_atomic_fetch_add(p, v, __ATOMIC_RELAXED, __HIP_MEMORY_SCOPE_AGENT); }
__device__ __forceinline__ unsigned xb_xcc_id() { return (unsigned)__builtin_amdgcn_s_getreg((3 << 11) | 20) & 0xFu; }
#define XB_SPIN(cond, bar) do { unsigned _sp = 0; while (cond) { __builtin_amdgcn_s_sleep(1); \
    if ((++_sp & 255u) == 0u) { if (xb_ld(&(bar)[XB_TMO])) break; if (_sp > XB_SPIN_CAP) { atomicAdd(&(bar)[XB_TMO], 1u); break; } } } } while (0)

struct XcdBarrier {
    unsigned* bar; unsigned x;
    volatile LAS unsigned* st;
};

__device__ __forceinline__ XcdBarrier xcd_barrier_post(unsigned* bar, volatile LAS unsigned* st) {
    XcdBarrier b; b.bar = bar; b.x = xb_xcc_id(); b.st = st;
    if (threadIdx.x == 0) (void)xb_add(&bar[XB_XCNT(b.x)], 1u);
    return b;
}
__device__ __forceinline__ void xcd_barrier_complete(unsigned* bar, unsigned x, unsigned& nloc, unsigned& nx) {
    const unsigned G = gridDim.x * gridDim.y * gridDim.z;
    unsigned sum, cnt, mine, sp = 0u;
    for (;;) {
        sum = 0u; cnt = 0u; mine = 0u;
#pragma unroll
        for (unsigned j = 0; j < 16; ++j) { const unsigned c = xb_ld(&bar[XB_XCNT(j)]); sum += c; cnt += (c > 0u) ? 1u : 0u; mine = (j == x) ? c : mine; }
        if (sum == G) break;
        __builtin_amdgcn_s_sleep(1);
        if ((++sp & 255u) == 0u) { if (xb_ld(&bar[XB_TMO])) break; if (sp > XB_SPIN_CAP) { atomicAdd(&bar[XB_TMO], 1u); break; } }
    }
    nloc = mine > 0u ? mine : 1u; nx = cnt > 0u ? cnt : 1u;
}

__device__ __forceinline__ void xcd_barrier(const XcdBarrier& b) {
    asm volatile("s_waitcnt vmcnt(0)" ::: "memory");
    __syncthreads();
    if (threadIdx.x == 0) {
        unsigned* bar = b.bar;
        __builtin_amdgcn_s_waitcnt(0);
        unsigned nloc = b.st[0], nx = b.st[1];
        if (nloc == 0u) { xcd_barrier_complete(bar, b.x, nloc, nx); b.st[0] = nloc; b.st[1] = nx; }
        const unsigned old = xb_add(&bar[XB_XSUB(b.x)], 1u);
        const unsigned gen = old / nloc;
        if (old + 1u == (gen + 1u) * nloc) {
            __builtin_amdgcn_fence(__ATOMIC_RELEASE, "agent");
            asm volatile("s_waitcnt vmcnt(0)" ::: "memory");
            const unsigned og = xb_add(&bar[XB_TOP], 1u);
            const unsigned tg = og / nx;
            if (og + 1u == (tg + 1u) * nx) xb_add(&bar[XB_TOPGEN], 1u);
            else XB_SPIN(xb_ld(&bar[XB_TOPGEN]) == tg, bar);
            __builtin_amdgcn_fence(__ATOMIC_ACQUIRE, "agent");
            xb_add(&bar[XB_XGEN(b.x)], 1u);
            asm volatile("s_waitcnt vmcnt(0)" ::: "memory");
        } else {
            XB_SPIN(xb_ld(&bar[XB_XGEN(b.x)]) == gen, bar);
            __builtin_amdgcn_fence(__ATOMIC_ACQUIRE, "agent");
            asm volatile("s_waitcnt vmcnt(0)" ::: "memory");
        }
    }
    __syncthreads();
}


template <int L, int Q>
__device__ __forceinline__ void layer_phase(unsigned char* lds_raw) {
    constexpr int l = L;
    Ctx c; make_ctx(c);
    if constexpr (Q == 0) {
        pg8::StaticOrder S; S.init(MT, DIN, (int)gridDim.x, BIDX);
        {
            typedef pg8::GemmT<DM / 2, DM / 2, DM / 2, 0, 0, true> GT; GT g{(const bf16_t*)c.H8, (const bf16_t*)(c.Win8 + (size_t)l * DIN * DM)};
            pg8::EpiZI8 E{c.Z, DIN, c.SH, c.SWI + (size_t)l * DIN};
            pg8::gemm_phase<pg8::EpiZI8, pg8::StaticOrder, GT, true, true>((PG8_LAS unsigned char*)lds_raw, g, S, E);
        }
        {
            const int G_ = (int)gridDim.x, c_ = BIDX, nfull = (MT / 256) * (DIN / 256) % G_;
            const int nidle = (nfull == 0) ? G_ : G_ - nfull, j_ = (nfull == 0) ? c_ : c_ - nfull;
            constexpr int g_lo = (l == 0) ? TR_WIN : TR_PER_LAYER + TR_WIN, g_hi = (l == 0) ? TR_PER_LAYER : 2 * TR_PER_LAYER;
            constexpr int nstrips = (l == 0) ? 64 + DIN / 64 : 64;
            if (l < 2 && j_ >= 0) {
                for (int s_ = j_; s_ < nstrips; s_ += nidle) { if (s_ < 64) convert_strip(c, (float*)lds_raw, l, s_); else convert_strip(c, (float*)lds_raw, 1, s_); }
                const int jf = (nstrips % nidle == 0 || nstrips % nidle > nidle - 8) ? 0 : nstrips % nidle;
                if (j_ >= jf) convert_items(c, (float*)lds_raw, g_lo, g_hi, j_ - jf, nidle - jf);
            }
        }
    } else if constexpr (Q == 1) {
        constexpr int NTK = NB * 64;
        attn_phase_mfma(c, lds_raw, true);
        __builtin_amdgcn_sched_barrier(0);
        { u32x4 ga[6], gg[6]; int u = BIDX; if (u < NTK) tok_load_glu(c, u, ga, gg);
          for (; u < NTK; u += gridDim.x) { const int un = (u + (int)gridDim.x < NTK) ? u + (int)gridDim.x : -1; tok_unit_mfma(c, l, u, un, ga, gg, lds_raw); } }
        __builtin_amdgcn_sched_barrier(0);
        fft1_phase_wave(c, lds_raw);
    } else if constexpr (Q == 3) {
        fft2_phase_mfma(c, l, lds_raw);
        phase_combine(c);
        __syncthreads();
        typedef pg8::GemmT<DM / 2, DM / 2, DM / 2, 0, 0, true> GT; GT g{(const bf16_t*)c.H8, (const bf16_t*)(c.Wg8 + (size_t)l * 4096 * DM)}; pg8::StaticOrder S; S.init(MT, 4096, (int)gridDim.x, BIDX);
        pg8::EpiGateU8 E{(unsigned char*)c.Z, c.b_gate + (size_t)l * 4096, c.SH, c.SW + (size_t)l * 4096};
        pg8::gemm_phase<pg8::EpiGateU8, pg8::StaticOrder, GT, true, true>((PG8_LAS unsigned char*)lds_raw, g, S, E);
    } else if constexpr (Q == 4) {
        typedef pg8::GemmT<DM, 256, 256, 512, 1024 * 256 * 2> GT; GT g{c.P, c.WbT + (size_t)l * 4 * 1024 * 256}; pg8::MergeOrder S; S.init(MT, DM, (int)gridDim.x, BIDX);
        pg8::EpiMergeChain E{(const unsigned char*)c.Z, c.H, c.FF};
        pg8::gemm_phase<pg8::EpiMergeChain, pg8::MergeOrder, GT, true, true>((PG8_LAS unsigned char*)lds_raw, g, S, E);
    } else if constexpr (Q == 5) {
        typedef pg8::GemmT<DM, DM, DM, 0, 0> GT; GT g{c.H, c.WoT + (size_t)l * DM * DM}; pg8::StaticOrder S; S.init(MT, DM, (int)gridDim.x, BIDX);
        typedef pg8::EpiOutNorm<(l + 1 == DEPTH)> EP;
        EP E{(l == 0) ? c.x : c.out, c.out, (l + 1 < DEPTH) ? c.norm_g + (size_t)(l + 1) * DM : c.final_g, c.SS + (size_t)l * MT, c.CNT + (size_t)l * 128 * 16, c.H, c.AM, c.H8, c.SH};
        pg8::gemm_phase<EP, pg8::StaticOrder, GT, true, true>((PG8_LAS unsigned char*)lds_raw, g, S, E);
    }
}

__global__ void __launch_bounds__(NTHREADS, 2) fwd_kernel(Args a) {
    extern __shared__ __attribute__((aligned(16))) unsigned char lds_raw[];
    const int lo = a.ph_lo, hi = a.ph_hi;
    volatile LAS unsigned* bst = (volatile LAS unsigned*)(lds_raw + LDS_BYTES - 16);
    if (threadIdx.x < 4) bst[threadIdx.x] = 0u;
    __syncthreads();
    XcdBarrier bar = xcd_barrier_post((unsigned*)(a.ws + WS_CTL), bst);
#define RUN_PHASE(k, ...) do { if (lo <= (k) && (k) < hi) { __VA_ARGS__; if ((k) + 1 < hi) xcd_barrier(bar); } } while (0)
    RUN_PHASE(0, { Ctx c; make_ctx(c); phase_pre(c, (float*)lds_raw); phase_norm_bf16(c.x, c.norm_g, c.H, c.H8, c.SH); });
    RUN_PHASE(1, layer_phase<0, 0>(lds_raw));
    RUN_PHASE(2, layer_phase<0, 1>(lds_raw));
    RUN_PHASE(3, layer_phase<0, 3>(lds_raw));
    RUN_PHASE(4, layer_phase<0, 4>(lds_raw));
    RUN_PHASE(5, layer_phase<0, 5>(lds_raw));
    RUN_PHASE(6, layer_phase<1, 0>(lds_raw));
    RUN_PHASE(7, layer_phase<1, 1>(lds_raw));
    RUN_PHASE(8, layer_phase<1, 3>(lds_raw));
    RUN_PHASE(9, layer_phase<1, 4>(lds_raw));
    RUN_PHASE(10, layer_phase<1, 5>(lds_raw));
#undef RUN_PHASE
}

extern "C" void kernel_launch(void* const* d_in, const int* in_sizes, int n_in, void* d_out, int out_size, void* d_ws, size_t ws_size, hipStream_t stream) {
    static int grid = 0;
    if (grid == 0) {
        if (n_in != 16 || in_sizes[0] != MT * DM || out_size != MT * DM || ws_size < WS_END) {
            fprintf(stderr, "kernel_launch: unexpected shapes: n_in %d in0 %d out %d ws %zu (need %zu)\n", n_in, n_in > 0 ? in_sizes[0] : -1, out_size, ws_size, (size_t)WS_END);
            grid = -1; return;
        }
        int dev = 0, cus = 0, per_cu = 0;
        hipGetDevice(&dev); hipDeviceGetAttribute(&cus, hipDeviceAttributeMultiprocessorCount, dev);
        if (hipFuncSetAttribute((const void*)fwd_kernel, hipFuncAttributeMaxDynamicSharedMemorySize, LDS_BYTES) != hipSuccess) { fprintf(stderr, "kernel_launch: hipFuncSetAttribute failed\n"); grid = -1; return; }
        hipOccupancyMaxActiveBlocksPerMultiprocessor(&per_cu, (const void*)fwd_kernel, NTHREADS, LDS_BYTES);
        if (per_cu < 1) { fprintf(stderr, "kernel_launch: occupancy query says %d blocks/CU\n", per_cu); per_cu = 1; }
        (void)hipGetLastError();
        grid = cus;
    }
    if (grid < 0) return;
    if (hipMemsetAsync((char*)d_ws + WS_CTL, 0, 16384, stream) != hipSuccess) { fprintf(stderr, "kernel_launch: hipMemsetAsync failed\n"); return; }
    Args a{};
    for (int i = 0; i < 16; ++i) a.in[i] = (const float*)d_in[i];
    a.out = (float*)d_out; a.ws = (unsigned char*)d_ws;
#if ONE_LAUNCH
    a.ph_lo = 0; a.ph_hi = NPHASES;
    void* args[] = {&a};
    hipError_t e = hipLaunchCooperativeKernel((const void*)fwd_kernel, dim3(grid), dim3(NTHREADS), args, LDS_BYTES, stream);
    if (e != hipSuccess) fprintf(stderr, "kernel_launch: cooperative launch failed: %s (grid %d)\n", hipGetErrorString(e), grid);
#else
    for (int ph = 0; ph < NPHASES; ++ph) {
        a.ph_lo = ph; a.ph_hi = ph + 1;
        hipLaunchKernelGGL(fwd_kernel, dim3(grid), dim3(NTHREADS), LDS_BYTES, stream, a);
    }
#endif
}
```
